# Optimizing an MI355X kernel written in HIP

```python
import jax, jax.numpy as jnp
from jax import lax
import numpy as np

D_MODEL = 1024
BATCH = 16
SEQ = 256
DEPTH = 4
DEC_BATCH = 2
DEC_SEQ = 1024
PAST_LEN = 512

GRID_W = 64
D_BRANCH = 512
D_POOL = D_BRANCH
POOL_WINDOWS = (2, 4, 8, 16)
N_POOL_GROUPS = 4
POOL_GROUP = D_POOL // N_POOL_GROUPS
D_SGU = D_BRANCH
N_SGU_GROUPS = 4
SGU_GROUP = D_SGU // N_SGU_GROUPS
CHUNK = 128
D_MLSTM = D_BRANCH
N_MLSTM_HEADS = 4
HEAD_DIM = D_MLSTM // N_MLSTM_HEADS
MLSTM_CHUNK = 64
N_BRANCH = 3
D_FF = 4 * D_MODEL
EPS = 1e-6
IN_WIDTHS = (D_POOL, D_SGU, D_SGU, D_MLSTM, D_MLSTM, D_MLSTM, D_MLSTM, 4 * N_MLSTM_HEADS)
D_IN = D_POOL + 2 * D_SGU + 4 * D_MLSTM + 4 * N_MLSTM_HEADS + N_BRANCH * D_MODEL

kernel_name = "hybrid_pool_sgu_mlstm_diffusion_step"


def rmsnorm(x, g):
    x32 = x.astype(jnp.float32)
    y = x32 * lax.rsqrt(jnp.mean(x32 * x32, axis=-1, keepdims=True) + EPS)
    return (y * g.astype(jnp.float32)).astype(x.dtype)


def centred_mean(x, w, axis):
    n = x.shape[axis]
    s = jnp.cumsum(x.astype(jnp.float32), axis=axis)
    pad = [(0, 0)] * x.ndim
    pad[axis] = (1, 0)
    s = jnp.pad(s, pad)
    t = jnp.arange(n)
    lo = jnp.clip(t - w // 2, 0, n)
    hi = jnp.clip(t + (w - w // 2), 0, n)
    total = jnp.take(s, hi, axis=axis) - jnp.take(s, lo, axis=axis)
    shape = [1] * x.ndim
    shape[axis] = n
    cnt = (hi - lo).astype(jnp.float32).reshape(shape)
    return total / cnt


def pool_branch(xp, w_pool, pool_scale, grid):
    B, T, _ = xp.shape
    groups = jnp.split(xp, N_POOL_GROUPS, axis=-1)
    outs = []
    for g, win in zip(groups, POOL_WINDOWS):
        if grid:
            rows = T // GRID_W
            gg = g.reshape(B, rows, GRID_W, POOL_GROUP)
            pooled = centred_mean(centred_mean(gg, win, 2), win, 1).reshape(B, T, POOL_GROUP)
        else:
            pooled = centred_mean(g, win, 1)
        outs.append(pooled - g.astype(jnp.float32))
    d = jnp.stack(outs, axis=2).astype(xp.dtype)
    y = jnp.einsum('btgc,gcd->btgd', d, w_pool).reshape(B, T, D_POOL)
    return y * pool_scale


def sgu_branch(u, v, g_sgu, w_sgu, b_sgu):
    B, T, _ = u.shape
    vn = rmsnorm(v, g_sgu).reshape(B, T // CHUNK, CHUNK, N_SGU_GROUPS, SGU_GROUP)
    mixed = jnp.einsum('gpq,bnqgc->bnpgc', w_sgu, vn) + jnp.swapaxes(b_sgu, 0, 1)[None, None, :, :, None]
    return u * mixed.reshape(B, T, D_SGU)


def mlstm_scan(q, k, v, i_pre, logf, C0, n0, m0):
    B, T, H, Dh = q.shape
    L = MLSTM_CHUNK
    nc = T // L

    def to_chunks(a):
        return jnp.moveaxis(a.reshape(B, nc, L, *a.shape[2:]), 1, 0)

    xs = (to_chunks(q), to_chunks(k), to_chunks(v), to_chunks(i_pre), to_chunks(logf))
    causal = jnp.tril(jnp.ones((L, L), dtype=bool))

    def step(carry, xc):
        C, n, m = carry
        qc, kc, vc, ic, fc = xc
        b = jnp.cumsum(fc, axis=1)
        dmat = b[:, :, None, :] - b[:, None, :, :] + ic[:, None, :, :]
        dmat = jnp.where(causal[None, :, :, None], dmat, -jnp.inf)
        inter = b + m[:, None, :]
        m_t = jnp.maximum(inter, jnp.max(dmat, axis=2))
        w_intra = jnp.exp(dmat - m_t[:, :, None, :])
        w_inter = jnp.exp(inter - m_t)
        s = jnp.einsum('bthd,bshd->btsh', qc, kc) * w_intra
        num = jnp.einsum('btsh,bshd->bthd', s, vc) + w_inter[..., None] * jnp.einsum('bthd,bhde->bthe', qc, C)
        den = jnp.sum(s, axis=2) + w_inter * jnp.einsum('bthd,bhd->bth', qc, n)
        h = num / jnp.maximum(jnp.abs(den), jnp.exp(-m_t))[..., None]
        bL = b[:, -1, :]
        m_new = m_t[:, -1, :]
        w_state = jnp.exp(bL[:, None, :] - b + ic - m_new[:, None, :])
        decay = jnp.exp(bL + m - m_new)
        C_new = decay[..., None, None] * C + jnp.einsum('bsh,bshd,bshe->bhde', w_state, kc, vc)
        n_new = decay[..., None] * n + jnp.einsum('bsh,bshd->bhd', w_state, kc)
        return (C_new, n_new, m_new), h

    (C, n, m), hs = lax.scan(step, (C0, n0, m0), xs)
    h = jnp.moveaxis(hs, 0, 1).reshape(B, T, H, Dh)
    return h, C, n, m


def mlstm_branch(q, k, v, o_pre, gate_pre, b_gates, g_mlstm, C0, n0, m0):
    B, T, _ = q.shape
    f32 = jnp.float32

    def heads(a):
        return a.astype(f32).reshape(B, T, N_MLSTM_HEADS, HEAD_DIM)

    qh, kh, vh = heads(q), heads(k) * (HEAD_DIM ** -0.5), heads(v)
    gp = gate_pre.astype(f32) + b_gates.astype(f32)
    i_f, i_b, f_f, f_b = jnp.split(gp, 4, axis=-1)
    logf_f = jax.nn.log_sigmoid(f_f)
    logf_b = jax.nn.log_sigmoid(f_b)
    C0, n0, m0 = C0.astype(f32), n0.astype(f32), m0.astype(f32)
    h_f, Cf, nf, mf = mlstm_scan(qh, kh, vh, i_f, logf_f, C0[:, 0], n0[:, 0], m0[:, 0])

    def flip(a):
        return jnp.flip(a, axis=1)

    h_b, Cb, nb, mb = mlstm_scan(flip(qh), flip(kh), flip(vh), flip(i_b), flip(logf_b), C0[:, 1], n0[:, 1], m0[:, 1])
    h = h_f + flip(h_b)
    h = h * lax.rsqrt(jnp.mean(h * h, axis=-1, keepdims=True) + EPS) * g_mlstm.astype(f32).reshape(N_MLSTM_HEADS, HEAD_DIM)
    y = jax.nn.sigmoid(o_pre.astype(f32)) * h.reshape(B, T, D_MLSTM)
    C_out = jnp.stack([Cf, Cb], axis=1)
    n_out = jnp.stack([nf, nb], axis=1)
    m_out = jnp.stack([mf, mb], axis=1)
    return y.astype(q.dtype), C_out, n_out, m_out


def trunk_layer(x, cond, grid, C0, n0, m0, w_ada, b_ada, g_norm1, g_norm2, w_in, b_gates, w_pool, pool_scale,
                g_sgu, w_sgu, b_sgu, g_mlstm, w_branch, w_out, w_ff1, w_ff2):
    B, T, _ = x.shape
    mod = (jax.nn.silu(cond) @ w_ada + b_ada)[:, None, :]
    sh1, sc1, gt1, sh2, sc2, gt2 = jnp.split(mod, 6, axis=-1)
    u = rmsnorm(x, g_norm1) * (1 + sc1) + sh1
    proj = u @ w_in
    points = np.cumsum(IN_WIDTHS).tolist()
    xp, su, sv, q, k, v, o_pre, gate_pre, br_pre = jnp.split(proj, points, axis=-1)
    y_a = pool_branch(xp, w_pool, pool_scale, grid)
    y_b = sgu_branch(su, sv, g_sgu, w_sgu, b_sgu)
    y_c, C_out, n_out, m_out = mlstm_branch(q, k, v, o_pre, gate_pre, b_gates, g_mlstm, C0, n0, m0)
    ys = jnp.stack([y_a.astype(x.dtype), y_b.astype(x.dtype), y_c.astype(x.dtype)], axis=2)
    branches = jnp.einsum('btrc,rcd->btrd', ys, w_branch)
    gates = jax.nn.sigmoid(br_pre).reshape(B, T, N_BRANCH, D_MODEL)
    merged = jnp.sum(gates * branches, axis=2)
    x = x + gt1 * (merged @ w_out)
    u2 = rmsnorm(x, g_norm2) * (1 + sc2) + sh2
    x = x + gt2 * (jnp.square(jax.nn.relu(u2 @ w_ff1)) @ w_ff2)
    return x, C_out, n_out, m_out


def setup_inputs(seed: int = 0) -> dict:
    key = jax.random.key(seed)
    ks = jax.random.split(key, 25)
    f32 = jnp.float32
    H, Dh, D = N_MLSTM_HEADS, HEAD_DIM, D_MODEL

    def nrm(k, shape, s):
        return jax.random.normal(k, shape, f32) * s

    f_bias = 3.0 + 3.0 * jnp.linspace(0.0, 1.0, H, dtype=f32)
    b_i = nrm(ks[12], (DEPTH, 2 * H), 0.1)
    b_f = jnp.tile(f_bias, 2)[None, :] + nrm(ks[13], (DEPTH, 2 * H), 0.1)
    return {
        "x_prompt": nrm(ks[0], (BATCH, SEQ, D), 1.0),
        "x_sample": nrm(ks[1], (DEC_BATCH, DEC_SEQ, D), 1.0),
        "state_C": nrm(ks[2], (DEC_BATCH, DEPTH, 2, H, Dh, Dh), 0.1),
        "state_n": nrm(ks[3], (DEC_BATCH, DEPTH, 2, H, Dh), 0.1),
        "state_m": 1.0 + nrm(ks[4], (DEC_BATCH, DEPTH, 2, H), 0.5),
        "c": nrm(ks[5], (DEC_BATCH, D), 1.0),
        "c_ctx": nrm(ks[6], (D,), 1.0),
        "w_ada": nrm(ks[7], (DEPTH, D, 6 * D), 0.5 * D ** -0.5),
        "b_ada": nrm(ks[8], (DEPTH, 6 * D), 0.01),
        "g_norm1": 1.0 + nrm(ks[9], (DEPTH, D), 0.05),
        "g_norm2": 1.0 + nrm(ks[10], (DEPTH, D), 0.05),
        "w_in": nrm(ks[11], (DEPTH, D, D_IN), D ** -0.5),
        "b_gates": jnp.concatenate([b_i, b_f], axis=-1),
        "w_pool": nrm(ks[14], (DEPTH, N_POOL_GROUPS, POOL_GROUP, POOL_GROUP), POOL_GROUP ** -0.5),
        "pool_scale": 1.0 + nrm(ks[15], (DEPTH, D_POOL), 0.1),
        "g_sgu": 1.0 + nrm(ks[16], (DEPTH, D_SGU), 0.05),
        "w_sgu": nrm(ks[17], (DEPTH, N_SGU_GROUPS, CHUNK, CHUNK), CHUNK ** -0.5),
        "b_sgu": 1.0 + nrm(ks[18], (DEPTH, N_SGU_GROUPS, CHUNK), 0.1),
        "g_mlstm": 1.0 + nrm(ks[19], (DEPTH, D_MLSTM), 0.05),
        "w_branch": nrm(ks[20], (DEPTH, N_BRANCH, D_BRANCH, D), D_BRANCH ** -0.5),
        "w_out": nrm(ks[21], (DEPTH, D, D), D ** -0.5),
        "w_ff1": nrm(ks[22], (DEPTH, D, D_FF), D ** -0.5),
        "w_ff2": nrm(ks[23], (DEPTH, D_FF, D), D_FF ** -0.5),
        "g_final": 1.0 + nrm(ks[24], (D,), 0.05),
    }


def reference(x_prompt, x_sample, state_C, state_n, state_m, c, c_ctx, w_ada, b_ada, g_norm1, g_norm2, w_in,
              b_gates, w_pool, pool_scale, g_sgu, w_sgu, b_sgu, g_mlstm, w_branch, w_out, w_ff1, w_ff2, g_final):
    B = x_prompt.shape[0]
    H, Dh = N_MLSTM_HEADS, HEAD_DIM
    ctx_cond = c_ctx[None, :]
    C_zero = jnp.zeros((B, 2, H, Dh, Dh), jnp.float32)
    n_zero = jnp.zeros((B, 2, H, Dh), jnp.float32)
    m_zero = jnp.zeros((B, 2, H), jnp.float32)
    xc, xs = x_prompt, x_sample
    new_C, new_n, new_m = [], [], []
    for l in range(DEPTH):
        lp = (w_ada[l], b_ada[l], g_norm1[l], g_norm2[l], w_in[l], b_gates[l], w_pool[l], pool_scale[l],
              g_sgu[l], w_sgu[l], b_sgu[l], g_mlstm[l], w_branch[l], w_out[l], w_ff1[l], w_ff2[l])
        xc, C_l, n_l, m_l = trunk_layer(xc, ctx_cond, False, C_zero, n_zero, m_zero, *lp)
        new_C.append(C_l)
        new_n.append(n_l)
        new_m.append(m_l)
        xs, _, _, _ = trunk_layer(xs, c, True, state_C[:, l], state_n[:, l], state_m[:, l], *lp)
    y_prompt = rmsnorm(xc, g_final)
    y_sample = rmsnorm(xs, g_final)
    new_C = jnp.stack(new_C, axis=1)
    new_n = jnp.stack(new_n, axis=1)
    new_m = jnp.stack(new_m, axis=1)
    return (y_prompt, y_sample, new_C, new_n, new_m)
```

```cpp
#ifndef CPU_EMU
#include <hip/hip_runtime.h>
#define LAUNCH(kern, nthreads, stream, ...) kern<<<dim3((unsigned)(((size_t)(nthreads) + 255) / 256)), dim3(256), 0, stream>>>(__VA_ARGS__)
#endif
#include <math.h>
#include <stddef.h>

#ifndef DM
#define DM 1024
#define NB_CTX 16
#define T_CTX 256
#define DEPTH 4
#define NB_LAT 2
#define T_LAT 1024
#define GRID_W 64
#define DB 512
#endif
#define NG 4
#define GRP (DB / NG)
#define SGU_CHUNK 128
#define NH 4
#define DH (DB / NH)
#define LCH 64
#define DFF (4 * DM)
#define D_IN (7 * DB + 4 * NH + 3 * DM)
#define R_CTX (NB_CTX * T_CTX)
#define R_LAT (NB_LAT * T_LAT)
#define NROW (R_CTX + R_LAT)
#define NCHK (NROW / LCH)
#define NSEQ (NB_CTX + NB_LAT)
#define EPSF 1e-6f
#define C_XP 0
#define C_SU (DB)
#define C_SV (2 * DB)
#define C_Q (3 * DB)
#define C_K (4 * DB)
#define C_V (5 * DB)
#define C_O (6 * DB)
#define C_G (7 * DB)
#define C_BR (7 * DB + 4 * NH)

struct P {
    const float *x_prompt, *x_sample, *state_C, *state_n, *state_m, *c, *c_ctx, *w_ada, *b_ada, *g_norm1, *g_norm2, *w_in,
        *b_gates, *w_pool, *pool_scale, *g_sgu, *w_sgu, *b_sgu, *g_mlstm, *w_branch, *w_out, *w_ff1, *w_ff2, *g_final;
    float* out;
    float *mod, *x, *u, *proj, *dbuf, *ys, *vn, *merged, *hff, *Cloc, *nloc, *bcum, *ival, *bL, *Mloc, *Mprev, *MT, *S, *hbuf;
};

__device__ __forceinline__ float sigmoidf_(float x) { return 1.0f / (1.0f + expf(-x)); }
__device__ __forceinline__ float logsigmoidf_(float x) { return fminf(x, 0.0f) - log1pf(expf(-fabsf(x))); }
__device__ __forceinline__ int cond_of_row(int r) { return r < R_CTX ? 0 : 1 + (r - R_CTX) / T_LAT; }
__device__ __forceinline__ int seq_start(int s) { return s < NB_CTX ? s * T_CTX : R_CTX + (s - NB_CTX) * T_LAT; }
__device__ __forceinline__ int seq_len(int s) { return s < NB_CTX ? T_CTX : T_LAT; }

#define GTID ((size_t)blockIdx.x * blockDim.x + threadIdx.x)

__global__ void k_mod(P p) {
    size_t i = GTID; if (i >= (size_t)DEPTH * 3 * 6 * DM) return;
    int j = i % (6 * DM), ci = (i / (6 * DM)) % 3, l = i / (6 * DM * 3);
    const float* cond = ci == 0 ? p.c_ctx : p.c + (size_t)(ci - 1) * DM;
    const float* w = p.w_ada + (size_t)l * DM * 6 * DM;
    float acc = 0.f;
    for (int k = 0; k < DM; ++k) { float cv = cond[k]; acc += cv * sigmoidf_(cv) * w[(size_t)k * 6 * DM + j]; }
    p.mod[i] = acc + p.b_ada[(size_t)l * 6 * DM + j];
}
__global__ void k_copy_x(P p) {
    size_t i = GTID; if (i >= (size_t)NROW * DM) return;
    p.x[i] = i < (size_t)R_CTX * DM ? p.x_prompt[i] : p.x_sample[i - (size_t)R_CTX * DM];
}
__global__ void k_norm(P p, int l, int which) {
    size_t r = GTID; if (r >= NROW) return;
    const float* xr = p.x + r * DM; float ss = 0.f;
    for (int k = 0; k < DM; ++k) ss += xr[k] * xr[k];
    float rs = 1.0f / sqrtf(ss / DM + EPSF);
    const float* g = (which ? p.g_norm2 : p.g_norm1) + (size_t)l * DM;
    const float* md = p.mod + ((size_t)l * 3 + cond_of_row((int)r)) * 6 * DM + (which ? 3 * DM : 0);
    for (int k = 0; k < DM; ++k) p.u[r * DM + k] = xr[k] * rs * g[k] * (1.0f + md[DM + k]) + md[k];
}
__global__ void k_gemm(P p, int l, int mode) {
    const int N = mode == 0 ? D_IN : mode == 3 ? DFF : DM;
    size_t i = GTID; if (i >= (size_t)NROW * N) return;
    int n = i % N; size_t m = i / N;
    if (mode == 0) {
        const float* a = p.u + m * DM; const float* w = p.w_in + (size_t)l * DM * D_IN + n; float acc = 0.f;
        for (int k = 0; k < DM; ++k) acc += a[k] * w[(size_t)k * D_IN];
        p.proj[m * D_IN + n] = acc;
    } else if (mode == 1) {
        float tot = 0.f;
        for (int r = 0; r < 3; ++r) {
            const float* a = p.ys + m * 3 * DB + r * DB; const float* w = p.w_branch + ((size_t)l * 3 + r) * DB * DM + n; float acc = 0.f;
            for (int k = 0; k < DB; ++k) acc += a[k] * w[(size_t)k * DM];
            tot += sigmoidf_(p.proj[m * D_IN + C_BR + r * DM + n]) * acc;
        }
        p.merged[m * DM + n] = tot;
    } else if (mode == 2) {
        const float* a = p.merged + m * DM; const float* w = p.w_out + (size_t)l * DM * DM + n; float acc = 0.f;
        for (int k = 0; k < DM; ++k) acc += a[k] * w[(size_t)k * DM];
        float gt = p.mod[((size_t)l * 3 + cond_of_row((int)m)) * 6 * DM + 2 * DM + n];
        p.x[m * DM + n] += gt * acc;
    } else if (mode == 3) {
        const float* a = p.u + m * DM; const float* w = p.w_ff1 + (size_t)l * DM * DFF + n; float acc = 0.f;
        for (int k = 0; k < DM; ++k) acc += a[k] * w[(size_t)k * DFF];
        acc = fmaxf(acc, 0.f); p.hff[m * DFF + n] = acc * acc;
    } else {
        const float* a = p.hff + m * DFF; const float* w = p.w_ff2 + (size_t)l * DFF * DM + n; float acc = 0.f;
        for (int k = 0; k < DFF; ++k) acc += a[k] * w[(size_t)k * DM];
        float gt = p.mod[((size_t)l * 3 + cond_of_row((int)m)) * 6 * DM + 5 * DM + n];
        p.x[m * DM + n] += gt * acc;
    }
}
__global__ void k_pool_d(P p) {
    size_t i = GTID; if (i >= (size_t)NROW * DB) return;
    int c = i % DB; int r = i / DB; int g = c / GRP; int win = 2 << g;
    float self = p.proj[(size_t)r * D_IN + C_XP + c]; float pooled;
    if (r < R_CTX) {
        int b = r / T_CTX, t = r % T_CTX; int lo = t - win / 2; if (lo < 0) lo = 0; int hi = t + (win - win / 2); if (hi > T_CTX) hi = T_CTX;
        float s = 0.f; for (int tt = lo; tt < hi; ++tt) s += p.proj[(size_t)(b * T_CTX + tt) * D_IN + C_XP + c];
        pooled = s / (float)(hi - lo);
    } else {
        int rr = r - R_CTX; int b = rr / T_LAT, t = rr % T_LAT; int gy = t / GRID_W, gx = t % GRID_W; const int rows = T_LAT / GRID_W;
        int xlo = gx - win / 2; if (xlo < 0) xlo = 0; int xhi = gx + (win - win / 2); if (xhi > GRID_W) xhi = GRID_W;
        int ylo = gy - win / 2; if (ylo < 0) ylo = 0; int yhi = gy + (win - win / 2); if (yhi > rows) yhi = rows;
        float s = 0.f;
        for (int yy = ylo; yy < yhi; ++yy) { float sx = 0.f; for (int xx = xlo; xx < xhi; ++xx) sx += p.proj[(size_t)(R_CTX + b * T_LAT + yy * GRID_W + xx) * D_IN + C_XP + c]; s += sx / (float)(xhi - xlo); }
        pooled = s / (float)(yhi - ylo);
    }
    p.dbuf[i] = pooled - self;
}
__global__ void k_pool_y(P p, int l) {
    size_t i = GTID; if (i >= (size_t)NROW * DB) return;
    int c = i % DB; size_t r = i / DB; int g = c / GRP, dd = c % GRP;
    const float* d = p.dbuf + r * DB + g * GRP; const float* w = p.w_pool + ((size_t)l * NG + g) * GRP * GRP + dd; float acc = 0.f;
    for (int k = 0; k < GRP; ++k) acc += d[k] * w[(size_t)k * GRP];
    p.ys[r * 3 * DB + c] = acc * p.pool_scale[(size_t)l * DB + c];
}
__global__ void k_sgu_vn(P p, int l) {
    size_t r = GTID; if (r >= NROW) return;
    const float* v = p.proj + r * D_IN + C_SV; float ss = 0.f;
    for (int k = 0; k < DB; ++k) ss += v[k] * v[k];
    float rs = 1.0f / sqrtf(ss / DB + EPSF);
    for (int k = 0; k < DB; ++k) p.vn[r * DB + k] = v[k] * rs * p.g_sgu[(size_t)l * DB + k];
}
__global__ void k_sgu_y(P p, int l) {
    size_t i = GTID; if (i >= (size_t)NROW * DB) return;
    int c = i % DB; int r = i / DB; int g = c / GRP; int pp = r % SGU_CHUNK; int r0 = r - pp;
    const float* w = p.w_sgu + (((size_t)l * NG + g) * SGU_CHUNK + pp) * SGU_CHUNK; float acc = 0.f;
    for (int q = 0; q < SGU_CHUNK; ++q) acc += w[q] * p.vn[(size_t)(r0 + q) * DB + c];
    acc += p.b_sgu[((size_t)l * NG + g) * SGU_CHUNK + pp];
    p.ys[(size_t)r * 3 * DB + DB + c] = p.proj[(size_t)r * D_IN + C_SU + c] * acc;
}
#define IDX_DHR(dir, h, row) (((size_t)(dir) * NH + (h)) * NROW + (row))
#define IDX_DHC(dir, h, gc) (((size_t)(dir) * NH + (h)) * NCHK + (gc))
__global__ void k_ml_gates(P p, int l) {
    size_t i = GTID; if (i >= (size_t)2 * NH * NCHK) return;
    int gc = i % NCHK, h = (i / NCHK) % NH, dir = i / (NCHK * NH); int c0 = gc * LCH;
    float b = 0.f;
    for (int tau = 0; tau < LCH; ++tau) {
        int row = dir == 0 ? c0 + tau : c0 + LCH - 1 - tau;
        const float* gp = p.proj + (size_t)row * D_IN + C_G; const float* bg = p.b_gates + (size_t)l * 4 * NH;
        float iv = gp[dir * NH + h] + bg[dir * NH + h];
        float fv = gp[2 * NH + dir * NH + h] + bg[2 * NH + dir * NH + h];
        b += logsigmoidf_(fv);
        p.bcum[IDX_DHR(dir, h, row)] = b; p.ival[IDX_DHR(dir, h, row)] = iv;
    }
    float bL = b, mx = -INFINITY;
    for (int tau = 0; tau < LCH; ++tau) { int row = c0 + tau; float a = bL - p.bcum[IDX_DHR(dir, h, row)] + p.ival[IDX_DHR(dir, h, row)]; mx = fmaxf(mx, a); }
    p.bL[IDX_DHC(dir, h, gc)] = bL; p.Mloc[IDX_DHC(dir, h, gc)] = mx;
}
__global__ void k_ml_cloc(P p) {
    size_t i = GTID; if (i >= (size_t)2 * NH * NCHK * DH * DH) return;
    int e = i % DH, d = (i / DH) % DH; size_t j = i / (DH * DH); int gc = j % NCHK, h = (j / NCHK) % NH, dir = j / (NCHK * NH); int c0 = gc * LCH;
    float bL = p.bL[IDX_DHC(dir, h, gc)], ml = p.Mloc[IDX_DHC(dir, h, gc)]; const float ksc = 1.0f / sqrtf((float)DH);
    float acc = 0.f, accn = 0.f;
    for (int s = 0; s < LCH; ++s) { int row = c0 + s;
        float w = expf(bL - p.bcum[IDX_DHR(dir, h, row)] + p.ival[IDX_DHR(dir, h, row)] - ml);
        float kv = p.proj[(size_t)row * D_IN + C_K + h * DH + d] * ksc;
        acc += w * kv * p.proj[(size_t)row * D_IN + C_V + h * DH + e]; accn += w * kv; }
    p.Cloc[i] = acc; if (e == 0) p.nloc[j * DH + d] = accn;
}
__global__ void k_ml_scan(P p, int l) {
    size_t i = GTID; if (i >= (size_t)2 * NH * NSEQ * DH * DH) return;
    int e = i % DH, d = (i / DH) % DH; size_t j = i / (DH * DH); int s = j % NSEQ, h = (j / NSEQ) % NH, dir = j / (NSEQ * NH);
    int gc0 = seq_start(s) / LCH, nc = seq_len(s) / LCH;
    float C, n, m;
    if (s < NB_CTX) { C = 0.f; n = 0.f; m = 0.f; }
    else { int b = s - NB_CTX; size_t base = (((size_t)b * DEPTH + l) * 2 + dir) * NH + h; C = p.state_C[(base * DH + d) * DH + e]; n = p.state_n[base * DH + d]; m = p.state_m[base]; }
    for (int jj = 0; jj < nc; ++jj) {
        int gc = gc0 + (dir == 0 ? jj : nc - 1 - jj); size_t ci = IDX_DHC(dir, h, gc);
        float bL = p.bL[ci], ml = p.Mloc[ci]; float mnew = fmaxf(bL + m, ml); float dec = expf(bL + m - mnew), sc = expf(ml - mnew);
        size_t ce = (ci * DH + d) * DH + e; float cl = p.Cloc[ce]; p.Cloc[ce] = C; C = dec * C + sc * cl;
        if (e == 0) { float nl = p.nloc[ci * DH + d]; p.nloc[ci * DH + d] = n; n = dec * n + sc * nl; }
        if (e == 0 && d == 0) p.Mprev[ci] = m;
        m = mnew;
    }
    if (s < NB_CTX) {
        size_t base = (((size_t)s * DEPTH + l) * 2 + dir) * NH + h;
        float* oC = p.out + (size_t)NROW * DM; float* on = oC + (size_t)NB_CTX * DEPTH * 2 * NH * DH * DH; float* om = on + (size_t)NB_CTX * DEPTH * 2 * NH * DH;
        oC[(base * DH + d) * DH + e] = C; if (e == 0) on[base * DH + d] = n; if (e == 0 && d == 0) om[base] = m;
    }
}
__global__ void k_ml_mt(P p) {
    size_t i = GTID; if (i >= (size_t)2 * NH * NROW) return;
    int row = i % NROW, h = (i / NROW) % NH, dir = i / ((size_t)NROW * NH); int gc = row / LCH, c0 = gc * LCH;
    int tau = dir == 0 ? row - c0 : c0 + LCH - 1 - row;
    float bt = p.bcum[IDX_DHR(dir, h, row)]; float mt = bt + p.Mprev[IDX_DHC(dir, h, gc)];
    for (int ts = 0; ts <= tau; ++ts) { int rs = dir == 0 ? c0 + ts : c0 + LCH - 1 - ts; mt = fmaxf(mt, bt - p.bcum[IDX_DHR(dir, h, rs)] + p.ival[IDX_DHR(dir, h, rs)]); }
    p.MT[i] = mt;
}
__global__ void k_ml_s(P p) {
    size_t i = GTID; if (i >= (size_t)2 * NH * NCHK * LCH * LCH) return;
    int ts = i % LCH, tt = (i / LCH) % LCH; size_t j = i / (LCH * LCH); int gc = j % NCHK, h = (j / NCHK) % NH, dir = j / (NCHK * NH); int c0 = gc * LCH;
    float val = 0.f;
    if (ts <= tt) {
        int rt = dir == 0 ? c0 + tt : c0 + LCH - 1 - tt, rs = dir == 0 ? c0 + ts : c0 + LCH - 1 - ts;
        const float* q = p.proj + (size_t)rt * D_IN + C_Q + h * DH; const float* k = p.proj + (size_t)rs * D_IN + C_K + h * DH; float acc = 0.f;
        for (int d = 0; d < DH; ++d) acc += q[d] * k[d];
        acc *= 1.0f / sqrtf((float)DH);
        float dm = p.bcum[IDX_DHR(dir, h, rt)] - p.bcum[IDX_DHR(dir, h, rs)] + p.ival[IDX_DHR(dir, h, rs)];
        val = acc * expf(dm - p.MT[IDX_DHR(dir, h, rt)]);
    }
    p.S[i] = val;
}
__global__ void k_ml_h(P p) {
    size_t i = GTID; if (i >= (size_t)2 * NROW * DB) return;
    int c = i % DB; int row = (i / DB) % NROW; int dir = i / ((size_t)DB * NROW); int h = c / DH, e = c % DH; int gc = row / LCH, c0 = gc * LCH;
    int tau = dir == 0 ? row - c0 : c0 + LCH - 1 - row; size_t ci = IDX_DHC(dir, h, gc);
    const float* Srow = p.S + (ci * LCH + tau) * LCH;
    float num = 0.f, den = 0.f;
    for (int ts = 0; ts <= tau; ++ts) { int rs = dir == 0 ? c0 + ts : c0 + LCH - 1 - ts; float sv = Srow[ts]; num += sv * p.proj[(size_t)rs * D_IN + C_V + h * DH + e]; den += sv; }
    float mt = p.MT[IDX_DHR(dir, h, row)]; float winter = expf(p.bcum[IDX_DHR(dir, h, row)] + p.Mprev[ci] - mt);
    const float* q = p.proj + (size_t)row * D_IN + C_Q + h * DH; float qc = 0.f, qn = 0.f;
    for (int d = 0; d < DH; ++d) { qc += q[d] * p.Cloc[(ci * DH + d) * DH + e]; qn += q[d] * p.nloc[ci * DH + d]; }
    num += winter * qc; den += winter * qn;
    p.hbuf[i] = num / fmaxf(fabsf(den), expf(-mt));
}
__global__ void k_ml_fin(P p, int l) {
    size_t i = GTID; if (i >= (size_t)NROW * NH) return;
    int h = i % NH; size_t row = i / NH;
    const float* h0 = p.hbuf + row * DB + h * DH; const float* h1 = p.hbuf + ((size_t)NROW + row) * DB + h * DH; float ss = 0.f;
    for (int e = 0; e < DH; ++e) { float v = h0[e] + h1[e]; ss += v * v; }
    float rs = 1.0f / sqrtf(ss / DH + EPSF);
    for (int e = 0; e < DH; ++e) { float v = (h0[e] + h1[e]) * rs * p.g_mlstm[(size_t)l * DB + h * DH + e];
        p.ys[row * 3 * DB + 2 * DB + h * DH + e] = sigmoidf_(p.proj[row * D_IN + C_O + h * DH + e]) * v; }
}
__global__ void k_final(P p) {
    size_t r = GTID; if (r >= NROW) return;
    const float* xr = p.x + r * DM; float ss = 0.f;
    for (int k = 0; k < DM; ++k) ss += xr[k] * xr[k];
    float rs = 1.0f / sqrtf(ss / DM + EPSF);
    for (int k = 0; k < DM; ++k) p.out[r * DM + k] = xr[k] * rs * p.g_final[k];
}

extern "C" void kernel_launch(void* const* d_in, const int* in_sizes, int n_in, void* d_out, int out_size, void* d_ws, size_t ws_size, hipStream_t stream) {
    P p{};
    const float** f = (const float**)&p;
    for (int i = 0; i < 24; ++i) f[i] = (const float*)d_in[i];
    p.out = (float*)d_out;
    float* w = (float*)d_ws; size_t o = 0;
    auto take = [&](size_t n) { float* r = w + o; o += (n + 63) / 64 * 64; return r; };
    p.mod = take((size_t)DEPTH * 3 * 6 * DM); p.x = take((size_t)NROW * DM); p.u = take((size_t)NROW * DM);
    p.proj = take((size_t)NROW * (D_IN > DFF ? D_IN : DFF)); p.hff = p.proj;
    p.dbuf = take((size_t)NROW * DB); p.ys = take((size_t)NROW * 3 * DB); p.vn = take((size_t)NROW * DB); p.merged = take((size_t)NROW * DM);
    p.Cloc = take((size_t)2 * NH * NCHK * DH * DH); p.nloc = take((size_t)2 * NH * NCHK * DH);
    p.bcum = take((size_t)2 * NH * NROW); p.ival = take((size_t)2 * NH * NROW); p.MT = take((size_t)2 * NH * NROW);
    p.bL = take((size_t)2 * NH * NCHK); p.Mloc = take((size_t)2 * NH * NCHK); p.Mprev = take((size_t)2 * NH * NCHK);
    p.S = take((size_t)2 * NH * NCHK * LCH * LCH); p.hbuf = take((size_t)2 * NROW * DB);
    LAUNCH(k_mod, (size_t)DEPTH * 3 * 6 * DM, stream, p);
    LAUNCH(k_copy_x, (size_t)NROW * DM, stream, p);
    for (int l = 0; l < DEPTH; ++l) {
        LAUNCH(k_norm, NROW, stream, p, l, 0);
        LAUNCH(k_gemm, (size_t)NROW * D_IN, stream, p, l, 0);
        LAUNCH(k_pool_d, (size_t)NROW * DB, stream, p);
        LAUNCH(k_pool_y, (size_t)NROW * DB, stream, p, l);
        LAUNCH(k_sgu_vn, NROW, stream, p, l);
        LAUNCH(k_sgu_y, (size_t)NROW * DB, stream, p, l);
        LAUNCH(k_ml_gates, (size_t)2 * NH * NCHK, stream, p, l);
        LAUNCH(k_ml_cloc, (size_t)2 * NH * NCHK * DH * DH, stream, p);
        LAUNCH(k_ml_scan, (size_t)2 * NH * NSEQ * DH * DH, stream, p, l);
        LAUNCH(k_ml_mt, (size_t)2 * NH * NROW, stream, p);
        LAUNCH(k_ml_s, (size_t)2 * NH * NCHK * LCH * LCH, stream, p);
        LAUNCH(k_ml_h, (size_t)2 * NROW * DB, stream, p);
        LAUNCH(k_ml_fin, (size_t)NROW * NH, stream, p, l);
        LAUNCH(k_gemm, (size_t)NROW * DM, stream, p, l, 1);
        LAUNCH(k_gemm, (size_t)NROW * DM, stream, p, l, 2);
        LAUNCH(k_norm, NROW, stream, p, l, 1);
        LAUNCH(k_gemm, (size_t)NROW * DFF, stream, p, l, 3);
        LAUNCH(k_gemm, (size_t)NROW * DM, stream, p, l, 4);
    }
    LAUNCH(k_final, NROW, stream, p);
}
```

```cpp
#ifndef CPU_EMU
#include <hip/hip_runtime.h>
#include <cstdio>
#endif
#include <math.h>
#include <stddef.h>
#include <string.h>

#ifndef DM
#define DM 1024
#define NB_CTX 16
#define T_CTX 256
#define DEPTH 4
#define NB_LAT 2
#define T_LAT 1024
#define GRID_W 64
#define DB 512
#endif
#define NG 4
#define GRP (DB / NG)
#define SGU_CHUNK 128
#define NH 4
#define DH (DB / NH)
#define LCH 64
#define DFF (4 * DM)
#define D_IN (7 * DB + 4 * NH + 3 * DM)
#define R_CTX (NB_CTX * T_CTX)
#define R_LAT (NB_LAT * T_LAT)
#define NROW (R_CTX + R_LAT)
#define NCHK (NROW / LCH)
#define NSEQ (NB_CTX + NB_LAT)
#define EPSF 1e-6f
#define C_XP 0
#define C_SU (DB)
#define C_SV (2 * DB)
#define C_Q (3 * DB)
#define C_K (4 * DB)
#define C_V (5 * DB)
#define C_O (6 * DB)
#define C_G (7 * DB)
#define C_BR (7 * DB)
#define PJ (7 * DB + 3 * DM)
#define NIN_PAD (PJ + 256)
typedef unsigned short bf16_t;

#ifdef CPU_EMU
#define NAIVE_ONLY(n) (n)
#else
#define NAIVE_ONLY(n) ((size_t)64)
#endif
constexpr size_t al256(size_t b) { return (b + 255) / 256 * 256; }
constexpr size_t OFF_CNT = 16384;
constexpr size_t OFF_BAR_END = OFF_CNT + (size_t)2 * DEPTH * (NROW / 128) * 256 + al256((size_t)3 * DEPTH * ((NROW / 256) * (DM / 256)) * 4);
constexpr size_t OFF_mod = OFF_BAR_END;
constexpr size_t END_mod = OFF_mod + al256(((size_t)DEPTH * 3 * 6 * DM) * 4);
constexpr size_t OFF_x = END_mod;
constexpr size_t END_x = OFF_x + al256(((size_t)NROW * DM) * 4);
constexpr size_t OFF_gate_pre = END_x;
constexpr size_t END_gate_pre = OFF_gate_pre + al256(((size_t)NROW * 16) * 4);
constexpr size_t END_mergedf = END_gate_pre;
constexpr size_t OFF_dbuf = END_mergedf;
constexpr size_t END_dbuf = OFF_dbuf + al256(((size_t)NROW * DB) * 4);
constexpr size_t OFF_vn = END_dbuf;
constexpr size_t END_vn = OFF_vn + al256(((size_t)NROW * DB) * 4);
constexpr size_t OFF_Cloc = END_vn;
constexpr size_t END_Cloc = OFF_Cloc + al256(((size_t)2 * NH * NCHK * DH * DH) * 4);
constexpr size_t OFF_nloc = END_Cloc;
constexpr size_t END_nloc = OFF_nloc + al256(((size_t)2 * NH * NCHK * DH) * 4);
constexpr size_t OFF_bcum = END_nloc;
constexpr size_t END_bcum = OFF_bcum + al256((NAIVE_ONLY((size_t)2 * NH * NROW)) * 4);
constexpr size_t OFF_ival = END_bcum;
constexpr size_t END_ival = OFF_ival + al256((NAIVE_ONLY((size_t)2 * NH * NROW)) * 4);
constexpr size_t OFF_bL = END_ival;
constexpr size_t END_bL = OFF_bL + al256(((size_t)2 * NH * NCHK) * 4);
constexpr size_t OFF_Mloc = END_bL;
constexpr size_t END_Mloc = OFF_Mloc + al256(((size_t)2 * NH * NCHK) * 4);
constexpr size_t OFF_Mprev = END_Mloc;
constexpr size_t END_Mprev = OFF_Mprev + al256(((size_t)2 * NH * NCHK) * 4);
constexpr size_t OFF_MT = END_Mprev;
constexpr size_t END_MT = OFF_MT + al256((NAIVE_ONLY((size_t)2 * NH * NROW)) * 4);
constexpr size_t OFF_S = END_MT;
constexpr size_t END_S = OFF_S + al256((NAIVE_ONLY((size_t)2 * NH * NCHK * LCH * LCH)) * 4);
constexpr size_t OFF_hbuf = END_S;
constexpr size_t END_hbuf = OFF_hbuf + al256((NAIVE_ONLY((size_t)2 * NROW * DB)) * 4);
constexpr size_t OFF_Wt_in = END_hbuf;
constexpr size_t END_Wt_in = OFF_Wt_in + al256(((size_t)DEPTH * NIN_PAD * DM) * 2);
constexpr size_t OFF_Wt_br = END_Wt_in;
constexpr size_t END_Wt_br = OFF_Wt_br + al256(((size_t)DEPTH * 3 * DM * DB) * 2);
constexpr size_t OFF_Wt_out = END_Wt_br;
constexpr size_t END_Wt_out = OFF_Wt_out + al256(((size_t)DEPTH * DM * DM) * 2);
constexpr size_t OFF_Wt_ff1 = END_Wt_out;
constexpr size_t END_Wt_ff1 = OFF_Wt_ff1 + al256(((size_t)DEPTH * DFF * DM) * 2);
constexpr size_t OFF_Wt_ff2 = END_Wt_ff1;
constexpr size_t END_Wt_ff2 = OFF_Wt_ff2 + al256(((size_t)DEPTH * DM * DFF) * 2);
constexpr size_t OFF_u = END_Wt_ff2;
constexpr size_t END_u = OFF_u + al256(((size_t)NROW * DM) * 2);
constexpr size_t OFF_proj = END_u;
constexpr size_t END_proj = OFF_proj + al256(((size_t)NROW * PJ) * 2);
constexpr size_t OFF_ys = END_proj;
constexpr size_t END_ys = OFF_ys + al256(((size_t)NROW * 3 * DB) * 2);
constexpr size_t OFF_merged = END_ys;
constexpr size_t END_merged = OFF_merged + al256(((size_t)NROW * DM) * 2);
constexpr size_t END_hff = END_merged;
constexpr size_t OFF_CprevT = END_hff;
constexpr size_t END_CprevT = OFF_CprevT + al256(((size_t)2 * NH * NCHK * DH * DH) * 2);
constexpr size_t OFF_nprev = END_CprevT;
constexpr size_t END_nprev = OFF_nprev + al256(((size_t)2 * NH * NCHK * DH) * 4);
constexpr size_t OFF_dbf = END_nprev;
constexpr size_t END_dbf = OFF_dbf + al256(((size_t)NROW * DB) * 2);
constexpr size_t OFF_Wt_pool = END_dbf;
constexpr size_t END_Wt_pool = OFF_Wt_pool + al256(((size_t)DEPTH * NG * GRP * GRP) * 2);
constexpr size_t OFF_ssq = END_Wt_pool;
constexpr size_t END_ssq = OFF_ssq + al256(((size_t)2 * DEPTH * NROW * 4) * 4);
constexpr size_t OFF_gsc = END_ssq;
constexpr size_t END_gsc = OFF_gsc + al256(((size_t)3 * 2 * NH * NROW) * 4);
constexpr size_t OFF_VTg = END_gsc;
constexpr size_t END_VTg = OFF_VTg + al256(((size_t)NH * NCHK * DH * LCH) * 2);
constexpr size_t OFF_hbc = END_VTg;
constexpr size_t END_hbc = OFF_hbc + al256(((size_t)2 * R_CTX * DB) * 4);
constexpr size_t WS_TOTAL = END_hbc;
constexpr size_t OFF_mergedf = OFF_dbuf;
constexpr size_t OFF_hff = OFF_proj;
static_assert(END_vn - OFF_dbuf >= (size_t)NROW * DM * 4 && END_dbuf == OFF_vn, "mergedf alias");
static_assert((size_t)NROW * PJ >= (size_t)NROW * DFF, "hff alias");
#ifndef CPU_EMU
#define IN_TAB_OFF 64
#endif
struct P {
#ifdef CPU_EMU
    const float* inp[24];
    const float* in(int i) const { return inp[i]; }
#else
    __device__ __forceinline__ const float* in(int i) const { return (const float*)(*(const __attribute__((address_space(3))) unsigned long long*)(unsigned)(IN_TAB_OFF + 8 * i)); }
#endif
    __device__ __forceinline__ const float* x_prompt() const { return in(0); }
    __device__ __forceinline__ const float* x_sample() const { return in(1); }
    __device__ __forceinline__ const float* state_C() const { return in(2); }
    __device__ __forceinline__ const float* state_n() const { return in(3); }
    __device__ __forceinline__ const float* state_m() const { return in(4); }
    __device__ __forceinline__ const float* c() const { return in(5); }
    __device__ __forceinline__ const float* c_ctx() const { return in(6); }
    __device__ __forceinline__ const float* w_ada() const { return in(7); }
    __device__ __forceinline__ const float* b_ada() const { return in(8); }
    __device__ __forceinline__ const float* g_norm1() const { return in(9); }
    __device__ __forceinline__ const float* g_norm2() const { return in(10); }
    __device__ __forceinline__ const float* w_in() const { return in(11); }
    __device__ __forceinline__ const float* b_gates() const { return in(12); }
    __device__ __forceinline__ const float* w_pool() const { return in(13); }
    __device__ __forceinline__ const float* pool_scale() const { return in(14); }
    __device__ __forceinline__ const float* g_sgu() const { return in(15); }
    __device__ __forceinline__ const float* w_sgu() const { return in(16); }
    __device__ __forceinline__ const float* b_sgu() const { return in(17); }
    __device__ __forceinline__ const float* g_mlstm() const { return in(18); }
    __device__ __forceinline__ const float* w_branch() const { return in(19); }
    __device__ __forceinline__ const float* w_out() const { return in(20); }
    __device__ __forceinline__ const float* w_ff1() const { return in(21); }
    __device__ __forceinline__ const float* w_ff2() const { return in(22); }
    __device__ __forceinline__ const float* g_final() const { return in(23); }
    float* out; char* ws;
    __device__ __forceinline__ float* mod() const { return (float*)(ws + OFF_mod); }
    __device__ __forceinline__ float* x() const { return (float*)(ws + OFF_x); }
    __device__ __forceinline__ float* gate_pre() const { return (float*)(ws + OFF_gate_pre); }
    __device__ __forceinline__ float* mergedf() const { return (float*)(ws + OFF_mergedf); }
    __device__ __forceinline__ float* dbuf() const { return (float*)(ws + OFF_dbuf); }
    __device__ __forceinline__ float* vn() const { return (float*)(ws + OFF_vn); }
    __device__ __forceinline__ float* Cloc() const { return (float*)(ws + OFF_Cloc); }
    __device__ __forceinline__ float* nloc() const { return (float*)(ws + OFF_nloc); }
    __device__ __forceinline__ float* bcum() const { return (float*)(ws + OFF_bcum); }
    __device__ __forceinline__ float* ival() const { return (float*)(ws + OFF_ival); }
    __device__ __forceinline__ float* bL() const { return (float*)(ws + OFF_bL); }
    __device__ __forceinline__ float* Mloc() const { return (float*)(ws + OFF_Mloc); }
    __device__ __forceinline__ float* Mprev() const { return (float*)(ws + OFF_Mprev); }
    __device__ __forceinline__ float* MT() const { return (float*)(ws + OFF_MT); }
    __device__ __forceinline__ float* S() const { return (float*)(ws + OFF_S); }
    __device__ __forceinline__ float* hbuf() const { return (float*)(ws + OFF_hbuf); }
    __device__ __forceinline__ bf16_t* Wt_in() const { return (bf16_t*)(ws + OFF_Wt_in); }
    __device__ __forceinline__ bf16_t* Wt_br() const { return (bf16_t*)(ws + OFF_Wt_br); }
    __device__ __forceinline__ bf16_t* Wt_out() const { return (bf16_t*)(ws + OFF_Wt_out); }
    __device__ __forceinline__ bf16_t* Wt_ff1() const { return (bf16_t*)(ws + OFF_Wt_ff1); }
    __device__ __forceinline__ bf16_t* Wt_ff2() const { return (bf16_t*)(ws + OFF_Wt_ff2); }
    __device__ __forceinline__ bf16_t* u() const { return (bf16_t*)(ws + OFF_u); }
    __device__ __forceinline__ bf16_t* proj() const { return (bf16_t*)(ws + OFF_proj); }
    __device__ __forceinline__ bf16_t* ys() const { return (bf16_t*)(ws + OFF_ys); }
    __device__ __forceinline__ bf16_t* merged() const { return (bf16_t*)(ws + OFF_merged); }
    __device__ __forceinline__ bf16_t* hff() const { return (bf16_t*)(ws + OFF_hff); }
    __device__ __forceinline__ bf16_t* CprevT() const { return (bf16_t*)(ws + OFF_CprevT); }
    __device__ __forceinline__ float* nprev() const { return (float*)(ws + OFF_nprev); }
    __device__ __forceinline__ bf16_t* dbf() const { return (bf16_t*)(ws + OFF_dbf); }
    __device__ __forceinline__ bf16_t* Wt_pool() const { return (bf16_t*)(ws + OFF_Wt_pool); }
    __device__ __forceinline__ float* ssq() const { return (float*)(ws + OFF_ssq); }
    __device__ __forceinline__ float* gsc() const { return (float*)(ws + OFF_gsc); }
    __device__ __forceinline__ bf16_t* VTg() const { return (bf16_t*)(ws + OFF_VTg); }
    __device__ __forceinline__ float* hbc() const { return (float*)(ws + OFF_hbc); }
    __device__ __forceinline__ unsigned* cnt() const { return (unsigned*)(ws + OFF_CNT); }
};
#ifdef CPU_EMU
static inline unsigned f_as_u(float f) { unsigned u; memcpy(&u, &f, 4); return u; }
static inline float u_as_f(unsigned u) { float f; memcpy(&f, &u, 4); return f; }
#else
__device__ __forceinline__ unsigned f_as_u(float f) { return __float_as_uint(f); }
__device__ __forceinline__ float u_as_f(unsigned u) { return __uint_as_float(u); }
#endif
__device__ __forceinline__ bf16_t f2bf(float f) { unsigned u = f_as_u(f); u += 0x7FFFu + ((u >> 16) & 1u); return (bf16_t)(u >> 16); }
__device__ __forceinline__ float bf2f(bf16_t b) { return u_as_f(((unsigned)b) << 16); }
#define PRJ(row, col) bf2f(p.proj()[(size_t)(row) * PJ + (col)])

__device__ __forceinline__ float sigmoidf_(float x) { return 1.0f / (1.0f + expf(-x)); }
__device__ __forceinline__ float logsigmoidf_(float x) { return fminf(x, 0.0f) - log1pf(expf(-fabsf(x))); }
__device__ __forceinline__ int cond_of_row(int r) { return r < R_CTX ? 0 : 1 + (r - R_CTX) / T_LAT; }
__device__ __forceinline__ int seq_start(int s) { return s < NB_CTX ? s * T_CTX : R_CTX + (s - NB_CTX) * T_LAT; }
__device__ __forceinline__ int seq_len(int s) { return s < NB_CTX ? T_CTX : T_LAT; }

#define GTID ((size_t)blockIdx.x * blockDim.x + threadIdx.x)

__device__ __forceinline__ void b_mod(const P& p, size_t i) {

    int j = i % (6 * DM), ci = (i / (6 * DM)) % 3, l = i / (6 * DM * 3);
    const float* cond = ci == 0 ? p.c_ctx() : p.c() + (size_t)(ci - 1) * DM;
    const float* w = p.w_ada() + (size_t)l * DM * 6 * DM;
    float acc = 0.f;
    for (int k = 0; k < DM; ++k) { float cv = cond[k]; acc += cv * sigmoidf_(cv) * w[(size_t)k * 6 * DM + j]; }
    p.mod()[i] = acc + p.b_ada()[(size_t)l * 6 * DM + j];
}
__device__ __forceinline__ void b_copy_x(const P& p, size_t i) {

    p.x()[i] = i < (size_t)R_CTX * DM ? p.x_prompt()[i] : p.x_sample()[i - (size_t)R_CTX * DM];
}
__device__ __forceinline__ void b_norm(const P& p, size_t r, int l, int which) {

    const float* xr = p.x() + r * DM; float ss = 0.f;
    for (int k = 0; k < DM; ++k) ss += xr[k] * xr[k];
    float rs = 1.0f / sqrtf(ss / DM + EPSF);
    const float* g = (which ? p.g_norm2() : p.g_norm1()) + (size_t)l * DM;
    const float* md = p.mod() + ((size_t)l * 3 + cond_of_row((int)r)) * 6 * DM + (which ? 3 * DM : 0);
    for (int k = 0; k < DM; ++k) p.u()[r * DM + k] = f2bf(xr[k] * rs * g[k] * (1.0f + md[DM + k]) + md[k]);
}
__device__ __forceinline__ void b_conv(const P& p, size_t i) {
    const size_t n_in = (size_t)DEPTH * NIN_PAD * DM, n_br = (size_t)DEPTH * 3 * DM * DB, n_out = (size_t)DEPTH * DM * DM, n_f1 = (size_t)DEPTH * DFF * DM, n_f2 = (size_t)DEPTH * DM * DFF;
    if (i < n_in) { int k = i % DM; int n = (i / DM) % NIN_PAD; int l = i / ((size_t)DM * NIN_PAD);
        int col = n < 7 * DB ? n : (n < PJ ? n + 4 * NH : (n < PJ + 4 * NH ? C_G + (n - PJ) : -1));
        p.Wt_in()[i] = col >= 0 ? f2bf(p.w_in()[((size_t)l * DM + k) * D_IN + col]) : (bf16_t)0; return; }
    i -= n_in;
    if (i < n_br) { int k = i % DB; int n = (i / DB) % DM; int lr = i / ((size_t)DB * DM); p.Wt_br()[i] = f2bf(p.w_branch()[((size_t)lr * DB + k) * DM + n]); return; }
    i -= n_br;
    if (i < n_out) { int k = i % DM; int n = (i / DM) % DM; int l = i / ((size_t)DM * DM); p.Wt_out()[i] = f2bf(p.w_out()[((size_t)l * DM + k) * DM + n]); return; }
    i -= n_out;
    if (i < n_f1) { int k = i % DM; int n = (i / DM) % DFF; int l = i / ((size_t)DM * DFF); p.Wt_ff1()[i] = f2bf(p.w_ff1()[((size_t)l * DM + k) * DFF + n]); return; }
    i -= n_f1;
    if (i < n_f2) { int k = i % DFF; int n = (i / DFF) % DM; int l = i / ((size_t)DFF * DM); p.Wt_ff2()[i] = f2bf(p.w_ff2()[((size_t)l * DFF + k) * DM + n]); return; }
}
#define N_CONV ((size_t)DEPTH * ((size_t)NIN_PAD * DM + (size_t)3 * DM * DB + (size_t)DM * DM + (size_t)2 * DFF * DM))

__device__ __forceinline__ void epi_scalar(const P& p, int l, int mode, int z, int m, int n, float acc) {
    if (mode == 0) { if (n < PJ) p.proj()[(size_t)m * PJ + n] = f2bf(acc); else if (n < PJ + 4 * NH) p.gate_pre()[(size_t)m * 16 + (n - PJ)] = acc; }
    else if (mode == 1) { float g = sigmoidf_(PRJ(m, C_BR + z * DM + n)) * acc; float* t = p.mergedf() + (size_t)m * DM + n;
        if (z == 0) *t = g; else if (z == 1) *t += g; else p.merged()[(size_t)m * DM + n] = f2bf(*t + g); }
    else if (mode == 2) p.x()[(size_t)m * DM + n] += p.mod()[((size_t)l * 3 + cond_of_row(m)) * 6 * DM + 2 * DM + n] * acc;
    else if (mode == 3) { float r = fmaxf(acc, 0.f); p.hff()[(size_t)m * DFF + n] = f2bf(r * r); }
    else p.x()[(size_t)m * DM + n] += p.mod()[((size_t)l * 3 + cond_of_row(m)) * 6 * DM + 5 * DM + n] * acc;
}
struct GemmArgs { const bf16_t* A; const bf16_t* Bt; int lda, ldb, K, M, N, nZ; long zA, zB; };
__device__ __forceinline__ GemmArgs gemm_args(const P& p, int l, int mode) {
    GemmArgs g;
    if (mode == 0) g = GemmArgs{p.u(), p.Wt_in() + (size_t)l * NIN_PAD * DM, DM, DM, DM, NROW, NIN_PAD, 1, 0, 0};
    else if (mode == 1) g = GemmArgs{p.ys(), p.Wt_br() + (size_t)l * 3 * DM * DB, 3 * DB, DB, DB, NROW, DM, 3, DB, (long)DM * DB};
    else if (mode == 2) g = GemmArgs{p.merged(), p.Wt_out() + (size_t)l * DM * DM, DM, DM, DM, NROW, DM, 1, 0, 0};
    else if (mode == 3) g = GemmArgs{p.u(), p.Wt_ff1() + (size_t)l * DFF * DM, DM, DM, DM, NROW, DFF, 1, 0, 0};
    else g = GemmArgs{p.hff(), p.Wt_ff2() + (size_t)l * DM * DFF, DFF, DFF, DFF, NROW, DM, 1, 0, 0};
    return g;
}
#ifdef CPU_EMU
__device__ __forceinline__ void b_gemm(const P& p, size_t i, int l, int mode) {
    GemmArgs g = gemm_args(p, l, mode);
    int n = i % g.N; int m = i / g.N;
    for (int z = 0; z < g.nZ; ++z) { const bf16_t* a = g.A + z * g.zA + (size_t)m * g.lda; const bf16_t* b = g.Bt + z * g.zB + (size_t)n * g.ldb; float acc = 0.f;
        for (int k = 0; k < g.K; ++k) acc += bf2f(a[k]) * bf2f(b[k]);
        epi_scalar(p, l, mode, z, m, n, acc); }
}
#else
namespace pg8 {
#define PG8_LAS __attribute__((address_space(3)))
typedef short bf16x8 __attribute__((ext_vector_type(8)));
typedef float f32x4 __attribute__((ext_vector_type(4)));
typedef unsigned u32x4 __attribute__((ext_vector_type(4)));
typedef unsigned u32x2 __attribute__((ext_vector_type(2)));
constexpr int BM = 256, BK = 64, HALF = 128, HTB = HALF * BK * 2, STAGE_BYTES = 8 * HTB, NXCD = 8, WGM = 4;
__host__ __device__ __forceinline__ int lds_byte(int r, int c) { const int st = (r >> 4) * 2 + (c >> 5), rr = r & 15, cc = c & 31, ob = rr * 64 + cc * 2; return st * 1024 + (ob ^ (((ob >> 9) & 1) << 5)); }
__host__ __device__ __forceinline__ void stage_rc(int b, int& R, int& C) { const int st = b / 1024, sb = b % 1024, swz = sb ^ (((sb >> 9) & 1) << 5); R = (st >> 1) * 16 + swz / 64; C = (st & 1) * 32 + (swz % 64) / 2; }
__host__ __device__ __forceinline__ int perm32(int rho) { const int n = rho >> 4, i = rho & 15; return 8 * (i >> 2) + 4 * n + (i & 3); }
struct Unit { int pm, pn, z; };
struct Order {
    int nM, nN, nZ, nwg, G, c;
    __device__ void init(int M, int N, int nZ_, int G_, int c_) { nM = M / BM; nN = N / BM; nZ = nZ_; nwg = nM * nN; G = G_; c = c_; }
    __device__ bool next(int i, Unit& u) const {
        const int ti = i / nZ; u.z = i - ti * nZ;
        const long L = (long)ti * G + c; if (L >= nwg) return false;
        int wgid = (int)L; { const int q = nwg / NXCD, r = nwg % NXCD, xcd = wgid % NXCD, off = wgid / NXCD; wgid = (xcd < r ? xcd * (q + 1) : r * (q + 1) + (xcd - r) * q) + off; }
        const int nig = WGM * nN, gid = wgid / nig, fm = gid * WGM, gsz = (nM - fm) < WGM ? (nM - fm) : WGM;
        u.pm = fm + ((wgid % nig) % gsz); u.pn = (wgid % nig) / gsz; return true;
    }
};
__device__ __forceinline__ void st16_wt(void* base_uniform, unsigned byte_off, u32x4 v) {
    const __amdgpu_buffer_rsrc_t r = __builtin_amdgcn_make_buffer_rsrc(base_uniform, (short)0, 0x7fffffff, 0x00020000);
    __builtin_amdgcn_raw_buffer_store_b128(v, r, byte_off, 0, 16); }
typedef __bf16 bf16x2v __attribute__((ext_vector_type(2)));
__device__ __forceinline__ unsigned cvt_pk_bf16(float lo, float hi) { bf16x2v v; v.x = (__bf16)lo; v.y = (__bf16)hi; return __builtin_bit_cast(unsigned, v); }
__device__ __forceinline__ float bf_lo(unsigned w) { return __uint_as_float(w << 16); }
__device__ __forceinline__ float bf_hi(unsigned w) { return __uint_as_float(w & 0xffff0000u); }

template <int MODE> struct Epi {
    static constexpr bool PERM = (MODE == 0 || MODE == 1 || MODE == 3);
    P p; int l;
    __device__ __forceinline__ void operator()(const f32x4 (&acc)[2][2][4][2], const Unit& u, int wr, int wc, int fr, int fq) const {
        const int row0 = u.pm * BM + wr * 64 + fr;
        if constexpr (PERM) {
            const int col0 = u.pn * BM + wc * 32 + 8 * fq;
#pragma unroll
            for (int ai = 0; ai < 2; ++ai)
#pragma unroll
                for (int m = 0; m < 4; ++m) { const int row = row0 + ai * HALF + m * 16;
#pragma unroll
                    for (int bj = 0; bj < 2; ++bj) { const int col = col0 + bj * HALF; f32x4 v0 = acc[ai][bj][m][0], v1 = acc[ai][bj][m][1];
                        if constexpr (MODE == 0) {
                            if (col < PJ) { u32x4 w; w.x = cvt_pk_bf16(v0[0], v0[1]); w.y = cvt_pk_bf16(v0[2], v0[3]); w.z = cvt_pk_bf16(v1[0], v1[1]); w.w = cvt_pk_bf16(v1[2], v1[3]); st16_wt(p.proj(), (unsigned)(row * PJ + col) * 2u, w); }
                            else if (col < PJ + 16) { float* g = p.gate_pre() + (size_t)row * 16 + (col - PJ); *(f32x4*)g = v0; *(f32x4*)(g + 4) = v1; }
                        } else if constexpr (MODE == 1) {
                            const u32x4 gw = *(const u32x4*)(p.proj() + (size_t)row * PJ + C_BR + u.z * DM + col);
                            f32x4 g0, g1; g0[0] = bf_lo(gw.x); g0[1] = bf_hi(gw.x); g0[2] = bf_lo(gw.y); g0[3] = bf_hi(gw.y); g1[0] = bf_lo(gw.z); g1[1] = bf_hi(gw.z); g1[2] = bf_lo(gw.w); g1[3] = bf_hi(gw.w);
#pragma unroll
                            for (int j = 0; j < 4; ++j) { v0[j] *= __builtin_amdgcn_rcpf(1.0f + __expf(-g0[j])); v1[j] *= __builtin_amdgcn_rcpf(1.0f + __expf(-g1[j])); }
                            float* t = p.mergedf() + (size_t)row * DM + col;
                            if (u.z == 0) { *(f32x4*)t = v0; *(f32x4*)(t + 4) = v1; }
                            else if (u.z == 1) { *(f32x4*)t = *(f32x4*)t + v0; *(f32x4*)(t + 4) = *(f32x4*)(t + 4) + v1; }
                            else { v0 = v0 + *(f32x4*)t; v1 = v1 + *(f32x4*)(t + 4); u32x4 w; w.x = cvt_pk_bf16(v0[0], v0[1]); w.y = cvt_pk_bf16(v0[2], v0[3]); w.z = cvt_pk_bf16(v1[0], v1[1]); w.w = cvt_pk_bf16(v1[2], v1[3]); *(u32x4*)(p.merged() + (size_t)row * DM + col) = w; }
                        } else {
#pragma unroll
                            for (int j = 0; j < 4; ++j) { float a = fmaxf(v0[j], 0.f), b = fmaxf(v1[j], 0.f); v0[j] = a * a; v1[j] = b * b; }
                            u32x4 w; w.x = cvt_pk_bf16(v0[0], v0[1]); w.y = cvt_pk_bf16(v0[2], v0[3]); w.z = cvt_pk_bf16(v1[0], v1[1]); w.w = cvt_pk_bf16(v1[2], v1[3]); st16_wt(p.hff(), (unsigned)(row * DFF + col) * 2u, w);
                        } } }
        } else {
            const int col0 = u.pn * BM + wc * 32 + 4 * fq;
#pragma unroll
            for (int ai = 0; ai < 2; ++ai)
#pragma unroll
                for (int m = 0; m < 4; ++m) { const int row = row0 + ai * HALF + m * 16;
                    const float* gt = p.mod() + ((size_t)l * 3 + cond_of_row(row)) * 6 * DM + (MODE == 2 ? 2 : 5) * DM; float* xr = p.x() + (size_t)row * DM;
#pragma unroll
                    for (int bj = 0; bj < 2; ++bj)
#pragma unroll
                        for (int n = 0; n < 2; ++n) { const int col = col0 + bj * HALF + n * 16; *(f32x4*)(xr + col) = *(f32x4*)(xr + col) + *(const f32x4*)(gt + col) * acc[ai][bj][m][n]; } }
        }
    }
};

template <class EpiT, class OrderT, bool ALIGN_EPI, bool SP2, bool LAST_DRAIN>
__device__ __forceinline__ void gemm_phase(PG8_LAS unsigned char* lds, const GemmArgs g, const OrderT& S, const EpiT& E) {
    int tid = threadIdx.x; asm volatile("" : "+v"(tid));
    const int wid = __builtin_amdgcn_readfirstlane(tid >> 6), lane = tid & 63, wr = wid >> 2, wc = wid & 3, fr = lane & 15, fq = lane >> 4;
    const int nt = g.K / BK;
    unsigned voffA[2], voffB[2];
#pragma unroll
    for (int i = 0; i < 2; ++i) { int R, C; stage_rc(tid * 16 + i * 8192, R, C); const int Rb = EpiT::PERM ? ((R & ~31) + perm32(R & 31)) : R;
        voffA[i] = (unsigned)(R * g.lda + C) * 2u; voffB[i] = (unsigned)(Rb * g.ldb + C) * 2u; }
    const size_t kstep = (size_t)(BK * 2);
    const size_t hstepA = (size_t)HALF * g.lda * 2, hstepB = (size_t)HALF * g.ldb * 2;
    const unsigned ldsw = (unsigned)wid * 1024u;
    const int aoff = lds_byte(wr * 64 + fr, fq * 8), boff = lds_byte(wc * 32 + fr, fq * 8);
#define PG8_SA(b, h) (((b) * 2 + (h)) * HTB)
#define PG8_SB(b, h) ((4 + (b) * 2 + (h)) * HTB)
#define PG8_STAGE(bufoff, gbase, voff) do { _Pragma("unroll") for (int _i = 0; _i < 2; ++_i) \
        __builtin_amdgcn_global_load_lds((const unsigned*)((const char*)(gbase) + (voff)[_i]), (PG8_LAS unsigned*)(lds + (bufoff) + ldsw + _i * 8192), 16, 0, 0); } while (0)
#define PG8_LDA(dst, b, h) do { _Pragma("unroll") for (int m = 0; m < 4; ++m) _Pragma("unroll") for (int k = 0; k < 2; ++k) dst[m][k] = *(const PG8_LAS bf16x8*)(lds + PG8_SA(b, h) + aoff + m * 2048 + k * 1024); } while (0)
#define PG8_LDB(dst, b, h) do { _Pragma("unroll") for (int n = 0; n < 2; ++n) _Pragma("unroll") for (int k = 0; k < 2; ++k) dst[n][k] = *(const PG8_LAS bf16x8*)(lds + PG8_SB(b, h) + boff + n * 2048 + k * 1024); } while (0)
#define PG8_MMA(ai, bj, At, Bt) do { __builtin_amdgcn_s_setprio(1); _Pragma("unroll") for (int m = 0; m < 4; ++m) _Pragma("unroll") for (int n = 0; n < 2; ++n) _Pragma("unroll") for (int k = 0; k < 2; ++k) \
        acc[ai][bj][m][n] = __builtin_amdgcn_mfma_f32_16x16x32_bf16(Bt[n][k], At[m][k], acc[ai][bj][m][n], 0, 0, 0); __builtin_amdgcn_s_setprio(0); } while (0)
#define PG8_WAIT_V(n) asm volatile("s_waitcnt vmcnt(" #n ")" ::: "memory")
#define PG8_WAIT_L(n) asm volatile("s_waitcnt lgkmcnt(" #n ")" ::: "memory")
#define PG8_BAR __builtin_amdgcn_s_barrier()
#define PG8_SCHED __builtin_amdgcn_sched_barrier(0)
#define PG8_APTR(u) ((const char*)(g.A + (size_t)(u).z * g.zA + (size_t)(u).pm * BM * g.lda))
#define PG8_BPTR(u) ((const char*)(g.Bt + (size_t)(u).z * g.zB + (size_t)(u).pn * BM * g.ldb))
    Unit cur, nxt; int ui = 0;
    if (!S.next(0, cur)) return;
    f32x4 acc[2][2][4][2];
#pragma unroll
    for (int a = 0; a < 2; ++a)
#pragma unroll
        for (int b = 0; b < 2; ++b)
#pragma unroll
            for (int m = 0; m < 4; ++m)
#pragma unroll
                for (int n = 0; n < 2; ++n) acc[a][b][m][n] = (f32x4){0.f, 0.f, 0.f, 0.f};
    const char* cA = PG8_APTR(cur); const char* cB = PG8_BPTR(cur);
    if constexpr (SP2) {
        PG8_STAGE(PG8_SB(0, 0), cB, voffB); PG8_STAGE(PG8_SB(0, 1), cB + hstepB, voffB); PG8_STAGE(PG8_SA(0, 0), cA, voffA); PG8_STAGE(PG8_SA(0, 1), cA + hstepA, voffA);
        if (wr == 1) PG8_BAR;
        PG8_WAIT_V(2); PG8_BAR;
        PG8_STAGE(PG8_SB(1, 0), cB + kstep, voffB); PG8_STAGE(PG8_SA(1, 0), cA + kstep, voffA); PG8_STAGE(PG8_SB(1, 1), cB + hstepB + kstep, voffB);
        PG8_WAIT_V(6); PG8_BAR;
    } else {
        PG8_STAGE(PG8_SB(0, 0), cB, voffB); PG8_STAGE(PG8_SA(0, 0), cA, voffA); PG8_STAGE(PG8_SB(0, 1), cB + hstepB, voffB); PG8_STAGE(PG8_SA(0, 1), cA + hstepA, voffA);
        if (wr == 1) PG8_BAR;
        PG8_WAIT_V(4); PG8_BAR;
        PG8_STAGE(PG8_SB(1, 0), cB + kstep, voffB); PG8_STAGE(PG8_SA(1, 0), cA + kstep, voffA); PG8_STAGE(PG8_SB(1, 1), cB + hstepB + kstep, voffB);
        PG8_WAIT_V(6); PG8_BAR;
    }
    for (;;) {
        const bool has_next = S.next(ui + 1, nxt);
        const char* nA = has_next ? PG8_APTR(nxt) : cA; const char* nB = has_next ? PG8_BPTR(nxt) : cB;
        for (int t = 0; t < nt; t += 2) {
            bf16x8 At[4][2], B0[2][2], B1[2][2];
            const bool last = (t == nt - 2);
            const char* a1 = cA + (size_t)(t + 1) * kstep;
            const char* a2 = last ? nA : cA + (size_t)(t + 2) * kstep; const char* b2 = last ? nB : cB + (size_t)(t + 2) * kstep;
            const char* a3 = a2 + kstep; const char* b3 = b2 + kstep;
            if constexpr (SP2) {
            PG8_LDB(B0, 0, 0); PG8_LDB(B1, 0, 1); PG8_SCHED; PG8_LDA(At, 0, 0); PG8_STAGE(PG8_SA(1, 1), a1 + hstepA, voffA);
            PG8_WAIT_V(8); PG8_WAIT_L(0); PG8_BAR; PG8_MMA(0, 0, At, B0); PG8_MMA(0, 1, At, B1); PG8_BAR; PG8_SCHED;
            PG8_LDA(At, 0, 1); PG8_STAGE(PG8_SB(0, 0), b2, voffB); PG8_STAGE(PG8_SB(0, 1), b2 + hstepB, voffB); PG8_STAGE(PG8_SA(0, 0), a2, voffA);
            PG8_WAIT_V(8); PG8_WAIT_L(0); PG8_BAR; PG8_MMA(1, 0, At, B0); PG8_MMA(1, 1, At, B1); PG8_BAR; PG8_SCHED;
            PG8_LDB(B0, 1, 0); PG8_LDB(B1, 1, 1); PG8_SCHED; PG8_LDA(At, 1, 0); PG8_STAGE(PG8_SA(0, 1), a2 + hstepA, voffA);
            PG8_WAIT_V(8); PG8_WAIT_L(0); PG8_BAR; PG8_MMA(0, 0, At, B0); PG8_MMA(0, 1, At, B1); PG8_BAR; PG8_SCHED;
            PG8_LDA(At, 1, 1); PG8_STAGE(PG8_SB(1, 0), b3, voffB); PG8_STAGE(PG8_SB(1, 1), b3 + hstepB, voffB); PG8_STAGE(PG8_SA(1, 0), a3, voffA);
            PG8_WAIT_V(8); PG8_WAIT_L(0); PG8_BAR; PG8_MMA(1, 0, At, B0); PG8_MMA(1, 1, At, B1); PG8_BAR; PG8_SCHED;
            } else {
            PG8_LDB(B0, 0, 0); PG8_SCHED; PG8_LDA(At, 0, 0); PG8_STAGE(PG8_SA(1, 1), a1 + hstepA, voffA);
            PG8_WAIT_L(8); PG8_BAR; PG8_WAIT_L(0); PG8_MMA(0, 0, At, B0); PG8_BAR; PG8_SCHED;
            PG8_LDB(B1, 0, 1); PG8_STAGE(PG8_SB(0, 0), b2, voffB);
            PG8_BAR; PG8_WAIT_L(0); PG8_MMA(0, 1, At, B1); PG8_BAR;
            PG8_LDA(At, 0, 1); PG8_STAGE(PG8_SA(0, 0), a2, voffA);
            PG8_BAR; PG8_WAIT_L(0); PG8_MMA(1, 0, At, B0); PG8_BAR; PG8_SCHED;
            PG8_STAGE(PG8_SB(0, 1), b2 + hstepB, voffB);
            PG8_WAIT_V(6); PG8_BAR; PG8_MMA(1, 1, At, B1); PG8_BAR;
            PG8_LDB(B0, 1, 0); PG8_SCHED; PG8_LDA(At, 1, 0); PG8_STAGE(PG8_SA(0, 1), a2 + hstepA, voffA);
            PG8_WAIT_L(8); PG8_BAR; PG8_WAIT_L(0); PG8_MMA(0, 0, At, B0); PG8_BAR; PG8_SCHED;
            PG8_LDB(B1, 1, 1); PG8_STAGE(PG8_SB(1, 0), b3, voffB);
            PG8_BAR; PG8_WAIT_L(0); PG8_MMA(0, 1, At, B1); PG8_BAR;
            PG8_LDA(At, 1, 1); PG8_STAGE(PG8_SA(1, 0), a3, voffA);
            PG8_BAR; PG8_WAIT_L(0); PG8_MMA(1, 0, At, B0); PG8_BAR; PG8_SCHED;
            PG8_STAGE(PG8_SB(1, 1), b3 + hstepB, voffB);
            PG8_WAIT_V(6); PG8_BAR; PG8_MMA(1, 1, At, B1); PG8_BAR;
            }
        }
        if constexpr (ALIGN_EPI) { if (wr == 0) PG8_BAR; }
        if constexpr (LAST_DRAIN) { if (has_next) E(acc, cur, wr, wc, fr, fq, tid); } else E(acc, cur, wr, wc, fr, fq);
        if (!has_next) break;
#pragma unroll
        for (int a = 0; a < 2; ++a)
#pragma unroll
            for (int b = 0; b < 2; ++b)
#pragma unroll
                for (int m = 0; m < 4; ++m)
#pragma unroll
                    for (int n = 0; n < 2; ++n) acc[a][b][m][n] = (f32x4){0.f, 0.f, 0.f, 0.f};
        cur = nxt; cA = nA; cB = nB; ++ui;
        if constexpr (ALIGN_EPI) { if (wr == 1) PG8_BAR; }
    }
    PG8_WAIT_V(0);
    if constexpr (!ALIGN_EPI) { if (wr == 0) PG8_BAR; }
    PG8_BAR;
    if constexpr (LAST_DRAIN) E.fused(acc, cur, wr, wc, fr, fq, lds, tid);
#undef PG8_SA
#undef PG8_SB
#undef PG8_STAGE
#undef PG8_LDA
#undef PG8_LDB
#undef PG8_MMA
#undef PG8_WAIT_V
#undef PG8_WAIT_L
#undef PG8_BAR
#undef PG8_SCHED
#undef PG8_APTR
#undef PG8_BPTR
}
}
namespace pg8 {
constexpr int STG = 3 * HTB;
struct Order128 {
    int nM, nN, nZ, nwg, G, c;
    __device__ void init(int M, int N, int nZ_, int G_, int c_) { nM = M / HALF; nN = N / BM; nZ = nZ_; nwg = nM * nN; G = G_; c = c_; }
    __device__ bool next(int i, Unit& u) const {
        const int ti = i / nZ; u.z = i - ti * nZ;
        const long L = (long)ti * G + c; if (L >= nwg) return false;
        int wgid = (int)L; { const int q = nwg / NXCD, r = nwg % NXCD, xcd = wgid % NXCD, off = wgid / NXCD; wgid = (xcd < r ? xcd * (q + 1) : r * (q + 1) + (xcd - r) * q) + off; }
        const int nig = WGM * nN, gid = wgid / nig, fm = gid * WGM, gsz = (nM - fm) < WGM ? (nM - fm) : WGM;
        u.pm = fm + ((wgid % nig) % gsz); u.pn = (wgid % nig) / gsz; return true;
    }
};
template <int MODE> struct Epi128 {
    static constexpr bool PERM = (MODE == 1), AFTER_DRAIN = (MODE != 1);
    P p; int l; float gsc;
    mutable u32x2 rsum[2][4][2];
    __device__ __forceinline__ void operator()(f32x4 (&acc)[2][4][2], const Unit& u, int wr_, int wc_, int fr_, int fq_) const {
        if constexpr (MODE == 1) {
            int tid = threadIdx.x; asm volatile("" : "+v"(tid));
            const int wid = __builtin_amdgcn_readfirstlane(tid >> 6), lane = tid & 63, wr = wid >> 2, wc = wid & 3, fr = lane & 15, fq = lane >> 4;
            const int row0 = u.pm * HALF + wr * 64 + fr, col0 = u.pn * BM + wc * 32 + 8 * fq;
            { u32x4 gw[4][2];
#pragma unroll
              for (int m = 0; m < 4; ++m)
#pragma unroll
                  for (int bj = 0; bj < 2; ++bj) gw[m][bj] = *(const u32x4*)(p.proj() + (size_t)(row0 + m * 16) * PJ + C_BR + u.z * DM + col0 + bj * HALF);
#pragma unroll
              for (int m = 0; m < 4; ++m) {
#pragma unroll
                  for (int bj = 0; bj < 2; ++bj) { const u32x4 g = gw[m][bj]; const float g0[4] = {bf_lo(g.x), bf_hi(g.x), bf_lo(g.y), bf_hi(g.y)}, g1[4] = {bf_lo(g.z), bf_hi(g.z), bf_lo(g.w), bf_hi(g.w)};
#pragma unroll
                      for (int j = 0; j < 4; ++j) { acc[bj][m][0][j] *= __builtin_amdgcn_rcpf(1.0f + __expf(-g0[j])); acc[bj][m][1][j] *= __builtin_amdgcn_rcpf(1.0f + __expf(-g1[j])); } }
                  asm volatile("" : "+v"(acc[0][m][0]), "+v"(acc[0][m][1]), "+v"(acc[1][m][0]), "+v"(acc[1][m][1]) :: "memory"); } }
#pragma unroll
            for (int m = 0; m < 4; ++m)
#pragma unroll
                for (int bj = 0; bj < 2; ++bj)
#pragma unroll
                    for (int n = 0; n < 2; ++n) { f32x4 v = acc[bj][m][n];
                        if (u.z != 0) { const u32x2 s = rsum[bj][m][n]; v[0] += bf_lo(s.x); v[1] += bf_hi(s.x); v[2] += bf_lo(s.y); v[3] += bf_hi(s.y); }
                        u32x2 w; w.x = cvt_pk_bf16(v[0], v[1]); w.y = cvt_pk_bf16(v[2], v[3]); rsum[bj][m][n] = w; }
            if (u.z == 2) {
#pragma unroll
                for (int m = 0; m < 4; ++m)
#pragma unroll
                    for (int bj = 0; bj < 2; ++bj) { const size_t o = (size_t)(row0 + m * 16) * DM + col0 + bj * HALF; u32x4 w; w.x = rsum[bj][m][0].x; w.y = rsum[bj][m][0].y; w.z = rsum[bj][m][1].x; w.w = rsum[bj][m][1].y;
                        st16_wt(p.merged(), (unsigned)o * 2u, w); } }
        }
    }
    __device__ __forceinline__ void fused(f32x4 (&acc)[2][4][2], const Unit& u, int wr_, int wc_, int fr_, int fq_, PG8_LAS unsigned char* lds, int tid_) const {
        int tid = tid_; asm volatile("" : "+v"(tid));
        const int wid = __builtin_amdgcn_readfirstlane(tid >> 6), lane = tid & 63, wr = wid >> 2, wc = wid & 3, fr = lane & 15, fq = lane >> 4;
        const int row0 = u.pm * HALF + wr * 64 + fr, col0 = u.pn * BM + wc * 32 + 4 * fq, ci = cond_of_row(u.pm * HALF);
        const float* gt = p.mod() + ((size_t)l * 3 + ci) * 6 * DM + (MODE == 2 ? 2 : 5) * DM;
        f32x4 gv[2][2], xv[4][2][2];
#pragma unroll
        for (int bj = 0; bj < 2; ++bj)
#pragma unroll
            for (int n = 0; n < 2; ++n) gv[bj][n] = *(const f32x4*)(gt + col0 + bj * HALF + n * 16) * gsc;
#pragma unroll
        for (int m = 0; m < 4; ++m)
#pragma unroll
            for (int bj = 0; bj < 2; ++bj)
#pragma unroll
                for (int n = 0; n < 2; ++n) xv[m][bj][n] = *(const f32x4*)(p.x() + (size_t)(row0 + m * 16) * DM + col0 + bj * HALF + n * 16);
        PG8_LAS float* Pp = (PG8_LAS float*)lds;
        PG8_LAS float* Rr = Pp + 512;
#pragma unroll
        for (int m = 0; m < 4; ++m) { float s = 0.f;
#pragma unroll
            for (int bj = 0; bj < 2; ++bj)
#pragma unroll
                for (int n = 0; n < 2; ++n) { const f32x4 v = xv[m][bj][n] + gv[bj][n] * acc[bj][m][n]; xv[m][bj][n] = v; s += v[0] * v[0] + v[1] * v[1] + v[2] * v[2] + v[3] * v[3]; }
            s += __shfl_xor(s, 16, 64); s += __shfl_xor(s, 32, 64);
            if (fq == 0) Pp[(wr * 64 + m * 16 + fr) * 4 + wc] = s; }
        asm volatile("" ::: "memory");
        const int kind = MODE == 2 ? 0 : 1;
        float* slots = p.ssq() + ((size_t)(kind * DEPTH + l) * NROW + (size_t)u.pm * HALF) * 4;
        unsigned* cnt = p.cnt() + ((size_t)(kind * DEPTH + l) * (NROW / HALF) + u.pm) * 64;
        __syncthreads();
        if (tid < HALF) { const float t = (Pp[tid * 4] + Pp[tid * 4 + 1]) + (Pp[tid * 4 + 2] + Pp[tid * 4 + 3]); __hip_atomic_store(slots + tid * 4 + u.pn, t, __ATOMIC_RELAXED, __HIP_MEMORY_SCOPE_AGENT); }
        asm volatile("s_waitcnt vmcnt(0)" ::: "memory");
        __syncthreads();
        if (tid == 0) { __hip_atomic_fetch_add(cnt, 1u, __ATOMIC_RELAXED, __HIP_MEMORY_SCOPE_AGENT);
            unsigned sp = 0; while (__hip_atomic_load(cnt, __ATOMIC_RELAXED, __HIP_MEMORY_SCOPE_AGENT) < (unsigned)(DM / BM)) { __builtin_amdgcn_s_sleep(2); if (++sp > (1u << 22)) break; }
            __builtin_amdgcn_fence(__ATOMIC_ACQUIRE, "agent"); asm volatile("s_waitcnt vmcnt(0)" ::: "memory"); }
        __syncthreads();
        if (tid < HALF) { float t = 0.f;
#pragma unroll
            for (int q = 0; q < DM / BM; ++q) t += __hip_atomic_load(slots + tid * 4 + q, __ATOMIC_RELAXED, __HIP_MEMORY_SCOPE_AGENT);
            Rr[tid] = 1.0f / sqrtf(t * (1.0f / DM) + EPSF); }
#pragma unroll
        for (int m = 0; m < 4; ++m)
#pragma unroll
            for (int bj = 0; bj < 2; ++bj)
#pragma unroll
                for (int n = 0; n < 2; ++n) *(f32x4*)(p.x() + (size_t)(row0 + m * 16) * DM + col0 + bj * HALF + n * 16) = xv[m][bj][n];
        __syncthreads();
        const bool fin = (MODE == 4 && l == DEPTH - 1);
        const int ln = MODE == 2 ? l : l + 1;
        const float* gn = fin ? p.g_final() : (MODE == 2 ? p.g_norm2() : p.g_norm1()) + (size_t)ln * DM;
        const float* md = p.mod() + ((size_t)(fin ? 0 : ln) * 3 + ci) * 6 * DM + (MODE == 2 ? 3 * DM : 0);
#pragma unroll
        for (int bj = 0; bj < 2; ++bj)
#pragma unroll
            for (int n = 0; n < 2; ++n) { const int col = col0 + bj * HALF + n * 16; f32x4 gg = *(const f32x4*)(gn + col), sh = {0.f, 0.f, 0.f, 0.f};
                if (!fin) { gg = gg * (*(const f32x4*)(md + DM + col) + 1.0f); sh = *(const f32x4*)(md + col); }
#pragma unroll
                for (int m = 0; m < 4; ++m) { const int r = wr * 64 + m * 16 + fr; const f32x4 o = xv[m][bj][n] * Rr[r] * gg + sh; const size_t off = (size_t)(u.pm * HALF + r) * DM + col;
                    if (fin) *(f32x4*)(p.out + off) = o;
                    else { u32x2 w; w.x = cvt_pk_bf16(o[0], o[1]); w.y = cvt_pk_bf16(o[2], o[3]); *(u32x2*)(p.u() + off) = w; } } }
    }
};
template <class EpiT>
__device__ __forceinline__ void gemm128_phase(PG8_LAS unsigned char* lds, const GemmArgs g, const Order128& S, const EpiT& E) {
    int tid = threadIdx.x; asm volatile("" : "+v"(tid));
    const int wid = __builtin_amdgcn_readfirstlane(tid >> 6), lane = tid & 63, wr = wid >> 2, wc = wid & 3, fr = lane & 15, fq = lane >> 4;
    const int nt = g.K / BK;
    unsigned voffA[2], voffB[2];
#pragma unroll
    for (int i = 0; i < 2; ++i) { int R, C; stage_rc(tid * 16 + i * 8192, R, C); const int Rb = EpiT::PERM ? ((R & ~31) + perm32(R & 31)) : R;
        voffA[i] = (unsigned)(R * g.lda + C) * 2u; voffB[i] = (unsigned)(Rb * g.ldb + C) * 2u; }
    const size_t kstep = (size_t)(BK * 2);
    const size_t hstepB = (size_t)HALF * g.ldb * 2;
    const unsigned ldsw = (unsigned)wid * 1024u;
    const int aoff = lds_byte(wr * 64 + fr, fq * 8), boff = lds_byte(wc * 32 + fr, fq * 8);
#define G1_STAGE(bufoff, gbase, voff) do { _Pragma("unroll") for (int _i = 0; _i < 2; ++_i) \
        __builtin_amdgcn_global_load_lds((const unsigned*)((const char*)(gbase) + (voff)[_i]), (PG8_LAS unsigned*)(lds + (bufoff) + ldsw + _i * 8192), 16, 0, 0); } while (0)
#define G1_STAGE3(so, pa, pb) do { G1_STAGE((so) + HTB, (pb), voffB); G1_STAGE((so) + 2 * HTB, (pb) + hstepB, voffB); G1_STAGE((so), (pa), voffA); } while (0)
#define G1_LDA(dst, so) do { _Pragma("unroll") for (int m = 0; m < 4; ++m) _Pragma("unroll") for (int k = 0; k < 2; ++k) dst[m][k] = *(const PG8_LAS bf16x8*)(lds + (so) + aoff + m * 2048 + k * 1024); } while (0)
#define G1_LDB(dst, so, h) do { _Pragma("unroll") for (int n = 0; n < 2; ++n) _Pragma("unroll") for (int k = 0; k < 2; ++k) dst[n][k] = *(const PG8_LAS bf16x8*)(lds + (so) + (1 + (h)) * HTB + boff + n * 2048 + k * 1024); } while (0)
#define G1_MMA(bj, At, Bt) do { _Pragma("unroll") for (int m = 0; m < 4; ++m) _Pragma("unroll") for (int n = 0; n < 2; ++n) _Pragma("unroll") for (int k = 0; k < 2; ++k) \
        acc[bj][m][n] = __builtin_amdgcn_mfma_f32_16x16x32_bf16(Bt[n][k], At[m][k], acc[bj][m][n], 0, 0, 0); } while (0)
#define G1_WAIT_V(n) asm volatile("s_waitcnt vmcnt(" #n ")" ::: "memory")
#define G1_WAIT_L(n) asm volatile("s_waitcnt lgkmcnt(" #n ")" ::: "memory")
#define G1_BAR __builtin_amdgcn_s_barrier()
#define G1_SCHED __builtin_amdgcn_sched_barrier(0)
#define G1_APTR(u) ((const char*)(g.A + (size_t)(u).z * g.zA + (size_t)(u).pm * HALF * g.lda))
#define G1_BPTR(u) ((const char*)(g.Bt + (size_t)(u).z * g.zB + (size_t)(u).pn * BM * g.ldb))
    Unit cur;
    if (!S.next(0, cur)) return;
    f32x4 acc[2][4][2];
#pragma unroll
    for (int b = 0; b < 2; ++b)
#pragma unroll
        for (int m = 0; m < 4; ++m)
#pragma unroll
            for (int n = 0; n < 2; ++n) acc[b][m][n] = (f32x4){0.f, 0.f, 0.f, 0.f};
    bf16x8 A0[4][2], P0[2][2], Q0[2][2], A1[4][2], P1[2][2], Q1[2][2];
    Unit iu = cur; int iui = 0, it = 0; const char* iA = G1_APTR(iu); const char* iB = G1_BPTR(iu); int iso = 0; bool ilive = true;
#define G1_ISSUE() do { G1_STAGE3(iso, iA + (size_t)it * kstep, iB + (size_t)it * kstep); iso = iso == 2 * STG ? 0 : iso + STG; \
        if (++it == nt) { it = 0; if (ilive) { Unit nx; if (S.next(iui + 1, nx)) { iu = nx; ++iui; iA = G1_APTR(iu); iB = G1_BPTR(iu); } else ilive = false; } } } while (0)
    G1_ISSUE(); G1_ISSUE(); G1_ISSUE();
    G1_WAIT_V(12); G1_BAR;
    G1_LDB(P0, 0, 0); G1_LDB(Q0, 0, 1); G1_LDA(A0, 0);
    G1_WAIT_L(0); G1_WAIT_V(6); G1_BAR;
    int so = STG;
    int ui = 0, t = 0;
    for (;;) {
        G1_ISSUE(); G1_LDB(P1, so, 0); G1_LDB(Q1, so, 1); G1_LDA(A1, so); so = so == 2 * STG ? 0 : so + STG;
        G1_SCHED; __builtin_amdgcn_s_setprio(1); G1_MMA(0, A0, P0); G1_MMA(1, A0, Q0); __builtin_amdgcn_s_setprio(0); G1_SCHED;
        G1_WAIT_L(0); G1_WAIT_V(6); G1_BAR;
        if (++t == nt) { t = 0; Unit nx; const bool hn = S.next(ui + 1, nx);
            if constexpr (!EpiT::AFTER_DRAIN) E(acc, cur, wr, wc, fr, fq);
            if (!hn) break;
#pragma unroll
            for (int b = 0; b < 2; ++b)
#pragma unroll
                for (int m = 0; m < 4; ++m)
#pragma unroll
                    for (int n = 0; n < 2; ++n) acc[b][m][n] = (f32x4){0.f, 0.f, 0.f, 0.f};
            cur = nx; ++ui; }
        G1_ISSUE(); G1_LDB(P0, so, 0); G1_LDB(Q0, so, 1); G1_LDA(A0, so); so = so == 2 * STG ? 0 : so + STG;
        G1_SCHED; __builtin_amdgcn_s_setprio(1); G1_MMA(0, A1, P1); G1_MMA(1, A1, Q1); __builtin_amdgcn_s_setprio(0); G1_SCHED;
        G1_WAIT_L(0); G1_WAIT_V(6); G1_BAR;
        if (++t == nt) { t = 0; Unit nx; const bool hn = S.next(ui + 1, nx);
            if constexpr (!EpiT::AFTER_DRAIN) E(acc, cur, wr, wc, fr, fq);
            if (!hn) break;
#pragma unroll
            for (int b = 0; b < 2; ++b)
#pragma unroll
                for (int m = 0; m < 4; ++m)
#pragma unroll
                    for (int n = 0; n < 2; ++n) acc[b][m][n] = (f32x4){0.f, 0.f, 0.f, 0.f};
            cur = nx; ++ui; }
    }
    G1_WAIT_V(0);
    G1_BAR;
    if constexpr (EpiT::AFTER_DRAIN) E.fused(acc, cur, wr, wc, fr, fq, lds, tid);
#undef G1_ISSUE
#undef G1_STAGE
#undef G1_STAGE3
#undef G1_LDA
#undef G1_LDB
#undef G1_MMA
#undef G1_WAIT_V
#undef G1_WAIT_L
#undef G1_BAR
#undef G1_SCHED
#undef G1_APTR
#undef G1_BPTR
}
template <class EpiT>
__device__ __forceinline__ void gemm128_phase_s(PG8_LAS unsigned char* lds, const GemmArgs g, const Order128& S, const EpiT& E) {
    int tid = threadIdx.x; asm volatile("" : "+v"(tid));
    const int wid = __builtin_amdgcn_readfirstlane(tid >> 6), lane = tid & 63, wr = wid >> 2, wc = wid & 3, fr = lane & 15, fq = lane >> 4;
    const int nt = g.K / BK;
    unsigned voffA[2], voffB[2];
#pragma unroll
    for (int i = 0; i < 2; ++i) { int R, C; stage_rc(tid * 16 + i * 8192, R, C); const int Rb = EpiT::PERM ? ((R & ~31) + perm32(R & 31)) : R;
        voffA[i] = (unsigned)(R * g.lda + C) * 2u; voffB[i] = (unsigned)(Rb * g.ldb + C) * 2u; }
    const size_t kstep = (size_t)(BK * 2);
    const size_t hstepB = (size_t)HALF * g.ldb * 2;
    const unsigned ldsw = (unsigned)wid * 1024u;
    const int aoff = lds_byte(wr * 64 + fr, fq * 8), boff = lds_byte(wc * 32 + fr, fq * 8);
#define G1_STAGE(bufoff, gbase, voff) do { _Pragma("unroll") for (int _i = 0; _i < 2; ++_i) \
        __builtin_amdgcn_global_load_lds((const unsigned*)((const char*)(gbase) + (voff)[_i]), (PG8_LAS unsigned*)(lds + (bufoff) + ldsw + _i * 8192), 16, 0, 0); } while (0)
#define G1_STAGE3(so, pa, pb) do { G1_STAGE((so) + HTB, (pb), voffB); G1_STAGE((so) + 2 * HTB, (pb) + hstepB, voffB); G1_STAGE((so), (pa), voffA); } while (0)
#define G1_LDA(dst, so) do { _Pragma("unroll") for (int m = 0; m < 4; ++m) _Pragma("unroll") for (int k = 0; k < 2; ++k) dst[m][k] = *(const PG8_LAS bf16x8*)(lds + (so) + aoff + m * 2048 + k * 1024); } while (0)
#define G1_LDB(dst, so, h) do { _Pragma("unroll") for (int n = 0; n < 2; ++n) _Pragma("unroll") for (int k = 0; k < 2; ++k) dst[n][k] = *(const PG8_LAS bf16x8*)(lds + (so) + (1 + (h)) * HTB + boff + n * 2048 + k * 1024); } while (0)
#define G1_MMA(bj, At, Bt) do { __builtin_amdgcn_s_setprio(1); _Pragma("unroll") for (int m = 0; m < 4; ++m) _Pragma("unroll") for (int n = 0; n < 2; ++n) _Pragma("unroll") for (int k = 0; k < 2; ++k) \
        acc[bj][m][n] = __builtin_amdgcn_mfma_f32_16x16x32_bf16(Bt[n][k], At[m][k], acc[bj][m][n], 0, 0, 0); __builtin_amdgcn_s_setprio(0); } while (0)
#define G1_WAIT_V(n) asm volatile("s_waitcnt vmcnt(" #n ")" ::: "memory")
#define G1_WAIT_L(n) asm volatile("s_waitcnt lgkmcnt(" #n ")" ::: "memory")
#define G1_BAR __builtin_amdgcn_s_barrier()
#define G1_SCHED __builtin_amdgcn_sched_barrier(0)
#define G1_APTR(u) ((const char*)(g.A + (size_t)(u).z * g.zA + (size_t)(u).pm * HALF * g.lda))
#define G1_BPTR(u) ((const char*)(g.Bt + (size_t)(u).z * g.zB + (size_t)(u).pn * BM * g.ldb))
    Unit cur, nxt; int ui = 0;
    if (!S.next(0, cur)) return;
    f32x4 acc[2][4][2];
#pragma unroll
    for (int b = 0; b < 2; ++b)
#pragma unroll
        for (int m = 0; m < 4; ++m)
#pragma unroll
            for (int n = 0; n < 2; ++n) acc[b][m][n] = (f32x4){0.f, 0.f, 0.f, 0.f};
    bf16x8 At[4][2], B0[2][2], B1[2][2];
    const char* cA = G1_APTR(cur); const char* cB = G1_BPTR(cur);
    G1_STAGE3(0, cA, cB); G1_STAGE3(STG, cA + kstep, cB + kstep);
    if (wr == 1) G1_BAR;
    G1_WAIT_V(6); G1_BAR; G1_BAR;
    int so = 0;
    for (;;) {
        const bool has_next = S.next(ui + 1, nxt);
        const char* nA = has_next ? G1_APTR(nxt) : cA; const char* nB = has_next ? G1_BPTR(nxt) : cB;
        for (int t = 0; t < nt; ++t) {
            const int t2 = t + 2; const bool over = t2 >= nt;
            const char* a2 = over ? nA + (size_t)(t2 - nt) * kstep : cA + (size_t)t2 * kstep; const char* b2 = over ? nB + (size_t)(t2 - nt) * kstep : cB + (size_t)t2 * kstep;
            const int sp = so == 0 ? 2 * STG : so - STG;
            G1_LDB(B0, so, 0); G1_LDB(B1, so, 1); G1_SCHED; G1_LDA(At, so); G1_STAGE3(sp, a2, b2);
            G1_WAIT_V(6); G1_WAIT_L(0); G1_BAR; G1_MMA(0, At, B0); G1_MMA(1, At, B1); G1_BAR; G1_SCHED;
            so = so == 2 * STG ? 0 : so + STG;
        }
        if constexpr (!EpiT::AFTER_DRAIN) E(acc, cur, wr, wc, fr, fq);
        if (!has_next) break;
#pragma unroll
        for (int b = 0; b < 2; ++b)
#pragma unroll
            for (int m = 0; m < 4; ++m)
#pragma unroll
                for (int n = 0; n < 2; ++n) acc[b][m][n] = (f32x4){0.f, 0.f, 0.f, 0.f};
        cur = nxt; cA = nA; cB = nB; ++ui;
    }
    G1_WAIT_V(0);
    if (wr == 0) G1_BAR;
    G1_BAR;
    if constexpr (EpiT::AFTER_DRAIN) E.fused(acc, cur, wr, wc, fr, fq, lds, tid);
#undef G1_STAGE
#undef G1_STAGE3
#undef G1_LDA
#undef G1_LDB
#undef G1_MMA
#undef G1_WAIT_V
#undef G1_WAIT_L
#undef G1_BAR
#undef G1_SCHED
#undef G1_APTR
#undef G1_BPTR
}
}
namespace pg8 {
constexpr int NT2 = (NROW / BM) * (DM / BM);
struct Order2K {
    int nZ, kh, slot; bool active;
    __device__ void init(int nZ_, int c) { nZ = nZ_; active = c < 2 * NT2; const int j = c & 7, i = c >> 3; kh = i & 1; slot = (i >> 1) * 8 + j; }
    __device__ bool next(int i, Unit& u) const {
        if (!active || i >= nZ) return false; u.z = i;
        constexpr int nN = DM / BM, nM = NROW / BM, nwg = nM * nN; int wgid = slot; { const int q = nwg / NXCD, r = nwg % NXCD, xcd = wgid % NXCD, off = wgid / NXCD; wgid = (xcd < r ? xcd * (q + 1) : r * (q + 1) + (xcd - r) * q) + off; }
        const int nig = WGM * nN, gid = wgid / nig, fm = gid * WGM, gsz = (nM - fm) < WGM ? (nM - fm) : WGM;
        u.pm = fm + ((wgid % nig) % gsz); u.pn = (wgid % nig) / gsz; return true;
    }
};
__device__ __forceinline__ void st_wt16(float* ptr, f32x4 v) { asm volatile("global_store_dwordx4 %0, %1, off sc1\n\ts_nop 1" :: "v"(ptr), "v"(v) : "memory"); }
__device__ __forceinline__ f32x4 ld_sc1_16(const float* ptr) { f32x4 v; asm volatile("global_load_dwordx4 %0, %1, off sc1" : "=v"(v) : "v"(ptr) : "memory"); return v; }
template <int MODE> struct EpiX {
    static constexpr bool PERM = (MODE == 1);
    P p; int l, kh, slot;
    __device__ __forceinline__ float* slab(int half) const { return p.Cloc() + ((size_t)slot * 2 + half) * (size_t)(BM * BM); }
    __device__ __forceinline__ unsigned* flag() const { return p.cnt() + 64 * (2 * DEPTH * (NROW / HALF)) + ((MODE == 1 ? 0 : (MODE == 2 ? 1 : 2)) * DEPTH + l) * NT2 + slot; }
    __device__ __forceinline__ void operator()(f32x4 (&acc)[2][2][4][2], const Unit& u, int wr_, int wc_, int fr_, int fq_, int tid_) const {
        if constexpr (MODE == 1) { int tid = tid_; asm volatile("" : "+v"(tid));
            const int wid = __builtin_amdgcn_readfirstlane(tid >> 6), lane = tid & 63, wr = wid >> 2, wc = wid & 3, fr = lane & 15, fq = lane >> 4;
            gate_mul(acc, u, wr, wc, fr, fq); float* s = slab(kh) + (size_t)tid * 4;
            if (u.z != 0) {
#pragma unroll
                for (int hh = 0; hh < 4; ++hh) { f32x4 t[8];
#pragma unroll
                    for (int i = 0; i < 8; ++i) t[i] = *(const f32x4*)(s + (size_t)(hh * 8 + i) * 2048);
#pragma unroll
                    for (int i = 0; i < 8; ++i) { const int q = hh * 8 + i; acc[q >> 4][(q >> 3) & 1][(q >> 1) & 3][q & 1] = acc[q >> 4][(q >> 3) & 1][(q >> 1) & 3][q & 1] + t[i]; }
#pragma unroll
                    for (int i = 0; i < 8; i += 2) { const int q = hh * 8 + i; asm volatile("" : "+v"(acc[q >> 4][(q >> 3) & 1][(q >> 1) & 3][0]), "+v"(acc[q >> 4][(q >> 3) & 1][(q >> 1) & 3][1]) :: "memory"); } } }
#pragma unroll
            for (int i = 0; i < 32; ++i) *(f32x4*)(s + (size_t)i * 2048) = acc[i >> 4][(i >> 3) & 1][(i >> 1) & 3][i & 1];
        }
    }
    __device__ __forceinline__ void gate_mul(f32x4 (&acc)[2][2][4][2], const Unit& u, int wr, int wc, int fr, int fq) const {
        const int row0 = u.pm * BM + wr * 64 + fr, col0 = u.pn * BM + wc * 32 + 8 * fq;
#pragma unroll
        for (int ai = 0; ai < 2; ++ai)
#pragma unroll
            for (int m = 0; m < 4; ++m) { u32x4 gw[2];
#pragma unroll
                for (int bj = 0; bj < 2; ++bj) gw[bj] = *(const u32x4*)(p.proj() + (size_t)(row0 + ai * HALF + m * 16) * PJ + C_BR + u.z * DM + col0 + bj * HALF);
#pragma unroll
                for (int bj = 0; bj < 2; ++bj) { const u32x4 g = gw[bj]; const float g0[4] = {bf_lo(g.x), bf_hi(g.x), bf_lo(g.y), bf_hi(g.y)}, g1[4] = {bf_lo(g.z), bf_hi(g.z), bf_lo(g.w), bf_hi(g.w)};
#pragma unroll
                    for (int j = 0; j < 4; ++j) { acc[ai][bj][m][0][j] *= __builtin_amdgcn_rcpf(1.0f + __expf(-g0[j])); acc[ai][bj][m][1][j] *= __builtin_amdgcn_rcpf(1.0f + __expf(-g1[j])); } }
                asm volatile("" : "+v"(acc[ai][0][m][0]), "+v"(acc[ai][0][m][1]), "+v"(acc[ai][1][m][0]), "+v"(acc[ai][1][m][1]) :: "memory"); }
    }
    __device__ __forceinline__ void fused(f32x4 (&acc)[2][2][4][2], const Unit& u, int wr_, int wc_, int fr_, int fq_, PG8_LAS unsigned char* lds, int tid_) const {
        int tid = tid_; asm volatile("" : "+v"(tid));
        const int wid = __builtin_amdgcn_readfirstlane(tid >> 6), lane = tid & 63, wr = wid >> 2, wc = wid & 3, fr = lane & 15, fq = lane >> 4;
        if constexpr (MODE == 1) { gate_mul(acc, u, wr, wc, fr, fq); const float* s = slab(kh) + (size_t)tid * 4;
#pragma unroll
            for (int hh = 0; hh < 4; ++hh) { f32x4 t[8];
#pragma unroll
                for (int i = 0; i < 8; ++i) t[i] = *(const f32x4*)(s + (size_t)(hh * 8 + i) * 2048);
#pragma unroll
                for (int i = 0; i < 8; ++i) { const int q = hh * 8 + i; acc[q >> 4][(q >> 3) & 1][(q >> 1) & 3][q & 1] = acc[q >> 4][(q >> 3) & 1][(q >> 1) & 3][q & 1] + t[i]; }
#pragma unroll
                for (int i = 0; i < 8; i += 2) { const int q = hh * 8 + i; asm volatile("" : "+v"(acc[q >> 4][(q >> 3) & 1][(q >> 1) & 3][0]), "+v"(acc[q >> 4][(q >> 3) & 1][(q >> 1) & 3][1]) :: "memory"); } } }
        if (kh == 1) {
            float* s = slab(1) + (size_t)tid * 4;
#pragma unroll
            for (int i = 0; i < 32; ++i) st_wt16(s + (size_t)i * 2048, acc[i >> 4][(i >> 3) & 1][(i >> 1) & 3][i & 1]);
            asm volatile("s_waitcnt vmcnt(0)" ::: "memory");
            __syncthreads();
            if (tid == 0) __hip_atomic_store(flag(), 1u, __ATOMIC_RELAXED, __HIP_MEMORY_SCOPE_AGENT);
            return;
        }
        if (tid == 0) { unsigned sp = 0; while (__hip_atomic_load(flag(), __ATOMIC_RELAXED, __HIP_MEMORY_SCOPE_AGENT) == 0u) { __builtin_amdgcn_s_sleep(2); if (++sp > (1u << 22)) break; }
            __builtin_amdgcn_fence(__ATOMIC_ACQUIRE, "agent"); asm volatile("s_waitcnt vmcnt(0)" ::: "memory"); }
        __syncthreads();
        { const float* s = slab(1) + (size_t)tid * 4;
#pragma unroll
          for (int h = 0; h < 4; ++h) { f32x4 t[8];
#pragma unroll
              for (int i = 0; i < 8; ++i) t[i] = *(const f32x4*)(s + (size_t)(h * 8 + i) * 2048);
#pragma unroll
              for (int i = 0; i < 8; ++i) { const int q = h * 8 + i; acc[q >> 4][(q >> 3) & 1][(q >> 1) & 3][q & 1] = acc[q >> 4][(q >> 3) & 1][(q >> 1) & 3][q & 1] + t[i]; }
#pragma unroll
              for (int i = 0; i < 8; i += 2) { const int q = h * 8 + i; asm volatile("" : "+v"(acc[q >> 4][(q >> 3) & 1][(q >> 1) & 3][0]), "+v"(acc[q >> 4][(q >> 3) & 1][(q >> 1) & 3][1]) :: "memory"); } } }
        const int row0 = u.pm * BM + wr * 64 + fr;
        if constexpr (MODE == 1) {
            const int col0 = u.pn * BM + wc * 32 + 8 * fq;
#pragma unroll
            for (int ai = 0; ai < 2; ++ai)
#pragma unroll
                for (int m = 0; m < 4; ++m)
#pragma unroll
                    for (int bj = 0; bj < 2; ++bj) { const f32x4 v0 = acc[ai][bj][m][0], v1 = acc[ai][bj][m][1]; u32x4 w; w.x = cvt_pk_bf16(v0[0], v0[1]); w.y = cvt_pk_bf16(v0[2], v0[3]); w.z = cvt_pk_bf16(v1[0], v1[1]); w.w = cvt_pk_bf16(v1[2], v1[3]);
                        *(u32x4*)(p.merged() + (size_t)(row0 + ai * HALF + m * 16) * DM + col0 + bj * HALF) = w; }
        } else {
            const int col0 = u.pn * BM + wc * 32 + 4 * fq, ci = cond_of_row(u.pm * BM);
            const float* gt = p.mod() + ((size_t)l * 3 + ci) * 6 * DM + (MODE == 2 ? 2 : 5) * DM;
            f32x4 gv[2][2];
#pragma unroll
            for (int bj = 0; bj < 2; ++bj)
#pragma unroll
                for (int n = 0; n < 2; ++n) gv[bj][n] = *(const f32x4*)(gt + col0 + bj * HALF + n * 16);
            PG8_LAS float* Pp = (PG8_LAS float*)lds;
            PG8_LAS float* Rr = Pp + 1024;
#pragma unroll
            for (int am = 0; am < 4; ++am) { const int ai = am >> 1; f32x4 xv[2][2][2];
#pragma unroll
                for (int mm = 0; mm < 2; ++mm)
#pragma unroll
                    for (int bj = 0; bj < 2; ++bj)
#pragma unroll
                        for (int n = 0; n < 2; ++n) xv[mm][bj][n] = *(const f32x4*)(p.x() + (size_t)(row0 + ai * HALF + ((am & 1) * 2 + mm) * 16) * DM + col0 + bj * HALF + n * 16);
#pragma unroll
                for (int mm = 0; mm < 2; ++mm) { const int m = (am & 1) * 2 + mm; float s = 0.f;
#pragma unroll
                    for (int bj = 0; bj < 2; ++bj)
#pragma unroll
                        for (int n = 0; n < 2; ++n) { const f32x4 v = xv[mm][bj][n] + gv[bj][n] * acc[ai][bj][m][n]; acc[ai][bj][m][n] = v; s += v[0] * v[0] + v[1] * v[1] + v[2] * v[2] + v[3] * v[3]; }
                    s += __shfl_xor(s, 16, 64); s += __shfl_xor(s, 32, 64);
                    if (fq == 0) Pp[(ai * HALF + wr * 64 + m * 16 + fr) * 4 + wc] = s;
                    asm volatile("" : "+v"(acc[ai][0][m][0]), "+v"(acc[ai][0][m][1]), "+v"(acc[ai][1][m][0]), "+v"(acc[ai][1][m][1]) :: "memory"); } }
            asm volatile("" ::: "memory");
            const int kind = MODE == 2 ? 0 : 1;
            float* slots = p.ssq() + ((size_t)(kind * DEPTH + l) * NROW + (size_t)u.pm * BM) * 4;
            unsigned* cnt = p.cnt() + ((size_t)(kind * DEPTH + l) * (NROW / HALF) + u.pm) * 64;
            __syncthreads();
            if (tid < BM) { const float t = (Pp[tid * 4] + Pp[tid * 4 + 1]) + (Pp[tid * 4 + 2] + Pp[tid * 4 + 3]); __hip_atomic_store(slots + tid * 4 + u.pn, t, __ATOMIC_RELAXED, __HIP_MEMORY_SCOPE_AGENT); }
#pragma unroll
            for (int ai = 0; ai < 2; ++ai)
#pragma unroll
                for (int m = 0; m < 4; ++m)
#pragma unroll
                    for (int bj = 0; bj < 2; ++bj)
#pragma unroll
                        for (int n = 0; n < 2; ++n) *(f32x4*)(p.x() + (size_t)(row0 + ai * HALF + m * 16) * DM + col0 + bj * HALF + n * 16) = acc[ai][bj][m][n];
            asm volatile("s_waitcnt vmcnt(0)" ::: "memory");
            __syncthreads();
            if (tid == 0) { __hip_atomic_fetch_add(cnt, 1u, __ATOMIC_RELAXED, __HIP_MEMORY_SCOPE_AGENT);
                unsigned sp = 0; while (__hip_atomic_load(cnt, __ATOMIC_RELAXED, __HIP_MEMORY_SCOPE_AGENT) < (unsigned)(DM / BM)) { __builtin_amdgcn_s_sleep(2); if (++sp > (1u << 22)) break; }
                __builtin_amdgcn_fence(__ATOMIC_ACQUIRE, "agent"); asm volatile("s_waitcnt vmcnt(0)" ::: "memory"); }
            __syncthreads();
            if (tid < BM) { float t = 0.f;
#pragma unroll
                for (int q = 0; q < DM / BM; ++q) t += __hip_atomic_load(slots + tid * 4 + q, __ATOMIC_RELAXED, __HIP_MEMORY_SCOPE_AGENT);
                Rr[tid] = 1.0f / sqrtf(t * (1.0f / DM) + EPSF); }
            __syncthreads();
            const bool fin = (MODE == 4 && l == DEPTH - 1);
            const int ln = MODE == 2 ? l : l + 1;
            const float* gn = fin ? p.g_final() : (MODE == 2 ? p.g_norm2() : p.g_norm1()) + (size_t)ln * DM;
            const float* md = p.mod() + ((size_t)(fin ? 0 : ln) * 3 + ci) * 6 * DM + (MODE == 2 ? 3 * DM : 0);
#pragma unroll
            for (int bj = 0; bj < 2; ++bj)
#pragma unroll
                for (int n = 0; n < 2; ++n) { const int col = col0 + bj * HALF + n * 16; f32x4 gg = *(const f32x4*)(gn + col), sh = {0.f, 0.f, 0.f, 0.f};
                    if (!fin) { gg = gg * (*(const f32x4*)(md + DM + col) + 1.0f); sh = *(const f32x4*)(md + col); }
#pragma unroll
                    for (int ai = 0; ai < 2; ++ai)
#pragma unroll
                        for (int m = 0; m < 4; ++m) { const int r = ai * HALF + wr * 64 + m * 16 + fr; const f32x4 o = acc[ai][bj][m][n] * Rr[r] * gg + sh; const size_t off = (size_t)(u.pm * BM + r) * DM + col;
                            if (fin) *(f32x4*)(p.out + off) = o;
                            else { u32x2 w; w.x = cvt_pk_bf16(o[0], o[1]); w.y = cvt_pk_bf16(o[2], o[3]); *(u32x2*)(p.u() + off) = w; } } }
        }
    }
};
}
#endif
__device__ __forceinline__ void b_pool_d(const P& p, size_t i) {

    int c = i % DB; int r = i / DB; int g = c / GRP; int win = 2 << g;
    float self = PRJ(r, C_XP + c); float pooled;
    if (r < R_CTX) {
        int b = r / T_CTX, t = r % T_CTX; int lo = t - win / 2; if (lo < 0) lo = 0; int hi = t + (win - win / 2); if (hi > T_CTX) hi = T_CTX;
        float s = 0.f; for (int tt = lo; tt < hi; ++tt) s += PRJ(b * T_CTX + tt, C_XP + c);
        pooled = s / (float)(hi - lo);
    } else {
        int rr = r - R_CTX; int b = rr / T_LAT, t = rr % T_LAT; int gy = t / GRID_W, gx = t % GRID_W; const int rows = T_LAT / GRID_W;
        int xlo = gx - win / 2; if (xlo < 0) xlo = 0; int xhi = gx + (win - win / 2); if (xhi > GRID_W) xhi = GRID_W;
        int ylo = gy - win / 2; if (ylo < 0) ylo = 0; int yhi = gy + (win - win / 2); if (yhi > rows) yhi = rows;
        float s = 0.f;
        for (int yy = ylo; yy < yhi; ++yy) { float sx = 0.f; for (int xx = xlo; xx < xhi; ++xx) sx += PRJ(R_CTX + b * T_LAT + yy * GRID_W + xx, C_XP + c); s += sx / (float)(xhi - xlo); }
        pooled = s / (float)(yhi - ylo);
    }
    p.dbuf()[i] = pooled - self;
}
__device__ __forceinline__ void b_pool_y(const P& p, size_t i, int l) {

    int c = i % DB; size_t r = i / DB; int g = c / GRP, dd = c % GRP;
    const float* d = p.dbuf() + r * DB + g * GRP; const float* w = p.w_pool() + ((size_t)l * NG + g) * GRP * GRP + dd; float acc = 0.f;
    for (int k = 0; k < GRP; ++k) acc += d[k] * w[(size_t)k * GRP];
    p.ys()[r * 3 * DB + c] = f2bf(acc * p.pool_scale()[(size_t)l * DB + c]);
}
__device__ __forceinline__ void b_sgu_vn(const P& p, size_t r, int l) {

    float ss = 0.f;
    for (int k = 0; k < DB; ++k) { float v = PRJ(r, C_SV + k); ss += v * v; }
    float rs = 1.0f / sqrtf(ss / DB + EPSF);
    for (int k = 0; k < DB; ++k) p.vn()[r * DB + k] = PRJ(r, C_SV + k) * rs * p.g_sgu()[(size_t)l * DB + k];
}
__device__ __forceinline__ void b_sgu_y(const P& p, size_t i, int l) {

    int c = i % DB; int r = i / DB; int g = c / GRP; int pp = r % SGU_CHUNK; int r0 = r - pp;
    const float* w = p.w_sgu() + (((size_t)l * NG + g) * SGU_CHUNK + pp) * SGU_CHUNK; float acc = 0.f;
    for (int q = 0; q < SGU_CHUNK; ++q) acc += w[q] * p.vn()[(size_t)(r0 + q) * DB + c];
    acc += p.b_sgu()[((size_t)l * NG + g) * SGU_CHUNK + pp];
    p.ys()[(size_t)r * 3 * DB + DB + c] = f2bf(PRJ(r, C_SU + c) * acc);
}
#define IDX_DHR(dir, h, row) (((size_t)(dir) * NH + (h)) * NROW + (row))
#define IDX_DHC(dir, h, gc) (((size_t)(dir) * NH + (h)) * NCHK + (gc))
__device__ __forceinline__ void b_ml_gates(const P& p, size_t i, int l) {

    int gc = i % NCHK, h = (i / NCHK) % NH, dir = i / (NCHK * NH); int c0 = gc * LCH;
    float b = 0.f;
    for (int tau = 0; tau < LCH; ++tau) {
        int row = dir == 0 ? c0 + tau : c0 + LCH - 1 - tau;
        const float* gp = p.gate_pre() + (size_t)row * 16; const float* bg = p.b_gates() + (size_t)l * 4 * NH;
        float iv = gp[dir * NH + h] + bg[dir * NH + h];
        float fv = gp[2 * NH + dir * NH + h] + bg[2 * NH + dir * NH + h];
        b += logsigmoidf_(fv);
        p.bcum()[IDX_DHR(dir, h, row)] = b; p.ival()[IDX_DHR(dir, h, row)] = iv;
    }
    float bL = b, mx = -INFINITY;
    for (int tau = 0; tau < LCH; ++tau) { int row = c0 + tau; float a = bL - p.bcum()[IDX_DHR(dir, h, row)] + p.ival()[IDX_DHR(dir, h, row)]; mx = fmaxf(mx, a); }
    p.bL()[IDX_DHC(dir, h, gc)] = bL; p.Mloc()[IDX_DHC(dir, h, gc)] = mx;
}
__device__ __forceinline__ void b_ml_cloc(const P& p, size_t i) {

    int e = i % DH, d = (i / DH) % DH; size_t j = i / (DH * DH); int gc = j % NCHK, h = (j / NCHK) % NH, dir = j / (NCHK * NH); int c0 = gc * LCH;
    float bL = p.bL()[IDX_DHC(dir, h, gc)], ml = p.Mloc()[IDX_DHC(dir, h, gc)]; const float ksc = 1.0f / sqrtf((float)DH);
    float acc = 0.f, accn = 0.f;
    for (int s = 0; s < LCH; ++s) { int row = c0 + s;
        float w = expf(bL - p.bcum()[IDX_DHR(dir, h, row)] + p.ival()[IDX_DHR(dir, h, row)] - ml);
        float kv = PRJ(row, C_K + h * DH + d) * ksc;
        acc += w * kv * PRJ(row, C_V + h * DH + e); accn += w * kv; }
    p.Cloc()[i] = acc; if (e == 0) p.nloc()[j * DH + d] = accn;
}
__device__ __forceinline__ void b_ml_scan(const P& p, size_t i, int l) {

    int e = i % DH, d = (i / DH) % DH; size_t j = i / (DH * DH); int s = j % NSEQ, h = (j / NSEQ) % NH, dir = j / (NSEQ * NH);
    int gc0 = seq_start(s) / LCH, nc = seq_len(s) / LCH;
    float C, n, m;
    if (s < NB_CTX) { C = 0.f; n = 0.f; m = 0.f; }
    else { int b = s - NB_CTX; size_t base = (((size_t)b * DEPTH + l) * 2 + dir) * NH + h; C = p.state_C()[(base * DH + d) * DH + e]; n = p.state_n()[base * DH + d]; m = p.state_m()[base]; }
    for (int jj = 0; jj < nc; ++jj) {
        int gc = gc0 + (dir == 0 ? jj : nc - 1 - jj); size_t ci = IDX_DHC(dir, h, gc);
        float bL = p.bL()[ci], ml = p.Mloc()[ci]; float mnew = fmaxf(bL + m, ml); float dec = expf(bL + m - mnew), sc = expf(ml - mnew);
        size_t ce = (ci * DH + d) * DH + e; float cl = p.Cloc()[ce]; p.Cloc()[ce] = C; C = dec * C + sc * cl;
        if (e == 0) { float nl = p.nloc()[ci * DH + d]; p.nloc()[ci * DH + d] = n; n = dec * n + sc * nl; }
        if (e == 0 && d == 0) p.Mprev()[ci] = m;
        m = mnew;
    }
    if (s < NB_CTX) {
        size_t base = (((size_t)s * DEPTH + l) * 2 + dir) * NH + h;
        float* oC = p.out + (size_t)NROW * DM; float* on = oC + (size_t)NB_CTX * DEPTH * 2 * NH * DH * DH; float* om = on + (size_t)NB_CTX * DEPTH * 2 * NH * DH;
        oC[(base * DH + d) * DH + e] = C; if (e == 0) on[base * DH + d] = n; if (e == 0 && d == 0) om[base] = m;
    }
}
__device__ __forceinline__ void b_ml_mt(const P& p, size_t i) {

    int row = i % NROW, h = (i / NROW) % NH, dir = i / ((size_t)NROW * NH); int gc = row / LCH, c0 = gc * LCH;
    int tau = dir == 0 ? row - c0 : c0 + LCH - 1 - row;
    float bt = p.bcum()[IDX_DHR(dir, h, row)]; float mt = bt + p.Mprev()[IDX_DHC(dir, h, gc)];
    for (int ts = 0; ts <= tau; ++ts) { int rs = dir == 0 ? c0 + ts : c0 + LCH - 1 - ts; mt = fmaxf(mt, bt - p.bcum()[IDX_DHR(dir, h, rs)] + p.ival()[IDX_DHR(dir, h, rs)]); }
    p.MT()[i] = mt;
}
__device__ __forceinline__ void b_ml_s(const P& p, size_t i) {

    int ts = i % LCH, tt = (i / LCH) % LCH; size_t j = i / (LCH * LCH); int gc = j % NCHK, h = (j / NCHK) % NH, dir = j / (NCHK * NH); int c0 = gc * LCH;
    float val = 0.f;
    if (ts <= tt) {
        int rt = dir == 0 ? c0 + tt : c0 + LCH - 1 - tt, rs = dir == 0 ? c0 + ts : c0 + LCH - 1 - ts;
        float acc = 0.f;
        for (int d = 0; d < DH; ++d) acc += PRJ(rt, C_Q + h * DH + d) * PRJ(rs, C_K + h * DH + d);
        acc *= 1.0f / sqrtf((float)DH);
        float dm = p.bcum()[IDX_DHR(dir, h, rt)] - p.bcum()[IDX_DHR(dir, h, rs)] + p.ival()[IDX_DHR(dir, h, rs)];
        val = acc * expf(dm - p.MT()[IDX_DHR(dir, h, rt)]);
    }
    p.S()[i] = val;
}
__device__ __forceinline__ void b_ml_h(const P& p, size_t i) {

    int c = i % DB; int row = (i / DB) % NROW; int dir = i / ((size_t)DB * NROW); int h = c / DH, e = c % DH; int gc = row / LCH, c0 = gc * LCH;
    int tau = dir == 0 ? row - c0 : c0 + LCH - 1 - row; size_t ci = IDX_DHC(dir, h, gc);
    const float* Srow = p.S() + (ci * LCH + tau) * LCH;
    float num = 0.f, den = 0.f;
    for (int ts = 0; ts <= tau; ++ts) { int rs = dir == 0 ? c0 + ts : c0 + LCH - 1 - ts; float sv = Srow[ts]; num += sv * PRJ(rs, C_V + h * DH + e); den += sv; }
    float mt = p.MT()[IDX_DHR(dir, h, row)]; float winter = expf(p.bcum()[IDX_DHR(dir, h, row)] + p.Mprev()[ci] - mt);
    float qc = 0.f, qn = 0.f;
    for (int d = 0; d < DH; ++d) { float qv = PRJ(row, C_Q + h * DH + d); qc += qv * p.Cloc()[(ci * DH + d) * DH + e]; qn += qv * p.nloc()[ci * DH + d]; }
    num += winter * qc; den += winter * qn;
    p.hbuf()[i] = num / fmaxf(fabsf(den), expf(-mt));
}
__device__ __forceinline__ void b_ml_fin(const P& p, size_t i, int l) {

    int h = i % NH; size_t row = i / NH;
    const float* h0 = p.hbuf() + row * DB + h * DH; const float* h1 = p.hbuf() + ((size_t)NROW + row) * DB + h * DH; float ss = 0.f;
    for (int e = 0; e < DH; ++e) { float v = h0[e] + h1[e]; ss += v * v; }
    float rs = 1.0f / sqrtf(ss / DH + EPSF);
    for (int e = 0; e < DH; ++e) { float v = (h0[e] + h1[e]) * rs * p.g_mlstm()[(size_t)l * DB + h * DH + e];
        p.ys()[row * 3 * DB + 2 * DB + h * DH + e] = f2bf(sigmoidf_(PRJ(row, C_O + h * DH + e)) * v); }
}
__device__ __forceinline__ void b_final(const P& p, size_t r) {

    const float* xr = p.x() + r * DM; float ss = 0.f;
    for (int k = 0; k < DM; ++k) ss += xr[k] * xr[k];
    float rs = 1.0f / sqrtf(ss / DM + EPSF);
    for (int k = 0; k < DM; ++k) p.out[r * DM + k] = xr[k] * rs * p.g_final()[k];
}


#ifndef CPU_EMU
#define XB_TMO      128
#define XB_XCNT(j)  (256  + 64 * (j))
#define XB_XSUB(j)  (1280 + 64 * (j))
#define XB_XGEN(j)  (2304 + 64 * (j))
#define XB_TOP      3328
#define XB_TOPGEN   3392
#define XCD_BAR_WORDS 3456
#define XB_SPIN_CAP (1u << 22)
#define LAS __attribute__((address_space(3)))
__device__ __forceinline__ unsigned xb_ld(unsigned* p)              { return __hip_atomic_load(p, __ATOMIC_RELAXED, __HIP_MEMORY_SCOPE_AGENT); }
__device__ __forceinline__ unsigned xb_add(unsigned* p, unsigned v) { return __hip_atomic_fetch_add(p, v, __ATOMIC_RELAXED, __HIP_MEMORY_SCOPE_AGENT); }
__device__ __forceinline__ unsigned xb_xcc_id() { return (unsigned)__builtin_amdgcn_s_getreg((3 << 11) | 20) & 0xFu; }
#define XB_SPIN(cond, bar) do { unsigned _sp = 0; while (cond) { __builtin_amdgcn_s_sleep(1); \
    if ((++_sp & 255u) == 0u) { if (xb_ld(&(bar)[XB_TMO])) break; if (_sp > XB_SPIN_CAP) { atomicAdd(&(bar)[XB_TMO], 1u); break; } } } } while (0)
struct XcdBarrier { unsigned* bar; unsigned x; volatile LAS unsigned* st; };
__device__ __forceinline__ XcdBarrier xcd_barrier_post(unsigned* bar, volatile LAS unsigned* st) {
    XcdBarrier b; b.bar = bar; b.x = xb_xcc_id(); b.st = st;
    if (threadIdx.x == 0) (void)xb_add(&bar[XB_XCNT(b.x)], 1u);
    return b;
}
__device__ __forceinline__ void xcd_barrier_complete(unsigned* bar, unsigned x, unsigned& nloc, unsigned& nx) {
    const unsigned G = gridDim.x * gridDim.y * gridDim.z;
    unsigned sum, cnt, mine, sp = 0u;
    for (;;) {
        sum = 0u; cnt = 0u; mine = 0u;
#pragma unroll
        for (unsigned j = 0; j < 16; ++j) { const unsigned c = xb_ld(&bar[XB_XCNT(j)]); sum += c; cnt += (c > 0u) ? 1u : 0u; mine = (j == x) ? c : mine; }
        if (sum == G) break;
        __builtin_amdgcn_s_sleep(1);
        if ((++sp & 255u) == 0u) { if (xb_ld(&bar[XB_TMO])) break; if (sp > XB_SPIN_CAP) { atomicAdd(&bar[XB_TMO], 1u); break; } }
    }
    nloc = mine > 0u ? mine : 1u; nx = cnt > 0u ? cnt : 1u;
}
__device__ __forceinline__ void xcd_barrier(const XcdBarrier& b) {
    asm volatile("s_waitcnt vmcnt(0)" ::: "memory");
    __syncthreads();
    if (threadIdx.x == 0) {
        unsigned* bar = b.bar; asm volatile("" : "+s"(bar));
        __builtin_amdgcn_s_waitcnt(0);
        unsigned nloc = b.st[0], nx = b.st[1];
        if (nloc == 0u) { xcd_barrier_complete(bar, b.x, nloc, nx); b.st[0] = nloc; b.st[1] = nx; }
        const unsigned old = xb_add(&bar[XB_XSUB(b.x)], 1u);
        const unsigned gen = old / nloc;
        if (old + 1u == (gen + 1u) * nloc) {
            __builtin_amdgcn_fence(__ATOMIC_RELEASE, "agent");
            asm volatile("s_waitcnt vmcnt(0)" ::: "memory");
            const unsigned og = xb_add(&bar[XB_TOP], 1u);
            const unsigned tg = og / nx;
            if (og + 1u == (tg + 1u) * nx) xb_add(&bar[XB_TOPGEN], 1u);
            else XB_SPIN(xb_ld(&bar[XB_TOPGEN]) == tg, bar);
            __builtin_amdgcn_fence(__ATOMIC_ACQUIRE, "agent");
            xb_add(&bar[XB_XGEN(b.x)], 1u);
            asm volatile("s_waitcnt vmcnt(0)" ::: "memory");
        } else {
            XB_SPIN(xb_ld(&bar[XB_XGEN(b.x)]) == gen, bar);
            __builtin_amdgcn_fence(__ATOMIC_ACQUIRE, "agent");
            asm volatile("s_waitcnt vmcnt(0)" ::: "memory");
        }
    }
    __syncthreads();
}

#endif

#ifndef CPU_EMU
#define NTHR 512
typedef short bf16x8 __attribute__((ext_vector_type(8)));
typedef float f32x4 __attribute__((ext_vector_type(4)));
typedef unsigned u32x4 __attribute__((ext_vector_type(4)));
typedef unsigned u32x2 __attribute__((ext_vector_type(2)));
#define MFMA16(a, b, c) __builtin_amdgcn_mfma_f32_16x16x32_bf16(a, b, c, 0, 0, 0)
typedef __bf16 bf16x2_t __attribute__((ext_vector_type(2)));
__device__ __forceinline__ unsigned pk_bf16(float lo, float hi) { bf16x2_t v; v.x = (__bf16)lo; v.y = (__bf16)hi; return __builtin_bit_cast(unsigned, v); }
__device__ __forceinline__ float bflo(unsigned w) { return __uint_as_float(w << 16); }
__device__ __forceinline__ float bfhi(unsigned w) { return __uint_as_float(w & 0xffff0000u); }
__device__ __forceinline__ float wscan_add(float v, int lane, int dir) {
#pragma unroll
    for (int off = 1; off < 64; off <<= 1) { const float o = dir == 0 ? __shfl_up(v, off, 64) : __shfl_down(v, off, 64); if (dir == 0 ? (lane >= off) : (lane + off < 64)) v += o; }
    return v; }
__device__ __forceinline__ float wscan_max(float v, int lane, int dir) {
#pragma unroll
    for (int off = 1; off < 64; off <<= 1) { const float o = dir == 0 ? __shfl_up(v, off, 64) : __shfl_down(v, off, 64); if (dir == 0 ? (lane >= off) : (lane + off < 64)) v = fmaxf(v, o); }
    return v; }
__device__ __forceinline__ float wred_max(float v) {
#pragma unroll
    for (int off = 32; off >= 1; off >>= 1) v = fmaxf(v, __shfl_xor(v, off, 64));
    return v; }
__device__ __forceinline__ void gate_lane(const P& p, int l, int h, int row, int dir, int lane, float& b, float& g) {
    const float* gp = p.gate_pre() + (size_t)row * 16; const float* bg = p.b_gates() + (size_t)l * 4 * NH;
    const float iv = gp[dir * NH + h] + bg[dir * NH + h];
    const float fv = gp[2 * NH + dir * NH + h] + bg[2 * NH + dir * NH + h];
    b = wscan_add(logsigmoidf_(fv), lane, dir); g = iv - b;
}
#define ML_LD 72
template <bool WITH_K> __device__ __forceinline__ void ml_stage_T(const P& p, int h, int c0, int wave, int lane, LAS bf16_t* VT, LAS bf16_t* KT, const LAS float* wl) {
#pragma unroll
    for (int i = 0; i < 2; ++i) { const int d0 = (wave * 2 + i) * 8;
        const u32x4 vv = *(const u32x4*)(p.proj() + (size_t)(c0 + lane) * PJ + C_V + h * DH + d0);
        const unsigned vw[4] = {vv.x, vv.y, vv.z, vv.w};
#pragma unroll
        for (int j = 0; j < 4; ++j) { VT[(d0 + 2 * j) * ML_LD + lane] = (bf16_t)(vw[j] & 0xffffu); VT[(d0 + 2 * j + 1) * ML_LD + lane] = (bf16_t)(vw[j] >> 16); }
        if constexpr (WITH_K) {
            const u32x4 kv = *(const u32x4*)(p.proj() + (size_t)(c0 + lane) * PJ + C_K + h * DH + d0);
            const unsigned kw[4] = {kv.x, kv.y, kv.z, kv.w}; const float w0 = wl[lane], w1 = wl[64 + lane];
#pragma unroll
            for (int j = 0; j < 4; ++j) { const float a = bflo(kw[j]), b = bfhi(kw[j]);
                KT[(d0 + 2 * j) * ML_LD + lane] = f2bf(a * w0); KT[(d0 + 2 * j + 1) * ML_LD + lane] = f2bf(b * w0);
                KT[(DH + d0 + 2 * j) * ML_LD + lane] = f2bf(a * w1); KT[(DH + d0 + 2 * j + 1) * ML_LD + lane] = f2bf(b * w1); }
        } }
}
__device__ __forceinline__ void unit_ml_cloc(const P& p, int l, int unit, LAS unsigned char* lds) {
    int tid = threadIdx.x; asm volatile("" : "+v"(tid));
    const int wave = __builtin_amdgcn_readfirstlane(tid >> 6), lane = tid & 63, fr = lane & 15, fq = lane >> 4;
    const int h = unit % NH, gc = unit / NH, c0 = gc * LCH;
    LAS float* wl = (LAS float*)lds;
    LAS bf16_t* VT = (LAS bf16_t*)(lds + 512);
    LAS bf16_t* KT = VT + DH * ML_LD;
    if (wave < 2) { const int dir = wave; float b, g; gate_lane(p, l, h, c0 + lane, dir, lane, b, g);
        const float total = __shfl(b, dir == 0 ? 63 : 0, 64), gmax = wred_max(g);
        wl[dir * 64 + lane] = expf(g - gmax) * 0.08838834764831845f;
        const float pm = wscan_max(g, lane, dir); float* gs = p.gsc() + IDX_DHR(dir, h, c0 + lane); gs[0] = b; gs[(size_t)2 * NH * NROW] = g; gs[(size_t)4 * NH * NROW] = pm;
        if (lane == 0) { p.bL()[IDX_DHC(dir, h, gc)] = total; p.Mloc()[IDX_DHC(dir, h, gc)] = total + gmax; } }
    __syncthreads();
    ml_stage_T<true>(p, h, c0, wave, lane, VT, KT, wl);
    __syncthreads();
    if (tid < 256) { const int dir = tid >> 7, d = tid & 127; float s = 0.f; const LAS bf16_t* r = KT + (dir * DH + d) * ML_LD;
#pragma unroll 8
        for (int j = 0; j < 64; ++j) s += bf2f(r[j]);
        p.nloc()[IDX_DHC(dir, h, gc) * DH + d] = s; }
    { const int e = tid >> 2, sg = (tid & 3) * 16; const LAS bf16_t* r = VT + e * ML_LD + sg; bf16_t* o = p.VTg() + ((size_t)(h * NCHK + gc) * DH + e) * LCH + sg;
      *(u32x4*)o = *(const LAS u32x4*)r; *(u32x4*)(o + 8) = *(const LAS u32x4*)(r + 8); }
#pragma unroll 1
    for (int dir = 0; dir < 2; ++dir) {
        f32x4 acc[8];
#pragma unroll
        for (int i = 0; i < 8; ++i) acc[i] = (f32x4){0.f, 0.f, 0.f, 0.f};
#pragma unroll
        for (int ks = 0; ks < 2; ++ks) { const bf16x8 a = *(const LAS bf16x8*)(VT + (16 * wave + fr) * ML_LD + 32 * ks + 8 * fq);
#pragma unroll
            for (int dt = 0; dt < 8; ++dt) { const bf16x8 b = *(const LAS bf16x8*)(KT + (dir * DH + 16 * dt + fr) * ML_LD + 32 * ks + 8 * fq); acc[dt] = MFMA16(b, a, acc[dt]); } }
        bf16_t* o = (bf16_t*)p.Cloc() + (IDX_DHC(dir, h, gc) * DH + 16 * wave + fr) * DH + 4 * fq;
#pragma unroll
        for (int dt = 0; dt < 8; ++dt) { u32x2 w; w.x = pk_bf16(acc[dt][0], acc[dt][1]); w.y = pk_bf16(acc[dt][2], acc[dt][3]); *(u32x2*)(o + 16 * dt) = w; }
    }
    __syncthreads();
}
struct ScanItem { int e, d, dir, h, sl; };
template <bool CTX> __device__ __forceinline__ ScanItem scan_decode(size_t i) { constexpr int NS = CTX ? NB_CTX : NB_LAT; ScanItem s; s.d = (int)(i % (DH / 4)) * 4; s.e = (int)((i / (DH / 4)) % DH); const size_t j = i / ((size_t)DH * DH / 4); s.sl = (int)(j % NS); s.h = (int)((j / NS) % NH); s.dir = (int)(j / (NS * NH)); return s; }
template <int NC, bool CTX> __device__ __forceinline__ void scan_load(const P& p, const ScanItem& it, u32x2 (&cl)[NC], float (&bLv)[NC], float (&mlv)[NC]) {
    const int gc0 = seq_start(CTX ? it.sl : NB_CTX + it.sl) / LCH;
#pragma unroll
    for (int jj = 0; jj < NC; ++jj) { const int gc = gc0 + (it.dir == 0 ? jj : NC - 1 - jj); const size_t ci = IDX_DHC(it.dir, it.h, gc);
        bLv[jj] = p.bL()[ci]; mlv[jj] = p.Mloc()[ci]; cl[jj] = *(const u32x2*)((const bf16_t*)p.Cloc() + (ci * DH + it.e) * DH + it.d); }
}
template <int NC, bool CTX> __device__ __forceinline__ void scan_run(const P& p, int l, const ScanItem& it, const u32x2 (&cl)[NC], const float (&bLv)[NC], const float (&mlv)[NC], f32x4& C, f32x4& n, float& m) {
    const int gc0 = seq_start(CTX ? it.sl : NB_CTX + it.sl) / LCH; const int e = it.e, d = it.d;
#pragma unroll
    for (int jj = 0; jj < NC; ++jj) {
        const int gc = gc0 + (it.dir == 0 ? jj : NC - 1 - jj); const size_t ci = IDX_DHC(it.dir, it.h, gc);
        const float mnew = fmaxf(bLv[jj] + m, mlv[jj]); const float dec = __expf(bLv[jj] + m - mnew), sc = __expf(mlv[jj] - mnew);
        u32x2 w; w.x = pk_bf16(C[0], C[1]); w.y = pk_bf16(C[2], C[3]); *(u32x2*)(p.CprevT() + (ci * DH + e) * DH + d) = w;
        C = dec * C + sc * (f32x4){bflo(cl[jj].x), bfhi(cl[jj].x), bflo(cl[jj].y), bfhi(cl[jj].y)};
        if (e == 0) { const f32x4 nl = *(const f32x4*)(p.nloc() + ci * DH + d); *(f32x4*)(p.nprev() + ci * DH + d) = n; n = dec * n + sc * nl; }
        if (e == 0 && d == 0) p.Mprev()[ci] = m;
        m = mnew;
    }
}
__device__ __forceinline__ void phase_scan(const P& p, int l, LAS unsigned char* lds) {
    int t_ = threadIdx.x; asm volatile("" : "+v"(t_));
    const size_t gtid = (size_t)blockIdx.x * NTHR + t_, nthr = (size_t)gridDim.x * NTHR;
    constexpr size_t NLAT = (size_t)2 * NH * NB_LAT * DH * (DH / 4); constexpr int NCL = T_LAT / LCH;
    for (size_t i = gtid; i < NLAT; i += nthr) { const ScanItem it = scan_decode<false>(i); u32x2 cl[NCL]; float bLv[NCL], mlv[NCL]; scan_load<NCL, false>(p, it, cl, bLv, mlv);
        const size_t base = (((size_t)it.sl * DEPTH + l) * 2 + it.dir) * NH + it.h; f32x4 C, n = {0.f, 0.f, 0.f, 0.f};
#pragma unroll
        for (int q = 0; q < 4; ++q) C[q] = p.state_C()[(base * DH + it.d + q) * DH + it.e];
        if (it.e == 0) n = *(const f32x4*)(p.state_n() + base * DH + it.d);
        float m = p.state_m()[base];
        asm volatile("" ::: "memory"); scan_run<NCL, false>(p, l, it, cl, bLv, mlv, C, n, m); }
}
__device__ __forceinline__ void unit_ml_out(const P& p, int l, int unit, LAS unsigned char* lds) {
    int tid = threadIdx.x; asm volatile("" : "+v"(tid));
    const int wave = __builtin_amdgcn_readfirstlane(tid >> 6), lane = tid & 63, fr = lane & 15, fq = lane >> 4;
    const int h = unit % NH, gc = unit / NH, c0 = gc * LCH;
    LAS float* ssq = (LAS float*)lds;
    LAS bf16_t* VT = (LAS bf16_t*)(lds + 1024);
    LAS bf16_t* SS = VT + DH * ML_LD;
    const bf16_t* Q = p.proj() + (size_t)c0 * PJ + C_Q + h * DH; const bf16_t* K = p.proj() + (size_t)c0 * PJ + C_K + h * DH;
    const int tt = wave & 3, wh = wave >> 2, t = 16 * tt + fr; const size_t row = (size_t)c0 + t;
    bf16x8 qf[4], kf[2][4], cf0[4][4], cf1[4][4];
#pragma unroll
    for (int ks = 0; ks < 4; ++ks) { qf[ks] = *(const bf16x8*)(Q + (size_t)t * PJ + 32 * ks + 8 * fq);
#pragma unroll
        for (int i = 0; i < 2; ++i) kf[i][ks] = *(const bf16x8*)(K + (size_t)(16 * (2 * wh + i) + fr) * PJ + 32 * ks + 8 * fq); }
    { const bf16_t* CT0 = p.CprevT() + IDX_DHC(0, h, gc) * DH * DH;
#pragma unroll
      for (int ks = 0; ks < 4; ++ks)
#pragma unroll
          for (int i = 0; i < 4; ++i) cf0[i][ks] = *(const bf16x8*)(CT0 + (size_t)(16 * (4 * wh + i) + fr) * DH + 32 * ks + 8 * fq); }
    { const int e = tid >> 2, sg = (tid & 3) * 16; const bf16_t* o = p.VTg() + ((size_t)(h * NCHK + gc) * DH + e) * LCH + sg; const u32x4 v0 = *(const u32x4*)o, v1 = *(const u32x4*)(o + 8);
      *(LAS u32x4*)(VT + e * ML_LD + sg) = v0; *(LAS u32x4*)(VT + e * ML_LD + sg + 8) = v1; }
    float rowterm[2], winter[2], emt[2], qn[2]; f32x4 colterm[2][2];
#pragma unroll
    for (int dir = 0; dir < 2; ++dir) { const float* gs = p.gsc() + IDX_DHR(dir, h, row); const float bt = gs[0], pmt = gs[(size_t)4 * NH * NROW]; const float mprev = p.Mprev()[IDX_DHC(dir, h, gc)];
        const float mt = bt + fmaxf(mprev, pmt); rowterm[dir] = bt - mt; winter[dir] = __expf(bt + mprev - mt); emt[dir] = __expf(-mt);
#pragma unroll
        for (int i = 0; i < 2; ++i) colterm[dir][i] = *(const f32x4*)(p.gsc() + (size_t)2 * NH * NROW + IDX_DHR(dir, h, c0 + 16 * (2 * wh + i) + 4 * fq));
        const float* np = p.nprev() + IDX_DHC(dir, h, gc) * DH + 8 * fq; float s = 0.f;
#pragma unroll
        for (int ks = 0; ks < 4; ++ks) { const f32x4 n0 = *(const f32x4*)(np + 32 * ks), n1 = *(const f32x4*)(np + 32 * ks + 4); const u32x4 qv = __builtin_bit_cast(u32x4, qf[ks]);
            s += bflo(qv.x) * n0[0] + bfhi(qv.x) * n0[1] + bflo(qv.y) * n0[2] + bfhi(qv.y) * n0[3] + bflo(qv.z) * n1[0] + bfhi(qv.z) * n1[1] + bflo(qv.w) * n1[2] + bfhi(qv.w) * n1[3]; }
        s += __shfl_xor(s, 16, 64); s += __shfl_xor(s, 32, 64); qn[dir] = s; asm volatile("" : "+v"(qn[dir]) :: "memory"); }
    {
        f32x4 sc[2] = {{0.f, 0.f, 0.f, 0.f}, {0.f, 0.f, 0.f, 0.f}};
#pragma unroll
        for (int ks = 0; ks < 4; ++ks)
#pragma unroll
            for (int i = 0; i < 2; ++i) sc[i] = MFMA16(kf[i][ks], qf[ks], sc[i]);
#pragma unroll
        for (int dir = 0; dir < 2; ++dir) {
#pragma unroll
            for (int i = 0; i < 2; ++i) { const int s0 = 16 * (2 * wh + i) + 4 * fq; float v[4];
#pragma unroll
                for (int j = 0; j < 4; ++j) { const int s = s0 + j; const bool ok = dir == 0 ? (s <= t) : (s >= t); v[j] = ok ? sc[i][j] * 0.08838834764831845f * __expf(rowterm[dir] + colterm[dir][i][j]) : 0.f; }
                u32x2 w; w.x = pk_bf16(v[0], v[1]); w.y = pk_bf16(v[2], v[3]); *(LAS u32x2*)(SS + (dir * 64 + t) * ML_LD + s0) = w; } }
    }
    asm volatile("" ::: "memory");
    { const bf16_t* CT1 = p.CprevT() + IDX_DHC(1, h, gc) * DH * DH;
#pragma unroll
      for (int ks = 0; ks < 4; ++ks)
#pragma unroll
          for (int i = 0; i < 4; ++i) cf1[i][ks] = *(const bf16x8*)(CT1 + (size_t)(16 * (4 * wh + i) + fr) * DH + 32 * ks + 8 * fq); }
    u32x2 ow[4];
#pragma unroll
    for (int i = 0; i < 4; ++i) ow[i] = *(const u32x2*)(p.proj() + row * PJ + C_O + h * DH + 16 * (4 * wh + i) + 4 * fq);
    __syncthreads();
    f32x4 hs[4];
#pragma unroll
    for (int i = 0; i < 4; ++i) hs[i] = (f32x4){0.f, 0.f, 0.f, 0.f};
#pragma unroll
    for (int dir = 0; dir < 2; ++dir) {
        f32x4 a1[4], a2[4];
#pragma unroll
        for (int i = 0; i < 4; ++i) { a1[i] = (f32x4){0.f, 0.f, 0.f, 0.f}; a2[i] = (f32x4){0.f, 0.f, 0.f, 0.f}; }
        const LAS bf16_t* Sd = SS + dir * 64 * ML_LD;
#pragma unroll
        for (int ks = 0; ks < 2; ++ks) { const bf16x8 sf = *(const LAS bf16x8*)(Sd + t * ML_LD + 32 * ks + 8 * fq);
#pragma unroll
            for (int i = 0; i < 4; ++i) { const bf16x8 vf = *(const LAS bf16x8*)(VT + (16 * (4 * wh + i) + fr) * ML_LD + 32 * ks + 8 * fq); a1[i] = MFMA16(vf, sf, a1[i]); } }
#pragma unroll
        for (int ks = 0; ks < 4; ++ks)
#pragma unroll
            for (int i = 0; i < 4; ++i) a2[i] = MFMA16(dir == 0 ? cf0[i][ks] : cf1[i][ks], qf[ks], a2[i]);
        float rs = 0.f;
        { const u32x4 s0 = *(const LAS u32x4*)(Sd + t * ML_LD + 16 * fq), s1 = *(const LAS u32x4*)(Sd + t * ML_LD + 16 * fq + 8);
            rs = bflo(s0.x) + bfhi(s0.x) + bflo(s0.y) + bfhi(s0.y) + bflo(s0.z) + bfhi(s0.z) + bflo(s0.w) + bfhi(s0.w) + bflo(s1.x) + bfhi(s1.x) + bflo(s1.y) + bfhi(s1.y) + bflo(s1.z) + bfhi(s1.z) + bflo(s1.w) + bfhi(s1.w); }
        rs += __shfl_xor(rs, 16, 64); rs += __shfl_xor(rs, 32, 64);
        const float wi = winter[dir]; const float den = rs + wi * qn[dir]; const float inv = 1.0f / fmaxf(fabsf(den), emt[dir]);
#pragma unroll
        for (int i = 0; i < 4; ++i) hs[i] = hs[i] + (a1[i] + wi * a2[i]) * inv;
    }
    f32x4 gm[4];
#pragma unroll
    for (int i = 0; i < 4; ++i) gm[i] = *(const f32x4*)(p.g_mlstm() + (size_t)l * DB + h * DH + 16 * (4 * wh + i) + 4 * fq);
    float q2 = 0.f;
#pragma unroll
    for (int i = 0; i < 4; ++i) q2 += hs[i][0] * hs[i][0] + hs[i][1] * hs[i][1] + hs[i][2] * hs[i][2] + hs[i][3] * hs[i][3];
    q2 += __shfl_xor(q2, 16, 64); q2 += __shfl_xor(q2, 32, 64);
    if (fq == 0) ssq[wh * 64 + t] = q2;
    __syncthreads();
    const float rstd = 1.0f / sqrtf((ssq[t] + ssq[64 + t]) * (1.0f / DH) + EPSF);
#pragma unroll
    for (int i = 0; i < 4; ++i) { const int e = 16 * (4 * wh + i) + 4 * fq;
        const float o0 = bflo(ow[i].x), o1 = bfhi(ow[i].x), o2 = bflo(ow[i].y), o3 = bfhi(ow[i].y);
        const float y0 = hs[i][0] * rstd * gm[i][0] * __builtin_amdgcn_rcpf(1.0f + __expf(-o0)), y1 = hs[i][1] * rstd * gm[i][1] * __builtin_amdgcn_rcpf(1.0f + __expf(-o1)), y2 = hs[i][2] * rstd * gm[i][2] * __builtin_amdgcn_rcpf(1.0f + __expf(-o2)), y3 = hs[i][3] * rstd * gm[i][3] * __builtin_amdgcn_rcpf(1.0f + __expf(-o3));
        u32x2 w; w.x = pk_bf16(y0, y1); w.y = pk_bf16(y2, y3); *(u32x2*)(p.ys() + row * 3 * DB + 2 * DB + h * DH + e) = w; }
    __syncthreads();
}
#endif
#ifndef CPU_EMU
#define SQ_LD 136
__device__ __forceinline__ void unit_ml_seq(const P& p, int l, int unit, LAS unsigned char* lds) {
    int tid = threadIdx.x; asm volatile("" : "+v"(tid));
    const int wave = __builtin_amdgcn_readfirstlane(tid >> 6), lane = tid & 63, fr = lane & 15, fq = lane >> 4;
    const int dir = unit & 1, h = (unit >> 1) & (NH - 1), b = unit / (2 * NH), r0 = b * T_CTX;
    constexpr int NCQ = T_CTX / LCH;
    LAS float* nst = (LAS float*)lds;
    LAS float* DEC = nst + 256;
    LAS float* GB = (LAS float*)(lds + 2048);
    LAS float* GG = GB + NCQ * 64;
    LAS float* GP = GG + NCQ * 64;
    LAS float* EM = GP + NCQ * 64;
    LAS float* WS = EM + NCQ * 64;
    LAS float* GT = WS + NCQ * 64; LAS float* GM = GT + NCQ;
    LAS bf16_t* VT = (LAS bf16_t*)(lds + 8192);
    LAS bf16_t* KT = VT + DH * ML_LD;
    LAS bf16_t* SS = KT + DH * ML_LD;
    LAS bf16_t* CTl = SS + 64 * ML_LD;
    const int tt = wave & 3, wh = wave >> 2, t = 16 * tt + fr;
    f32x4 cacc[8];
#pragma unroll
    for (int i = 0; i < 8; ++i) cacc[i] = (f32x4){0.f, 0.f, 0.f, 0.f};
    if (tid < DH) nst[tid] = 0.f;
    float* hb = p.hbc() + ((size_t)dir * R_CTX) * DB + h * DH;
    if (wave < NCQ) { const int jo = dir == 0 ? wave : NCQ - 1 - wave; float bb, g; gate_lane(p, l, h, r0 + jo * LCH + lane, dir, lane, bb, g);
        const float pm = wscan_max(g, lane, dir), total = __shfl(bb, dir == 0 ? 63 : 0, 64), gmax = wred_max(g);
        GB[wave * 64 + lane] = bb; GG[wave * 64 + lane] = g; GP[wave * 64 + lane] = pm; if (lane == 0) { GT[wave] = total; GM[wave] = gmax; } }
    bf16x8 qf[4], kf[2][4]; u32x4 kvr[2], vvr[2];
#define SQ_LOAD(jj_) do { const int jo_ = dir == 0 ? (jj_) : NCQ - 1 - (jj_), c0_ = r0 + jo_ * LCH; const bf16_t* Q_ = p.proj() + (size_t)c0_ * PJ + C_Q + h * DH; const bf16_t* K_ = p.proj() + (size_t)c0_ * PJ + C_K + h * DH; \
        _Pragma("unroll") for (int ks = 0; ks < 4; ++ks) { qf[ks] = *(const bf16x8*)(Q_ + (size_t)t * PJ + 32 * ks + 8 * fq); \
            _Pragma("unroll") for (int i = 0; i < 2; ++i) kf[i][ks] = *(const bf16x8*)(K_ + (size_t)(16 * (2 * wh + i) + fr) * PJ + 32 * ks + 8 * fq); } \
        _Pragma("unroll") for (int i = 0; i < 2; ++i) { const int d0 = (wave * 2 + i) * 8; kvr[i] = *(const u32x4*)(p.proj() + (size_t)(c0_ + lane) * PJ + C_K + h * DH + d0); vvr[i] = *(const u32x4*)(p.proj() + (size_t)(c0_ + lane) * PJ + C_V + h * DH + d0); } } while (0)
    SQ_LOAD(0);
    __syncthreads();
    if (wave == 0) { float mm = 0.f;
#pragma unroll
        for (int jj = 0; jj < NCQ; ++jj) { const float bb = GB[jj * 64 + lane], g = GG[jj * 64 + lane], pm = GP[jj * 64 + lane], total = GT[jj], gmax = GM[jj];
            const float mt = bb + fmaxf(mm, pm), mnew = total + fmaxf(mm, gmax);
            GB[jj * 64 + lane] = bb - mt; GP[jj * 64 + lane] = __expf(bb + mm - mt); EM[jj * 64 + lane] = __expf(-mt); WS[jj * 64 + lane] = __expf(total + g - mnew) * 0.08838834764831845f;
            if (lane == 0) DEC[jj] = __expf(total + mm - mnew);
            mm = mnew; }
        if (lane == 0) DEC[NCQ] = mm; }
    __syncthreads();
#pragma unroll 1
    for (int jj = 0; jj < NCQ; ++jj) {
        const int jo = dir == 0 ? jj : NCQ - 1 - jj, c0 = r0 + jo * LCH;
        { const float w0 = WS[jj * 64 + lane];
#pragma unroll
          for (int i = 0; i < 2; ++i) { const int d0 = (wave * 2 + i) * 8; const unsigned vw[4] = {vvr[i].x, vvr[i].y, vvr[i].z, vvr[i].w}, kw[4] = {kvr[i].x, kvr[i].y, kvr[i].z, kvr[i].w};
#pragma unroll
              for (int j = 0; j < 4; ++j) { VT[(d0 + 2 * j) * ML_LD + lane] = (bf16_t)(vw[j] & 0xffffu); VT[(d0 + 2 * j + 1) * ML_LD + lane] = (bf16_t)(vw[j] >> 16);
                  KT[(d0 + 2 * j) * ML_LD + lane] = f2bf(bflo(kw[j]) * w0); KT[(d0 + 2 * j + 1) * ML_LD + lane] = f2bf(bfhi(kw[j]) * w0); } } }
#pragma unroll
        for (int dt = 0; dt < 8; ++dt) { u32x2 w; w.x = pk_bf16(cacc[dt][0], cacc[dt][1]); w.y = pk_bf16(cacc[dt][2], cacc[dt][3]); *(LAS u32x2*)(CTl + (16 * wave + fr) * SQ_LD + 16 * dt + 4 * fq) = w; }
        {
            f32x4 sc[2] = {{0.f, 0.f, 0.f, 0.f}, {0.f, 0.f, 0.f, 0.f}};
#pragma unroll
            for (int ks = 0; ks < 4; ++ks)
#pragma unroll
                for (int i = 0; i < 2; ++i) sc[i] = MFMA16(kf[i][ks], qf[ks], sc[i]);
            const float rt = GB[jj * 64 + t];
#pragma unroll
            for (int i = 0; i < 2; ++i) { const int s0 = 16 * (2 * wh + i) + 4 * fq; float v[4];
#pragma unroll
                for (int j = 0; j < 4; ++j) { const int s = s0 + j; const bool ok = dir == 0 ? (s <= t) : (s >= t); v[j] = ok ? sc[i][j] * 0.08838834764831845f * __expf(rt + GG[jj * 64 + s]) : 0.f; }
                u32x2 w; w.x = pk_bf16(v[0], v[1]); w.y = pk_bf16(v[2], v[3]); *(LAS u32x2*)(SS + t * ML_LD + s0) = w; }
        }
        __syncthreads();
        {
            f32x4 a1[4], a2[4];
#pragma unroll
            for (int i = 0; i < 4; ++i) { a1[i] = (f32x4){0.f, 0.f, 0.f, 0.f}; a2[i] = (f32x4){0.f, 0.f, 0.f, 0.f}; }
#pragma unroll
            for (int ks = 0; ks < 2; ++ks) { const bf16x8 sf = *(const LAS bf16x8*)(SS + t * ML_LD + 32 * ks + 8 * fq);
#pragma unroll
                for (int i = 0; i < 4; ++i) { const bf16x8 vf = *(const LAS bf16x8*)(VT + (16 * (4 * wh + i) + fr) * ML_LD + 32 * ks + 8 * fq); a1[i] = MFMA16(vf, sf, a1[i]); } }
#pragma unroll
            for (int ks = 0; ks < 4; ++ks)
#pragma unroll
                for (int i = 0; i < 4; ++i) { const bf16x8 cf = *(const LAS bf16x8*)(CTl + (16 * (4 * wh + i) + fr) * SQ_LD + 32 * ks + 8 * fq); a2[i] = MFMA16(cf, qf[ks], a2[i]); }
            float qn = 0.f;
#pragma unroll
            for (int ks = 0; ks < 4; ++ks) { const LAS float* np = nst + (jj & 1) * DH + 32 * ks + 8 * fq; const f32x4 n0 = *(const LAS f32x4*)np, n1 = *(const LAS f32x4*)(np + 4); const u32x4 qv = __builtin_bit_cast(u32x4, qf[ks]);
                qn += bflo(qv.x) * n0[0] + bfhi(qv.x) * n0[1] + bflo(qv.y) * n0[2] + bfhi(qv.y) * n0[3] + bflo(qv.z) * n1[0] + bfhi(qv.z) * n1[1] + bflo(qv.w) * n1[2] + bfhi(qv.w) * n1[3]; }
            qn += __shfl_xor(qn, 16, 64); qn += __shfl_xor(qn, 32, 64);
            if (jj + 1 < NCQ) SQ_LOAD(jj + 1);
            float rs = 0.f;
            { const u32x4 s0 = *(const LAS u32x4*)(SS + t * ML_LD + 16 * fq), s1 = *(const LAS u32x4*)(SS + t * ML_LD + 16 * fq + 8);
                rs = bflo(s0.x) + bfhi(s0.x) + bflo(s0.y) + bfhi(s0.y) + bflo(s0.z) + bfhi(s0.z) + bflo(s0.w) + bfhi(s0.w) + bflo(s1.x) + bfhi(s1.x) + bflo(s1.y) + bfhi(s1.y) + bflo(s1.z) + bfhi(s1.z) + bflo(s1.w) + bfhi(s1.w); }
            rs += __shfl_xor(rs, 16, 64); rs += __shfl_xor(rs, 32, 64);
            const float wi = GP[jj * 64 + t]; const float den = rs + wi * qn; const float inv = 1.0f / fmaxf(fabsf(den), EM[jj * 64 + t]);
            float* ho = hb + (size_t)(c0 + t) * DB + 4 * fq;
#pragma unroll
            for (int i = 0; i < 4; ++i) *(f32x4*)(ho + 16 * (4 * wh + i)) = (a1[i] + wi * a2[i]) * inv;
        }
        const float decay = DEC[jj];
#pragma unroll
        for (int dt = 0; dt < 8; ++dt) cacc[dt] = cacc[dt] * decay;
#pragma unroll
        for (int ks = 0; ks < 2; ++ks) { const bf16x8 a = *(const LAS bf16x8*)(VT + (16 * wave + fr) * ML_LD + 32 * ks + 8 * fq);
#pragma unroll
            for (int dt = 0; dt < 8; ++dt) { const bf16x8 bb = *(const LAS bf16x8*)(KT + (16 * dt + fr) * ML_LD + 32 * ks + 8 * fq); cacc[dt] = MFMA16(bb, a, cacc[dt]); } }
        if (tid < DH) { float s = 0.f; const LAS bf16_t* r = KT + tid * ML_LD;
#pragma unroll
            for (int j4 = 0; j4 < 8; ++j4) { const u32x4 v = *(const LAS u32x4*)(r + 8 * j4); s += (bflo(v.x) + bfhi(v.x)) + (bflo(v.y) + bfhi(v.y)) + (bflo(v.z) + bfhi(v.z)) + (bflo(v.w) + bfhi(v.w)); }
            nst[((jj + 1) & 1) * DH + tid] = decay * nst[(jj & 1) * DH + tid] + s; }
        __syncthreads();
    }
#undef SQ_LOAD
    __syncthreads();
    { LAS float* T = (LAS float*)(lds + 8192);
#pragma unroll
      for (int dt = 0; dt < 8; ++dt)
#pragma unroll
          for (int j = 0; j < 4; ++j) T[(16 * wave + fr) * 129 + 16 * dt + 4 * fq + j] = cacc[dt][j];
      __syncthreads();
      const size_t base = (((size_t)b * DEPTH + l) * 2 + dir) * NH + h;
      float* oC = p.out + (size_t)NROW * DM; float* on = oC + (size_t)NB_CTX * DEPTH * 2 * NH * DH * DH; float* om = on + (size_t)NB_CTX * DEPTH * 2 * NH * DH;
      const int d = tid >> 2, es = (tid & 3) * 32;
#pragma unroll
      for (int k = 0; k < 8; ++k) { f32x4 v; v[0] = T[(es + 4 * k) * 129 + d]; v[1] = T[(es + 4 * k + 1) * 129 + d]; v[2] = T[(es + 4 * k + 2) * 129 + d]; v[3] = T[(es + 4 * k + 3) * 129 + d];
          *(f32x4*)(oC + (base * DH + d) * DH + es + 4 * k) = v; }
      if (tid < DH) on[base * DH + tid] = nst[(NCQ & 1) * DH + tid];
      if (tid == 0) om[base] = DEC[NCQ]; }
    __syncthreads();
}
__device__ __forceinline__ void phase_ctx_fin(const P& p, int l, int cu, int ncu) {
    int tid = threadIdx.x; asm volatile("" : "+v"(tid));
    const int wave = tid >> 6, lane = tid & 63, c = 8 * lane;
    const f32x4 g0 = *(const f32x4*)(p.g_mlstm() + (size_t)l * DB + c), g1 = *(const f32x4*)(p.g_mlstm() + (size_t)l * DB + c + 4);
    for (int r = (cu * 8 + wave) * 2; r < R_CTX; r += ncu * 16) {
        f32x4 v[2][2]; u32x4 ow[2];
#pragma unroll
        for (int k = 0; k < 2; ++k) { const float* h0 = p.hbc() + (size_t)(r + k) * DB + c; const float* h1 = h0 + (size_t)R_CTX * DB;
            v[k][0] = *(const f32x4*)h0 + *(const f32x4*)h1; v[k][1] = *(const f32x4*)(h0 + 4) + *(const f32x4*)(h1 + 4); ow[k] = *(const u32x4*)(p.proj() + (size_t)(r + k) * PJ + C_O + c); }
#pragma unroll
        for (int k = 0; k < 2; ++k) { float ss = 0.f;
#pragma unroll
            for (int j = 0; j < 4; ++j) ss += v[k][0][j] * v[k][0][j] + v[k][1][j] * v[k][1][j];
            ss += __shfl_xor(ss, 1, 64); ss += __shfl_xor(ss, 2, 64); ss += __shfl_xor(ss, 4, 64); ss += __shfl_xor(ss, 8, 64);
            const float rs = 1.0f / sqrtf(ss * (1.0f / DH) + EPSF); const u32x4 o = ow[k]; const float og[8] = {bflo(o.x), bfhi(o.x), bflo(o.y), bfhi(o.y), bflo(o.z), bfhi(o.z), bflo(o.w), bfhi(o.w)};
            float y[8];
#pragma unroll
            for (int j = 0; j < 4; ++j) { y[j] = v[k][0][j] * rs * g0[j] * __builtin_amdgcn_rcpf(1.0f + __expf(-og[j])); y[4 + j] = v[k][1][j] * rs * g1[j] * __builtin_amdgcn_rcpf(1.0f + __expf(-og[4 + j])); }
            u32x4 w; w.x = pk_bf16(y[0], y[1]); w.y = pk_bf16(y[2], y[3]); w.z = pk_bf16(y[4], y[5]); w.w = pk_bf16(y[6], y[7]);
            *(u32x4*)(p.ys() + (size_t)(r + k) * 3 * DB + 2 * DB + c) = w; }
    }
}
#define SG_LD 136
__device__ __forceinline__ void unit_sgu(const P& p, int l, int unit, LAS unsigned char* lds) {
    int tid = threadIdx.x; asm volatile("" : "+v"(tid));
    const int wave = __builtin_amdgcn_readfirstlane(tid >> 6), lane = tid & 63, fr = lane & 15, fq = lane >> 4;
    const int g = unit % NG, ch = unit / NG, r0 = ch * SGU_CHUNK;
    LAS float* rstd = (LAS float*)lds;
    LAS bf16_t* Aw = (LAS bf16_t*)(lds + 1024);
    LAS bf16_t* Bv = Aw + 128 * SG_LD;
    { const int row = tid >> 2, part = tid & 3; const bf16_t* sv = p.proj() + (size_t)(r0 + row) * PJ + C_SV + part * 128; float ss = 0.f;
#pragma unroll
        for (int c = 0; c < 16; ++c) { const u32x4 v = *(const u32x4*)(sv + 8 * c); const float a0 = bflo(v.x), a1 = bfhi(v.x), a2 = bflo(v.y), a3 = bfhi(v.y), a4 = bflo(v.z), a5 = bfhi(v.z), a6 = bflo(v.w), a7 = bfhi(v.w);
            ss += a0 * a0 + a1 * a1 + a2 * a2 + a3 * a3 + a4 * a4 + a5 * a5 + a6 * a6 + a7 * a7; }
        ss += __shfl_xor(ss, 1, 64); ss += __shfl_xor(ss, 2, 64);
        if (part == 0) rstd[row] = 1.0f / sqrtf(ss * (1.0f / DB) + EPSF); }
    { const float* W = p.w_sgu() + ((size_t)l * NG + g) * SGU_CHUNK * SGU_CHUNK;
#pragma unroll
        for (int it = 0; it < 8; ++it) { const int idx = (it * 512 + tid) * 4; const f32x4 w = *(const f32x4*)(W + idx); u32x2 o; o.x = pk_bf16(w[0], w[1]); o.y = pk_bf16(w[2], w[3]);
            *(LAS u32x2*)(Aw + (idx >> 7) * SG_LD + (idx & 127)) = o; } }
    u32x4 svv[2][2]; f32x4 gg0[2], gg1[2];
#pragma unroll
    for (int i = 0; i < 2; ++i) { const int cb = (wave * 2 + i) * 8; const float* gs = p.g_sgu() + (size_t)l * DB + g * GRP + cb; gg0[i] = *(const f32x4*)gs; gg1[i] = *(const f32x4*)(gs + 4);
#pragma unroll
        for (int half = 0; half < 2; ++half) svv[half][i] = *(const u32x4*)(p.proj() + (size_t)(r0 + 64 * half + lane) * PJ + C_SV + g * GRP + cb); }
    __syncthreads();
#pragma unroll
    for (int half = 0; half < 2; ++half) { const int q = 64 * half + lane; const float rs = rstd[q];
#pragma unroll
        for (int i = 0; i < 2; ++i) { const int cb = (wave * 2 + i) * 8;
            const u32x4 v = svv[half][i];
            const f32x4 g0 = gg0[i], g1 = gg1[i];
            Bv[(cb + 0) * SG_LD + q] = f2bf(bflo(v.x) * rs * g0[0]); Bv[(cb + 1) * SG_LD + q] = f2bf(bfhi(v.x) * rs * g0[1]);
            Bv[(cb + 2) * SG_LD + q] = f2bf(bflo(v.y) * rs * g0[2]); Bv[(cb + 3) * SG_LD + q] = f2bf(bfhi(v.y) * rs * g0[3]);
            Bv[(cb + 4) * SG_LD + q] = f2bf(bflo(v.z) * rs * g1[0]); Bv[(cb + 5) * SG_LD + q] = f2bf(bfhi(v.z) * rs * g1[1]);
            Bv[(cb + 6) * SG_LD + q] = f2bf(bflo(v.w) * rs * g1[2]); Bv[(cb + 7) * SG_LD + q] = f2bf(bfhi(v.w) * rs * g1[3]); } }
    const int pp = 16 * wave + fr; const size_t row = (size_t)r0 + pp; const float bias = p.b_sgu()[((size_t)l * NG + g) * SGU_CHUNK + pp];
    u32x2 suv[8];
#pragma unroll
    for (int ct = 0; ct < 8; ++ct) suv[ct] = *(const u32x2*)(p.proj() + row * PJ + C_SU + g * GRP + 16 * ct + 4 * fq);
    __syncthreads();
    f32x4 acc[8];
#pragma unroll
    for (int i = 0; i < 8; ++i) acc[i] = (f32x4){0.f, 0.f, 0.f, 0.f};
#pragma unroll
    for (int ks = 0; ks < 4; ++ks) { const bf16x8 a = *(const LAS bf16x8*)(Aw + (16 * wave + fr) * SG_LD + 32 * ks + 8 * fq);
#pragma unroll
        for (int ct = 0; ct < 8; ++ct) { const bf16x8 b = *(const LAS bf16x8*)(Bv + (16 * ct + fr) * SG_LD + 32 * ks + 8 * fq); acc[ct] = MFMA16(b, a, acc[ct]); } }
#pragma unroll
    for (int ct = 0; ct < 8; ++ct) { const int cc = g * GRP + 16 * ct + 4 * fq; const u32x2 su = suv[ct];
        u32x2 o; o.x = pk_bf16(bflo(su.x) * (acc[ct][0] + bias), bfhi(su.x) * (acc[ct][1] + bias)); o.y = pk_bf16(bflo(su.y) * (acc[ct][2] + bias), bfhi(su.y) * (acc[ct][3] + bias));
        *(u32x2*)(p.ys() + row * 3 * DB + DB + cc) = o; }
    __syncthreads();
}
#define N_POOL_ITEMS ((size_t)R_CTX * (DB / 2) + (size_t)NB_LAT * GRID_W * (DB / 2))
__device__ __forceinline__ void b_pool_d2(const P& p, size_t i) {
    const unsigned* pj = (const unsigned*)p.proj();
    if (i < (size_t)R_CTX * (DB / 2)) {
        const int c2 = i % (DB / 2); const int r = i / (DB / 2); const int g = (2 * c2) / GRP, win = 2 << g; const int b = r / T_CTX, t = r % T_CTX;
        int lo = t - win / 2; if (lo < 0) lo = 0; int hi = t + (win - win / 2); if (hi > T_CTX) hi = T_CTX;
        float s0 = 0.f, s1 = 0.f;
        for (int tt = lo; tt < hi; ++tt) { const unsigned w = pj[(size_t)(b * T_CTX + tt) * (PJ / 2) + c2]; s0 += bflo(w); s1 += bfhi(w); }
        const float inv = 1.0f / (float)(hi - lo); const unsigned w = pj[(size_t)r * (PJ / 2) + c2];
        ((unsigned*)p.dbf())[(size_t)r * (DB / 2) + c2] = pk_bf16(s0 * inv - bflo(w), s1 * inv - bfhi(w));
    } else {
        i -= (size_t)R_CTX * (DB / 2);
        const int c2 = i % (DB / 2); const int gx = (i / (DB / 2)) % GRID_W; const int b = i / ((size_t)(DB / 2) * GRID_W); const int g = (2 * c2) / GRP, win = 2 << g; constexpr int rows = T_LAT / GRID_W;
        int xlo = gx - win / 2; if (xlo < 0) xlo = 0; int xhi = gx + (win - win / 2); if (xhi > GRID_W) xhi = GRID_W; const float invx = 1.0f / (float)(xhi - xlo);
        float m0[rows], m1[rows];
#pragma unroll
        for (int y = 0; y < rows; ++y) { float s0 = 0.f, s1 = 0.f; const unsigned* rp = pj + (size_t)(R_CTX + b * T_LAT + y * GRID_W) * (PJ / 2) + c2;
            for (int xx = xlo; xx < xhi; ++xx) { const unsigned w = rp[(size_t)xx * (PJ / 2)]; s0 += bflo(w); s1 += bfhi(w); }
            m0[y] = s0 * invx; m1[y] = s1 * invx; }
#pragma unroll
        for (int y = 0; y < rows; ++y) { int ylo = y - win / 2; if (ylo < 0) ylo = 0; int yhi = y + (win - win / 2); if (yhi > rows) yhi = rows; float s0 = 0.f, s1 = 0.f;
#pragma unroll
            for (int yy = 0; yy < rows; ++yy) { const bool in = yy >= ylo && yy < yhi; s0 += in ? m0[yy] : 0.f; s1 += in ? m1[yy] : 0.f; }
            const float invy = 1.0f / (float)(yhi - ylo); const size_t r = (size_t)R_CTX + b * T_LAT + y * GRID_W + gx; const unsigned w = pj[r * (PJ / 2) + c2];
            ((unsigned*)p.dbf())[r * (DB / 2) + c2] = pk_bf16(s0 * invy - bflo(w), s1 * invy - bfhi(w)); }
    }
}
__device__ __forceinline__ void unit_pool(const P& p, int l, int unit) {
    int tid = threadIdx.x; asm volatile("" : "+v"(tid));
    const int wave = __builtin_amdgcn_readfirstlane(tid >> 6), lane = tid & 63, fr = lane & 15, fq = lane >> 4;
    const int g = unit % NG, r0 = (unit / NG) * 128 + 16 * wave;
    const bf16_t* A = p.dbf() + (size_t)(r0 + fr) * DB + g * GRP + 8 * fq; const bf16_t* B = p.Wt_pool() + ((size_t)l * NG + g) * GRP * GRP + (size_t)fr * GRP + 8 * fq;
    f32x4 acc[8];
#pragma unroll
    for (int i = 0; i < 8; ++i) acc[i] = (f32x4){0.f, 0.f, 0.f, 0.f};
#pragma unroll
    for (int ks = 0; ks < 4; ++ks) { const bf16x8 a = *(const bf16x8*)(A + 32 * ks);
#pragma unroll
        for (int dt = 0; dt < 8; ++dt) { const bf16x8 b = *(const bf16x8*)(B + (size_t)16 * dt * GRP + 32 * ks); acc[dt] = MFMA16(b, a, acc[dt]); } }
    const size_t row = (size_t)r0 + fr;
#pragma unroll
    for (int dt = 0; dt < 8; ++dt) { const int c = g * GRP + 16 * dt + 4 * fq; const f32x4 sc = *(const f32x4*)(p.pool_scale() + (size_t)l * DB + c);
        u32x2 o; o.x = pk_bf16(acc[dt][0] * sc[0], acc[dt][1] * sc[1]); o.y = pk_bf16(acc[dt][2] * sc[2], acc[dt][3] * sc[3]); *(u32x2*)(p.ys() + row * 3 * DB + c) = o; }
}
#define N_FOLD (DEPTH * NG * (DM / 32))
__device__ __forceinline__ void unit_fold(const P& p, int unit, LAS unsigned char* lds) {
    int tid = threadIdx.x; asm volatile("" : "+v"(tid));
    const int kt = unit % (DM / 32), g = (unit / (DM / 32)) % NG, l = unit / ((DM / 32) * NG), k0 = kt * 32;
    LAS float* Wp = (LAS float*)lds;
    LAS float* A = Wp + GRP * GRP;
    LAS float* T = A + 32 * GRP;
    const float* wp = p.w_pool() + ((size_t)l * NG + g) * GRP * GRP;
#pragma unroll
    for (int it = 0; it < 8; ++it) { const int idx = (it * 512 + tid) * 4; *(LAS f32x4*)(Wp + idx) = *(const f32x4*)(wp + idx); }
#pragma unroll
    for (int it = 0; it < 2; ++it) { const int idx = (it * 512 + tid) * 4; const int k = idx >> 7, c = idx & 127; *(LAS f32x4*)(A + idx) = *(const f32x4*)(p.w_in() + ((size_t)l * DM + k0 + k) * D_IN + g * GRP + c); }
    __syncthreads();
    { const int k = tid >> 4, ddb = (tid & 15) * 8; f32x4 a0 = {0.f, 0.f, 0.f, 0.f}, a1 = a0;
#pragma unroll 8
        for (int c = 0; c < GRP; ++c) { const float a = A[k * GRP + c]; a0 = a0 + a * *(const LAS f32x4*)(Wp + c * GRP + ddb); a1 = a1 + a * *(const LAS f32x4*)(Wp + c * GRP + ddb + 4); }
#pragma unroll
        for (int j = 0; j < 4; ++j) { T[(ddb + j) * 33 + k] = a0[j]; T[(ddb + 4 + j) * 33 + k] = a1[j]; } }
    __syncthreads();
    { const int dd = tid >> 2, ks = (tid & 3) * 8; const LAS float* t = T + dd * 33 + ks;
        u32x4 o; o.x = pk_bf16(t[0], t[1]); o.y = pk_bf16(t[2], t[3]); o.z = pk_bf16(t[4], t[5]); o.w = pk_bf16(t[6], t[7]);
        *(u32x4*)(p.Wt_in() + ((size_t)l * NIN_PAD + g * GRP + dd) * DM + k0 + ks) = o; }
    __syncthreads();
}
#define N_POOL_UNITS (NB_CTX * (T_CTX / 64) + NB_LAT * (DB / 16))
__device__ __forceinline__ void unit_pool2(const P& p, int l, int unit, LAS unsigned char* lds) {
    int tid = threadIdx.x; asm volatile("" : "+v"(tid));
    if (unit < NB_CTX * (T_CTX / 64)) {
        const int b = unit / (T_CTX / 64), t0 = (unit % (T_CTX / 64)) * 64; LAS bf16_t* Z = (LAS bf16_t*)lds;
#pragma unroll
        for (int it = 0; it < 10; ++it) { const int idx = it * 512 + tid; const int j = idx >> 6, c8 = idx & 63; const int t = t0 - 8 + j;
            if (t >= 0 && t < T_CTX) *(LAS u32x4*)(Z + j * DB + c8 * 8) = *(const u32x4*)(p.proj() + (size_t)(b * T_CTX + t) * PJ + c8 * 8); }
        __syncthreads();
#pragma unroll 2
        for (int it = 0; it < 8; ++it) { const int idx = it * 512 + tid; const int tl = idx >> 6, c8 = idx & 63; const int t = t0 + tl; const int win = 2 << (c8 >> 4);
            int lo = t - win / 2; if (lo < 0) lo = 0; int hi = t + (win - win / 2); if (hi > T_CTX) hi = T_CTX;
            float s[8] = {0.f, 0.f, 0.f, 0.f, 0.f, 0.f, 0.f, 0.f};
#pragma unroll
            for (int j = 0; j < 16; ++j) { const int tt = t - 8 + j; const bool ok = tt >= lo && tt < hi; const u32x4 v = *(const LAS u32x4*)(Z + (tl + j) * DB + c8 * 8);
                s[0] += ok ? bflo(v.x) : 0.f; s[1] += ok ? bfhi(v.x) : 0.f; s[2] += ok ? bflo(v.y) : 0.f; s[3] += ok ? bfhi(v.y) : 0.f; s[4] += ok ? bflo(v.z) : 0.f; s[5] += ok ? bfhi(v.z) : 0.f; s[6] += ok ? bflo(v.w) : 0.f; s[7] += ok ? bfhi(v.w) : 0.f; }
            const float inv = 1.0f / (float)(hi - lo); const u32x4 v = *(const LAS u32x4*)(Z + (tl + 8) * DB + c8 * 8);
            const float* sc = p.pool_scale() + (size_t)l * DB + c8 * 8; const f32x4 s0 = *(const f32x4*)sc, s1 = *(const f32x4*)(sc + 4);
            u32x4 o; o.x = pk_bf16((s[0] * inv - bflo(v.x)) * s0[0], (s[1] * inv - bfhi(v.x)) * s0[1]); o.y = pk_bf16((s[2] * inv - bflo(v.y)) * s0[2], (s[3] * inv - bfhi(v.y)) * s0[3]);
            o.z = pk_bf16((s[4] * inv - bflo(v.z)) * s1[0], (s[5] * inv - bfhi(v.z)) * s1[1]); o.w = pk_bf16((s[6] * inv - bflo(v.w)) * s1[2], (s[7] * inv - bfhi(v.w)) * s1[3]);
            pg8::st16_wt(p.ys(), (unsigned)((b * T_CTX + t) * 3 * DB + c8 * 8) * 2u, o); }
    } else {
        const int u2 = unit - NB_CTX * (T_CTX / 64); const int b = u2 / (DB / 16), cs = (u2 % (DB / 16)) * 16; const int win = 2 << (cs / GRP); constexpr int rows = T_LAT / GRID_W;
        LAS bf16_t* Z = (LAS bf16_t*)lds;
        LAS float* XM = (LAS float*)(lds + T_LAT * 32);
        const size_t rb = (size_t)R_CTX + (size_t)b * T_LAT;
#pragma unroll
        for (int it = 0; it < T_LAT * 2 / 512; ++it) { const int idx = it * 512 + tid; const int tok = idx >> 1, hf = idx & 1; *(LAS u32x4*)(Z + tok * 16 + hf * 8) = *(const u32x4*)(p.proj() + (rb + tok) * PJ + cs + hf * 8); }
        __syncthreads();
#pragma unroll 2
        for (int it = 0; it < T_LAT * 2 / 512; ++it) { const int idx = it * 512 + tid; const int tok = idx >> 1, hf = idx & 1; const int gy = tok / GRID_W, gx = tok % GRID_W;
            int xlo = gx - win / 2; if (xlo < 0) xlo = 0; int xhi = gx + (win - win / 2); if (xhi > GRID_W) xhi = GRID_W;
            float s[8] = {0.f, 0.f, 0.f, 0.f, 0.f, 0.f, 0.f, 0.f};
#pragma unroll
            for (int j = 0; j < 16; ++j) { const int xx = gx - 8 + j; const bool ok = xx >= xlo && xx < xhi; const int xc = xx < 0 ? 0 : (xx > GRID_W - 1 ? GRID_W - 1 : xx);
                const u32x4 v = *(const LAS u32x4*)(Z + (gy * GRID_W + xc) * 16 + hf * 8);
                s[0] += ok ? bflo(v.x) : 0.f; s[1] += ok ? bfhi(v.x) : 0.f; s[2] += ok ? bflo(v.y) : 0.f; s[3] += ok ? bfhi(v.y) : 0.f; s[4] += ok ? bflo(v.z) : 0.f; s[5] += ok ? bfhi(v.z) : 0.f; s[6] += ok ? bflo(v.w) : 0.f; s[7] += ok ? bfhi(v.w) : 0.f; }
            const float inv = 1.0f / (float)(xhi - xlo);
            *(LAS f32x4*)(XM + tok * 16 + hf * 8) = (f32x4){s[0] * inv, s[1] * inv, s[2] * inv, s[3] * inv}; *(LAS f32x4*)(XM + tok * 16 + hf * 8 + 4) = (f32x4){s[4] * inv, s[5] * inv, s[6] * inv, s[7] * inv}; }
        __syncthreads();
#pragma unroll 2
        for (int it = 0; it < T_LAT * 2 / 512; ++it) { const int idx = it * 512 + tid; const int tok = idx >> 1, hf = idx & 1; const int gy = tok / GRID_W, gx = tok % GRID_W;
            int ylo = gy - win / 2; if (ylo < 0) ylo = 0; int yhi = gy + (win - win / 2); if (yhi > rows) yhi = rows;
            f32x4 a0 = {0.f, 0.f, 0.f, 0.f}, a1 = a0;
#pragma unroll
            for (int j = 0; j < 16; ++j) { const int yy = gy - 8 + j; const bool ok = yy >= ylo && yy < yhi; const int yc = yy < 0 ? 0 : (yy > rows - 1 ? rows - 1 : yy);
                const f32x4 x0 = *(const LAS f32x4*)(XM + (yc * GRID_W + gx) * 16 + hf * 8), x1 = *(const LAS f32x4*)(XM + (yc * GRID_W + gx) * 16 + hf * 8 + 4);
                const float m = ok ? 1.0f : 0.0f; a0 = a0 + x0 * m; a1 = a1 + x1 * m; }
            const float inv = 1.0f / (float)(yhi - ylo); const u32x4 v = *(const LAS u32x4*)(Z + tok * 16 + hf * 8);
            const float* sc = p.pool_scale() + (size_t)l * DB + cs + hf * 8; const f32x4 s0 = *(const f32x4*)sc, s1 = *(const f32x4*)(sc + 4);
            u32x4 o; o.x = pk_bf16((a0[0] * inv - bflo(v.x)) * s0[0], (a0[1] * inv - bfhi(v.x)) * s0[1]); o.y = pk_bf16((a0[2] * inv - bflo(v.y)) * s0[2], (a0[3] * inv - bfhi(v.y)) * s0[3]);
            o.z = pk_bf16((a1[0] * inv - bflo(v.z)) * s1[0], (a1[1] * inv - bfhi(v.z)) * s1[1]); o.w = pk_bf16((a1[2] * inv - bflo(v.w)) * s1[2], (a1[3] * inv - bfhi(v.w)) * s1[3]);
            pg8::st16_wt(p.ys(), (unsigned)((rb + tok) * 3 * DB + cs + hf * 8) * 2u, o); }
    }
    __syncthreads();
}
__device__ __forceinline__ void phase_norm(const P& p, int l, int which) {
    int tid = threadIdx.x; asm volatile("" : "+v"(tid));
    const int wave = tid >> 6, lane = tid & 63;
    for (int r = blockIdx.x * 8 + wave; r < NROW; r += gridDim.x * 8) {
        const float* xr = which == 3 ? (r < R_CTX ? p.x_prompt() + (size_t)r * DM : p.x_sample() + (size_t)(r - R_CTX) * DM) : p.x() + (size_t)r * DM; f32x4 v[DM / 256]; float ss = 0.f;
#pragma unroll
        for (int i = 0; i < DM / 256; ++i) { v[i] = *(const f32x4*)(xr + (i * 64 + lane) * 4); if (which == 3) *(f32x4*)(p.x() + (size_t)r * DM + (i * 64 + lane) * 4) = v[i]; ss += v[i][0] * v[i][0] + v[i][1] * v[i][1] + v[i][2] * v[i][2] + v[i][3] * v[i][3]; }
#pragma unroll
        for (int off = 32; off >= 1; off >>= 1) ss += __shfl_xor(ss, off, 64);
        const float rs = 1.0f / sqrtf(ss * (1.0f / DM) + EPSF);
        if (which == 2) {
#pragma unroll
            for (int i = 0; i < DM / 256; ++i) { const int k = (i * 64 + lane) * 4; *(f32x4*)(p.out + (size_t)r * DM + k) = v[i] * rs * *(const f32x4*)(p.g_final() + k); }
        } else {
            const float* g = (which == 1 ? p.g_norm2() : p.g_norm1()) + (size_t)l * DM; const float* md = p.mod() + ((size_t)l * 3 + cond_of_row(r)) * 6 * DM + (which == 1 ? 3 * DM : 0);
#pragma unroll
            for (int i = 0; i < DM / 256; ++i) { const int k = (i * 64 + lane) * 4; const f32x4 o = v[i] * rs * *(const f32x4*)(g + k) * (*(const f32x4*)(md + DM + k) + 1.0f) + *(const f32x4*)(md + k);
                u32x2 w; w.x = pk_bf16(o[0], o[1]); w.y = pk_bf16(o[2], o[3]); *(u32x2*)(p.u() + (size_t)r * DM + k) = w; }
        }
    }
}
#define N_MOD_BLK (DEPTH * (6 * DM / 128))
__device__ __forceinline__ void unit_mod(const P& p, int unit, LAS unsigned char* lds) {
    int tid = threadIdx.x; asm volatile("" : "+v"(tid));
    const int l = unit / (6 * DM / 128), j0 = (unit % (6 * DM / 128)) * 128; const int j4 = tid & 31, ks = tid >> 5, k0 = ks * (DM / 16);
    LAS float* R = (LAS float*)lds;
    const float* w = p.w_ada() + ((size_t)l * DM + k0) * 6 * DM + j0 + j4 * 4;
    f32x4 a0 = {0.f, 0.f, 0.f, 0.f}, a1 = a0, a2 = a0;
#pragma unroll 4
    for (int k = 0; k < DM / 16; ++k) { const f32x4 wv = *(const f32x4*)(w + (size_t)k * 6 * DM);
        const float c0 = p.c_ctx()[k0 + k], c1 = p.c()[k0 + k], c2 = p.c()[DM + k0 + k];
        a0 = a0 + wv * (c0 / (1.0f + expf(-c0))); a1 = a1 + wv * (c1 / (1.0f + expf(-c1))); a2 = a2 + wv * (c2 / (1.0f + expf(-c2))); }
    *(LAS f32x4*)(R + (ks * 3 + 0) * 128 + j4 * 4) = a0; *(LAS f32x4*)(R + (ks * 3 + 1) * 128 + j4 * 4) = a1; *(LAS f32x4*)(R + (ks * 3 + 2) * 128 + j4 * 4) = a2;
    __syncthreads();
    if (tid < 384) { const int ci = tid >> 7, j = tid & 127; float s = p.b_ada()[(size_t)l * 6 * DM + j0 + j];
#pragma unroll
        for (int q = 0; q < 16; ++q) s += R[(q * 3 + ci) * 128 + j];
        p.mod()[((size_t)l * 3 + ci) * 6 * DM + j0 + j] = s; }
    __syncthreads();
}
__device__ __forceinline__ void conv_tile(const float* __restrict__ W, int N, bf16_t* __restrict__ Wt, int K, int kt, int nt, int rowmap, LAS unsigned char* lds) {
    int tid = threadIdx.x; asm volatile("" : "+v"(tid));
    LAS float* T = (LAS float*)lds;
    const int k0 = kt * 64, n0 = nt * 256;
    { const int c4 = (tid & 63) * 4, kb = tid >> 6; f32x4 v[8];
#pragma unroll
        for (int i = 0; i < 8; ++i) { v[i] = (f32x4){0.f, 0.f, 0.f, 0.f}; if (n0 + c4 < N) v[i] = *(const f32x4*)(W + (size_t)(k0 + kb + 8 * i) * N + n0 + c4); }
#pragma unroll
        for (int i = 0; i < 8; ++i) *(LAS f32x4*)(T + (kb + 8 * i) * 260 + c4) = v[i]; }
    __syncthreads();
    { const int n = tid >> 1, ks = (tid & 1) * 32; const int col = n0 + n;
        if (col < N) { int row = col; if (rowmap) row = col < 7 * DB ? col : (col < 7 * DB + 4 * NH ? PJ + (col - 7 * DB) : col - 4 * NH);
            bf16_t* dst = Wt + (size_t)row * K + k0 + ks;
#pragma unroll
            for (int q = 0; q < 4; ++q) { const LAS float* t = T + (ks + q * 8) * 260 + n;
                u32x4 o; o.x = pk_bf16(t[0], t[260]); o.y = pk_bf16(t[2 * 260], t[3 * 260]); o.z = pk_bf16(t[4 * 260], t[5 * 260]); o.w = pk_bf16(t[6 * 260], t[7 * 260]);
                *(u32x4*)(dst + q * 8) = o; } } }
    __syncthreads();
}
#define CT_IN (16 * ((D_IN + 255) / 256))
#define CT_BR (3 * (DB / 64) * (DM / 256))
#define CT_OUT ((DM / 64) * (DM / 256))
#define CT_FF ((DM / 64) * (DFF / 256))
#define CT_LAYER (CT_IN + CT_BR + CT_OUT + 2 * CT_FF)
#define N_FOLD_L (NG * (DM / 32))
#define CONV_ITEMS (CT_LAYER + N_FOLD_L)
__device__ __forceinline__ void conv_layer(const P& p, int l, int i_lo, int i_hi, int cu, int ncu, LAS unsigned char* lds) {
    for (int t = i_lo + cu; t < i_hi; t += ncu) {
        int r = t;
        if (r >= CT_LAYER) { unit_fold(p, l * N_FOLD_L + (r - CT_LAYER), lds); continue; }
        if (r < CT_IN) { constexpr int nn = (D_IN + 255) / 256; if (r % nn >= DB / 256) conv_tile(p.w_in() + (size_t)l * DM * D_IN, D_IN, p.Wt_in() + (size_t)l * NIN_PAD * DM, DM, r / nn, r % nn, 1, lds); continue; } r -= CT_IN;
        if (r < CT_BR) { constexpr int per = (DB / 64) * (DM / 256); const int br = r / per, q = r % per; conv_tile(p.w_branch() + ((size_t)l * 3 + br) * DB * DM, DM, p.Wt_br() + ((size_t)l * 3 + br) * DM * DB, DB, q / (DM / 256), q % (DM / 256), 0, lds); continue; } r -= CT_BR;
        if (r < CT_OUT) { conv_tile(p.w_out() + (size_t)l * DM * DM, DM, p.Wt_out() + (size_t)l * DM * DM, DM, r / (DM / 256), r % (DM / 256), 0, lds); continue; } r -= CT_OUT;
        if (r < CT_FF) { conv_tile(p.w_ff1() + (size_t)l * DM * DFF, DFF, p.Wt_ff1() + (size_t)l * DFF * DM, DM, r / (DFF / 256), r % (DFF / 256), 0, lds); continue; } r -= CT_FF;
        conv_tile(p.w_ff2() + (size_t)l * DFF * DM, DM, p.Wt_ff2() + (size_t)l * DM * DFF, DFF, r / (DM / 256), r % (DM / 256), 0, lds);
    }
    if (i_lo == 0) { const size_t per = (size_t)(NIN_PAD - PJ - 4 * NH) * DM / 8;
      int tz = threadIdx.x; asm volatile("" : "+v"(tz));
      for (size_t i = (size_t)cu * NTHR + tz; i < per; i += (size_t)ncu * NTHR) *(u32x4*)(p.Wt_in() + ((size_t)l * NIN_PAD + PJ + 4 * NH) * DM + i * 8) = (u32x4){0u, 0u, 0u, 0u}; }
}
#endif
#ifndef CPU_EMU
#define STAGE_OFF 1024
#define LDS_BYTES (STAGE_OFF + 147456)
struct Args { const float* in[24]; P p; unsigned* bar; };
#define GS(n, call) do { int t_ = threadIdx.x; asm volatile("" : "+v"(t_)); const size_t nthr_ = (size_t)gridDim.x * NTHR; for (size_t i_ = (size_t)blockIdx.x * NTHR + t_; i_ < (size_t)(n); i_ += nthr_) { call; } } while (0)
#define BAR() xcd_barrier(bar)
template <int MODE> __device__ __forceinline__ void run_gemm128(const P& p, int l, LAS unsigned char* lds, float gsc = 1.0f, bool conv = true) {
    constexpr int NU = (NROW / 128) * (DM / 256);
    if ((int)blockIdx.x >= NU && l + 1 < DEPTH && conv) {
        constexpr int c0 = CONV_ITEMS * 30 / 100, c1 = CONV_ITEMS * 45 / 100;
        conv_layer(p, l + 1, MODE == 1 ? 0 : (MODE == 2 ? c0 : c1), MODE == 1 ? c0 : (MODE == 2 ? c1 : CONV_ITEMS), (int)blockIdx.x - NU, (int)gridDim.x - NU, lds + STAGE_OFF);
        return; }
    const GemmArgs g = gemm_args(p, l, MODE);
    pg8::Order128 S; S.init(g.M, g.N, g.nZ, (int)gridDim.x, (int)blockIdx.x);
    pg8::Epi128<MODE> E; E.p = p; E.l = l; E.gsc = gsc;
    if constexpr (MODE == 1) pg8::gemm128_phase_s<pg8::Epi128<MODE>>(lds + STAGE_OFF, g, S, E);
    else pg8::gemm128_phase<pg8::Epi128<MODE>>(lds + STAGE_OFF, g, S, E);
}
template <int MODE> __device__ __forceinline__ void run_gemm2k(const P& p, int l, LAS unsigned char* lds) {
    constexpr int NU = 2 * pg8::NT2;
    if ((int)blockIdx.x >= NU) {
        if (l + 1 < DEPTH) { constexpr int c0 = CONV_ITEMS * 25 / 100, c1 = CONV_ITEMS * 45 / 100;
            conv_layer(p, l + 1, MODE == 1 ? 0 : (MODE == 2 ? c0 : c1), MODE == 1 ? c0 : (MODE == 2 ? c1 : CONV_ITEMS), (int)blockIdx.x - NU, (int)gridDim.x - NU, lds + STAGE_OFF); }
        return; }
    GemmArgs g = gemm_args(p, l, MODE);
    pg8::Order2K S; S.init(g.nZ, (int)blockIdx.x);
    g.K /= 2; g.A += (size_t)S.kh * g.K; g.Bt += (size_t)S.kh * g.K;
    pg8::EpiX<MODE> E{p, l, S.kh, S.slot};
    pg8::gemm_phase<pg8::EpiX<MODE>, pg8::Order2K, true, true, true>(lds + STAGE_OFF, g, S, E);
}
template <int MODE> __device__ __forceinline__ void run_gemm(const P& p, int l, LAS unsigned char* lds) {
    const GemmArgs g = gemm_args(p, l, MODE);
    pg8::Order S; S.init(g.M, g.N, g.nZ, (int)gridDim.x, (int)blockIdx.x);
    pg8::Epi<MODE> E{p, l};
    pg8::gemm_phase<pg8::Epi<MODE>, pg8::Order, true, true, false>(lds + STAGE_OFF, g, S, E);
}
__global__ void __launch_bounds__(NTHR, 2) mega(Args a) {
    extern __shared__ __attribute__((aligned(16))) unsigned char lds_[];
    LAS unsigned char* lds = (LAS unsigned char*)lds_;
    volatile LAS unsigned* st = (volatile LAS unsigned*)lds;
    if (threadIdx.x < 4) st[threadIdx.x] = 0u;
    __syncthreads();
    if (threadIdx.x < 24) ((LAS unsigned long long*)(lds + IN_TAB_OFF))[threadIdx.x] = (unsigned long long)a.in[threadIdx.x];
    __syncthreads();
    XcdBarrier bar = xcd_barrier_post(a.bar, st);
    const P p = a.p;
    for (int u_ = blockIdx.x; u_ < N_MOD_BLK; u_ += gridDim.x) unit_mod(p, u_, lds + STAGE_OFF);
    conv_layer(p, 0, 0, CONV_ITEMS, (int)blockIdx.x, (int)gridDim.x, lds + STAGE_OFF); BAR();
#pragma unroll 1
    for (int l = 0; l < DEPTH; ++l) {
        if (l == 0) { phase_norm(p, 0, 3); BAR(); }
        run_gemm<0>(p, l, lds); BAR();
        { const int c = blockIdx.x, G = gridDim.x; constexpr int NSEQU = NB_CTX * NH * 2, LAT0 = (R_CTX / LCH) * NH, NLATU = (R_LAT / LCH) * NH;
          if (c < NSEQU) unit_ml_seq(p, l, c, lds + STAGE_OFF);
          else { int k = c - NSEQU;
              asm volatile("" : "+s"(k)); unit_ml_cloc(p, l, LAT0 + k, lds + STAGE_OFF);
              asm volatile("" : "+s"(k)); unit_pool2(p, l, k, lds + STAGE_OFF);
#pragma unroll 1
              for (int q = 0; q < 2; ++q) { asm volatile("" : "+s"(k)); if (q == 0 || k < 64) unit_sgu(p, l, q * 128 + k, lds + STAGE_OFF); } }
          BAR();
          phase_scan(p, l, lds + STAGE_OFF);
          BAR();
          if (c < NLATU) unit_ml_out(p, l, LAT0 + c, lds + STAGE_OFF); else phase_ctx_fin(p, l, c - NLATU, G - NLATU);
          BAR(); }
        run_gemm128<1>(p, l, lds); BAR();
        run_gemm128<2>(p, l, lds); BAR();
        run_gemm<3>(p, l, lds); BAR();
        run_gemm128<4>(p, l, lds); BAR();
    }
}
#endif

extern "C" void kernel_launch(void* const* d_in, const int* in_sizes, int n_in, void* d_out, int out_size, void* d_ws, size_t ws_size, hipStream_t stream) {
#ifndef CPU_EMU
    static int grid = 0;
    if (grid == 0) {
        int dev = 0, cus = 0, per_cu = 0;
        (void)hipGetDevice(&dev); (void)hipDeviceGetAttribute(&cus, hipDeviceAttributeMultiprocessorCount, dev);
        if (hipFuncSetAttribute((const void*)mega, hipFuncAttributeMaxDynamicSharedMemorySize, LDS_BYTES) != hipSuccess) { fprintf(stderr, "hipFuncSetAttribute failed\n"); grid = -1; return; }
        if (hipOccupancyMaxActiveBlocksPerMultiprocessor(&per_cu, (const void*)mega, NTHR, LDS_BYTES) != hipSuccess || per_cu < 1) { fprintf(stderr, "occupancy query failed (%d)\n", per_cu); grid = -1; return; }
        grid = cus * per_cu;
        if (grid != 256) { fprintf(stderr, "kernel_launch: this kernel's unit dealing is written for 256 workgroups (256 CUs x 1), got %d\n", grid); grid = -1; return; }
    }
    if (grid < 0) return;
    Args a{};
    P& p = a.p;
#else
    P p{};
#endif
#ifdef CPU_EMU
    for (int i = 0; i < 24; ++i) p.inp[i] = (const float*)d_in[i];
#else
    for (int i = 0; i < 24; ++i) a.in[i] = (const float*)d_in[i];
#endif
    p.out = (float*)d_out;
    p.ws = (char*)d_ws;
    if (ws_size < WS_TOTAL) { fprintf(stderr, "workspace too small: need %zu have %zu\n", (size_t)WS_TOTAL, ws_size); return; }
#ifndef CPU_EMU
    a.bar = (unsigned*)d_ws;
    (void)hipMemsetAsync(d_ws, 0, OFF_BAR_END, stream);
    void* args[] = {&a};
    hipError_t e = hipLaunchCooperativeKernel((const void*)mega, dim3(grid), dim3(NTHR), args, LDS_BYTES, stream);
    if (e != hipSuccess) fprintf(stderr, "cooperative launch failed: %s (grid %d)\n", hipGetErrorString(e), grid);
#else
    LAUNCH(k_body, (size_t)DEPTH * 3 * 6 * DM, b_mod(p, i_)); LAUNCH(k_body, (size_t)NROW * DM, b_copy_x(p, i_)); LAUNCH(k_body, N_CONV, b_conv(p, i_));
    for (int l = 0; l < DEPTH; ++l) {
        LAUNCH(k_body, NROW, b_norm(p, i_, l, 0));
        LAUNCH(k_body, (size_t)NROW * NIN_PAD, b_gemm(p, i_, l, 0));
        LAUNCH(k_body, (size_t)NROW * DB, b_pool_d(p, i_)); LAUNCH(k_body, NROW, b_sgu_vn(p, i_, l)); LAUNCH(k_body, (size_t)2 * NH * NCHK, b_ml_gates(p, i_, l));
        LAUNCH(k_body, (size_t)NROW * DB, b_pool_y(p, i_, l)); LAUNCH(k_body, (size_t)NROW * DB, b_sgu_y(p, i_, l)); LAUNCH(k_body, (size_t)2 * NH * NCHK * DH * DH, b_ml_cloc(p, i_));
        LAUNCH(k_body, (size_t)2 * NH * NSEQ * DH * DH, b_ml_scan(p, i_, l));
        LAUNCH(k_body, (size_t)2 * NH * NROW, b_ml_mt(p, i_));
        LAUNCH(k_body, (size_t)2 * NH * NCHK * LCH * LCH, b_ml_s(p, i_));
        LAUNCH(k_body, (size_t)2 * NROW * DB, b_ml_h(p, i_));
        LAUNCH(k_body, (size_t)NROW * NH, b_ml_fin(p, i_, l));
        LAUNCH(k_body, (size_t)NROW * DM, b_gemm(p, i_, l, 1));
        LAUNCH(k_body, (size_t)NROW * DM, b_gemm(p, i_, l, 2));
        LAUNCH(k_body, NROW, b_norm(p, i_, l, 1));
        LAUNCH(k_body, (size_t)NROW * DFF, b_gemm(p, i_, l, 3));
        LAUNCH(k_body, (size_t)NROW * DM, b_gemm(p, i_, l, 4));
    }
    LAUNCH(k_body, NROW, b_final(p, i_));
#endif
}
```

```cpp
#ifndef CPU_EMU
#include <hip/hip_runtime.h>
#include <cstdio>
#endif
#include <math.h>
#include <stddef.h>
#include <string.h>

#ifndef DM
#define DM 1024
#define NB_CTX 16
#define T_CTX 256
#define DEPTH 4
#define NB_LAT 2
#define T_LAT 1024
#define GRID_W 64
#define DB 512
#endif
#define NG 4
#define GRP (DB / NG)
#define SGU_CHUNK 128
#define NH 4
#define DH (DB / NH)
#define LCH 64
#define DFF (4 * DM)
#define D_IN (7 * DB + 4 * NH + 3 * DM)
#define R_CTX (NB_CTX * T_CTX)
#define R_LAT (NB_LAT * T_LAT)
#define NROW (R_CTX + R_LAT)
#define NCHK (NROW / LCH)
#define NSEQ (NB_CTX + NB_LAT)
#define EPSF 1e-6f
#define C_XP 0
#define C_SU (DB)
#define C_SV (2 * DB)
#define C_Q (3 * DB)
#define C_K (4 * DB)
#define C_V (5 * DB)
#define C_O (6 * DB)
#define C_G (7 * DB)
#define C_BR (7 * DB)
#define PJ (7 * DB + 3 * DM)
#define NIN_PAD (PJ + 256)
typedef unsigned short bf16_t;

#ifdef CPU_EMU
#define NAIVE_ONLY(n) (n)
#else
#define NAIVE_ONLY(n) ((size_t)64)
#endif
constexpr size_t al256(size_t b) { return (b + 255) / 256 * 256; }
constexpr size_t OFF_CNT = 16384;
constexpr size_t OFF_BAR_END = OFF_CNT + (size_t)2 * DEPTH * (NROW / 128) * 256 + al256((size_t)3 * DEPTH * ((NROW / 256) * (DM / 256)) * 4);
constexpr size_t OFF_mod = OFF_BAR_END;
constexpr size_t END_mod = OFF_mod + al256(((size_t)DEPTH * 3 * 6 * DM) * 4);
constexpr size_t OFF_x = END_mod;
constexpr size_t END_x = OFF_x + al256(((size_t)NROW * DM) * 4);
constexpr size_t OFF_gate_pre = END_x;
constexpr size_t END_gate_pre = OFF_gate_pre + al256(((size_t)NROW * 16) * 4);
constexpr size_t END_mergedf = END_gate_pre;
constexpr size_t OFF_dbuf = END_mergedf;
constexpr size_t END_dbuf = OFF_dbuf + al256(((size_t)NROW * DB) * 4);
constexpr size_t OFF_vn = END_dbuf;
constexpr size_t END_vn = OFF_vn + al256(((size_t)NROW * DB) * 4);
constexpr size_t OFF_Cloc = END_vn;
constexpr size_t END_Cloc = OFF_Cloc + al256(((size_t)2 * NH * NCHK * DH * DH) * 4);
constexpr size_t OFF_nloc = END_Cloc;
constexpr size_t END_nloc = OFF_nloc + al256(((size_t)2 * NH * NCHK * DH) * 4);
constexpr size_t OFF_bcum = END_nloc;
constexpr size_t END_bcum = OFF_bcum + al256((NAIVE_ONLY((size_t)2 * NH * NROW)) * 4);
constexpr size_t OFF_ival = END_bcum;
constexpr size_t END_ival = OFF_ival + al256((NAIVE_ONLY((size_t)2 * NH * NROW)) * 4);
constexpr size_t OFF_bL = END_ival;
constexpr size_t END_bL = OFF_bL + al256(((size_t)2 * NH * NCHK) * 4);
constexpr size_t OFF_Mloc = END_bL;
constexpr size_t END_Mloc = OFF_Mloc + al256(((size_t)2 * NH * NCHK) * 4);
constexpr size_t OFF_Mprev = END_Mloc;
constexpr size_t END_Mprev = OFF_Mprev + al256(((size_t)2 * NH * NCHK) * 4);
constexpr size_t OFF_MT = END_Mprev;
constexpr size_t END_MT = OFF_MT + al256((NAIVE_ONLY((size_t)2 * NH * NROW)) * 4);
constexpr size_t OFF_S = END_MT;
constexpr size_t END_S = OFF_S + al256((NAIVE_ONLY((size_t)2 * NH * NCHK * LCH * LCH)) * 4);
constexpr size_t OFF_hbuf = END_S;
constexpr size_t END_hbuf = OFF_hbuf + al256((NAIVE_ONLY((size_t)2 * NROW * DB)) * 4);
constexpr size_t OFF_Wt_in = END_hbuf;
constexpr size_t END_Wt_in = OFF_Wt_in + al256(((size_t)DEPTH * NIN_PAD * DM) * 2);
constexpr size_t OFF_Wt_br = END_Wt_in;
constexpr size_t END_Wt_br = OFF_Wt_br + al256(((size_t)DEPTH * 3 * DM * DB) * 2);
constexpr size_t OFF_Wt_out = END_Wt_br;
constexpr size_t END_Wt_out = OFF_Wt_out + al256(((size_t)DEPTH * DM * DM) * 2);
constexpr size_t OFF_Wt_ff1 = END_Wt_out;
constexpr size_t END_Wt_ff1 = OFF_Wt_ff1 + al256(((size_t)DEPTH * DFF * DM) * 2);
constexpr size_t OFF_Wt_ff2 = END_Wt_ff1;
constexpr size_t END_Wt_ff2 = OFF_Wt_ff2 + al256(((size_t)DEPTH * DM * DFF) * 2);
constexpr size_t OFF_u = END_Wt_ff2;
constexpr size_t END_u = OFF_u + al256(((size_t)NROW * DM) * 2);
constexpr size_t OFF_proj = END_u;
constexpr size_t END_proj = OFF_proj + al256(((size_t)NROW * PJ) * 2);
constexpr size_t OFF_ys = END_proj;
constexpr size_t END_ys = OFF_ys + al256(((size_t)NROW * 3 * DB) * 2);
constexpr size_t OFF_merged = END_ys;
constexpr size_t END_merged = OFF_merged + al256(((size_t)NROW * DM) * 2);
constexpr size_t END_hff = END_merged;
constexpr size_t OFF_CprevT = END_hff;
constexpr size_t END_CprevT = OFF_CprevT + al256(((size_t)2 * NH * NCHK * DH * DH) * 2);
constexpr size_t OFF_nprev = END_CprevT;
constexpr size_t END_nprev = OFF_nprev + al256(((size_t)2 * NH * NCHK * DH) * 4);
constexpr size_t OFF_dbf = END_nprev;
constexpr size_t END_dbf = OFF_dbf + al256(((size_t)NROW * DB) * 2);
constexpr size_t OFF_Wt_pool = END_dbf;
constexpr size_t END_Wt_pool = OFF_Wt_pool + al256(((size_t)DEPTH * NG * GRP * GRP) * 2);
constexpr size_t OFF_ssq = END_Wt_pool;
constexpr size_t END_ssq = OFF_ssq + al256(((size_t)2 * DEPTH * NROW * 4) * 4);
constexpr size_t OFF_gsc = END_ssq;
constexpr size_t END_gsc = OFF_gsc + al256(((size_t)3 * 2 * NH * NROW) * 4);
constexpr size_t OFF_VTg = END_gsc;
constexpr size_t END_VTg = OFF_VTg + al256(((size_t)NH * NCHK * DH * LCH) * 2);
constexpr size_t OFF_hbc = END_VTg;
constexpr size_t END_hbc = OFF_hbc + al256(((size_t)2 * R_CTX * DB) * 4);
constexpr size_t WS_TOTAL = END_hbc;
constexpr size_t OFF_mergedf = OFF_dbuf;
constexpr size_t OFF_hff = OFF_proj;
static_assert(END_vn - OFF_dbuf >= (size_t)NROW * DM * 4 && END_dbuf == OFF_vn, "mergedf alias");
static_assert((size_t)NROW * PJ >= (size_t)NROW * DFF, "hff alias");
#ifndef CPU_EMU
#define IN_TAB_OFF 64
#endif
struct P {
#ifdef CPU_EMU
    const float* inp[24];
    const float* in(int i) const { return inp[i]; }
#else
    __device__ __forceinline__ const float* in(int i) const { return (const float*)(*(const __attribute__((address_space(3))) unsigned long long*)(unsigned)(IN_TAB_OFF + 8 * i)); }
#endif
    __device__ __forceinline__ const float* x_prompt() const { return in(0); }
    __device__ __forceinline__ const float* x_sample() const { return in(1); }
    __device__ __forceinline__ const float* state_C() const { return in(2); }
    __device__ __forceinline__ const float* state_n() const { return in(3); }
    __device__ __forceinline__ const float* state_m() const { return in(4); }
    __device__ __forceinline__ const float* c() const { return in(5); }
    __device__ __forceinline__ const float* c_ctx() const { return in(6); }
    __device__ __forceinline__ const float* w_ada() const { return in(7); }
    __device__ __forceinline__ const float* b_ada() const { return in(8); }
    __device__ __forceinline__ const float* g_norm1() const { return in(9); }
    __device__ __forceinline__ const float* g_norm2() const { return in(10); }
    __device__ __forceinline__ const float* w_in() const { return in(11); }
    __device__ __forceinline__ const float* b_gates() const { return in(12); }
    __device__ __forceinline__ const float* w_pool() const { return in(13); }
    __device__ __forceinline__ const float* pool_scale() const { return in(14); }
    __device__ __forceinline__ const float* g_sgu() const { return in(15); }
    __device__ __forceinline__ const float* w_sgu() const { return in(16); }
    __device__ __forceinline__ const float* b_sgu() const { return in(17); }
    __device__ __forceinline__ const float* g_mlstm() const { return in(18); }
    __device__ __forceinline__ const float* w_branch() const { return in(19); }
    __device__ __forceinline__ const float* w_out() const { return in(20); }
    __device__ __forceinline__ const float* w_ff1() const { return in(21); }
    __device__ __forceinline__ const float* w_ff2() const { return in(22); }
    __device__ __forceinline__ const float* g_final() const { return in(23); }
    float* out; char* ws;
    __device__ __forceinline__ float* mod() const { return (float*)(ws + OFF_mod); }
    __device__ __forceinline__ float* x() const { return (float*)(ws + OFF_x); }
    __device__ __forceinline__ float* gate_pre() const { return (float*)(ws + OFF_gate_pre); }
    __device__ __forceinline__ float* mergedf() const { return (float*)(ws + OFF_mergedf); }
    __device__ __forceinline__ float* dbuf() const { return (float*)(ws + OFF_dbuf); }
    __device__ __forceinline__ float* vn() const { return (float*)(ws + OFF_vn); }
    __device__ __forceinline__ float* Cloc() const { return (float*)(ws + OFF_Cloc); }
    __device__ __forceinline__ float* nloc() const { return (float*)(ws + OFF_nloc); }
    __device__ __forceinline__ float* bcum() const { return (float*)(ws + OFF_bcum); }
    __device__ __forceinline__ float* ival() const { return (float*)(ws + OFF_ival); }
    __device__ __forceinline__ float* bL() const { return (float*)(ws + OFF_bL); }
    __device__ __forceinline__ float* Mloc() const { return (float*)(ws + OFF_Mloc); }
    __device__ __forceinline__ float* Mprev() const { return (float*)(ws + OFF_Mprev); }
    __device__ __forceinline__ float* MT() const { return (float*)(ws + OFF_MT); }
    __device__ __forceinline__ float* S() const { return (float*)(ws + OFF_S); }
    __device__ __forceinline__ float* hbuf() const { return (float*)(ws + OFF_hbuf); }
    __device__ __forceinline__ bf16_t* Wt_in() const { return (bf16_t*)(ws + OFF_Wt_in); }
    __device__ __forceinline__ bf16_t* Wt_br() const { return (bf16_t*)(ws + OFF_Wt_br); }
    __device__ __forceinline__ bf16_t* Wt_out() const { return (bf16_t*)(ws + OFF_Wt_out); }
    __device__ __forceinline__ bf16_t* Wt_ff1() const { return (bf16_t*)(ws + OFF_Wt_ff1); }
    __device__ __forceinline__ bf16_t* Wt_ff2() const { return (bf16_t*)(ws + OFF_Wt_ff2); }
    __device__ __forceinline__ bf16_t* u() const { return (bf16_t*)(ws + OFF_u); }
    __device__ __forceinline__ bf16_t* proj() const { return (bf16_t*)(ws + OFF_proj); }
    __device__ __forceinline__ bf16_t* ys() const { return (bf16_t*)(ws + OFF_ys); }
    __device__ __forceinline__ bf16_t* merged() const { return (bf16_t*)(ws + OFF_merged); }
    __device__ __forceinline__ bf16_t* hff() const { return (bf16_t*)(ws + OFF_hff); }
    __device__ __forceinline__ bf16_t* CprevT() const { return (bf16_t*)(ws + OFF_CprevT); }
    __device__ __forceinline__ float* nprev() const { return (float*)(ws + OFF_nprev); }
    __device__ __forceinline__ bf16_t* dbf() const { return (bf16_t*)(ws + OFF_dbf); }
    __device__ __forceinline__ bf16_t* Wt_pool() const { return (bf16_t*)(ws + OFF_Wt_pool); }
    __device__ __forceinline__ float* ssq() const { return (float*)(ws + OFF_ssq); }
    __device__ __forceinline__ float* gsc() const { return (float*)(ws + OFF_gsc); }
    __device__ __forceinline__ bf16_t* VTg() const { return (bf16_t*)(ws + OFF_VTg); }
    __device__ __forceinline__ float* hbc() const { return (float*)(ws + OFF_hbc); }
    __device__ __forceinline__ unsigned* cnt() const { return (unsigned*)(ws + OFF_CNT); }
};
#ifdef CPU_EMU
static inline unsigned f_as_u(float f) { unsigned u; memcpy(&u, &f, 4); return u; }
static inline float u_as_f(unsigned u) { float f; memcpy(&f, &u, 4); return f; }
#else
__device__ __forceinline__ unsigned f_as_u(float f) { return __float_as_uint(f); }
__device__ __forceinline__ float u_as_f(unsigned u) { return __uint_as_float(u); }
#endif
__device__ __forceinline__ bf16_t f2bf(float f) { unsigned u = f_as_u(f); u += 0x7FFFu + ((u >> 16) & 1u); return (bf16_t)(u >> 16); }
__device__ __forceinline__ float bf2f(bf16_t b) { return u_as_f(((unsigned)b) << 16); }
#define PRJ(row, col) bf2f(p.proj()[(size_t)(row) * PJ + (col)])

__device__ __forceinline__ float sigmoidf_(float x) { return 1.0f / (1.0f + expf(-x)); }
__device__ __forceinline__ float logsigmoidf_(float x) { return fminf(x, 0.0f) - log1pf(expf(-fabsf(x))); }
__device__ __forceinline__ int cond_of_row(int r) { return r < R_CTX ? 0 : 1 + (r - R_CTX) / T_LAT; }
__device__ __forceinline__ int seq_start(int s) { return s < NB_CTX ? s * T_CTX : R_CTX + (s - NB_CTX) * T_LAT; }
__device__ __forceinline__ int seq_len(int s) { return s < NB_CTX ? T_CTX : T_LAT; }

#define GTID ((size_t)blockIdx.x * blockDim.x + threadIdx.x)

__device__ __forceinline__ void b_mod(const P& p, size_t i) {

    int j = i % (6 * DM), ci = (i / (6 * DM)) % 3, l = i / (6 * DM * 3);
    const float* cond = ci == 0 ? p.c_ctx() : p.c() + (size_t)(ci - 1) * DM;
    const float* w = p.w_ada() + (size_t)l * DM * 6 * DM;
    float acc = 0.f;
    for (int k = 0; k < DM; ++k) { float cv = cond[k]; acc += cv * sigmoidf_(cv) * w[(size_t)k * 6 * DM + j]; }
    p.mod()[i] = acc + p.b_ada()[(size_t)l * 6 * DM + j];
}
__device__ __forceinline__ void b_copy_x(const P& p, size_t i) {

    p.x()[i] = i < (size_t)R_CTX * DM ? p.x_prompt()[i] : p.x_sample()[i - (size_t)R_CTX * DM];
}
__device__ __forceinline__ void b_norm(const P& p, size_t r, int l, int which) {

    const float* xr = p.x() + r * DM; float ss = 0.f;
    for (int k = 0; k < DM; ++k) ss += xr[k] * xr[k];
    float rs = 1.0f / sqrtf(ss / DM + EPSF);
    const float* g = (which ? p.g_norm2() : p.g_norm1()) + (size_t)l * DM;
    const float* md = p.mod() + ((size_t)l * 3 + cond_of_row((int)r)) * 6 * DM + (which ? 3 * DM : 0);
    for (int k = 0; k < DM; ++k) p.u()[r * DM + k] = f2bf(xr[k] * rs * g[k] * (1.0f + md[DM + k]) + md[k]);
}
__device__ __forceinline__ void b_conv(const P& p, size_t i) {
    const size_t n_in = (size_t)DEPTH * NIN_PAD * DM, n_br = (size_t)DEPTH * 3 * DM * DB, n_out = (size_t)DEPTH * DM * DM, n_f1 = (size_t)DEPTH * DFF * DM, n_f2 = (size_t)DEPTH * DM * DFF;
    if (i < n_in) { int k = i % DM; int n = (i / DM) % NIN_PAD; int l = i / ((size_t)DM * NIN_PAD);
        int col = n < 7 * DB ? n : (n < PJ ? n + 4 * NH : (n < PJ + 4 * NH ? C_G + (n - PJ) : -1));
        p.Wt_in()[i] = col >= 0 ? f2bf(p.w_in()[((size_t)l * DM + k) * D_IN + col]) : (bf16_t)0; return; }
    i -= n_in;
    if (i < n_br) { int k = i % DB; int n = (i / DB) % DM; int lr = i / ((size_t)DB * DM); p.Wt_br()[i] = f2bf(p.w_branch()[((size_t)lr * DB + k) * DM + n]); return; }
    i -= n_br;
    if (i < n_out) { int k = i % DM; int n = (i / DM) % DM; int l = i / ((size_t)DM * DM); p.Wt_out()[i] = f2bf(p.w_out()[((size_t)l * DM + k) * DM + n]); return; }
    i -= n_out;
    if (i < n_f1) { int k = i % DM; int n = (i / DM) % DFF; int l = i / ((size_t)DM * DFF); p.Wt_ff1()[i] = f2bf(p.w_ff1()[((size_t)l * DM + k) * DFF + n]); return; }
    i -= n_f1;
    if (i < n_f2) { int k = i % DFF; int n = (i / DFF) % DM; int l = i / ((size_t)DFF * DM); p.Wt_ff2()[i] = f2bf(p.w_ff2()[((size_t)l * DFF + k) * DM + n]); return; }
}
#define N_CONV ((size_t)DEPTH * ((size_t)NIN_PAD * DM + (size_t)3 * DM * DB + (size_t)DM * DM + (size_t)2 * DFF * DM))

__device__ __forceinline__ void epi_scalar(const P& p, int l, int mode, int z, int m, int n, float acc) {
    if (mode == 0) { if (n < PJ) p.proj()[(size_t)m * PJ + n] = f2bf(acc); else if (n < PJ + 4 * NH) p.gate_pre()[(size_t)m * 16 + (n - PJ)] = acc; }
    else if (mode == 1) { float g = sigmoidf_(PRJ(m, C_BR + z * DM + n)) * acc; float* t = p.mergedf() + (size_t)m * DM + n;
        if (z == 0) *t = g; else if (z == 1) *t += g; else p.merged()[(size_t)m * DM + n] = f2bf(*t + g); }
    else if (mode == 2) p.x()[(size_t)m * DM + n] += p.mod()[((size_t)l * 3 + cond_of_row(m)) * 6 * DM + 2 * DM + n] * acc;
    else if (mode == 3) { float r = fmaxf(acc, 0.f); p.hff()[(size_t)m * DFF + n] = f2bf(r * r); }
    else p.x()[(size_t)m * DM + n] += p.mod()[((size_t)l * 3 + cond_of_row(m)) * 6 * DM + 5 * DM + n] * acc;
}
struct GemmArgs { const bf16_t* A; const bf16_t* Bt; int lda, ldb, K, M, N, nZ; long zA, zB; };
__device__ __forceinline__ GemmArgs gemm_args(const P& p, int l, int mode) {
    GemmArgs g;
    if (mode == 0) g = GemmArgs{p.u(), p.Wt_in() + (size_t)l * NIN_PAD * DM, DM, DM, DM, NROW, NIN_PAD, 1, 0, 0};
    else if (mode == 1) g = GemmArgs{p.ys(), p.Wt_br() + (size_t)l * 3 * DM * DB, 3 * DB, DB, DB, NROW, DM, 3, DB, (long)DM * DB};
    else if (mode == 2) g = GemmArgs{p.merged(), p.Wt_out() + (size_t)l * DM * DM, DM, DM, DM, NROW, DM, 1, 0, 0};
    else if (mode == 3) g = GemmArgs{p.u(), p.Wt_ff1() + (size_t)l * DFF * DM, DM, DM, DM, NROW, DFF, 1, 0, 0};
    else g = GemmArgs{p.hff(), p.Wt_ff2() + (size_t)l * DM * DFF, DFF, DFF, DFF, NROW, DM, 1, 0, 0};
    return g;
}
#ifdef CPU_EMU
__device__ __forceinline__ void b_gemm(const P& p, size_t i, int l, int mode) {
    GemmArgs g = gemm_args(p, l, mode);
    int n = i % g.N; int m = i / g.N;
    for (int z = 0; z < g.nZ; ++z) { const bf16_t* a = g.A + z * g.zA + (size_t)m * g.lda; const bf16_t* b = g.Bt + z * g.zB + (size_t)n * g.ldb; float acc = 0.f;
        for (int k = 0; k < g.K; ++k) acc += bf2f(a[k]) * bf2f(b[k]);
        epi_scalar(p, l, mode, z, m, n, acc); }
}
#else
namespace pg8 {
#define PG8_LAS __attribute__((address_space(3)))
typedef short bf16x8 __attribute__((ext_vector_type(8)));
typedef float f32x4 __attribute__((ext_vector_type(4)));
typedef unsigned u32x4 __attribute__((ext_vector_type(4)));
typedef unsigned u32x2 __attribute__((ext_vector_type(2)));
constexpr int BM = 256, BK = 64, HALF = 128, HTB = HALF * BK * 2, STAGE_BYTES = 8 * HTB, NXCD = 8, WGM = 8;
__host__ __device__ __forceinline__ int lds_byte(int r, int c) { const int st = (r >> 4) * 2 + (c >> 5), rr = r & 15, cc = c & 31, ob = rr * 64 + cc * 2; return st * 1024 + (ob ^ (((ob >> 9) & 1) << 5)); }
__host__ __device__ __forceinline__ void stage_rc(int b, int& R, int& C) { const int st = b / 1024, sb = b % 1024, swz = sb ^ (((sb >> 9) & 1) << 5); R = (st >> 1) * 16 + swz / 64; C = (st & 1) * 32 + (swz % 64) / 2; }
__host__ __device__ __forceinline__ int perm32(int rho) { const int n = rho >> 4, i = rho & 15; return 8 * (i >> 2) + 4 * n + (i & 3); }
struct Unit { int pm, pn, z; };
struct Order {
    int nM, nN, nZ, nwg, G, c;
    __device__ void init(int M, int N, int nZ_, int G_, int c_) { nM = M / BM; nN = N / BM; nZ = nZ_; nwg = nM * nN; G = G_; c = c_; }
    __device__ bool next(int i, Unit& u) const {
        const int ti = i / nZ; u.z = i - ti * nZ;
        const long L = (long)ti * G + c; if (L >= nwg) return false;
        int wgid = (int)L; { const int q = nwg / NXCD, r = nwg % NXCD, xcd = wgid % NXCD, off = wgid / NXCD; wgid = (xcd < r ? xcd * (q + 1) : r * (q + 1) + (xcd - r) * q) + off; }
        const int nig = WGM * nN, gid = wgid / nig, fm = gid * WGM, gsz = (nM - fm) < WGM ? (nM - fm) : WGM;
        u.pm = fm + ((wgid % nig) % gsz); u.pn = (wgid % nig) / gsz; return true;
    }
};
__device__ __forceinline__ void st16_wt(void* base_uniform, unsigned byte_off, u32x4 v) {
    const __amdgpu_buffer_rsrc_t r = __builtin_amdgcn_make_buffer_rsrc(base_uniform, (short)0, 0x7fffffff, 0x00020000);
    __builtin_amdgcn_raw_buffer_store_b128(v, r, byte_off, 0, 16); }
typedef __bf16 bf16x2v __attribute__((ext_vector_type(2)));
__device__ __forceinline__ unsigned cvt_pk_bf16(float lo, float hi) { bf16x2v v; v.x = (__bf16)lo; v.y = (__bf16)hi; return __builtin_bit_cast(unsigned, v); }
__device__ __forceinline__ float bf_lo(unsigned w) { return __uint_as_float(w << 16); }
__device__ __forceinline__ float bf_hi(unsigned w) { return __uint_as_float(w & 0xffff0000u); }

template <int MODE> struct Epi {
    static constexpr bool PERM = (MODE == 0 || MODE == 1 || MODE == 3);
    P p; int l;
    __device__ __forceinline__ void operator()(const f32x4 (&acc)[2][2][4][2], const Unit& u, int wr, int wc, int fr, int fq) const {
        const int row0 = u.pm * BM + wr * 64 + fr;
        if constexpr (PERM) {
            const int col0 = u.pn * BM + wc * 32 + 8 * fq;
#pragma unroll
            for (int ai = 0; ai < 2; ++ai)
#pragma unroll
                for (int m = 0; m < 4; ++m) { const int row = row0 + ai * HALF + m * 16;
#pragma unroll
                    for (int bj = 0; bj < 2; ++bj) { const int col = col0 + bj * HALF; f32x4 v0 = acc[ai][bj][m][0], v1 = acc[ai][bj][m][1];
                        if constexpr (MODE == 0) {
                            if (col < PJ) { u32x4 w; w.x = cvt_pk_bf16(v0[0], v0[1]); w.y = cvt_pk_bf16(v0[2], v0[3]); w.z = cvt_pk_bf16(v1[0], v1[1]); w.w = cvt_pk_bf16(v1[2], v1[3]); st16_wt(p.proj(), (unsigned)(row * PJ + col) * 2u, w); }
                            else if (col < PJ + 16) { float* g = p.gate_pre() + (size_t)row * 16 + (col - PJ); *(f32x4*)g = v0; *(f32x4*)(g + 4) = v1; }
                        } else if constexpr (MODE == 1) {
                            const u32x4 gw = *(const u32x4*)(p.proj() + (size_t)row * PJ + C_BR + u.z * DM + col);
                            f32x4 g0, g1; g0[0] = bf_lo(gw.x); g0[1] = bf_hi(gw.x); g0[2] = bf_lo(gw.y); g0[3] = bf_hi(gw.y); g1[0] = bf_lo(gw.z); g1[1] = bf_hi(gw.z); g1[2] = bf_lo(gw.w); g1[3] = bf_hi(gw.w);
#pragma unroll
                            for (int j = 0; j < 4; ++j) { v0[j] *= __builtin_amdgcn_rcpf(1.0f + __expf(-g0[j])); v1[j] *= __builtin_amdgcn_rcpf(1.0f + __expf(-g1[j])); }
                            float* t = p.mergedf() + (size_t)row * DM + col;
                            if (u.z == 0) { *(f32x4*)t = v0; *(f32x4*)(t + 4) = v1; }
                            else if (u.z == 1) { *(f32x4*)t = *(f32x4*)t + v0; *(f32x4*)(t + 4) = *(f32x4*)(t + 4) + v1; }
                            else { v0 = v0 + *(f32x4*)t; v1 = v1 + *(f32x4*)(t + 4); u32x4 w; w.x = cvt_pk_bf16(v0[0], v0[1]); w.y = cvt_pk_bf16(v0[2], v0[3]); w.z = cvt_pk_bf16(v1[0], v1[1]); w.w = cvt_pk_bf16(v1[2], v1[3]); *(u32x4*)(p.merged() + (size_t)row * DM + col) = w; }
                        } else {
#pragma unroll
                            for (int j = 0; j < 4; ++j) { float a = fmaxf(v0[j], 0.f), b = fmaxf(v1[j], 0.f); v0[j] = a * a; v1[j] = b * b; }
                            u32x4 w; w.x = cvt_pk_bf16(v0[0], v0[1]); w.y = cvt_pk_bf16(v0[2], v0[3]); w.z = cvt_pk_bf16(v1[0], v1[1]); w.w = cvt_pk_bf16(v1[2], v1[3]); st16_wt(p.hff(), (unsigned)(row * DFF + col) * 2u, w);
                        } } }
        } else {
            const int col0 = u.pn * BM + wc * 32 + 4 * fq;
#pragma unroll
            for (int ai = 0; ai < 2; ++ai)
#pragma unroll
                for (int m = 0; m < 4; ++m) { const int row = row0 + ai * HALF + m * 16;
                    const float* gt = p.mod() + ((size_t)l * 3 + cond_of_row(row)) * 6 * DM + (MODE == 2 ? 2 : 5) * DM; float* xr = p.x() + (size_t)row * DM;
#pragma unroll
                    for (int bj = 0; bj < 2; ++bj)
#pragma unroll
                        for (int n = 0; n < 2; ++n) { const int col = col0 + bj * HALF + n * 16; *(f32x4*)(xr + col) = *(f32x4*)(xr + col) + *(const f32x4*)(gt + col) * acc[ai][bj][m][n]; } }
        }
    }
};

template <class EpiT, class OrderT, bool ALIGN_EPI, bool SP2, bool LAST_DRAIN>
__device__ __forceinline__ void gemm_phase(PG8_LAS unsigned char* lds, const GemmArgs g, const OrderT& S, const EpiT& E) {
    int tid = threadIdx.x; asm volatile("" : "+v"(tid));
    const int wid = __builtin_amdgcn_readfirstlane(tid >> 6), lane = tid & 63, wr = wid >> 2, wc = wid & 3, fr = lane & 15, fq = lane >> 4;
    const int nt = g.K / BK;
    unsigned voffA[2], voffB[2];
#pragma unroll
    for (int i = 0; i < 2; ++i) { int R, C; stage_rc(tid * 16 + i * 8192, R, C); const int Rb = EpiT::PERM ? ((R & ~31) + perm32(R & 31)) : R;
        voffA[i] = (unsigned)(R * g.lda + C) * 2u; voffB[i] = (unsigned)(Rb * g.ldb + C) * 2u; }
    const size_t kstep = (size_t)(BK * 2);
    const size_t hstepA = (size_t)HALF * g.lda * 2, hstepB = (size_t)HALF * g.ldb * 2;
    const unsigned ldsw = (unsigned)wid * 1024u;
    const int aoff = lds_byte(wr * 64 + fr, fq * 8), boff = lds_byte(wc * 32 + fr, fq * 8);
#define PG8_SA(b, h) (((b) * 2 + (h)) * HTB)
#define PG8_SB(b, h) ((4 + (b) * 2 + (h)) * HTB)
#define PG8_STAGE(bufoff, gbase, voff) do { _Pragma("unroll") for (int _i = 0; _i < 2; ++_i) \
        __builtin_amdgcn_global_load_lds((const unsigned*)((const char*)(gbase) + (voff)[_i]), (PG8_LAS unsigned*)(lds + (bufoff) + ldsw + _i * 8192), 16, 0, 0); } while (0)
#define PG8_LDA(dst, b, h) do { _Pragma("unroll") for (int m = 0; m < 4; ++m) _Pragma("unroll") for (int k = 0; k < 2; ++k) dst[m][k] = *(const PG8_LAS bf16x8*)(lds + PG8_SA(b, h) + aoff + m * 2048 + k * 1024); } while (0)
#define PG8_LDB(dst, b, h) do { _Pragma("unroll") for (int n = 0; n < 2; ++n) _Pragma("unroll") for (int k = 0; k < 2; ++k) dst[n][k] = *(const PG8_LAS bf16x8*)(lds + PG8_SB(b, h) + boff + n * 2048 + k * 1024); } while (0)
#define PG8_MMA(ai, bj, At, Bt) do { __builtin_amdgcn_s_setprio(1); _Pragma("unroll") for (int m = 0; m < 4; ++m) _Pragma("unroll") for (int n = 0; n < 2; ++n) _Pragma("unroll") for (int k = 0; k < 2; ++k) \
        acc[ai][bj][m][n] = __builtin_amdgcn_mfma_f32_16x16x32_bf16(Bt[n][k], At[m][k], acc[ai][bj][m][n], 0, 0, 0); __builtin_amdgcn_s_setprio(0); } while (0)
#define PG8_WAIT_V(n) asm volatile("s_waitcnt vmcnt(" #n ")" ::: "memory")
#define PG8_WAIT_L(n) asm volatile("s_waitcnt lgkmcnt(" #n ")" ::: "memory")
#define PG8_BAR __builtin_amdgcn_s_barrier()
#define PG8_SCHED __builtin_amdgcn_sched_barrier(0)
#define PG8_APTR(u) ((const char*)(g.A + (size_t)(u).z * g.zA + (size_t)(u).pm * BM * g.lda))
#define PG8_BPTR(u) ((const char*)(g.Bt + (size_t)(u).z * g.zB + (size_t)(u).pn * BM * g.ldb))
    Unit cur, nxt; int ui = 0;
    if (!S.next(0, cur)) return;
    f32x4 acc[2][2][4][2];
#pragma unroll
    for (int a = 0; a < 2; ++a)
#pragma unroll
        for (int b = 0; b < 2; ++b)
#pragma unroll
            for (int m = 0; m < 4; ++m)
#pragma unroll
                for (int n = 0; n < 2; ++n) acc[a][b][m][n] = (f32x4){0.f, 0.f, 0.f, 0.f};
    const char* cA = PG8_APTR(cur); const char* cB = PG8_BPTR(cur);
    if constexpr (SP2) {
        PG8_STAGE(PG8_SB(0, 0), cB, voffB); PG8_STAGE(PG8_SB(0, 1), cB + hstepB, voffB); PG8_STAGE(PG8_SA(0, 0), cA, voffA); PG8_STAGE(PG8_SA(0, 1), cA + hstepA, voffA);
        if (wr == 1) PG8_BAR;
        PG8_WAIT_V(2); PG8_BAR;
        PG8_STAGE(PG8_SB(1, 0), cB + kstep, voffB); PG8_STAGE(PG8_SA(1, 0), cA + kstep, voffA); PG8_STAGE(PG8_SB(1, 1), cB + hstepB + kstep, voffB);
        PG8_WAIT_V(6); PG8_BAR;
    } else {
        PG8_STAGE(PG8_SB(0, 0), cB, voffB); PG8_STAGE(PG8_SA(0, 0), cA, voffA); PG8_STAGE(PG8_SB(0, 1), cB + hstepB, voffB); PG8_STAGE(PG8_SA(0, 1), cA + hstepA, voffA);
        if (wr == 1) PG8_BAR;
        PG8_WAIT_V(4); PG8_BAR;
        PG8_STAGE(PG8_SB(1, 0), cB + kstep, voffB); PG8_STAGE(PG8_SA(1, 0), cA + kstep, voffA); PG8_STAGE(PG8_SB(1, 1), cB + hstepB + kstep, voffB);
        PG8_WAIT_V(6); PG8_BAR;
    }
    for (;;) {
        const bool has_next = S.next(ui + 1, nxt);
        const char* nA = has_next ? PG8_APTR(nxt) : cA; const char* nB = has_next ? PG8_BPTR(nxt) : cB;
        for (int t = 0; t < nt; t += 2) {
            bf16x8 At[4][2], B0[2][2], B1[2][2];
            const bool last = (t == nt - 2);
            const char* a1 = cA + (size_t)(t + 1) * kstep;
            const char* a2 = last ? nA : cA + (size_t)(t + 2) * kstep; const char* b2 = last ? nB : cB + (size_t)(t + 2) * kstep;
            const char* a3 = a2 + kstep; const char* b3 = b2 + kstep;
            if constexpr (SP2) {
            PG8_LDB(B0, 0, 0); PG8_LDB(B1, 0, 1); PG8_SCHED; PG8_LDA(At, 0, 0); PG8_STAGE(PG8_SA(1, 1), a1 + hstepA, voffA);
            PG8_WAIT_V(8); PG8_WAIT_L(0); PG8_BAR; PG8_MMA(0, 0, At, B0); PG8_MMA(0, 1, At, B1); PG8_BAR; PG8_SCHED;
            PG8_LDA(At, 0, 1); PG8_STAGE(PG8_SB(0, 0), b2, voffB); PG8_STAGE(PG8_SB(0, 1), b2 + hstepB, voffB); PG8_STAGE(PG8_SA(0, 0), a2, voffA);
            PG8_WAIT_V(8); PG8_WAIT_L(0); PG8_BAR; PG8_MMA(1, 0, At, B0); PG8_MMA(1, 1, At, B1); PG8_BAR; PG8_SCHED;
            PG8_LDB(B0, 1, 0); PG8_LDB(B1, 1, 1); PG8_SCHED; PG8_LDA(At, 1, 0); PG8_STAGE(PG8_SA(0, 1), a2 + hstepA, voffA);
            PG8_WAIT_V(8); PG8_WAIT_L(0); PG8_BAR; PG8_MMA(0, 0, At, B0); PG8_MMA(0, 1, At, B1); PG8_BAR; PG8_SCHED;
            PG8_LDA(At, 1, 1); PG8_STAGE(PG8_SB(1, 0), b3, voffB); PG8_STAGE(PG8_SB(1, 1), b3 + hstepB, voffB); PG8_STAGE(PG8_SA(1, 0), a3, voffA);
            PG8_WAIT_V(8); PG8_WAIT_L(0); PG8_BAR; PG8_MMA(1, 0, At, B0); PG8_MMA(1, 1, At, B1); PG8_BAR; PG8_SCHED;
            } else {
            PG8_LDB(B0, 0, 0); PG8_SCHED; PG8_LDA(At, 0, 0); PG8_STAGE(PG8_SA(1, 1), a1 + hstepA, voffA);
            PG8_WAIT_L(8); PG8_BAR; PG8_WAIT_L(0); PG8_MMA(0, 0, At, B0); PG8_BAR; PG8_SCHED;
            PG8_LDB(B1, 0, 1); PG8_STAGE(PG8_SB(0, 0), b2, voffB);
            PG8_BAR; PG8_WAIT_L(0); PG8_MMA(0, 1, At, B1); PG8_BAR;
            PG8_LDA(At, 0, 1); PG8_STAGE(PG8_SA(0, 0), a2, voffA);
            PG8_BAR; PG8_WAIT_L(0); PG8_MMA(1, 0, At, B0); PG8_BAR; PG8_SCHED;
            PG8_STAGE(PG8_SB(0, 1), b2 + hstepB, voffB);
            PG8_WAIT_V(6); PG8_BAR; PG8_MMA(1, 1, At, B1); PG8_BAR;
            PG8_LDB(B0, 1, 0); PG8_SCHED; PG8_LDA(At, 1, 0); PG8_STAGE(PG8_SA(0, 1), a2 + hstepA, voffA);
            PG8_WAIT_L(8); PG8_BAR; PG8_WAIT_L(0); PG8_MMA(0, 0, At, B0); PG8_BAR; PG8_SCHED;
            PG8_LDB(B1, 1, 1); PG8_STAGE(PG8_SB(1, 0), b3, voffB);
            PG8_BAR; PG8_WAIT_L(0); PG8_MMA(0, 1, At, B1); PG8_BAR;
            PG8_LDA(At, 1, 1); PG8_STAGE(PG8_SA(1, 0), a3, voffA);
            PG8_BAR; PG8_WAIT_L(0); PG8_MMA(1, 0, At, B0); PG8_BAR; PG8_SCHED;
            PG8_STAGE(PG8_SB(1, 1), b3 + hstepB, voffB);
            PG8_WAIT_V(6); PG8_BAR; PG8_MMA(1, 1, At, B1); PG8_BAR;
            }
        }
        if constexpr (ALIGN_EPI) { if (wr == 0) PG8_BAR; }
        if constexpr (LAST_DRAIN) { if (has_next) E(acc, cur, wr, wc, fr, fq, tid); } else E(acc, cur, wr, wc, fr, fq);
        if (!has_next) break;
#pragma unroll
        for (int a = 0; a < 2; ++a)
#pragma unroll
            for (int b = 0; b < 2; ++b)
#pragma unroll
                for (int m = 0; m < 4; ++m)
#pragma unroll
                    for (int n = 0; n < 2; ++n) acc[a][b][m][n] = (f32x4){0.f, 0.f, 0.f, 0.f};
        cur = nxt; cA = nA; cB = nB; ++ui;
        if constexpr (ALIGN_EPI) { if (wr == 1) PG8_BAR; }
    }
    PG8_WAIT_V(0);
    if constexpr (!ALIGN_EPI) { if (wr == 0) PG8_BAR; }
    PG8_BAR;
    if constexpr (LAST_DRAIN) E.fused(acc, cur, wr, wc, fr, fq, lds, tid);
#undef PG8_SA
#undef PG8_SB
#undef PG8_STAGE
#undef PG8_LDA
#undef PG8_LDB
#undef PG8_MMA
#undef PG8_WAIT_V
#undef PG8_WAIT_L
#undef PG8_BAR
#undef PG8_SCHED
#undef PG8_APTR
#undef PG8_BPTR
}
}
namespace pg8 {
constexpr int STG = 3 * HTB;
struct Order128 {
    int nM, nN, nZ, nwg, G, c;
    __device__ void init(int M, int N, int nZ_, int G_, int c_) { nM = M / HALF; nN = N / BM; nZ = nZ_; nwg = nM * nN; G = G_; c = c_; }
    __device__ bool next(int i, Unit& u) const {
        const int ti = i / nZ; u.z = i - ti * nZ;
        const long L = (long)ti * G + c; if (L >= nwg) return false;
        int wgid = (int)L; { const int q = nwg / NXCD, r = nwg % NXCD, xcd = wgid % NXCD, off = wgid / NXCD; wgid = (xcd < r ? xcd * (q + 1) : r * (q + 1) + (xcd - r) * q) + off; }
        const int nig = WGM * nN, gid = wgid / nig, fm = gid * WGM, gsz = (nM - fm) < WGM ? (nM - fm) : WGM;
        u.pm = fm + ((wgid % nig) % gsz); u.pn = (wgid % nig) / gsz; return true;
    }
};
template <int MODE> struct Epi128 {
    static constexpr bool PERM = (MODE == 1), AFTER_DRAIN = (MODE != 1);
    P p; int l; float gsc;
    mutable u32x2 rsum[2][4][2];
    __device__ __forceinline__ void operator()(f32x4 (&acc)[2][4][2], const Unit& u, int wr_, int wc_, int fr_, int fq_) const {
        if constexpr (MODE == 1) {
            int tid = threadIdx.x; asm volatile("" : "+v"(tid));
            const int wid = __builtin_amdgcn_readfirstlane(tid >> 6), lane = tid & 63, wr = wid >> 2, wc = wid & 3, fr = lane & 15, fq = lane >> 4;
            const int row0 = u.pm * HALF + wr * 64 + fr, col0 = u.pn * BM + wc * 32 + 8 * fq;
            { u32x4 gw[4][2];
#pragma unroll
              for (int m = 0; m < 4; ++m)
#pragma unroll
                  for (int bj = 0; bj < 2; ++bj) gw[m][bj] = *(const u32x4*)(p.proj() + (size_t)(row0 + m * 16) * PJ + C_BR + u.z * DM + col0 + bj * HALF);
#pragma unroll
              for (int m = 0; m < 4; ++m) {
#pragma unroll
                  for (int bj = 0; bj < 2; ++bj) { const u32x4 g = gw[m][bj]; const float g0[4] = {bf_lo(g.x), bf_hi(g.x), bf_lo(g.y), bf_hi(g.y)}, g1[4] = {bf_lo(g.z), bf_hi(g.z), bf_lo(g.w), bf_hi(g.w)};
#pragma unroll
                      for (int j = 0; j < 4; ++j) { acc[bj][m][0][j] *= __builtin_amdgcn_rcpf(1.0f + __expf(-g0[j])); acc[bj][m][1][j] *= __builtin_amdgcn_rcpf(1.0f + __expf(-g1[j])); } }
                  asm volatile("" : "+v"(acc[0][m][0]), "+v"(acc[0][m][1]), "+v"(acc[1][m][0]), "+v"(acc[1][m][1]) :: "memory"); } }
#pragma unroll
            for (int m = 0; m < 4; ++m)
#pragma unroll
                for (int bj = 0; bj < 2; ++bj)
#pragma unroll
                    for (int n = 0; n < 2; ++n) { f32x4 v = acc[bj][m][n];
                        if (u.z != 0) { const u32x2 s = rsum[bj][m][n]; v[0] += bf_lo(s.x); v[1] += bf_hi(s.x); v[2] += bf_lo(s.y); v[3] += bf_hi(s.y); }
                        u32x2 w; w.x = cvt_pk_bf16(v[0], v[1]); w.y = cvt_pk_bf16(v[2], v[3]); rsum[bj][m][n] = w; }
            if (u.z == 2) {
#pragma unroll
                for (int m = 0; m < 4; ++m)
#pragma unroll
                    for (int bj = 0; bj < 2; ++bj) { const size_t o = (size_t)(row0 + m * 16) * DM + col0 + bj * HALF; u32x4 w; w.x = rsum[bj][m][0].x; w.y = rsum[bj][m][0].y; w.z = rsum[bj][m][1].x; w.w = rsum[bj][m][1].y;
                        st16_wt(p.merged(), (unsigned)o * 2u, w); } }
        }
    }
    __device__ __forceinline__ void fused(f32x4 (&acc)[2][4][2], const Unit& u, int wr_, int wc_, int fr_, int fq_, PG8_LAS unsigned char* lds, int tid_) const {
        int tid = tid_; asm volatile("" : "+v"(tid));
        const int wid = __builtin_amdgcn_readfirstlane(tid >> 6), lane = tid & 63, wr = wid >> 2, wc = wid & 3, fr = lane & 15, fq = lane >> 4;
        const int row0 = u.pm * HALF + wr * 64 + fr, col0 = u.pn * BM + wc * 32 + 4 * fq, ci = cond_of_row(u.pm * HALF);
        const float* gt = p.mod() + ((size_t)l * 3 + ci) * 6 * DM + (MODE == 2 ? 2 : 5) * DM;
        f32x4 gv[2][2], xv[4][2][2];
#pragma unroll
        for (int bj = 0; bj < 2; ++bj)
#pragma unroll
            for (int n = 0; n < 2; ++n) gv[bj][n] = *(const f32x4*)(gt + col0 + bj * HALF + n * 16) * gsc;
#pragma unroll
        for (int m = 0; m < 4; ++m)
#pragma unroll
            for (int bj = 0; bj < 2; ++bj)
#pragma unroll
                for (int n = 0; n < 2; ++n) xv[m][bj][n] = *(const f32x4*)(p.x() + (size_t)(row0 + m * 16) * DM + col0 + bj * HALF + n * 16);
        PG8_LAS float* Pp = (PG8_LAS float*)lds;
        PG8_LAS float* Rr = Pp + 512;
#pragma unroll
        for (int m = 0; m < 4; ++m) { float s = 0.f;
#pragma unroll
            for (int bj = 0; bj < 2; ++bj)
#pragma unroll
                for (int n = 0; n < 2; ++n) { const f32x4 v = xv[m][bj][n] + gv[bj][n] * acc[bj][m][n]; xv[m][bj][n] = v; s += v[0] * v[0] + v[1] * v[1] + v[2] * v[2] + v[3] * v[3]; }
            s += __shfl_xor(s, 16, 64); s += __shfl_xor(s, 32, 64);
            if (fq == 0) Pp[(wr * 64 + m * 16 + fr) * 4 + wc] = s; }
        asm volatile("" ::: "memory");
        const int kind = MODE == 2 ? 0 : 1;
        float* slots = p.ssq() + ((size_t)(kind * DEPTH + l) * NROW + (size_t)u.pm * HALF) * 4;
        unsigned* cnt = p.cnt() + ((size_t)(kind * DEPTH + l) * (NROW / HALF) + u.pm) * 64;
        __syncthreads();
        if (tid < HALF) { const float t = (Pp[tid * 4] + Pp[tid * 4 + 1]) + (Pp[tid * 4 + 2] + Pp[tid * 4 + 3]); __hip_atomic_store(slots + tid * 4 + u.pn, t, __ATOMIC_RELAXED, __HIP_MEMORY_SCOPE_AGENT); }
        asm volatile("s_waitcnt vmcnt(0)" ::: "memory");
        __syncthreads();
        if (tid == 0) { __hip_atomic_fetch_add(cnt, 1u, __ATOMIC_RELAXED, __HIP_MEMORY_SCOPE_AGENT);
            unsigned sp = 0; while (__hip_atomic_load(cnt, __ATOMIC_RELAXED, __HIP_MEMORY_SCOPE_AGENT) < (unsigned)(DM / BM)) { __builtin_amdgcn_s_sleep(2); if (++sp > (1u << 22)) break; }
            }
        __syncthreads();
        if (tid < HALF) { float t = 0.f;
#pragma unroll
            for (int q = 0; q < DM / BM; ++q) t += __hip_atomic_load(slots + tid * 4 + q, __ATOMIC_RELAXED, __HIP_MEMORY_SCOPE_AGENT);
            Rr[tid] = 1.0f / sqrtf(t * (1.0f / DM) + EPSF); }
#pragma unroll
        for (int m = 0; m < 4; ++m)
#pragma unroll
            for (int bj = 0; bj < 2; ++bj)
#pragma unroll
                for (int n = 0; n < 2; ++n) *(f32x4*)(p.x() + (size_t)(row0 + m * 16) * DM + col0 + bj * HALF + n * 16) = xv[m][bj][n];
        __syncthreads();
        const bool fin = (MODE == 4 && l == DEPTH - 1);
        const int ln = MODE == 2 ? l : l + 1;
        const float* gn = fin ? p.g_final() : (MODE == 2 ? p.g_norm2() : p.g_norm1()) + (size_t)ln * DM;
        const float* md = p.mod() + ((size_t)(fin ? 0 : ln) * 3 + ci) * 6 * DM + (MODE == 2 ? 3 * DM : 0);
#pragma unroll
        for (int bj = 0; bj < 2; ++bj)
#pragma unroll
            for (int n = 0; n < 2; ++n) { const int col = col0 + bj * HALF + n * 16; f32x4 gg = *(const f32x4*)(gn + col), sh = {0.f, 0.f, 0.f, 0.f};
                if (!fin) { gg = gg * (*(const f32x4*)(md + DM + col) + 1.0f); sh = *(const f32x4*)(md + col); }
#pragma unroll
                for (int m = 0; m < 4; ++m) { const int r = wr * 64 + m * 16 + fr; const f32x4 o = xv[m][bj][n] * Rr[r] * gg + sh; const size_t off = (size_t)(u.pm * HALF + r) * DM + col;
                    if (fin) *(f32x4*)(p.out + off) = o;
                    else { u32x2 w; w.x = cvt_pk_bf16(o[0], o[1]); w.y = cvt_pk_bf16(o[2], o[3]); *(u32x2*)(p.u() + off) = w; } } }
    }
};
template <class EpiT>
__device__ __forceinline__ void gemm128_phase(PG8_LAS unsigned char* lds, const GemmArgs g, const Order128& S, const EpiT& E) {
    int tid = threadIdx.x; asm volatile("" : "+v"(tid));
    const int wid = __builtin_amdgcn_readfirstlane(tid >> 6), lane = tid & 63, wr = wid >> 2, wc = wid & 3, fr = lane & 15, fq = lane >> 4;
    const int nt = g.K / BK;
    unsigned voffA[2], voffB[2];
#pragma unroll
    for (int i = 0; i < 2; ++i) { int R, C; stage_rc(tid * 16 + i * 8192, R, C); const int Rb = EpiT::PERM ? ((R & ~31) + perm32(R & 31)) : R;
        voffA[i] = (unsigned)(R * g.lda + C) * 2u; voffB[i] = (unsigned)(Rb * g.ldb + C) * 2u; }
    const size_t kstep = (size_t)(BK * 2);
    const size_t hstepB = (size_t)HALF * g.ldb * 2;
    const unsigned ldsw = (unsigned)wid * 1024u;
    const int aoff = lds_byte(wr * 64 + fr, fq * 8), boff = lds_byte(wc * 32 + fr, fq * 8);
#define G1_STAGE(bufoff, gbase, voff) do { _Pragma("unroll") for (int _i = 0; _i < 2; ++_i) \
        __builtin_amdgcn_global_load_lds((const unsigned*)((const char*)(gbase) + (voff)[_i]), (PG8_LAS unsigned*)(lds + (bufoff) + ldsw + _i * 8192), 16, 0, 0); } while (0)
#define G1_STAGE3(so, pa, pb) do { G1_STAGE((so) + HTB, (pb), voffB); G1_STAGE((so) + 2 * HTB, (pb) + hstepB, voffB); G1_STAGE((so), (pa), voffA); } while (0)
#define G1_LDA(dst, so) do { _Pragma("unroll") for (int m = 0; m < 4; ++m) _Pragma("unroll") for (int k = 0; k < 2; ++k) dst[m][k] = *(const PG8_LAS bf16x8*)(lds + (so) + aoff + m * 2048 + k * 1024); } while (0)
#define G1_LDB(dst, so, h) do { _Pragma("unroll") for (int n = 0; n < 2; ++n) _Pragma("unroll") for (int k = 0; k < 2; ++k) dst[n][k] = *(const PG8_LAS bf16x8*)(lds + (so) + (1 + (h)) * HTB + boff + n * 2048 + k * 1024); } while (0)
#define G1_MMA(bj, At, Bt) do { _Pragma("unroll") for (int m = 0; m < 4; ++m) _Pragma("unroll") for (int n = 0; n < 2; ++n) _Pragma("unroll") for (int k = 0; k < 2; ++k) \
        acc[bj][m][n] = __builtin_amdgcn_mfma_f32_16x16x32_bf16(Bt[n][k], At[m][k], acc[bj][m][n], 0, 0, 0); } while (0)
#define G1_WAIT_V(n) asm volatile("s_waitcnt vmcnt(" #n ")" ::: "memory")
#define G1_WAIT_L(n) asm volatile("s_waitcnt lgkmcnt(" #n ")" ::: "memory")
#define G1_BAR __builtin_amdgcn_s_barrier()
#define G1_SCHED __builtin_amdgcn_sched_barrier(0)
#define G1_APTR(u) ((const char*)(g.A + (size_t)(u).z * g.zA + (size_t)(u).pm * HALF * g.lda))
#define G1_BPTR(u) ((const char*)(g.Bt + (size_t)(u).z * g.zB + (size_t)(u).pn * BM * g.ldb))
    Unit cur;
    if (!S.next(0, cur)) return;
    f32x4 acc[2][4][2];
#pragma unroll
    for (int b = 0; b < 2; ++b)
#pragma unroll
        for (int m = 0; m < 4; ++m)
#pragma unroll
            for (int n = 0; n < 2; ++n) acc[b][m][n] = (f32x4){0.f, 0.f, 0.f, 0.f};
    bf16x8 A0[4][2], P0[2][2], Q0[2][2], A1[4][2], P1[2][2], Q1[2][2];
    Unit iu = cur; int iui = 0, it = 0; const char* iA = G1_APTR(iu); const char* iB = G1_BPTR(iu); int iso = 0; bool ilive = true;
#define G1_ISSUE() do { G1_STAGE3(iso, iA + (size_t)it * kstep, iB + (size_t)it * kstep); iso = iso == 2 * STG ? 0 : iso + STG; \
        if (++it == nt) { it = 0; if (ilive) { Unit nx; if (S.next(iui + 1, nx)) { iu = nx; ++iui; iA = G1_APTR(iu); iB = G1_BPTR(iu); } else ilive = false; } } } while (0)
    G1_ISSUE(); G1_ISSUE(); G1_ISSUE();
    G1_WAIT_V(12); G1_BAR;
    G1_LDB(P0, 0, 0); G1_LDB(Q0, 0, 1); G1_LDA(A0, 0);
    G1_WAIT_L(0); G1_WAIT_V(6); G1_BAR;
    int so = STG;
    int ui = 0, t = 0;
    for (;;) {
        G1_ISSUE(); G1_LDB(P1, so, 0); G1_LDB(Q1, so, 1); G1_LDA(A1, so); so = so == 2 * STG ? 0 : so + STG;
        G1_SCHED; __builtin_amdgcn_s_setprio(1); G1_MMA(0, A0, P0); G1_MMA(1, A0, Q0); __builtin_amdgcn_s_setprio(0); G1_SCHED;
        G1_WAIT_L(0); G1_WAIT_V(6); G1_BAR;
        if (++t == nt) { t = 0; Unit nx; const bool hn = S.next(ui + 1, nx);
            if constexpr (!EpiT::AFTER_DRAIN) E(acc, cur, wr, wc, fr, fq);
            if (!hn) break;
#pragma unroll
            for (int b = 0; b < 2; ++b)
#pragma unroll
                for (int m = 0; m < 4; ++m)
#pragma unroll
                    for (int n = 0; n < 2; ++n) acc[b][m][n] = (f32x4){0.f, 0.f, 0.f, 0.f};
            cur = nx; ++ui; }
        G1_ISSUE(); G1_LDB(P0, so, 0); G1_LDB(Q0, so, 1); G1_LDA(A0, so); so = so == 2 * STG ? 0 : so + STG;
        G1_SCHED; __builtin_amdgcn_s_setprio(1); G1_MMA(0, A1, P1); G1_MMA(1, A1, Q1); __builtin_amdgcn_s_setprio(0); G1_SCHED;
        G1_WAIT_L(0); G1_WAIT_V(6); G1_BAR;
        if (++t == nt) { t = 0; Unit nx; const bool hn = S.next(ui + 1, nx);
            if constexpr (!EpiT::AFTER_DRAIN) E(acc, cur, wr, wc, fr, fq);
            if (!hn) break;
#pragma unroll
            for (int b = 0; b < 2; ++b)
#pragma unroll
                for (int m = 0; m < 4; ++m)
#pragma unroll
                    for (int n = 0; n < 2; ++n) acc[b][m][n] = (f32x4){0.f, 0.f, 0.f, 0.f};
            cur = nx; ++ui; }
    }
    G1_WAIT_V(0);
    G1_BAR;
    if constexpr (EpiT::AFTER_DRAIN) E.fused(acc, cur, wr, wc, fr, fq, lds, tid);
#undef G1_ISSUE
#undef G1_STAGE
#undef G1_STAGE3
#undef G1_LDA
#undef G1_LDB
#undef G1_MMA
#undef G1_WAIT_V
#undef G1_WAIT_L
#undef G1_BAR
#undef G1_SCHED
#undef G1_APTR
#undef G1_BPTR
}
template <class EpiT>
__device__ __forceinline__ void gemm128_phase_s(PG8_LAS unsigned char* lds, const GemmArgs g, const Order128& S, const EpiT& E) {
    int tid = threadIdx.x; asm volatile("" : "+v"(tid));
    const int wid = __builtin_amdgcn_readfirstlane(tid >> 6), lane = tid & 63, wr = wid >> 2, wc = wid & 3, fr = lane & 15, fq = lane >> 4;
    const int nt = g.K / BK;
    unsigned voffA[2], voffB[2];
#pragma unroll
    for (int i = 0; i < 2; ++i) { int R, C; stage_rc(tid * 16 + i * 8192, R, C); const int Rb = EpiT::PERM ? ((R & ~31) + perm32(R & 31)) : R;
        voffA[i] = (unsigned)(R * g.lda + C) * 2u; voffB[i] = (unsigned)(Rb * g.ldb + C) * 2u; }
    const size_t kstep = (size_t)(BK * 2);
    const size_t hstepB = (size_t)HALF * g.ldb * 2;
    const unsigned ldsw = (unsigned)wid * 1024u;
    const int aoff = lds_byte(wr * 64 + fr, fq * 8), boff = lds_byte(wc * 32 + fr, fq * 8);
#define G1_STAGE(bufoff, gbase, voff) do { _Pragma("unroll") for (int _i = 0; _i < 2; ++_i) \
        __builtin_amdgcn_global_load_lds((const unsigned*)((const char*)(gbase) + (voff)[_i]), (PG8_LAS unsigned*)(lds + (bufoff) + ldsw + _i * 8192), 16, 0, 0); } while (0)
#define G1_STAGE3(so, pa, pb) do { G1_STAGE((so) + HTB, (pb), voffB); G1_STAGE((so) + 2 * HTB, (pb) + hstepB, voffB); G1_STAGE((so), (pa), voffA); } while (0)
#define G1_LDA(dst, so) do { _Pragma("unroll") for (int m = 0; m < 4; ++m) _Pragma("unroll") for (int k = 0; k < 2; ++k) dst[m][k] = *(const PG8_LAS bf16x8*)(lds + (so) + aoff + m * 2048 + k * 1024); } while (0)
#define G1_LDB(dst, so, h) do { _Pragma("unroll") for (int n = 0; n < 2; ++n) _Pragma("unroll") for (int k = 0; k < 2; ++k) dst[n][k] = *(const PG8_LAS bf16x8*)(lds + (so) + (1 + (h)) * HTB + boff + n * 2048 + k * 1024); } while (0)
#define G1_MMA(bj, At, Bt) do { __builtin_amdgcn_s_setprio(1); _Pragma("unroll") for (int m = 0; m < 4; ++m) _Pragma("unroll") for (int n = 0; n < 2; ++n) _Pragma("unroll") for (int k = 0; k < 2; ++k) \
        acc[bj][m][n] = __builtin_amdgcn_mfma_f32_16x16x32_bf16(Bt[n][k], At[m][k], acc[bj][m][n], 0, 0, 0); __builtin_amdgcn_s_setprio(0); } while (0)
#define G1_WAIT_V(n) asm volatile("s_waitcnt vmcnt(" #n ")" ::: "memory")
#define G1_WAIT_L(n) asm volatile("s_waitcnt lgkmcnt(" #n ")" ::: "memory")
#define G1_BAR __builtin_amdgcn_s_barrier()
#define G1_SCHED __builtin_amdgcn_sched_barrier(0)
#define G1_APTR(u) ((const char*)(g.A + (size_t)(u).z * g.zA + (size_t)(u).pm * HALF * g.lda))
#define G1_BPTR(u) ((const char*)(g.Bt + (size_t)(u).z * g.zB + (size_t)(u).pn * BM * g.ldb))
    Unit cur, nxt; int ui = 0;
    if (!S.next(0, cur)) return;
    f32x4 acc[2][4][2];
#pragma unroll
    for (int b = 0; b < 2; ++b)
#pragma unroll
        for (int m = 0; m < 4; ++m)
#pragma unroll
            for (int n = 0; n < 2; ++n) acc[b][m][n] = (f32x4){0.f, 0.f, 0.f, 0.f};
    bf16x8 At[4][2], B0[2][2], B1[2][2];
    const char* cA = G1_APTR(cur); const char* cB = G1_BPTR(cur);
    G1_STAGE3(0, cA, cB); G1_STAGE3(STG, cA + kstep, cB + kstep);
    if (wr == 1) G1_BAR;
    G1_WAIT_V(6); G1_BAR; G1_BAR;
    int so = 0;
    for (;;) {
        const bool has_next = S.next(ui + 1, nxt);
        const char* nA = has_next ? G1_APTR(nxt) : cA; const char* nB = has_next ? G1_BPTR(nxt) : cB;
        for (int t = 0; t < nt; ++t) {
            const int t2 = t + 2; const bool over = t2 >= nt;
            const char* a2 = over ? nA + (size_t)(t2 - nt) * kstep : cA + (size_t)t2 * kstep; const char* b2 = over ? nB + (size_t)(t2 - nt) * kstep : cB + (size_t)t2 * kstep;
            const int sp = so == 0 ? 2 * STG : so - STG;
            G1_LDB(B0, so, 0); G1_LDB(B1, so, 1); G1_SCHED; G1_LDA(At, so); G1_STAGE3(sp, a2, b2);
            G1_WAIT_V(6); G1_WAIT_L(0); G1_BAR; G1_MMA(0, At, B0); G1_MMA(1, At, B1); G1_BAR; G1_SCHED;
            so = so == 2 * STG ? 0 : so + STG;
        }
        if constexpr (!EpiT::AFTER_DRAIN) E(acc, cur, wr, wc, fr, fq);
        if (!has_next) break;
#pragma unroll
        for (int b = 0; b < 2; ++b)
#pragma unroll
            for (int m = 0; m < 4; ++m)
#pragma unroll
                for (int n = 0; n < 2; ++n) acc[b][m][n] = (f32x4){0.f, 0.f, 0.f, 0.f};
        cur = nxt; cA = nA; cB = nB; ++ui;
    }
    G1_WAIT_V(0);
    if (wr == 0) G1_BAR;
    G1_BAR;
    if constexpr (EpiT::AFTER_DRAIN) E.fused(acc, cur, wr, wc, fr, fq, lds, tid);
#undef G1_STAGE
#undef G1_STAGE3
#undef G1_LDA
#undef G1_LDB
#undef G1_MMA
#undef G1_WAIT_V
#undef G1_WAIT_L
#undef G1_BAR
#undef G1_SCHED
#undef G1_APTR
#undef G1_BPTR
}
}
namespace pg8 {
constexpr int NT2 = (NROW / BM) * (DM / BM);
struct Order2K {
    int nZ, kh, slot; bool active;
    __device__ void init(int nZ_, int c) { nZ = nZ_; active = c < 2 * NT2; const int j = c & 7, i = c >> 3; kh = i & 1; slot = (i >> 1) * 8 + j; }
    __device__ bool next(int i, Unit& u) const {
        if (!active || i >= nZ) return false; u.z = i;
        constexpr int nN = DM / BM, nM = NROW / BM, nwg = nM * nN; int wgid = slot; { const int q = nwg / NXCD, r = nwg % NXCD, xcd = wgid % NXCD, off = wgid / NXCD; wgid = (xcd < r ? xcd * (q + 1) : r * (q + 1) + (xcd - r) * q) + off; }
        const int nig = WGM * nN, gid = wgid / nig, fm = gid * WGM, gsz = (nM - fm) < WGM ? (nM - fm) : WGM;
        u.pm = fm + ((wgid % nig) % gsz); u.pn = (wgid % nig) / gsz; return true;
    }
};
__device__ __forceinline__ void st_wt16(float* ptr, f32x4 v) { asm volatile("global_store_dwordx4 %0, %1, off sc1\n\ts_nop 1" :: "v"(ptr), "v"(v) : "memory"); }
__device__ __forceinline__ f32x4 ld_sc1_16(const float* ptr) { f32x4 v; asm volatile("global_load_dwordx4 %0, %1, off sc1" : "=v"(v) : "v"(ptr) : "memory"); return v; }
template <int MODE> struct EpiX {
    static constexpr bool PERM = (MODE == 1);
    P p; int l, kh, slot;
    __device__ __forceinline__ float* slab(int half) const { return p.Cloc() + ((size_t)slot * 2 + half) * (size_t)(BM * BM); }
    __device__ __forceinline__ unsigned* flag() const { return p.cnt() + 64 * (2 * DEPTH * (NROW / HALF)) + ((MODE == 1 ? 0 : (MODE == 2 ? 1 : 2)) * DEPTH + l) * NT2 + slot; }
    __device__ __forceinline__ void operator()(f32x4 (&acc)[2][2][4][2], const Unit& u, int wr_, int wc_, int fr_, int fq_, int tid_) const {
        if constexpr (MODE == 1) { int tid = tid_; asm volatile("" : "+v"(tid));
            const int wid = __builtin_amdgcn_readfirstlane(tid >> 6), lane = tid & 63, wr = wid >> 2, wc = wid & 3, fr = lane & 15, fq = lane >> 4;
            gate_mul(acc, u, wr, wc, fr, fq); float* s = slab(kh) + (size_t)tid * 4;
            if (u.z != 0) {
#pragma unroll
                for (int hh = 0; hh < 4; ++hh) { f32x4 t[8];
#pragma unroll
                    for (int i = 0; i < 8; ++i) t[i] = *(const f32x4*)(s + (size_t)(hh * 8 + i) * 2048);
#pragma unroll
                    for (int i = 0; i < 8; ++i) { const int q = hh * 8 + i; acc[q >> 4][(q >> 3) & 1][(q >> 1) & 3][q & 1] = acc[q >> 4][(q >> 3) & 1][(q >> 1) & 3][q & 1] + t[i]; }
#pragma unroll
                    for (int i = 0; i < 8; i += 2) { const int q = hh * 8 + i; asm volatile("" : "+v"(acc[q >> 4][(q >> 3) & 1][(q >> 1) & 3][0]), "+v"(acc[q >> 4][(q >> 3) & 1][(q >> 1) & 3][1]) :: "memory"); } } }
#pragma unroll
            for (int i = 0; i < 32; ++i) *(f32x4*)(s + (size_t)i * 2048) = acc[i >> 4][(i >> 3) & 1][(i >> 1) & 3][i & 1];
        }
    }
    __device__ __forceinline__ void gate_mul(f32x4 (&acc)[2][2][4][2], const Unit& u, int wr, int wc, int fr, int fq) const {
        const int row0 = u.pm * BM + wr * 64 + fr, col0 = u.pn * BM + wc * 32 + 8 * fq;
#pragma unroll
        for (int ai = 0; ai < 2; ++ai)
#pragma unroll
            for (int m = 0; m < 4; ++m) { u32x4 gw[2];
#pragma unroll
                for (int bj = 0; bj < 2; ++bj) gw[bj] = *(const u32x4*)(p.proj() + (size_t)(row0 + ai * HALF + m * 16) * PJ + C_BR + u.z * DM + col0 + bj * HALF);
#pragma unroll
                for (int bj = 0; bj < 2; ++bj) { const u32x4 g = gw[bj]; const float g0[4] = {bf_lo(g.x), bf_hi(g.x), bf_lo(g.y), bf_hi(g.y)}, g1[4] = {bf_lo(g.z), bf_hi(g.z), bf_lo(g.w), bf_hi(g.w)};
#pragma unroll
                    for (int j = 0; j < 4; ++j) { acc[ai][bj][m][0][j] *= __builtin_amdgcn_rcpf(1.0f + __expf(-g0[j])); acc[ai][bj][m][1][j] *= __builtin_amdgcn_rcpf(1.0f + __expf(-g1[j])); } }
                asm volatile("" : "+v"(acc[ai][0][m][0]), "+v"(acc[ai][0][m][1]), "+v"(acc[ai][1][m][0]), "+v"(acc[ai][1][m][1]) :: "memory"); }
    }
    __device__ __forceinline__ void fused(f32x4 (&acc)[2][2][4][2], const Unit& u, int wr_, int wc_, int fr_, int fq_, PG8_LAS unsigned char* lds, int tid_) const {
        int tid = tid_; asm volatile("" : "+v"(tid));
        const int wid = __builtin_amdgcn_readfirstlane(tid >> 6), lane = tid & 63, wr = wid >> 2, wc = wid & 3, fr = lane & 15, fq = lane >> 4;
        if constexpr (MODE == 1) { gate_mul(acc, u, wr, wc, fr, fq); const float* s = slab(kh) + (size_t)tid * 4;
#pragma unroll
            for (int hh = 0; hh < 4; ++hh) { f32x4 t[8];
#pragma unroll
                for (int i = 0; i < 8; ++i) t[i] = *(const f32x4*)(s + (size_t)(hh * 8 + i) * 2048);
#pragma unroll
                for (int i = 0; i < 8; ++i) { const int q = hh * 8 + i; acc[q >> 4][(q >> 3) & 1][(q >> 1) & 3][q & 1] = acc[q >> 4][(q >> 3) & 1][(q >> 1) & 3][q & 1] + t[i]; }
#pragma unroll
                for (int i = 0; i < 8; i += 2) { const int q = hh * 8 + i; asm volatile("" : "+v"(acc[q >> 4][(q >> 3) & 1][(q >> 1) & 3][0]), "+v"(acc[q >> 4][(q >> 3) & 1][(q >> 1) & 3][1]) :: "memory"); } } }
        if (kh == 1) {
            float* s = slab(1) + (size_t)tid * 4;
#pragma unroll
            for (int i = 0; i < 32; ++i) st_wt16(s + (size_t)i * 2048, acc[i >> 4][(i >> 3) & 1][(i >> 1) & 3][i & 1]);
            asm volatile("s_waitcnt vmcnt(0)" ::: "memory");
            __syncthreads();
            if (tid == 0) __hip_atomic_store(flag(), 1u, __ATOMIC_RELAXED, __HIP_MEMORY_SCOPE_AGENT);
            return;
        }
        if (tid == 0) { unsigned sp = 0; while (__hip_atomic_load(flag(), __ATOMIC_RELAXED, __HIP_MEMORY_SCOPE_AGENT) == 0u) { __builtin_amdgcn_s_sleep(2); if (++sp > (1u << 22)) break; }
            __builtin_amdgcn_fence(__ATOMIC_ACQUIRE, "agent"); asm volatile("s_waitcnt vmcnt(0)" ::: "memory"); }
        __syncthreads();
        { const float* s = slab(1) + (size_t)tid * 4;
#pragma unroll
          for (int h = 0; h < 4; ++h) { f32x4 t[8];
#pragma unroll
              for (int i = 0; i < 8; ++i) t[i] = *(const f32x4*)(s + (size_t)(h * 8 + i) * 2048);
#pragma unroll
              for (int i = 0; i < 8; ++i) { const int q = h * 8 + i; acc[q >> 4][(q >> 3) & 1][(q >> 1) & 3][q & 1] = acc[q >> 4][(q >> 3) & 1][(q >> 1) & 3][q & 1] + t[i]; }
#pragma unroll
              for (int i = 0; i < 8; i += 2) { const int q = h * 8 + i; asm volatile("" : "+v"(acc[q >> 4][(q >> 3) & 1][(q >> 1) & 3][0]), "+v"(acc[q >> 4][(q >> 3) & 1][(q >> 1) & 3][1]) :: "memory"); } } }
        const int row0 = u.pm * BM + wr * 64 + fr;
        if constexpr (MODE == 1) {
            const int col0 = u.pn * BM + wc * 32 + 8 * fq;
#pragma unroll
            for (int ai = 0; ai < 2; ++ai)
#pragma unroll
                for (int m = 0; m < 4; ++m)
#pragma unroll
                    for (int bj = 0; bj < 2; ++bj) { const f32x4 v0 = acc[ai][bj][m][0], v1 = acc[ai][bj][m][1]; u32x4 w; w.x = cvt_pk_bf16(v0[0], v0[1]); w.y = cvt_pk_bf16(v0[2], v0[3]); w.z = cvt_pk_bf16(v1[0], v1[1]); w.w = cvt_pk_bf16(v1[2], v1[3]);
                        *(u32x4*)(p.merged() + (size_t)(row0 + ai * HALF + m * 16) * DM + col0 + bj * HALF) = w; }
        } else {
            const int col0 = u.pn * BM + wc * 32 + 4 * fq, ci = cond_of_row(u.pm * BM);
            const float* gt = p.mod() + ((size_t)l * 3 + ci) * 6 * DM + (MODE == 2 ? 2 : 5) * DM;
            f32x4 gv[2][2];
#pragma unroll
            for (int bj = 0; bj < 2; ++bj)
#pragma unroll
                for (int n = 0; n < 2; ++n) gv[bj][n] = *(const f32x4*)(gt + col0 + bj * HALF + n * 16);
            PG8_LAS float* Pp = (PG8_LAS float*)lds;
            PG8_LAS float* Rr = Pp + 1024;
#pragma unroll
            for (int am = 0; am < 4; ++am) { const int ai = am >> 1; f32x4 xv[2][2][2];
#pragma unroll
                for (int mm = 0; mm < 2; ++mm)
#pragma unroll
                    for (int bj = 0; bj < 2; ++bj)
#pragma unroll
                        for (int n = 0; n < 2; ++n) xv[mm][bj][n] = *(const f32x4*)(p.x() + (size_t)(row0 + ai * HALF + ((am & 1) * 2 + mm) * 16) * DM + col0 + bj * HALF + n * 16);
#pragma unroll
                for (int mm = 0; mm < 2; ++mm) { const int m = (am & 1) * 2 + mm; float s = 0.f;
#pragma unroll
                    for (int bj = 0; bj < 2; ++bj)
#pragma unroll
                        for (int n = 0; n < 2; ++n) { const f32x4 v = xv[mm][bj][n] + gv[bj][n] * acc[ai][bj][m][n]; acc[ai][bj][m][n] = v; s += v[0] * v[0] + v[1] * v[1] + v[2] * v[2] + v[3] * v[3]; }
                    s += __shfl_xor(s, 16, 64); s += __shfl_xor(s, 32, 64);
                    if (fq == 0) Pp[(ai * HALF + wr * 64 + m * 16 + fr) * 4 + wc] = s;
                    asm volatile("" : "+v"(acc[ai][0][m][0]), "+v"(acc[ai][0][m][1]), "+v"(acc[ai][1][m][0]), "+v"(acc[ai][1][m][1]) :: "memory"); } }
            asm volatile("" ::: "memory");
            const int kind = MODE == 2 ? 0 : 1;
            float* slots = p.ssq() + ((size_t)(kind * DEPTH + l) * NROW + (size_t)u.pm * BM) * 4;
            unsigned* cnt = p.cnt() + ((size_t)(kind * DEPTH + l) * (NROW / HALF) + u.pm) * 64;
            __syncthreads();
            if (tid < BM) { const float t = (Pp[tid * 4] + Pp[tid * 4 + 1]) + (Pp[tid * 4 + 2] + Pp[tid * 4 + 3]); __hip_atomic_store(slots + tid * 4 + u.pn, t, __ATOMIC_RELAXED, __HIP_MEMORY_SCOPE_AGENT); }
#pragma unroll
            for (int ai = 0; ai < 2; ++ai)
#pragma unroll
                for (int m = 0; m < 4; ++m)
#pragma unroll
                    for (int bj = 0; bj < 2; ++bj)
#pragma unroll
                        for (int n = 0; n < 2; ++n) *(f32x4*)(p.x() + (size_t)(row0 + ai * HALF + m * 16) * DM + col0 + bj * HALF + n * 16) = acc[ai][bj][m][n];
            asm volatile("s_waitcnt vmcnt(0)" ::: "memory");
            __syncthreads();
            if (tid == 0) { __hip_atomic_fetch_add(cnt, 1u, __ATOMIC_RELAXED, __HIP_MEMORY_SCOPE_AGENT);
                unsigned sp = 0; while (__hip_atomic_load(cnt, __ATOMIC_RELAXED, __HIP_MEMORY_SCOPE_AGENT) < (unsigned)(DM / BM)) { __builtin_amdgcn_s_sleep(2); if (++sp > (1u << 22)) break; }
                __builtin_amdgcn_fence(__ATOMIC_ACQUIRE, "agent"); asm volatile("s_waitcnt vmcnt(0)" ::: "memory"); }
            __syncthreads();
            if (tid < BM) { float t = 0.f;
#pragma unroll
                for (int q = 0; q < DM / BM; ++q) t += __hip_atomic_load(slots + tid * 4 + q, __ATOMIC_RELAXED, __HIP_MEMORY_SCOPE_AGENT);
                Rr[tid] = 1.0f / sqrtf(t * (1.0f / DM) + EPSF); }
            __syncthreads();
            const bool fin = (MODE == 4 && l == DEPTH - 1);
            const int ln = MODE == 2 ? l : l + 1;
            const float* gn = fin ? p.g_final() : (MODE == 2 ? p.g_norm2() : p.g_norm1()) + (size_t)ln * DM;
            const float* md = p.mod() + ((size_t)(fin ? 0 : ln) * 3 + ci) * 6 * DM + (MODE == 2 ? 3 * DM : 0);
#pragma unroll
            for (int bj = 0; bj < 2; ++bj)
#pragma unroll
                for (int n = 0; n < 2; ++n) { const int col = col0 + bj * HALF + n * 16; f32x4 gg = *(const f32x4*)(gn + col), sh = {0.f, 0.f, 0.f, 0.f};
                    if (!fin) { gg = gg * (*(const f32x4*)(md + DM + col) + 1.0f); sh = *(const f32x4*)(md + col); }
#pragma unroll
                    for (int ai = 0; ai < 2; ++ai)
#pragma unroll
                        for (int m = 0; m < 4; ++m) { const int r = ai * HALF + wr * 64 + m * 16 + fr; const f32x4 o = acc[ai][bj][m][n] * Rr[r] * gg + sh; const size_t off = (size_t)(u.pm * BM + r) * DM + col;
                            if (fin) *(f32x4*)(p.out + off) = o;
                            else { u32x2 w; w.x = cvt_pk_bf16(o[0], o[1]); w.y = cvt_pk_bf16(o[2], o[3]); *(u32x2*)(p.u() + off) = w; } } }
        }
    }
};
}
#endif
__device__ __forceinline__ void b_pool_d(const P& p, size_t i) {

    int c = i % DB; int r = i / DB; int g = c / GRP; int win = 2 << g;
    float self = PRJ(r, C_XP + c); float pooled;
    if (r < R_CTX) {
        int b = r / T_CTX, t = r % T_CTX; int lo = t - win / 2; if (lo < 0) lo = 0; int hi = t + (win - win / 2); if (hi > T_CTX) hi = T_CTX;
        float s = 0.f; for (int tt = lo; tt < hi; ++tt) s += PRJ(b * T_CTX + tt, C_XP + c);
        pooled = s / (float)(hi - lo);
    } else {
        int rr = r - R_CTX; int b = rr / T_LAT, t = rr % T_LAT; int gy = t / GRID_W, gx = t % GRID_W; const int rows = T_LAT / GRID_W;
        int xlo = gx - win / 2; if (xlo < 0) xlo = 0; int xhi = gx + (win - win / 2); if (xhi > GRID_W) xhi = GRID_W;
        int ylo = gy - win / 2; if (ylo < 0) ylo = 0; int yhi = gy + (win - win / 2); if (yhi > rows) yhi = rows;
        float s = 0.f;
        for (int yy = ylo; yy < yhi; ++yy) { float sx = 0.f; for (int xx = xlo; xx < xhi; ++xx) sx += PRJ(R_CTX + b * T_LAT + yy * GRID_W + xx, C_XP + c); s += sx / (float)(xhi - xlo); }
        pooled = s / (float)(yhi - ylo);
    }
    p.dbuf()[i] = pooled - self;
}
__device__ __forceinline__ void b_pool_y(const P& p, size_t i, int l) {

    int c = i % DB; size_t r = i / DB; int g = c / GRP, dd = c % GRP;
    const float* d = p.dbuf() + r * DB + g * GRP; const float* w = p.w_pool() + ((size_t)l * NG + g) * GRP * GRP + dd; float acc = 0.f;
    for (int k = 0; k < GRP; ++k) acc += d[k] * w[(size_t)k * GRP];
    p.ys()[r * 3 * DB + c] = f2bf(acc * p.pool_scale()[(size_t)l * DB + c]);
}
__device__ __forceinline__ void b_sgu_vn(const P& p, size_t r, int l) {

    float ss = 0.f;
    for (int k = 0; k < DB; ++k) { float v = PRJ(r, C_SV + k); ss += v * v; }
    float rs = 1.0f / sqrtf(ss / DB + EPSF);
    for (int k = 0; k < DB; ++k) p.vn()[r * DB + k] = PRJ(r, C_SV + k) * rs * p.g_sgu()[(size_t)l * DB + k];
}
__device__ __forceinline__ void b_sgu_y(const P& p, size_t i, int l) {

    int c = i % DB; int r = i / DB; int g = c / GRP; int pp = r % SGU_CHUNK; int r0 = r - pp;
    const float* w = p.w_sgu() + (((size_t)l * NG + g) * SGU_CHUNK + pp) * SGU_CHUNK; float acc = 0.f;
    for (int q = 0; q < SGU_CHUNK; ++q) acc += w[q] * p.vn()[(size_t)(r0 + q) * DB + c];
    acc += p.b_sgu()[((size_t)l * NG + g) * SGU_CHUNK + pp];
    p.ys()[(size_t)r * 3 * DB + DB + c] = f2bf(PRJ(r, C_SU + c) * acc);
}
#define IDX_DHR(dir, h, row) (((size_t)(dir) * NH + (h)) * NROW + (row))
#define IDX_DHC(dir, h, gc) (((size_t)(dir) * NH + (h)) * NCHK + (gc))
__device__ __forceinline__ void b_ml_gates(const P& p, size_t i, int l) {

    int gc = i % NCHK, h = (i / NCHK) % NH, dir = i / (NCHK * NH); int c0 = gc * LCH;
    float b = 0.f;
    for (int tau = 0; tau < LCH; ++tau) {
        int row = dir == 0 ? c0 + tau : c0 + LCH - 1 - tau;
        const float* gp = p.gate_pre() + (size_t)row * 16; const float* bg = p.b_gates() + (size_t)l * 4 * NH;
        float iv = gp[dir * NH + h] + bg[dir * NH + h];
        float fv = gp[2 * NH + dir * NH + h] + bg[2 * NH + dir * NH + h];
        b += logsigmoidf_(fv);
        p.bcum()[IDX_DHR(dir, h, row)] = b; p.ival()[IDX_DHR(dir, h, row)] = iv;
    }
    float bL = b, mx = -INFINITY;
    for (int tau = 0; tau < LCH; ++tau) { int row = c0 + tau; float a = bL - p.bcum()[IDX_DHR(dir, h, row)] + p.ival()[IDX_DHR(dir, h, row)]; mx = fmaxf(mx, a); }
    p.bL()[IDX_DHC(dir, h, gc)] = bL; p.Mloc()[IDX_DHC(dir, h, gc)] = mx;
}
__device__ __forceinline__ void b_ml_cloc(const P& p, size_t i) {

    int e = i % DH, d = (i / DH) % DH; size_t j = i / (DH * DH); int gc = j % NCHK, h = (j / NCHK) % NH, dir = j / (NCHK * NH); int c0 = gc * LCH;
    float bL = p.bL()[IDX_DHC(dir, h, gc)], ml = p.Mloc()[IDX_DHC(dir, h, gc)]; const float ksc = 1.0f / sqrtf((float)DH);
    float acc = 0.f, accn = 0.f;
    for (int s = 0; s < LCH; ++s) { int row = c0 + s;
        float w = expf(bL - p.bcum()[IDX_DHR(dir, h, row)] + p.ival()[IDX_DHR(dir, h, row)] - ml);
        float kv = PRJ(row, C_K + h * DH + d) * ksc;
        acc += w * kv * PRJ(row, C_V + h * DH + e); accn += w * kv; }
    p.Cloc()[i] = acc; if (e == 0) p.nloc()[j * DH + d] = accn;
}
__device__ __forceinline__ void b_ml_scan(const P& p, size_t i, int l) {

    int e = i % DH, d = (i / DH) % DH; size_t j = i / (DH * DH); int s = j % NSEQ, h = (j / NSEQ) % NH, dir = j / (NSEQ * NH);
    int gc0 = seq_start(s) / LCH, nc = seq_len(s) / LCH;
    float C, n, m;
    if (s < NB_CTX) { C = 0.f; n = 0.f; m = 0.f; }
    else { int b = s - NB_CTX; size_t base = (((size_t)b * DEPTH + l) * 2 + dir) * NH + h; C = p.state_C()[(base * DH + d) * DH + e]; n = p.state_n()[base * DH + d]; m = p.state_m()[base]; }
    for (int jj = 0; jj < nc; ++jj) {
        int gc = gc0 + (dir == 0 ? jj : nc - 1 - jj); size_t ci = IDX_DHC(dir, h, gc);
        float bL = p.bL()[ci], ml = p.Mloc()[ci]; float mnew = fmaxf(bL + m, ml); float dec = expf(bL + m - mnew), sc = expf(ml - mnew);
        size_t ce = (ci * DH + d) * DH + e; float cl = p.Cloc()[ce]; p.Cloc()[ce] = C; C = dec * C + sc * cl;
        if (e == 0) { float nl = p.nloc()[ci * DH + d]; p.nloc()[ci * DH + d] = n; n = dec * n + sc * nl; }
        if (e == 0 && d == 0) p.Mprev()[ci] = m;
        m = mnew;
    }
    if (s < NB_CTX) {
        size_t base = (((size_t)s * DEPTH + l) * 2 + dir) * NH + h;
        float* oC = p.out + (size_t)NROW * DM; float* on = oC + (size_t)NB_CTX * DEPTH * 2 * NH * DH * DH; float* om = on + (size_t)NB_CTX * DEPTH * 2 * NH * DH;
        oC[(base * DH + d) * DH + e] = C; if (e == 0) on[base * DH + d] = n; if (e == 0 && d == 0) om[base] = m;
    }
}
__device__ __forceinline__ void b_ml_mt(const P& p, size_t i) {

    int row = i % NROW, h = (i / NROW) % NH, dir = i / ((size_t)NROW * NH); int gc = row / LCH, c0 = gc * LCH;
    int tau = dir == 0 ? row - c0 : c0 + LCH - 1 - row;
    float bt = p.bcum()[IDX_DHR(dir, h, row)]; float mt = bt + p.Mprev()[IDX_DHC(dir, h, gc)];
    for (int ts = 0; ts <= tau; ++ts) { int rs = dir == 0 ? c0 + ts : c0 + LCH - 1 - ts; mt = fmaxf(mt, bt - p.bcum()[IDX_DHR(dir, h, rs)] + p.ival()[IDX_DHR(dir, h, rs)]); }
    p.MT()[i] = mt;
}
__device__ __forceinline__ void b_ml_s(const P& p, size_t i) {

    int ts = i % LCH, tt = (i / LCH) % LCH; size_t j = i / (LCH * LCH); int gc = j % NCHK, h = (j / NCHK) % NH, dir = j / (NCHK * NH); int c0 = gc * LCH;
    float val = 0.f;
    if (ts <= tt) {
        int rt = dir == 0 ? c0 + tt : c0 + LCH - 1 - tt, rs = dir == 0 ? c0 + ts : c0 + LCH - 1 - ts;
        float acc = 0.f;
        for (int d = 0; d < DH; ++d) acc += PRJ(rt, C_Q + h * DH + d) * PRJ(rs, C_K + h * DH + d);
        acc *= 1.0f / sqrtf((float)DH);
        float dm = p.bcum()[IDX_DHR(dir, h, rt)] - p.bcum()[IDX_DHR(dir, h, rs)] + p.ival()[IDX_DHR(dir, h, rs)];
        val = acc * expf(dm - p.MT()[IDX_DHR(dir, h, rt)]);
    }
    p.S()[i] = val;
}
__device__ __forceinline__ void b_ml_h(const P& p, size_t i) {

    int c = i % DB; int row = (i / DB) % NROW; int dir = i / ((size_t)DB * NROW); int h = c / DH, e = c % DH; int gc = row / LCH, c0 = gc * LCH;
    int tau = dir == 0 ? row - c0 : c0 + LCH - 1 - row; size_t ci = IDX_DHC(dir, h, gc);
    const float* Srow = p.S() + (ci * LCH + tau) * LCH;
    float num = 0.f, den = 0.f;
    for (int ts = 0; ts <= tau; ++ts) { int rs = dir == 0 ? c0 + ts : c0 + LCH - 1 - ts; float sv = Srow[ts]; num += sv * PRJ(rs, C_V + h * DH + e); den += sv; }
    float mt = p.MT()[IDX_DHR(dir, h, row)]; float winter = expf(p.bcum()[IDX_DHR(dir, h, row)] + p.Mprev()[ci] - mt);
    float qc = 0.f, qn = 0.f;
    for (int d = 0; d < DH; ++d) { float qv = PRJ(row, C_Q + h * DH + d); qc += qv * p.Cloc()[(ci * DH + d) * DH + e]; qn += qv * p.nloc()[ci * DH + d]; }
    num += winter * qc; den += winter * qn;
    p.hbuf()[i] = num / fmaxf(fabsf(den), expf(-mt));
}
__device__ __forceinline__ void b_ml_fin(const P& p, size_t i, int l) {

    int h = i % NH; size_t row = i / NH;
    const float* h0 = p.hbuf() + row * DB + h * DH; const float* h1 = p.hbuf() + ((size_t)NROW + row) * DB + h * DH; float ss = 0.f;
    for (int e = 0; e < DH; ++e) { float v = h0[e] + h1[e]; ss += v * v; }
    float rs = 1.0f / sqrtf(ss / DH + EPSF);
    for (int e = 0; e < DH; ++e) { float v = (h0[e] + h1[e]) * rs * p.g_mlstm()[(size_t)l * DB + h * DH + e];
        p.ys()[row * 3 * DB + 2 * DB + h * DH + e] = f2bf(sigmoidf_(PRJ(row, C_O + h * DH + e)) * v); }
}
__device__ __forceinline__ void b_final(const P& p, size_t r) {

    const float* xr = p.x() + r * DM; float ss = 0.f;
    for (int k = 0; k < DM; ++k) ss += xr[k] * xr[k];
    float rs = 1.0f / sqrtf(ss / DM + EPSF);
    for (int k = 0; k < DM; ++k) p.out[r * DM + k] = xr[k] * rs * p.g_final()[k];
}


#ifndef CPU_EMU
#define XB_TMO      128
#define XB_XCNT(j)  (256  + 64 * (j))
#define XB_XSUB(j)  (1280 + 64 * (j))
#define XB_XGEN(j)  (2304 + 64 * (j))
#define XB_TOP      3328
#define XB_TOPGEN   3392
#define XCD_BAR_WORDS 3456
#define XB_SPIN_CAP (1u << 22)
#define LAS __attribute__((address_space(3)))
__device__ __forceinline__ unsigned xb_ld(unsigned* p)              { return __hip_atomic_load(p, __ATOMIC_RELAXED, __HIP_MEMORY_SCOPE_AGENT); }
__device__ __forceinline__ unsigned xb_add(unsigned* p, unsigned v) { return __hip_atomic_fetch_add(p, v, __ATOMIC_RELAXED, __HIP_MEMORY_SCOPE_AGENT); }
__device__ __forceinline__ unsigned xb_xcc_id() { return (unsigned)__builtin_amdgcn_s_getreg((3 << 11) | 20) & 0xFu; }
#define XB_SPIN(cond, bar) do { unsigned _sp = 0; while (cond) { __builtin_amdgcn_s_sleep(1); \
    if ((++_sp & 255u) == 0u) { if (xb_ld(&(bar)[XB_TMO])) break; if (_sp > XB_SPIN_CAP) { atomicAdd(&(bar)[XB_TMO], 1u); break; } } } } while (0)
struct XcdBarrier { unsigned* bar; unsigned x; volatile LAS unsigned* st; };
__device__ __forceinline__ XcdBarrier xcd_barrier_post(unsigned* bar, volatile LAS unsigned* st) {
    XcdBarrier b; b.bar = bar; b.x = xb_xcc_id(); b.st = st;
    if (threadIdx.x == 0) (void)xb_add(&bar[XB_XCNT(b.x)], 1u);
    return b;
}
__device__ __forceinline__ void xcd_barrier_complete(unsigned* bar, unsigned x, unsigned& nloc, unsigned& nx) {
    const unsigned G = gridDim.x * gridDim.y * gridDim.z;
    unsigned sum, cnt, mine, sp = 0u;
    for (;;) {
        sum = 0u; cnt = 0u; mine = 0u;
#pragma unroll
        for (unsigned j = 0; j < 16; ++j) { const unsigned c = xb_ld(&bar[XB_XCNT(j)]); sum += c; cnt += (c > 0u) ? 1u : 0u; mine = (j == x) ? c : mine; }
        if (sum == G) break;
        __builtin_amdgcn_s_sleep(1);
        if ((++sp & 255u) == 0u) { if (xb_ld(&bar[XB_TMO])) break; if (sp > XB_SPIN_CAP) { atomicAdd(&bar[XB_TMO], 1u); break; } }
    }
    nloc = mine > 0u ? mine : 1u; nx = cnt > 0u ? cnt : 1u;
}
__device__ __forceinline__ void xcd_barrier(const XcdBarrier& b) {
    asm volatile("s_waitcnt vmcnt(0)" ::: "memory");
    __syncthreads();
    if (threadIdx.x == 0) {
        unsigned* bar = b.bar; asm volatile("" : "+s"(bar));
        __builtin_amdgcn_s_waitcnt(0);
        unsigned nloc = b.st[0], nx = b.st[1];
        if (nloc == 0u) { xcd_barrier_complete(bar, b.x, nloc, nx); b.st[0] = nloc; b.st[1] = nx; }
        const unsigned old = xb_add(&bar[XB_XSUB(b.x)], 1u);
        const unsigned gen = old / nloc;
        if (old + 1u == (gen + 1u) * nloc) {
            __builtin_amdgcn_fence(__ATOMIC_RELEASE, "agent");
            asm volatile("s_waitcnt vmcnt(0)" ::: "memory");
            const unsigned og = xb_add(&bar[XB_TOP], 1u);
            const unsigned tg = og / nx;
            if (og + 1u == (tg + 1u) * nx) xb_add(&bar[XB_TOPGEN], 1u);
            else XB_SPIN(xb_ld(&bar[XB_TOPGEN]) == tg, bar);
            __builtin_amdgcn_fence(__ATOMIC_ACQUIRE, "agent");
            xb_add(&bar[XB_XGEN(b.x)], 1u);
            asm volatile("s_waitcnt vmcnt(0)" ::: "memory");
        } else {
            XB_SPIN(xb_ld(&bar[XB_XGEN(b.x)]) == gen, bar);
            __builtin_amdgcn_fence(__ATOMIC_ACQUIRE, "agent");
            asm volatile("s_waitcnt vmcnt(0)" ::: "memory");
        }
    }
    __syncthreads();
}

#endif

#ifndef CPU_EMU
#define NTHR 512
typedef short bf16x8 __attribute__((ext_vector_type(8)));
typedef float f32x4 __attribute__((ext_vector_type(4)));
typedef unsigned u32x4 __attribute__((ext_vector_type(4)));
typedef unsigned u32x2 __attribute__((ext_vector_type(2)));
#define MFMA16(a, b, c) __builtin_amdgcn_mfma_f32_16x16x32_bf16(a, b, c, 0, 0, 0)
typedef __bf16 bf16x2_t __attribute__((ext_vector_type(2)));
__device__ __forceinline__ unsigned pk_bf16(float lo, float hi) { bf16x2_t v; v.x = (__bf16)lo; v.y = (__bf16)hi; return __builtin_bit_cast(unsigned, v); }
__device__ __forceinline__ float bflo(unsigned w) { return __uint_as_float(w << 16); }
__device__ __forceinline__ float bfhi(unsigned w) { return __uint_as_float(w & 0xffff0000u); }
__device__ __forceinline__ float wscan_add(float v, int lane, int dir) {
#pragma unroll
    for (int off = 1; off < 64; off <<= 1) { const float o = dir == 0 ? __shfl_up(v, off, 64) : __shfl_down(v, off, 64); if (dir == 0 ? (lane >= off) : (lane + off < 64)) v += o; }
    return v; }
__device__ __forceinline__ float wscan_max(float v, int lane, int dir) {
#pragma unroll
    for (int off = 1; off < 64; off <<= 1) { const float o = dir == 0 ? __shfl_up(v, off, 64) : __shfl_down(v, off, 64); if (dir == 0 ? (lane >= off) : (lane + off < 64)) v = fmaxf(v, o); }
    return v; }
__device__ __forceinline__ float wred_max(float v) {
#pragma unroll
    for (int off = 32; off >= 1; off >>= 1) v = fmaxf(v, __shfl_xor(v, off, 64));
    return v; }
__device__ __forceinline__ void gate_lane(const P& p, int l, int h, int row, int dir, int lane, float& b, float& g) {
    const float* gp = p.gate_pre() + (size_t)row * 16; const float* bg = p.b_gates() + (size_t)l * 4 * NH;
    const float iv = gp[dir * NH + h] + bg[dir * NH + h];
    const float fv = gp[2 * NH + dir * NH + h] + bg[2 * NH + dir * NH + h];
    b = wscan_add(logsigmoidf_(fv), lane, dir); g = iv - b;
}
#define ML_LD 72
template <bool WITH_K> __device__ __forceinline__ void ml_stage_T(const P& p, int h, int c0, int wave, int lane, LAS bf16_t* VT, LAS bf16_t* KT, const LAS float* wl) {
#pragma unroll
    for (int i = 0; i < 2; ++i) { const int d0 = (wave * 2 + i) * 8;
        const u32x4 vv = *(const u32x4*)(p.proj() + (size_t)(c0 + lane) * PJ + C_V + h * DH + d0);
        const unsigned vw[4] = {vv.x, vv.y, vv.z, vv.w};
#pragma unroll
        for (int j = 0; j < 4; ++j) { VT[(d0 + 2 * j) * ML_LD + lane] = (bf16_t)(vw[j] & 0xffffu); VT[(d0 + 2 * j + 1) * ML_LD + lane] = (bf16_t)(vw[j] >> 16); }
        if constexpr (WITH_K) {
            const u32x4 kv = *(const u32x4*)(p.proj() + (size_t)(c0 + lane) * PJ + C_K + h * DH + d0);
            const unsigned kw[4] = {kv.x, kv.y, kv.z, kv.w}; const float w0 = wl[lane], w1 = wl[64 + lane];
#pragma unroll
            for (int j = 0; j < 4; ++j) { const float a = bflo(kw[j]), b = bfhi(kw[j]);
                KT[(d0 + 2 * j) * ML_LD + lane] = f2bf(a * w0); KT[(d0 + 2 * j + 1) * ML_LD + lane] = f2bf(b * w0);
                KT[(DH + d0 + 2 * j) * ML_LD + lane] = f2bf(a * w1); KT[(DH + d0 + 2 * j + 1) * ML_LD + lane] = f2bf(b * w1); }
        } }
}
__device__ __forceinline__ void unit_ml_cloc(const P& p, int l, int unit, LAS unsigned char* lds) {
    int tid = threadIdx.x; asm volatile("" : "+v"(tid));
    const int wave = __builtin_amdgcn_readfirstlane(tid >> 6), lane = tid & 63, fr = lane & 15, fq = lane >> 4;
    const int h = unit % NH, gc = unit / NH, c0 = gc * LCH;
    LAS float* wl = (LAS float*)lds;
    LAS bf16_t* VT = (LAS bf16_t*)(lds + 512);
    LAS bf16_t* KT = VT + DH * ML_LD;
    if (wave < 2) { const int dir = wave; float b, g; gate_lane(p, l, h, c0 + lane, dir, lane, b, g);
        const float total = __shfl(b, dir == 0 ? 63 : 0, 64), gmax = wred_max(g);
        wl[dir * 64 + lane] = expf(g - gmax) * 0.08838834764831845f;
        const float pm = wscan_max(g, lane, dir); float* gs = p.gsc() + IDX_DHR(dir, h, c0 + lane); gs[0] = b; gs[(size_t)2 * NH * NROW] = g; gs[(size_t)4 * NH * NROW] = pm;
        if (lane == 0) { p.bL()[IDX_DHC(dir, h, gc)] = total; p.Mloc()[IDX_DHC(dir, h, gc)] = total + gmax; } }
    __syncthreads();
    ml_stage_T<true>(p, h, c0, wave, lane, VT, KT, wl);
    __syncthreads();
    if (tid < 256) { const int dir = tid >> 7, d = tid & 127; float s = 0.f; const LAS bf16_t* r = KT + (dir * DH + d) * ML_LD;
#pragma unroll 8
        for (int j = 0; j < 64; ++j) s += bf2f(r[j]);
        p.nloc()[IDX_DHC(dir, h, gc) * DH + d] = s; }
    { const int e = tid >> 2, sg = (tid & 3) * 16; const LAS bf16_t* r = VT + e * ML_LD + sg; bf16_t* o = p.VTg() + ((size_t)(h * NCHK + gc) * DH + e) * LCH + sg;
      *(u32x4*)o = *(const LAS u32x4*)r; *(u32x4*)(o + 8) = *(const LAS u32x4*)(r + 8); }
#pragma unroll 1
    for (int dir = 0; dir < 2; ++dir) {
        f32x4 acc[8];
#pragma unroll
        for (int i = 0; i < 8; ++i) acc[i] = (f32x4){0.f, 0.f, 0.f, 0.f};
#pragma unroll
        for (int ks = 0; ks < 2; ++ks) { const bf16x8 a = *(const LAS bf16x8*)(VT + (16 * wave + fr) * ML_LD + 32 * ks + 8 * fq);
#pragma unroll
            for (int dt = 0; dt < 8; ++dt) { const bf16x8 b = *(const LAS bf16x8*)(KT + (dir * DH + 16 * dt + fr) * ML_LD + 32 * ks + 8 * fq); acc[dt] = MFMA16(b, a, acc[dt]); } }
        bf16_t* o = (bf16_t*)p.Cloc() + (IDX_DHC(dir, h, gc) * DH + 16 * wave + fr) * DH + 4 * fq;
#pragma unroll
        for (int dt = 0; dt < 8; ++dt) { u32x2 w; w.x = pk_bf16(acc[dt][0], acc[dt][1]); w.y = pk_bf16(acc[dt][2], acc[dt][3]); *(u32x2*)(o + 16 * dt) = w; }
    }
    __syncthreads();
}
struct ScanItem { int e, d, dir, h, sl; };
template <bool CTX> __device__ __forceinline__ ScanItem scan_decode(size_t i) { constexpr int NS = CTX ? NB_CTX : NB_LAT; ScanItem s; s.d = (int)(i % (DH / 4)) * 4; s.e = (int)((i / (DH / 4)) % DH); const size_t j = i / ((size_t)DH * DH / 4); s.sl = (int)(j % NS); s.h = (int)((j / NS) % NH); s.dir = (int)(j / (NS * NH)); return s; }
template <int NC, bool CTX> __device__ __forceinline__ void scan_load(const P& p, const ScanItem& it, u32x2 (&cl)[NC], float (&bLv)[NC], float (&mlv)[NC]) {
    const int gc0 = seq_start(CTX ? it.sl : NB_CTX + it.sl) / LCH;
#pragma unroll
    for (int jj = 0; jj < NC; ++jj) { const int gc = gc0 + (it.dir == 0 ? jj : NC - 1 - jj); const size_t ci = IDX_DHC(it.dir, it.h, gc);
        bLv[jj] = p.bL()[ci]; mlv[jj] = p.Mloc()[ci]; cl[jj] = *(const u32x2*)((const bf16_t*)p.Cloc() + (ci * DH + it.e) * DH + it.d); }
}
template <int NC, bool CTX> __device__ __forceinline__ void scan_run(const P& p, int l, const ScanItem& it, const u32x2 (&cl)[NC], const float (&bLv)[NC], const float (&mlv)[NC], f32x4& C, f32x4& n, float& m) {
    const int gc0 = seq_start(CTX ? it.sl : NB_CTX + it.sl) / LCH; const int e = it.e, d = it.d;
#pragma unroll
    for (int jj = 0; jj < NC; ++jj) {
        const int gc = gc0 + (it.dir == 0 ? jj : NC - 1 - jj); const size_t ci = IDX_DHC(it.dir, it.h, gc);
        const float mnew = fmaxf(bLv[jj] + m, mlv[jj]); const float dec = __expf(bLv[jj] + m - mnew), sc = __expf(mlv[jj] - mnew);
        u32x2 w; w.x = pk_bf16(C[0], C[1]); w.y = pk_bf16(C[2], C[3]); *(u32x2*)(p.CprevT() + (ci * DH + e) * DH + d) = w;
        C = dec * C + sc * (f32x4){bflo(cl[jj].x), bfhi(cl[jj].x), bflo(cl[jj].y), bfhi(cl[jj].y)};
        if (e == 0) { const f32x4 nl = *(const f32x4*)(p.nloc() + ci * DH + d); *(f32x4*)(p.nprev() + ci * DH + d) = n; n = dec * n + sc * nl; }
        if (e == 0 && d == 0) p.Mprev()[ci] = m;
        m = mnew;
    }
}
__device__ __forceinline__ void phase_scan(const P& p, int l, LAS unsigned char* lds) {
    int t_ = threadIdx.x; asm volatile("" : "+v"(t_));
    const size_t gtid = (size_t)blockIdx.x * NTHR + t_, nthr = (size_t)gridDim.x * NTHR;
    constexpr size_t NLAT = (size_t)2 * NH * NB_LAT * DH * (DH / 4); constexpr int NCL = T_LAT / LCH;
    for (size_t i = gtid; i < NLAT; i += nthr) { const ScanItem it = scan_decode<false>(i); u32x2 cl[NCL]; float bLv[NCL], mlv[NCL]; scan_load<NCL, false>(p, it, cl, bLv, mlv);
        const size_t base = (((size_t)it.sl * DEPTH + l) * 2 + it.dir) * NH + it.h; f32x4 C, n = {0.f, 0.f, 0.f, 0.f};
#pragma unroll
        for (int q = 0; q < 4; ++q) C[q] = p.state_C()[(base * DH + it.d + q) * DH + it.e];
        if (it.e == 0) n = *(const f32x4*)(p.state_n() + base * DH + it.d);
        float m = p.state_m()[base];
        asm volatile("" ::: "memory"); scan_run<NCL, false>(p, l, it, cl, bLv, mlv, C, n, m); }
}
__device__ __forceinline__ void unit_ml_out(const P& p, int l, int unit, LAS unsigned char* lds) {
    int tid = threadIdx.x; asm volatile("" : "+v"(tid));
    const int wave = __builtin_amdgcn_readfirstlane(tid >> 6), lane = tid & 63, fr = lane & 15, fq = lane >> 4;
    const int h = unit % NH, gc = unit / NH, c0 = gc * LCH;
    LAS float* ssq = (LAS float*)lds;
    LAS bf16_t* VT = (LAS bf16_t*)(lds + 1024);
    LAS bf16_t* SS = VT + DH * ML_LD;
    const bf16_t* Q = p.proj() + (size_t)c0 * PJ + C_Q + h * DH; const bf16_t* K = p.proj() + (size_t)c0 * PJ + C_K + h * DH;
    const int tt = wave & 3, wh = wave >> 2, t = 16 * tt + fr; const size_t row = (size_t)c0 + t;
    bf16x8 qf[4], kf[2][4], cf0[4][4], cf1[4][4];
#pragma unroll
    for (int ks = 0; ks < 4; ++ks) { qf[ks] = *(const bf16x8*)(Q + (size_t)t * PJ + 32 * ks + 8 * fq);
#pragma unroll
        for (int i = 0; i < 2; ++i) kf[i][ks] = *(const bf16x8*)(K + (size_t)(16 * (2 * wh + i) + fr) * PJ + 32 * ks + 8 * fq); }
    { const bf16_t* CT0 = p.CprevT() + IDX_DHC(0, h, gc) * DH * DH;
#pragma unroll
      for (int ks = 0; ks < 4; ++ks)
#pragma unroll
          for (int i = 0; i < 4; ++i) cf0[i][ks] = *(const bf16x8*)(CT0 + (size_t)(16 * (4 * wh + i) + fr) * DH + 32 * ks + 8 * fq); }
    { const int e = tid >> 2, sg = (tid & 3) * 16; const bf16_t* o = p.VTg() + ((size_t)(h * NCHK + gc) * DH + e) * LCH + sg; const u32x4 v0 = *(const u32x4*)o, v1 = *(const u32x4*)(o + 8);
      *(LAS u32x4*)(VT + e * ML_LD + sg) = v0; *(LAS u32x4*)(VT + e * ML_LD + sg + 8) = v1; }
    float rowterm[2], winter[2], emt[2], qn[2]; f32x4 colterm[2][2];
#pragma unroll
    for (int dir = 0; dir < 2; ++dir) { const float* gs = p.gsc() + IDX_DHR(dir, h, row); const float bt = gs[0], pmt = gs[(size_t)4 * NH * NROW]; const float mprev = p.Mprev()[IDX_DHC(dir, h, gc)];
        const float mt = bt + fmaxf(mprev, pmt); rowterm[dir] = bt - mt; winter[dir] = __expf(bt + mprev - mt); emt[dir] = __expf(-mt);
#pragma unroll
        for (int i = 0; i < 2; ++i) colterm[dir][i] = *(const f32x4*)(p.gsc() + (size_t)2 * NH * NROW + IDX_DHR(dir, h, c0 + 16 * (2 * wh + i) + 4 * fq));
        const float* np = p.nprev() + IDX_DHC(dir, h, gc) * DH + 8 * fq; float s = 0.f;
#pragma unroll
        for (int ks = 0; ks < 4; ++ks) { const f32x4 n0 = *(const f32x4*)(np + 32 * ks), n1 = *(const f32x4*)(np + 32 * ks + 4); const u32x4 qv = __builtin_bit_cast(u32x4, qf[ks]);
            s += bflo(qv.x) * n0[0] + bfhi(qv.x) * n0[1] + bflo(qv.y) * n0[2] + bfhi(qv.y) * n0[3] + bflo(qv.z) * n1[0] + bfhi(qv.z) * n1[1] + bflo(qv.w) * n1[2] + bfhi(qv.w) * n1[3]; }
        s += __shfl_xor(s, 16, 64); s += __shfl_xor(s, 32, 64); qn[dir] = s; asm volatile("" : "+v"(qn[dir]) :: "memory"); }
    {
        f32x4 sc[2] = {{0.f, 0.f, 0.f, 0.f}, {0.f, 0.f, 0.f, 0.f}};
#pragma unroll
        for (int ks = 0; ks < 4; ++ks)
#pragma unroll
            for (int i = 0; i < 2; ++i) sc[i] = MFMA16(kf[i][ks], qf[ks], sc[i]);
#pragma unroll
        for (int dir = 0; dir < 2; ++dir) {
#pragma unroll
            for (int i = 0; i < 2; ++i) { const int s0 = 16 * (2 * wh + i) + 4 * fq; float v[4];
#pragma unroll
                for (int j = 0; j < 4; ++j) { const int s = s0 + j; const bool ok = dir == 0 ? (s <= t) : (s >= t); v[j] = ok ? sc[i][j] * 0.08838834764831845f * __expf(rowterm[dir] + colterm[dir][i][j]) : 0.f; }
                u32x2 w; w.x = pk_bf16(v[0], v[1]); w.y = pk_bf16(v[2], v[3]); *(LAS u32x2*)(SS + (dir * 64 + t) * ML_LD + s0) = w; } }
    }
    asm volatile("" ::: "memory");
    { const bf16_t* CT1 = p.CprevT() + IDX_DHC(1, h, gc) * DH * DH;
#pragma unroll
      for (int ks = 0; ks < 4; ++ks)
#pragma unroll
          for (int i = 0; i < 4; ++i) cf1[i][ks] = *(const bf16x8*)(CT1 + (size_t)(16 * (4 * wh + i) + fr) * DH + 32 * ks + 8 * fq); }
    u32x2 ow[4];
#pragma unroll
    for (int i = 0; i < 4; ++i) ow[i] = *(const u32x2*)(p.proj() + row * PJ + C_O + h * DH + 16 * (4 * wh + i) + 4 * fq);
    __syncthreads();
    f32x4 hs[4];
#pragma unroll
    for (int i = 0; i < 4; ++i) hs[i] = (f32x4){0.f, 0.f, 0.f, 0.f};
#pragma unroll
    for (int dir = 0; dir < 2; ++dir) {
        f32x4 a1[4], a2[4];
#pragma unroll
        for (int i = 0; i < 4; ++i) { a1[i] = (f32x4){0.f, 0.f, 0.f, 0.f}; a2[i] = (f32x4){0.f, 0.f, 0.f, 0.f}; }
        const LAS bf16_t* Sd = SS + dir * 64 * ML_LD;
#pragma unroll
        for (int ks = 0; ks < 2; ++ks) { const bf16x8 sf = *(const LAS bf16x8*)(Sd + t * ML_LD + 32 * ks + 8 * fq);
#pragma unroll
            for (int i = 0; i < 4; ++i) { const bf16x8 vf = *(const LAS bf16x8*)(VT + (16 * (4 * wh + i) + fr) * ML_LD + 32 * ks + 8 * fq); a1[i] = MFMA16(vf, sf, a1[i]); } }
#pragma unroll
        for (int ks = 0; ks < 4; ++ks)
#pragma unroll
            for (int i = 0; i < 4; ++i) a2[i] = MFMA16(dir == 0 ? cf0[i][ks] : cf1[i][ks], qf[ks], a2[i]);
        float rs = 0.f;
        { const u32x4 s0 = *(const LAS u32x4*)(Sd + t * ML_LD + 16 * fq), s1 = *(const LAS u32x4*)(Sd + t * ML_LD + 16 * fq + 8);
            rs = bflo(s0.x) + bfhi(s0.x) + bflo(s0.y) + bfhi(s0.y) + bflo(s0.z) + bfhi(s0.z) + bflo(s0.w) + bfhi(s0.w) + bflo(s1.x) + bfhi(s1.x) + bflo(s1.y) + bfhi(s1.y) + bflo(s1.z) + bfhi(s1.z) + bflo(s1.w) + bfhi(s1.w); }
        rs += __shfl_xor(rs, 16, 64); rs += __shfl_xor(rs, 32, 64);
        const float wi = winter[dir]; const float den = rs + wi * qn[dir]; const float inv = 1.0f / fmaxf(fabsf(den), emt[dir]);
#pragma unroll
        for (int i = 0; i < 4; ++i) hs[i] = hs[i] + (a1[i] + wi * a2[i]) * inv;
    }
    f32x4 gm[4];
#pragma unroll
    for (int i = 0; i < 4; ++i) gm[i] = *(const f32x4*)(p.g_mlstm() + (size_t)l * DB + h * DH + 16 * (4 * wh + i) + 4 * fq);
    float q2 = 0.f;
#pragma unroll
    for (int i = 0; i < 4; ++i) q2 += hs[i][0] * hs[i][0] + hs[i][1] * hs[i][1] + hs[i][2] * hs[i][2] + hs[i][3] * hs[i][3];
    q2 += __shfl_xor(q2, 16, 64); q2 += __shfl_xor(q2, 32, 64);
    if (fq == 0) ssq[wh * 64 + t] = q2;
    __syncthreads();
    const float rstd = 1.0f / sqrtf((ssq[t] + ssq[64 + t]) * (1.0f / DH) + EPSF);
#pragma unroll
    for (int i = 0; i < 4; ++i) { const int e = 16 * (4 * wh + i) + 4 * fq;
        const float o0 = bflo(ow[i].x), o1 = bfhi(ow[i].x), o2 = bflo(ow[i].y), o3 = bfhi(ow[i].y);
        const float y0 = hs[i][0] * rstd * gm[i][0] * __builtin_amdgcn_rcpf(1.0f + __expf(-o0)), y1 = hs[i][1] * rstd * gm[i][1] * __builtin_amdgcn_rcpf(1.0f + __expf(-o1)), y2 = hs[i][2] * rstd * gm[i][2] * __builtin_amdgcn_rcpf(1.0f + __expf(-o2)), y3 = hs[i][3] * rstd * gm[i][3] * __builtin_amdgcn_rcpf(1.0f + __expf(-o3));
        u32x2 w; w.x = pk_bf16(y0, y1); w.y = pk_bf16(y2, y3); *(u32x2*)(p.ys() + row * 3 * DB + 2 * DB + h * DH + e) = w; }
    __syncthreads();
}
#endif
#ifndef CPU_EMU
#define SQ_LD 136
__device__ __forceinline__ void unit_ml_seq(const P& p, int l, int unit, LAS unsigned char* lds) {
    int tid = threadIdx.x; asm volatile("" : "+v"(tid));
    const int wave = __builtin_amdgcn_readfirstlane(tid >> 6), lane = tid & 63, fr = lane & 15, fq = lane >> 4;
    const int dir = unit & 1, h = (unit >> 1) & (NH - 1), b = unit / (2 * NH), r0 = b * T_CTX;
    constexpr int NCQ = T_CTX / LCH;
    LAS float* nst = (LAS float*)lds;
    LAS float* DEC = nst + 256;
    LAS float* GB = (LAS float*)(lds + 2048);
    LAS float* GG = GB + NCQ * 64;
    LAS float* GP = GG + NCQ * 64;
    LAS float* EM = GP + NCQ * 64;
    LAS float* WS = EM + NCQ * 64;
    LAS float* GT = WS + NCQ * 64; LAS float* GM = GT + NCQ;
    LAS bf16_t* VT = (LAS bf16_t*)(lds + 8192);
    LAS bf16_t* KT = VT + DH * ML_LD;
    LAS bf16_t* SS = KT + DH * ML_LD;
    LAS bf16_t* CTl = SS + 64 * ML_LD;
    const int tt = wave & 3, wh = wave >> 2, t = 16 * tt + fr;
    f32x4 cacc[8];
#pragma unroll
    for (int i = 0; i < 8; ++i) cacc[i] = (f32x4){0.f, 0.f, 0.f, 0.f};
    if (tid < DH) nst[tid] = 0.f;
    float* hb = p.hbc() + ((size_t)dir * R_CTX) * DB + h * DH;
    if (wave < NCQ) { const int jo = dir == 0 ? wave : NCQ - 1 - wave; float bb, g; gate_lane(p, l, h, r0 + jo * LCH + lane, dir, lane, bb, g);
        const float pm = wscan_max(g, lane, dir), total = __shfl(bb, dir == 0 ? 63 : 0, 64), gmax = wred_max(g);
        GB[wave * 64 + lane] = bb; GG[wave * 64 + lane] = g; GP[wave * 64 + lane] = pm; if (lane == 0) { GT[wave] = total; GM[wave] = gmax; } }
    bf16x8 qf[4], kf[2][4]; u32x4 kvr[2], vvr[2];
#define SQ_LOAD(jj_) do { const int jo_ = dir == 0 ? (jj_) : NCQ - 1 - (jj_), c0_ = r0 + jo_ * LCH; const bf16_t* Q_ = p.proj() + (size_t)c0_ * PJ + C_Q + h * DH; const bf16_t* K_ = p.proj() + (size_t)c0_ * PJ + C_K + h * DH; \
        _Pragma("unroll") for (int ks = 0; ks < 4; ++ks) { qf[ks] = *(const bf16x8*)(Q_ + (size_t)t * PJ + 32 * ks + 8 * fq); \
            _Pragma("unroll") for (int i = 0; i < 2; ++i) kf[i][ks] = *(const bf16x8*)(K_ + (size_t)(16 * (2 * wh + i) + fr) * PJ + 32 * ks + 8 * fq); } \
        _Pragma("unroll") for (int i = 0; i < 2; ++i) { const int d0 = (wave * 2 + i) * 8; kvr[i] = *(const u32x4*)(p.proj() + (size_t)(c0_ + lane) * PJ + C_K + h * DH + d0); vvr[i] = *(const u32x4*)(p.proj() + (size_t)(c0_ + lane) * PJ + C_V + h * DH + d0); } } while (0)
    SQ_LOAD(0);
    __syncthreads();
    if (wave == 0) { float mm = 0.f;
#pragma unroll
        for (int jj = 0; jj < NCQ; ++jj) { const float bb = GB[jj * 64 + lane], g = GG[jj * 64 + lane], pm = GP[jj * 64 + lane], total = GT[jj], gmax = GM[jj];
            const float mt = bb + fmaxf(mm, pm), mnew = total + fmaxf(mm, gmax);
            GB[jj * 64 + lane] = bb - mt; GP[jj * 64 + lane] = __expf(bb + mm - mt); EM[jj * 64 + lane] = __expf(-mt); WS[jj * 64 + lane] = __expf(total + g - mnew) * 0.08838834764831845f;
            if (lane == 0) DEC[jj] = __expf(total + mm - mnew);
            mm = mnew; }
        if (lane == 0) DEC[NCQ] = mm; }
    __syncthreads();
#pragma unroll 1
    for (int jj = 0; jj < NCQ; ++jj) {
        const int jo = dir == 0 ? jj : NCQ - 1 - jj, c0 = r0 + jo * LCH;
        { const float w0 = WS[jj * 64 + lane];
#pragma unroll
          for (int i = 0; i < 2; ++i) { const int d0 = (wave * 2 + i) * 8; const unsigned vw[4] = {vvr[i].x, vvr[i].y, vvr[i].z, vvr[i].w}, kw[4] = {kvr[i].x, kvr[i].y, kvr[i].z, kvr[i].w};
#pragma unroll
              for (int j = 0; j < 4; ++j) { VT[(d0 + 2 * j) * ML_LD + lane] = (bf16_t)(vw[j] & 0xffffu); VT[(d0 + 2 * j + 1) * ML_LD + lane] = (bf16_t)(vw[j] >> 16);
                  KT[(d0 + 2 * j) * ML_LD + lane] = f2bf(bflo(kw[j]) * w0); KT[(d0 + 2 * j + 1) * ML_LD + lane] = f2bf(bfhi(kw[j]) * w0); } } }
#pragma unroll
        for (int dt = 0; dt < 8; ++dt) { u32x2 w; w.x = pk_bf16(cacc[dt][0], cacc[dt][1]); w.y = pk_bf16(cacc[dt][2], cacc[dt][3]); *(LAS u32x2*)(CTl + (16 * wave + fr) * SQ_LD + 16 * dt + 4 * fq) = w; }
        {
            f32x4 sc[2] = {{0.f, 0.f, 0.f, 0.f}, {0.f, 0.f, 0.f, 0.f}};
#pragma unroll
            for (int ks = 0; ks < 4; ++ks)
#pragma unroll
                for (int i = 0; i < 2; ++i) sc[i] = MFMA16(kf[i][ks], qf[ks], sc[i]);
            const float rt = GB[jj * 64 + t];
#pragma unroll
            for (int i = 0; i < 2; ++i) { const int s0 = 16 * (2 * wh + i) + 4 * fq; float v[4];
#pragma unroll
                for (int j = 0; j < 4; ++j) { const int s = s0 + j; const bool ok = dir == 0 ? (s <= t) : (s >= t); v[j] = ok ? sc[i][j] * 0.08838834764831845f * __expf(rt + GG[jj * 64 + s]) : 0.f; }
                u32x2 w; w.x = pk_bf16(v[0], v[1]); w.y = pk_bf16(v[2], v[3]); *(LAS u32x2*)(SS + t * ML_LD + s0) = w; }
        }
        __syncthreads();
        {
            f32x4 a1[4], a2[4];
#pragma unroll
            for (int i = 0; i < 4; ++i) { a1[i] = (f32x4){0.f, 0.f, 0.f, 0.f}; a2[i] = (f32x4){0.f, 0.f, 0.f, 0.f}; }
#pragma unroll
            for (int ks = 0; ks < 2; ++ks) { const bf16x8 sf = *(const LAS bf16x8*)(SS + t * ML_LD + 32 * ks + 8 * fq);
#pragma unroll
                for (int i = 0; i < 4; ++i) { const bf16x8 vf = *(const LAS bf16x8*)(VT + (16 * (4 * wh + i) + fr) * ML_LD + 32 * ks + 8 * fq); a1[i] = MFMA16(vf, sf, a1[i]); } }
#pragma unroll
            for (int ks = 0; ks < 4; ++ks)
#pragma unroll
                for (int i = 0; i < 4; ++i) { const bf16x8 cf = *(const LAS bf16x8*)(CTl + (16 * (4 * wh + i) + fr) * SQ_LD + 32 * ks + 8 * fq); a2[i] = MFMA16(cf, qf[ks], a2[i]); }
            float qn = 0.f;
#pragma unroll
            for (int ks = 0; ks < 4; ++ks) { const LAS float* np = nst + (jj & 1) * DH + 32 * ks + 8 * fq; const f32x4 n0 = *(const LAS f32x4*)np, n1 = *(const LAS f32x4*)(np + 4); const u32x4 qv = __builtin_bit_cast(u32x4, qf[ks]);
                qn += bflo(qv.x) * n0[0] + bfhi(qv.x) * n0[1] + bflo(qv.y) * n0[2] + bfhi(qv.y) * n0[3] + bflo(qv.z) * n1[0] + bfhi(qv.z) * n1[1] + bflo(qv.w) * n1[2] + bfhi(qv.w) * n1[3]; }
            qn += __shfl_xor(qn, 16, 64); qn += __shfl_xor(qn, 32, 64);
            if (jj + 1 < NCQ) SQ_LOAD(jj + 1);
            float rs = 0.f;
            { const u32x4 s0 = *(const LAS u32x4*)(SS + t * ML_LD + 16 * fq), s1 = *(const LAS u32x4*)(SS + t * ML_LD + 16 * fq + 8);
                rs = bflo(s0.x) + bfhi(s0.x) + bflo(s0.y) + bfhi(s0.y) + bflo(s0.z) + bfhi(s0.z) + bflo(s0.w) + bfhi(s0.w) + bflo(s1.x) + bfhi(s1.x) + bflo(s1.y) + bfhi(s1.y) + bflo(s1.z) + bfhi(s1.z) + bflo(s1.w) + bfhi(s1.w); }
            rs += __shfl_xor(rs, 16, 64); rs += __shfl_xor(rs, 32, 64);
            const float wi = GP[jj * 64 + t]; const float den = rs + wi * qn; const float inv = 1.0f / fmaxf(fabsf(den), EM[jj * 64 + t]);
            float* ho = hb + (size_t)(c0 + t) * DB + 4 * fq;
#pragma unroll
            for (int i = 0; i < 4; ++i) *(f32x4*)(ho + 16 * (4 * wh + i)) = (a1[i] + wi * a2[i]) * inv;
        }
        const float decay = DEC[jj];
#pragma unroll
        for (int dt = 0; dt < 8; ++dt) cacc[dt] = cacc[dt] * decay;
#pragma unroll
        for (int ks = 0; ks < 2; ++ks) { const bf16x8 a = *(const LAS bf16x8*)(VT + (16 * wave + fr) * ML_LD + 32 * ks + 8 * fq);
#pragma unroll
            for (int dt = 0; dt < 8; ++dt) { const bf16x8 bb = *(const LAS bf16x8*)(KT + (16 * dt + fr) * ML_LD + 32 * ks + 8 * fq); cacc[dt] = MFMA16(bb, a, cacc[dt]); } }
        if (tid < DH) { float s = 0.f; const LAS bf16_t* r = KT + tid * ML_LD;
#pragma unroll
            for (int j4 = 0; j4 < 8; ++j4) { const u32x4 v = *(const LAS u32x4*)(r + 8 * j4); s += (bflo(v.x) + bfhi(v.x)) + (bflo(v.y) + bfhi(v.y)) + (bflo(v.z) + bfhi(v.z)) + (bflo(v.w) + bfhi(v.w)); }
            nst[((jj + 1) & 1) * DH + tid] = decay * nst[(jj & 1) * DH + tid] + s; }
        __syncthreads();
    }
#undef SQ_LOAD
    __syncthreads();
    { LAS float* T = (LAS float*)(lds + 8192);
#pragma unroll
      for (int dt = 0; dt < 8; ++dt)
#pragma unroll
          for (int j = 0; j < 4; ++j) T[(16 * wave + fr) * 129 + 16 * dt + 4 * fq + j] = cacc[dt][j];
      __syncthreads();
      const size_t base = (((size_t)b * DEPTH + l) * 2 + dir) * NH + h;
      float* oC = p.out + (size_t)NROW * DM; float* on = oC + (size_t)NB_CTX * DEPTH * 2 * NH * DH * DH; float* om = on + (size_t)NB_CTX * DEPTH * 2 * NH * DH;
      const int d = tid >> 2, es = (tid & 3) * 32;
#pragma unroll
      for (int k = 0; k < 8; ++k) { f32x4 v; v[0] = T[(es + 4 * k) * 129 + d]; v[1] = T[(es + 4 * k + 1) * 129 + d]; v[2] = T[(es + 4 * k + 2) * 129 + d]; v[3] = T[(es + 4 * k + 3) * 129 + d];
          *(f32x4*)(oC + (base * DH + d) * DH + es + 4 * k) = v; }
      if (tid < DH) on[base * DH + tid] = nst[(NCQ & 1) * DH + tid];
      if (tid == 0) om[base] = DEC[NCQ]; }
    __syncthreads();
}
__device__ __forceinline__ void phase_ctx_fin(const P& p, int l, int cu, int ncu) {
    int tid = threadIdx.x; asm volatile("" : "+v"(tid));
    const int wave = tid >> 6, lane = tid & 63, c = 8 * lane;
    const f32x4 g0 = *(const f32x4*)(p.g_mlstm() + (size_t)l * DB + c), g1 = *(const f32x4*)(p.g_mlstm() + (size_t)l * DB + c + 4);
    for (int r = (cu * 8 + wave) * 2; r < R_CTX; r += ncu * 16) {
        f32x4 v[2][2]; u32x4 ow[2];
#pragma unroll
        for (int k = 0; k < 2; ++k) { const float* h0 = p.hbc() + (size_t)(r + k) * DB + c; const float* h1 = h0 + (size_t)R_CTX * DB;
            v[k][0] = *(const f32x4*)h0 + *(const f32x4*)h1; v[k][1] = *(const f32x4*)(h0 + 4) + *(const f32x4*)(h1 + 4); ow[k] = *(const u32x4*)(p.proj() + (size_t)(r + k) * PJ + C_O + c); }
#pragma unroll
        for (int k = 0; k < 2; ++k) { float ss = 0.f;
#pragma unroll
            for (int j = 0; j < 4; ++j) ss += v[k][0][j] * v[k][0][j] + v[k][1][j] * v[k][1][j];
            ss += __shfl_xor(ss, 1, 64); ss += __shfl_xor(ss, 2, 64); ss += __shfl_xor(ss, 4, 64); ss += __shfl_xor(ss, 8, 64);
            const float rs = 1.0f / sqrtf(ss * (1.0f / DH) + EPSF); const u32x4 o = ow[k]; const float og[8] = {bflo(o.x), bfhi(o.x), bflo(o.y), bfhi(o.y), bflo(o.z), bfhi(o.z), bflo(o.w), bfhi(o.w)};
            float y[8];
#pragma unroll
            for (int j = 0; j < 4; ++j) { y[j] = v[k][0][j] * rs * g0[j] * __builtin_amdgcn_rcpf(1.0f + __expf(-og[j])); y[4 + j] = v[k][1][j] * rs * g1[j] * __builtin_amdgcn_rcpf(1.0f + __expf(-og[4 + j])); }
            u32x4 w; w.x = pk_bf16(y[0], y[1]); w.y = pk_bf16(y[2], y[3]); w.z = pk_bf16(y[4], y[5]); w.w = pk_bf16(y[6], y[7]);
            *(u32x4*)(p.ys() + (size_t)(r + k) * 3 * DB + 2 * DB + c) = w; }
    }
}
#define SG_LD 136
__device__ __forceinline__ void unit_sgu(const P& p, int l, int unit, LAS unsigned char* lds) {
    int tid = threadIdx.x; asm volatile("" : "+v"(tid));
    const int wave = __builtin_amdgcn_readfirstlane(tid >> 6), lane = tid & 63, fr = lane & 15, fq = lane >> 4;
    const int g = unit % NG, ch = unit / NG, r0 = ch * SGU_CHUNK;
    LAS float* rstd = (LAS float*)lds;
    LAS bf16_t* Aw = (LAS bf16_t*)(lds + 1024);
    LAS bf16_t* Bv = Aw + 128 * SG_LD;
    { const int row = tid >> 2, part = tid & 3; const bf16_t* sv = p.proj() + (size_t)(r0 + row) * PJ + C_SV + part * 128; float ss = 0.f;
#pragma unroll
        for (int c = 0; c < 16; ++c) { const u32x4 v = *(const u32x4*)(sv + 8 * c); const float a0 = bflo(v.x), a1 = bfhi(v.x), a2 = bflo(v.y), a3 = bfhi(v.y), a4 = bflo(v.z), a5 = bfhi(v.z), a6 = bflo(v.w), a7 = bfhi(v.w);
            ss += a0 * a0 + a1 * a1 + a2 * a2 + a3 * a3 + a4 * a4 + a5 * a5 + a6 * a6 + a7 * a7; }
        ss += __shfl_xor(ss, 1, 64); ss += __shfl_xor(ss, 2, 64);
        if (part == 0) rstd[row] = 1.0f / sqrtf(ss * (1.0f / DB) + EPSF); }
    { const float* W = p.w_sgu() + ((size_t)l * NG + g) * SGU_CHUNK * SGU_CHUNK;
#pragma unroll
        for (int it = 0; it < 8; ++it) { const int idx = (it * 512 + tid) * 4; const f32x4 w = *(const f32x4*)(W + idx); u32x2 o; o.x = pk_bf16(w[0], w[1]); o.y = pk_bf16(w[2], w[3]);
            *(LAS u32x2*)(Aw + (idx >> 7) * SG_LD + (idx & 127)) = o; } }
    u32x4 svv[2][2]; f32x4 gg0[2], gg1[2];
#pragma unroll
    for (int i = 0; i < 2; ++i) { const int cb = (wave * 2 + i) * 8; const float* gs = p.g_sgu() + (size_t)l * DB + g * GRP + cb; gg0[i] = *(const f32x4*)gs; gg1[i] = *(const f32x4*)(gs + 4);
#pragma unroll
        for (int half = 0; half < 2; ++half) svv[half][i] = *(const u32x4*)(p.proj() + (size_t)(r0 + 64 * half + lane) * PJ + C_SV + g * GRP + cb); }
    __syncthreads();
#pragma unroll
    for (int half = 0; half < 2; ++half) { const int q = 64 * half + lane; const float rs = rstd[q];
#pragma unroll
        for (int i = 0; i < 2; ++i) { const int cb = (wave * 2 + i) * 8;
            const u32x4 v = svv[half][i];
            const f32x4 g0 = gg0[i], g1 = gg1[i];
            Bv[(cb + 0) * SG_LD + q] = f2bf(bflo(v.x) * rs * g0[0]); Bv[(cb + 1) * SG_LD + q] = f2bf(bfhi(v.x) * rs * g0[1]);
            Bv[(cb + 2) * SG_LD + q] = f2bf(bflo(v.y) * rs * g0[2]); Bv[(cb + 3) * SG_LD + q] = f2bf(bfhi(v.y) * rs * g0[3]);
            Bv[(cb + 4) * SG_LD + q] = f2bf(bflo(v.z) * rs * g1[0]); Bv[(cb + 5) * SG_LD + q] = f2bf(bfhi(v.z) * rs * g1[1]);
            Bv[(cb + 6) * SG_LD + q] = f2bf(bflo(v.w) * rs * g1[2]); Bv[(cb + 7) * SG_LD + q] = f2bf(bfhi(v.w) * rs * g1[3]); } }
    const int pp = 16 * wave + fr; const size_t row = (size_t)r0 + pp; const float bias = p.b_sgu()[((size_t)l * NG + g) * SGU_CHUNK + pp];
    u32x2 suv[8];
#pragma unroll
    for (int ct = 0; ct < 8; ++ct) suv[ct] = *(const u32x2*)(p.proj() + row * PJ + C_SU + g * GRP + 16 * ct + 4 * fq);
    __syncthreads();
    f32x4 acc[8];
#pragma unroll
    for (int i = 0; i < 8; ++i) acc[i] = (f32x4){0.f, 0.f, 0.f, 0.f};
#pragma unroll
    for (int ks = 0; ks < 4; ++ks) { const bf16x8 a = *(const LAS bf16x8*)(Aw + (16 * wave + fr) * SG_LD + 32 * ks + 8 * fq);
#pragma unroll
        for (int ct = 0; ct < 8; ++ct) { const bf16x8 b = *(const LAS bf16x8*)(Bv + (16 * ct + fr) * SG_LD + 32 * ks + 8 * fq); acc[ct] = MFMA16(b, a, acc[ct]); } }
#pragma unroll
    for (int ct = 0; ct < 8; ++ct) { const int cc = g * GRP + 16 * ct + 4 * fq; const u32x2 su = suv[ct];
        u32x2 o; o.x = pk_bf16(bflo(su.x) * (acc[ct][0] + bias), bfhi(su.x) * (acc[ct][1] + bias)); o.y = pk_bf16(bflo(su.y) * (acc[ct][2] + bias), bfhi(su.y) * (acc[ct][3] + bias));
        *(u32x2*)(p.ys() + row * 3 * DB + DB + cc) = o; }
    __syncthreads();
}
#define N_POOL_ITEMS ((size_t)R_CTX * (DB / 2) + (size_t)NB_LAT * GRID_W * (DB / 2))
__device__ __forceinline__ void b_pool_d2(const P& p, size_t i) {
    const unsigned* pj = (const unsigned*)p.proj();
    if (i < (size_t)R_CTX * (DB / 2)) {
        const int c2 = i % (DB / 2); const int r = i / (DB / 2); const int g = (2 * c2) / GRP, win = 2 << g; const int b = r / T_CTX, t = r % T_CTX;
        int lo = t - win / 2; if (lo < 0) lo = 0; int hi = t + (win - win / 2); if (hi > T_CTX) hi = T_CTX;
        float s0 = 0.f, s1 = 0.f;
        for (int tt = lo; tt < hi; ++tt) { const unsigned w = pj[(size_t)(b * T_CTX + tt) * (PJ / 2) + c2]; s0 += bflo(w); s1 += bfhi(w); }
        const float inv = 1.0f / (float)(hi - lo); const unsigned w = pj[(size_t)r * (PJ / 2) + c2];
        ((unsigned*)p.dbf())[(size_t)r * (DB / 2) + c2] = pk_bf16(s0 * inv - bflo(w), s1 * inv - bfhi(w));
    } else {
        i -= (size_t)R_CTX * (DB / 2);
        const int c2 = i % (DB / 2); const int gx = (i / (DB / 2)) % GRID_W; const int b = i / ((size_t)(DB / 2) * GRID_W); const int g = (2 * c2) / GRP, win = 2 << g; constexpr int rows = T_LAT / GRID_W;
        int xlo = gx - win / 2; if (xlo < 0) xlo = 0; int xhi = gx + (win - win / 2); if (xhi > GRID_W) xhi = GRID_W; const float invx = 1.0f / (float)(xhi - xlo);
        float m0[rows], m1[rows];
#pragma unroll
        for (int y = 0; y < rows; ++y) { float s0 = 0.f, s1 = 0.f; const unsigned* rp = pj + (size_t)(R_CTX + b * T_LAT + y * GRID_W) * (PJ / 2) + c2;
            for (int xx = xlo; xx < xhi; ++xx) { const unsigned w = rp[(size_t)xx * (PJ / 2)]; s0 += bflo(w); s1 += bfhi(w); }
            m0[y] = s0 * invx; m1[y] = s1 * invx; }
#pragma unroll
        for (int y = 0; y < rows; ++y) { int ylo = y - win / 2; if (ylo < 0) ylo = 0; int yhi = y + (win - win / 2); if (yhi > rows) yhi = rows; float s0 = 0.f, s1 = 0.f;
#pragma unroll
            for (int yy = 0; yy < rows; ++yy) { const bool in = yy >= ylo && yy < yhi; s0 += in ? m0[yy] : 0.f; s1 += in ? m1[yy] : 0.f; }
            const float invy = 1.0f / (float)(yhi - ylo); const size_t r = (size_t)R_CTX + b * T_LAT + y * GRID_W + gx; const unsigned w = pj[r * (PJ / 2) + c2];
            ((unsigned*)p.dbf())[r * (DB / 2) + c2] = pk_bf16(s0 * invy - bflo(w), s1 * invy - bfhi(w)); }
    }
}
__device__ __forceinline__ void unit_pool(const P& p, int l, int unit) {
    int tid = threadIdx.x; asm volatile("" : "+v"(tid));
    const int wave = __builtin_amdgcn_readfirstlane(tid >> 6), lane = tid & 63, fr = lane & 15, fq = lane >> 4;
    const int g = unit % NG, r0 = (unit / NG) * 128 + 16 * wave;
    const bf16_t* A = p.dbf() + (size_t)(r0 + fr) * DB + g * GRP + 8 * fq; const bf16_t* B = p.Wt_pool() + ((size_t)l * NG + g) * GRP * GRP + (size_t)fr * GRP + 8 * fq;
    f32x4 acc[8];
#pragma unroll
    for (int i = 0; i < 8; ++i) acc[i] = (f32x4){0.f, 0.f, 0.f, 0.f};
#pragma unroll
    for (int ks = 0; ks < 4; ++ks) { const bf16x8 a = *(const bf16x8*)(A + 32 * ks);
#pragma unroll
        for (int dt = 0; dt < 8; ++dt) { const bf16x8 b = *(const bf16x8*)(B + (size_t)16 * dt * GRP + 32 * ks); acc[dt] = MFMA16(b, a, acc[dt]); } }
    const size_t row = (size_t)r0 + fr;
#pragma unroll
    for (int dt = 0; dt < 8; ++dt) { const int c = g * GRP + 16 * dt + 4 * fq; const f32x4 sc = *(const f32x4*)(p.pool_scale() + (size_t)l * DB + c);
        u32x2 o; o.x = pk_bf16(acc[dt][0] * sc[0], acc[dt][1] * sc[1]); o.y = pk_bf16(acc[dt][2] * sc[2], acc[dt][3] * sc[3]); *(u32x2*)(p.ys() + row * 3 * DB + c) = o; }
}
#define N_FOLD (DEPTH * NG * (DM / 32))
__device__ __forceinline__ void unit_fold(const P& p, int unit, LAS unsigned char* lds) {
    int tid = threadIdx.x; asm volatile("" : "+v"(tid));
    const int kt = unit % (DM / 32), g = (unit / (DM / 32)) % NG, l = unit / ((DM / 32) * NG), k0 = kt * 32;
    LAS float* Wp = (LAS float*)lds;
    LAS float* A = Wp + GRP * GRP;
    LAS float* T = A + 32 * GRP;
    const float* wp = p.w_pool() + ((size_t)l * NG + g) * GRP * GRP;
#pragma unroll
    for (int it = 0; it < 8; ++it) { const int idx = (it * 512 + tid) * 4; *(LAS f32x4*)(Wp + idx) = *(const f32x4*)(wp + idx); }
#pragma unroll
    for (int it = 0; it < 2; ++it) { const int idx = (it * 512 + tid) * 4; const int k = idx >> 7, c = idx & 127; *(LAS f32x4*)(A + idx) = *(const f32x4*)(p.w_in() + ((size_t)l * DM + k0 + k) * D_IN + g * GRP + c); }
    __syncthreads();
    { const int k = tid >> 4, ddb = (tid & 15) * 8; f32x4 a0 = {0.f, 0.f, 0.f, 0.f}, a1 = a0;
#pragma unroll 8
        for (int c = 0; c < GRP; ++c) { const float a = A[k * GRP + c]; a0 = a0 + a * *(const LAS f32x4*)(Wp + c * GRP + ddb); a1 = a1 + a * *(const LAS f32x4*)(Wp + c * GRP + ddb + 4); }
#pragma unroll
        for (int j = 0; j < 4; ++j) { T[(ddb + j) * 33 + k] = a0[j]; T[(ddb + 4 + j) * 33 + k] = a1[j]; } }
    __syncthreads();
    { const int dd = tid >> 2, ks = (tid & 3) * 8; const LAS float* t = T + dd * 33 + ks;
        u32x4 o; o.x = pk_bf16(t[0], t[1]); o.y = pk_bf16(t[2], t[3]); o.z = pk_bf16(t[4], t[5]); o.w = pk_bf16(t[6], t[7]);
        *(u32x4*)(p.Wt_in() + ((size_t)l * NIN_PAD + g * GRP + dd) * DM + k0 + ks) = o; }
    __syncthreads();
}
#define N_POOL_UNITS (NB_CTX * (T_CTX / 64) + NB_LAT * (DB / 16))
__device__ __forceinline__ void unit_pool2(const P& p, int l, int unit, LAS unsigned char* lds) {
    int tid = threadIdx.x; asm volatile("" : "+v"(tid));
    if (unit < NB_CTX * (T_CTX / 64)) {
        const int b = unit / (T_CTX / 64), t0 = (unit % (T_CTX / 64)) * 64; LAS bf16_t* Z = (LAS bf16_t*)lds;
#pragma unroll
        for (int it = 0; it < 10; ++it) { const int idx = it * 512 + tid; const int j = idx >> 6, c8 = idx & 63; const int t = t0 - 8 + j;
            if (t >= 0 && t < T_CTX) *(LAS u32x4*)(Z + j * DB + c8 * 8) = *(const u32x4*)(p.proj() + (size_t)(b * T_CTX + t) * PJ + c8 * 8); }
        __syncthreads();
#pragma unroll 2
        for (int it = 0; it < 8; ++it) { const int idx = it * 512 + tid; const int tl = idx >> 6, c8 = idx & 63; const int t = t0 + tl; const int win = 2 << (c8 >> 4);
            int lo = t - win / 2; if (lo < 0) lo = 0; int hi = t + (win - win / 2); if (hi > T_CTX) hi = T_CTX;
            float s[8] = {0.f, 0.f, 0.f, 0.f, 0.f, 0.f, 0.f, 0.f};
#pragma unroll
            for (int j = 0; j < 16; ++j) { const int tt = t - 8 + j; const bool ok = tt >= lo && tt < hi; const u32x4 v = *(const LAS u32x4*)(Z + (tl + j) * DB + c8 * 8);
                s[0] += ok ? bflo(v.x) : 0.f; s[1] += ok ? bfhi(v.x) : 0.f; s[2] += ok ? bflo(v.y) : 0.f; s[3] += ok ? bfhi(v.y) : 0.f; s[4] += ok ? bflo(v.z) : 0.f; s[5] += ok ? bfhi(v.z) : 0.f; s[6] += ok ? bflo(v.w) : 0.f; s[7] += ok ? bfhi(v.w) : 0.f; }
            const float inv = 1.0f / (float)(hi - lo); const u32x4 v = *(const LAS u32x4*)(Z + (tl + 8) * DB + c8 * 8);
            const float* sc = p.pool_scale() + (size_t)l * DB + c8 * 8; const f32x4 s0 = *(const f32x4*)sc, s1 = *(const f32x4*)(sc + 4);
            u32x4 o; o.x = pk_bf16((s[0] * inv - bflo(v.x)) * s0[0], (s[1] * inv - bfhi(v.x)) * s0[1]); o.y = pk_bf16((s[2] * inv - bflo(v.y)) * s0[2], (s[3] * inv - bfhi(v.y)) * s0[3]);
            o.z = pk_bf16((s[4] * inv - bflo(v.z)) * s1[0], (s[5] * inv - bfhi(v.z)) * s1[1]); o.w = pk_bf16((s[6] * inv - bflo(v.w)) * s1[2], (s[7] * inv - bfhi(v.w)) * s1[3]);
            pg8::st16_wt(p.ys(), (unsigned)((b * T_CTX + t) * 3 * DB + c8 * 8) * 2u, o); }
    } else {
        const int u2 = unit - NB_CTX * (T_CTX / 64); const int b = u2 / (DB / 16), cs = (u2 % (DB / 16)) * 16; const int win = 2 << (cs / GRP); constexpr int rows = T_LAT / GRID_W;
        LAS bf16_t* Z = (LAS bf16_t*)lds;
        LAS float* XM = (LAS float*)(lds + T_LAT * 32);
        const size_t rb = (size_t)R_CTX + (size_t)b * T_LAT;
#pragma unroll
        for (int it = 0; it < T_LAT * 2 / 512; ++it) { const int idx = it * 512 + tid; const int tok = idx >> 1, hf = idx & 1; *(LAS u32x4*)(Z + tok * 16 + hf * 8) = *(const u32x4*)(p.proj() + (rb + tok) * PJ + cs + hf * 8); }
        __syncthreads();
#pragma unroll 2
        for (int it = 0; it < T_LAT * 2 / 512; ++it) { const int idx = it * 512 + tid; const int tok = idx >> 1, hf = idx & 1; const int gy = tok / GRID_W, gx = tok % GRID_W;
            int xlo = gx - win / 2; if (xlo < 0) xlo = 0; int xhi = gx + (win - win / 2); if (xhi > GRID_W) xhi = GRID_W;
            float s[8] = {0.f, 0.f, 0.f, 0.f, 0.f, 0.f, 0.f, 0.f};
#pragma unroll
            for (int j = 0; j < 16; ++j) { const int xx = gx - 8 + j; const bool ok = xx >= xlo && xx < xhi; const int xc = xx < 0 ? 0 : (xx > GRID_W - 1 ? GRID_W - 1 : xx);
                const u32x4 v = *(const LAS u32x4*)(Z + (gy * GRID_W + xc) * 16 + hf * 8);
                s[0] += ok ? bflo(v.x) : 0.f; s[1] += ok ? bfhi(v.x) : 0.f; s[2] += ok ? bflo(v.y) : 0.f; s[3] += ok ? bfhi(v.y) : 0.f; s[4] += ok ? bflo(v.z) : 0.f; s[5] += ok ? bfhi(v.z) : 0.f; s[6] += ok ? bflo(v.w) : 0.f; s[7] += ok ? bfhi(v.w) : 0.f; }
            const float inv = 1.0f / (float)(xhi - xlo);
            *(LAS f32x4*)(XM + tok * 16 + hf * 8) = (f32x4){s[0] * inv, s[1] * inv, s[2] * inv, s[3] * inv}; *(LAS f32x4*)(XM + tok * 16 + hf * 8 + 4) = (f32x4){s[4] * inv, s[5] * inv, s[6] * inv, s[7] * inv}; }
        __syncthreads();
#pragma unroll 2
        for (int it = 0; it < T_LAT * 2 / 512; ++it) { const int idx = it * 512 + tid; const int tok = idx >> 1, hf = idx & 1; const int gy = tok / GRID_W, gx = tok % GRID_W;
            int ylo = gy - win / 2; if (ylo < 0) ylo = 0; int yhi = gy + (win - win / 2); if (yhi > rows) yhi = rows;
            f32x4 a0 = {0.f, 0.f, 0.f, 0.f}, a1 = a0;
#pragma unroll
            for (int j = 0; j < 16; ++j) { const int yy = gy - 8 + j; const bool ok = yy >= ylo && yy < yhi; const int yc = yy < 0 ? 0 : (yy > rows - 1 ? rows - 1 : yy);
                const f32x4 x0 = *(const LAS f32x4*)(XM + (yc * GRID_W + gx) * 16 + hf * 8), x1 = *(const LAS f32x4*)(XM + (yc * GRID_W + gx) * 16 + hf * 8 + 4);
                const float m = ok ? 1.0f : 0.0f; a0 = a0 + x0 * m; a1 = a1 + x1 * m; }
            const float inv = 1.0f / (float)(yhi - ylo); const u32x4 v = *(const LAS u32x4*)(Z + tok * 16 + hf * 8);
            const float* sc = p.pool_scale() + (size_t)l * DB + cs + hf * 8; const f32x4 s0 = *(const f32x4*)sc, s1 = *(const f32x4*)(sc + 4);
            u32x4 o; o.x = pk_bf16((a0[0] * inv - bflo(v.x)) * s0[0], (a0[1] * inv - bfhi(v.x)) * s0[1]); o.y = pk_bf16((a0[2] * inv - bflo(v.y)) * s0[2], (a0[3] * inv - bfhi(v.y)) * s0[3]);
            o.z = pk_bf16((a1[0] * inv - bflo(v.z)) * s1[0], (a1[1] * inv - bfhi(v.z)) * s1[1]); o.w = pk_bf16((a1[2] * inv - bflo(v.w)) * s1[2], (a1[3] * inv - bfhi(v.w)) * s1[3]);
            pg8::st16_wt(p.ys(), (unsigned)((rb + tok) * 3 * DB + cs + hf * 8) * 2u, o); }
    }
    __syncthreads();
}
__device__ __forceinline__ void phase_norm(const P& p, int l, int which) {
    int tid = threadIdx.x; asm volatile("" : "+v"(tid));
    const int wave = tid >> 6, lane = tid & 63; const int stride = gridDim.x * 8;
    for (int r0 = blockIdx.x * 8 + wave; r0 < NROW; r0 += 3 * stride) {
        f32x4 v[3][DM / 256];
#pragma unroll
        for (int q = 0; q < 3; ++q) { const int r = r0 + q * stride; if (r < NROW) { const float* xr = r < R_CTX ? p.x_prompt() + (size_t)r * DM : p.x_sample() + (size_t)(r - R_CTX) * DM;
#pragma unroll
            for (int i = 0; i < DM / 256; ++i) v[q][i] = *(const f32x4*)(xr + (i * 64 + lane) * 4); } }
#pragma unroll
        for (int q = 0; q < 3; ++q) { const int r = r0 + q * stride; if (r < NROW) { float ss = 0.f;
#pragma unroll
            for (int i = 0; i < DM / 256; ++i) { *(f32x4*)(p.x() + (size_t)r * DM + (i * 64 + lane) * 4) = v[q][i]; ss += v[q][i][0] * v[q][i][0] + v[q][i][1] * v[q][i][1] + v[q][i][2] * v[q][i][2] + v[q][i][3] * v[q][i][3]; }
#pragma unroll
            for (int off = 32; off >= 1; off >>= 1) ss += __shfl_xor(ss, off, 64);
            const float rs = 1.0f / sqrtf(ss * (1.0f / DM) + EPSF);
            const float* g = p.g_norm1() + (size_t)l * DM; const float* md = p.mod() + ((size_t)l * 3 + cond_of_row(r)) * 6 * DM;
#pragma unroll
            for (int i = 0; i < DM / 256; ++i) { const int k = (i * 64 + lane) * 4; const f32x4 o = v[q][i] * rs * *(const f32x4*)(g + k) * (*(const f32x4*)(md + DM + k) + 1.0f) + *(const f32x4*)(md + k);
                u32x2 w; w.x = pk_bf16(o[0], o[1]); w.y = pk_bf16(o[2], o[3]); *(u32x2*)(p.u() + (size_t)r * DM + k) = w; } } }
    }
}
#define N_MOD_BLK (DEPTH * (6 * DM / 128))
__device__ __forceinline__ void unit_mod(const P& p, int unit, LAS unsigned char* lds) {
    int tid = threadIdx.x; asm volatile("" : "+v"(tid));
    const int l = unit / (6 * DM / 128), j0 = (unit % (6 * DM / 128)) * 128; const int j4 = tid & 31, ks = tid >> 5, k0 = ks * (DM / 16);
    LAS float* R = (LAS float*)lds;
    const float* w = p.w_ada() + ((size_t)l * DM + k0) * 6 * DM + j0 + j4 * 4;
    f32x4 a0 = {0.f, 0.f, 0.f, 0.f}, a1 = a0, a2 = a0;
#pragma unroll 4
    for (int k = 0; k < DM / 16; ++k) { const f32x4 wv = *(const f32x4*)(w + (size_t)k * 6 * DM);
        const float c0 = p.c_ctx()[k0 + k], c1 = p.c()[k0 + k], c2 = p.c()[DM + k0 + k];
        a0 = a0 + wv * (c0 / (1.0f + expf(-c0))); a1 = a1 + wv * (c1 / (1.0f + expf(-c1))); a2 = a2 + wv * (c2 / (1.0f + expf(-c2))); }
    *(LAS f32x4*)(R + (ks * 3 + 0) * 128 + j4 * 4) = a0; *(LAS f32x4*)(R + (ks * 3 + 1) * 128 + j4 * 4) = a1; *(LAS f32x4*)(R + (ks * 3 + 2) * 128 + j4 * 4) = a2;
    __syncthreads();
    if (tid < 384) { const int ci = tid >> 7, j = tid & 127; float s = p.b_ada()[(size_t)l * 6 * DM + j0 + j];
#pragma unroll
        for (int q = 0; q < 16; ++q) s += R[(q * 3 + ci) * 128 + j];
        p.mod()[((size_t)l * 3 + ci) * 6 * DM + j0 + j] = s; }
    __syncthreads();
}
__device__ __forceinline__ void conv_tile(const float* __restrict__ W, int N, bf16_t* __restrict__ Wt, int K, int kt, int nt, int rowmap, LAS unsigned char* lds) {
    int tid = threadIdx.x; asm volatile("" : "+v"(tid));
    LAS float* T = (LAS float*)lds;
    const int k0 = kt * 64, n0 = nt * 256;
    { const int c4 = (tid & 63) * 4, kb = tid >> 6; f32x4 v[8];
#pragma unroll
        for (int i = 0; i < 8; ++i) { v[i] = (f32x4){0.f, 0.f, 0.f, 0.f}; if (n0 + c4 < N) v[i] = *(const f32x4*)(W + (size_t)(k0 + kb + 8 * i) * N + n0 + c4); }
#pragma unroll
        for (int i = 0; i < 8; ++i) *(LAS f32x4*)(T + (kb + 8 * i) * 260 + c4) = v[i]; }
    __syncthreads();
    { const int n = tid >> 1, ks = (tid & 1) * 32; const int col = n0 + n;
        if (col < N) { int row = col; if (rowmap) row = col < 7 * DB ? col : (col < 7 * DB + 4 * NH ? PJ + (col - 7 * DB) : col - 4 * NH);
            bf16_t* dst = Wt + (size_t)row * K + k0 + ks;
#pragma unroll
            for (int q = 0; q < 4; ++q) { const LAS float* t = T + (ks + q * 8) * 260 + n;
                u32x4 o; o.x = pk_bf16(t[0], t[260]); o.y = pk_bf16(t[2 * 260], t[3 * 260]); o.z = pk_bf16(t[4 * 260], t[5 * 260]); o.w = pk_bf16(t[6 * 260], t[7 * 260]);
                *(u32x4*)(dst + q * 8) = o; } } }
    __syncthreads();
}
#define CT_IN (16 * ((D_IN + 255) / 256))
#define CT_BR (3 * (DB / 64) * (DM / 256))
#define CT_OUT ((DM / 64) * (DM / 256))
#define CT_FF ((DM / 64) * (DFF / 256))
#define CT_LAYER (CT_IN + CT_BR + CT_OUT + 2 * CT_FF)
#define N_FOLD_L (NG * (DM / 32))
#define CONV_ITEMS (CT_LAYER + N_FOLD_L)
__device__ __forceinline__ void conv_layer(const P& p, int l, int i_lo, int i_hi, int cu, int ncu, LAS unsigned char* lds) {
    for (int t = i_lo + cu; t < i_hi; t += ncu) {
        int r = t;
        if (r >= CT_LAYER) { unit_fold(p, l * N_FOLD_L + (r - CT_LAYER), lds); continue; }
        if (r < CT_IN) { constexpr int nn = (D_IN + 255) / 256; if (r % nn >= DB / 256) conv_tile(p.w_in() + (size_t)l * DM * D_IN, D_IN, p.Wt_in() + (size_t)l * NIN_PAD * DM, DM, r / nn, r % nn, 1, lds); continue; } r -= CT_IN;
        if (r < CT_BR) { constexpr int per = (DB / 64) * (DM / 256); const int br = r / per, q = r % per; conv_tile(p.w_branch() + ((size_t)l * 3 + br) * DB * DM, DM, p.Wt_br() + ((size_t)l * 3 + br) * DM * DB, DB, q / (DM / 256), q % (DM / 256), 0, lds); continue; } r -= CT_BR;
        if (r < CT_OUT) { conv_tile(p.w_out() + (size_t)l * DM * DM, DM, p.Wt_out() + (size_t)l * DM * DM, DM, r / (DM / 256), r % (DM / 256), 0, lds); continue; } r -= CT_OUT;
        if (r < CT_FF) { conv_tile(p.w_ff1() + (size_t)l * DM * DFF, DFF, p.Wt_ff1() + (size_t)l * DFF * DM, DM, r / (DFF / 256), r % (DFF / 256), 0, lds); continue; } r -= CT_FF;
        conv_tile(p.w_ff2() + (size_t)l * DFF * DM, DM, p.Wt_ff2() + (size_t)l * DM * DFF, DFF, r / (DM / 256), r % (DM / 256), 0, lds);
    }
    if (i_lo == 0) { const size_t per = (size_t)(NIN_PAD - PJ - 4 * NH) * DM / 8;
      int tz = threadIdx.x; asm volatile("" : "+v"(tz));
      for (size_t i = (size_t)cu * NTHR + tz; i < per; i += (size_t)ncu * NTHR) *(u32x4*)(p.Wt_in() + ((size_t)l * NIN_PAD + PJ + 4 * NH) * DM + i * 8) = (u32x4){0u, 0u, 0u, 0u}; }
}
#endif
#ifndef CPU_EMU
#define STAGE_OFF 1024
#define LDS_BYTES (STAGE_OFF + 147456)
struct Args { const float* in[24]; P p; unsigned* bar; };
#define GS(n, call) do { int t_ = threadIdx.x; asm volatile("" : "+v"(t_)); const size_t nthr_ = (size_t)gridDim.x * NTHR; for (size_t i_ = (size_t)blockIdx.x * NTHR + t_; i_ < (size_t)(n); i_ += nthr_) { call; } } while (0)
#define BAR() xcd_barrier(bar)
template <int MODE> __device__ __forceinline__ void run_gemm128(const P& p, int l, LAS unsigned char* lds, float gsc = 1.0f, bool conv = true) {
    constexpr int NU = (NROW / 128) * (DM / 256);
    if ((int)blockIdx.x >= NU && l + 1 < DEPTH && conv) {
        constexpr int c0 = CONV_ITEMS * 30 / 100, c1 = CONV_ITEMS * 45 / 100;
        conv_layer(p, l + 1, MODE == 1 ? 0 : (MODE == 2 ? c0 : c1), MODE == 1 ? c0 : (MODE == 2 ? c1 : CONV_ITEMS), (int)blockIdx.x - NU, (int)gridDim.x - NU, lds + STAGE_OFF);
        return; }
    const GemmArgs g = gemm_args(p, l, MODE);
    pg8::Order128 S; S.init(g.M, g.N, g.nZ, (int)gridDim.x, (int)blockIdx.x);
    pg8::Epi128<MODE> E; E.p = p; E.l = l; E.gsc = gsc;
    if constexpr (MODE == 1) pg8::gemm128_phase_s<pg8::Epi128<MODE>>(lds + STAGE_OFF, g, S, E);
    else pg8::gemm128_phase<pg8::Epi128<MODE>>(lds + STAGE_OFF, g, S, E);
}
template <int MODE> __device__ __forceinline__ void run_gemm2k(const P& p, int l, LAS unsigned char* lds) {
    constexpr int NU = 2 * pg8::NT2;
    if ((int)blockIdx.x >= NU) {
        if (l + 1 < DEPTH) { constexpr int c0 = CONV_ITEMS * 25 / 100, c1 = CONV_ITEMS * 45 / 100;
            conv_layer(p, l + 1, MODE == 1 ? 0 : (MODE == 2 ? c0 : c1), MODE == 1 ? c0 : (MODE == 2 ? c1 : CONV_ITEMS), (int)blockIdx.x - NU, (int)gridDim.x - NU, lds + STAGE_OFF); }
        return; }
    GemmArgs g = gemm_args(p, l, MODE);
    pg8::Order2K S; S.init(g.nZ, (int)blockIdx.x);
    g.K /= 2; g.A += (size_t)S.kh * g.K; g.Bt += (size_t)S.kh * g.K;
    pg8::EpiX<MODE> E{p, l, S.kh, S.slot};
    pg8::gemm_phase<pg8::EpiX<MODE>, pg8::Order2K, true, true, true>(lds + STAGE_OFF, g, S, E);
}
template <int MODE> __device__ __forceinline__ void run_gemm(const P& p, int l, LAS unsigned char* lds) {
    const GemmArgs g = gemm_args(p, l, MODE);
    pg8::Order S; S.init(g.M, g.N, g.nZ, (int)gridDim.x, (int)blockIdx.x);
    pg8::Epi<MODE> E{p, l};
    pg8::gemm_phase<pg8::Epi<MODE>, pg8::Order, true, true, false>(lds + STAGE_OFF, g, S, E);
}
__global__ void __launch_bounds__(NTHR, 2) mega(Args a) {
    extern __shared__ __attribute__((aligned(16))) unsigned char lds_[];
    LAS unsigned char* lds = (LAS unsigned char*)lds_;
    volatile LAS unsigned* st = (volatile LAS unsigned*)lds;
    if (threadIdx.x < 4) st[threadIdx.x] = 0u;
    __syncthreads();
    if (threadIdx.x < 24) ((LAS unsigned long long*)(lds + IN_TAB_OFF))[threadIdx.x] = (unsigned long long)a.in[threadIdx.x];
    __syncthreads();
    XcdBarrier bar = xcd_barrier_post(a.bar, st);
    const P p = a.p;
    for (int u_ = blockIdx.x; u_ < N_MOD_BLK; u_ += gridDim.x) unit_mod(p, u_, lds + STAGE_OFF);
    conv_layer(p, 0, 0, CONV_ITEMS, (int)blockIdx.x, (int)gridDim.x, lds + STAGE_OFF); BAR();
#pragma unroll 1
    for (int l = 0; l < DEPTH; ++l) {
        if (l == 0) { phase_norm(p, 0, 3); BAR(); }
        run_gemm<0>(p, l, lds); BAR();
        { const int c = blockIdx.x, G = gridDim.x; constexpr int NSEQU = NB_CTX * NH * 2, LAT0 = (R_CTX / LCH) * NH, NLATU = (R_LAT / LCH) * NH;
          if (c < NSEQU) unit_ml_seq(p, l, c, lds + STAGE_OFF);
          else { int k = c - NSEQU;
              asm volatile("" : "+s"(k)); unit_ml_cloc(p, l, LAT0 + k, lds + STAGE_OFF);
              asm volatile("" : "+s"(k)); unit_pool2(p, l, k, lds + STAGE_OFF);
#pragma unroll 1
              for (int q = 0; q < 2; ++q) { asm volatile("" : "+s"(k)); if (q == 0 || k < 64) unit_sgu(p, l, q * 128 + k, lds + STAGE_OFF); } }
          BAR();
          phase_scan(p, l, lds + STAGE_OFF);
          BAR();
          if (c < NLATU) unit_ml_out(p, l, LAT0 + c, lds + STAGE_OFF); else phase_ctx_fin(p, l, c - NLATU, G - NLATU);
          BAR(); }
        run_gemm128<1>(p, l, lds); BAR();
        run_gemm128<2>(p, l, lds); BAR();
        run_gemm<3>(p, l, lds); BAR();
        run_gemm128<4>(p, l, lds); BAR();
    }
}
#endif

extern "C" void kernel_launch(void* const* d_in, const int* in_sizes, int n_in, void* d_out, int out_size, void* d_ws, size_t ws_size, hipStream_t stream) {
#ifndef CPU_EMU
    static int grid = 0;
    if (grid == 0) {
        int dev = 0, cus = 0, per_cu = 0;
        (void)hipGetDevice(&dev); (void)hipDeviceGetAttribute(&cus, hipDeviceAttributeMultiprocessorCount, dev);
        if (hipFuncSetAttribute((const void*)mega, hipFuncAttributeMaxDynamicSharedMemorySize, LDS_BYTES) != hipSuccess) { fprintf(stderr, "hipFuncSetAttribute failed\n"); grid = -1; return; }
        if (hipOccupancyMaxActiveBlocksPerMultiprocessor(&per_cu, (const void*)mega, NTHR, LDS_BYTES) != hipSuccess || per_cu < 1) { fprintf(stderr, "occupancy query failed (%d)\n", per_cu); grid = -1; return; }
        grid = cus * per_cu;
        if (grid != 256) { fprintf(stderr, "kernel_launch: this kernel's unit dealing is written for 256 workgroups (256 CUs x 1), got %d\n", grid); grid = -1; return; }
    }
    if (grid < 0) return;
    Args a{};
    P& p = a.p;
#else
    P p{};
#endif
#ifdef CPU_EMU
    for (int i = 0; i < 24; ++i) p.inp[i] = (const float*)d_in[i];
#else
    for (int i = 0; i < 24; ++i) a.in[i] = (const float*)d_in[i];
#endif
    p.out = (float*)d_out;
    p.ws = (char*)d_ws;
    if (ws_size < WS_TOTAL) { fprintf(stderr, "workspace too small: need %zu have %zu\n", (size_t)WS_TOTAL, ws_size); return; }
#ifndef CPU_EMU
    a.bar = (unsigned*)d_ws;
    (void)hipMemsetAsync(d_ws, 0, OFF_BAR_END, stream);
    void* args[] = {&a};
    hipError_t e = hipLaunchCooperativeKernel((const void*)mega, dim3(grid), dim3(NTHR), args, LDS_BYTES, stream);
    if (e != hipSuccess) fprintf(stderr, "cooperative launch failed: %s (grid %d)\n", hipGetErrorString(e), grid);
#else
    LAUNCH(k_body, (size_t)DEPTH * 3 * 6 * DM, b_mod(p, i_)); LAUNCH(k_body, (size_t)NROW * DM, b_copy_x(p, i_)); LAUNCH(k_body, N_CONV, b_conv(p, i_));
    for (int l = 0; l < DEPTH; ++l) {
        LAUNCH(k_body, NROW, b_norm(p, i_, l, 0));
        LAUNCH(k_body, (size_t)NROW * NIN_PAD, b_gemm(p, i_, l, 0));
        LAUNCH(k_body, (size_t)NROW * DB, b_pool_d(p, i_)); LAUNCH(k_body, NROW, b_sgu_vn(p, i_, l)); LAUNCH(k_body, (size_t)2 * NH * NCHK, b_ml_gates(p, i_, l));
        LAUNCH(k_body, (size_t)NROW * DB, b_pool_y(p, i_, l)); LAUNCH(k_body, (size_t)NROW * DB, b_sgu_y(p, i_, l)); LAUNCH(k_body, (size_t)2 * NH * NCHK * DH * DH, b_ml_cloc(p, i_));
        LAUNCH(k_body, (size_t)2 * NH * NSEQ * DH * DH, b_ml_scan(p, i_, l));
        LAUNCH(k_body, (size_t)2 * NH * NROW, b_ml_mt(p, i_));
        LAUNCH(k_body, (size_t)2 * NH * NCHK * LCH * LCH, b_ml_s(p, i_));
        LAUNCH(k_body, (size_t)2 * NROW * DB, b_ml_h(p, i_));
        LAUNCH(k_body, (size_t)NROW * NH, b_ml_fin(p, i_, l));
        LAUNCH(k_body, (size_t)NROW * DM, b_gemm(p, i_, l, 1));
        LAUNCH(k_body, (size_t)NROW * DM, b_gemm(p, i_, l, 2));
        LAUNCH(k_body, NROW, b_norm(p, i_, l, 1));
        LAUNCH(k_body, (size_t)NROW * DFF, b_gemm(p, i_, l, 3));
        LAUNCH(k_body, (size_t)NROW * DM, b_gemm(p, i_, l, 4));
    }
    LAUNCH(k_body, NROW, b_final(p, i_));
#endif
}
```

```cpp
#ifndef CPU_EMU
#include <hip/hip_runtime.h>
#include <cstdio>
#endif
#include <math.h>
#include <stddef.h>
#include <string.h>

#ifndef DM
#define DM 1024
#define NB_CTX 16
#define T_CTX 256
#define DEPTH 4
#define NB_LAT 2
#define T_LAT 1024
#define GRID_W 64
#define DB 512
#endif
#define NG 4
#define GRP (DB / NG)
#define SGU_CHUNK 128
#define NH 4
#define DH (DB / NH)
#define LCH 64
#define DFF (4 * DM)
#define D_IN (7 * DB + 4 * NH + 3 * DM)
#define R_CTX (NB_CTX * T_CTX)
#define R_LAT (NB_LAT * T_LAT)
#define NROW (R_CTX + R_LAT)
#define NCHK (NROW / LCH)
#define NSEQ (NB_CTX + NB_LAT)
#define EPSF 1e-6f
#define C_XP 0
#define C_SU (DB)
#define C_SV (2 * DB)
#define C_Q (3 * DB)
#define C_K (4 * DB)
#define C_V (5 * DB)
#define C_O (6 * DB)
#define C_G (7 * DB)
#define C_BR (7 * DB)
#define PJ (7 * DB + 3 * DM)
#define NIN_PAD (PJ + 256)
typedef unsigned short bf16_t;

#ifdef CPU_EMU
#define NAIVE_ONLY(n) (n)
#else
#define NAIVE_ONLY(n) ((size_t)64)
#endif
constexpr size_t al256(size_t b) { return (b + 255) / 256 * 256; }
constexpr size_t OFF_CNT = 16384;
constexpr size_t OFF_BAR_END = OFF_CNT + (size_t)2 * DEPTH * (NROW / 128) * 256 + al256((size_t)3 * DEPTH * ((NROW / 256) * (DM / 256)) * 4);
constexpr size_t OFF_mod = OFF_BAR_END;
constexpr size_t END_mod = OFF_mod + al256(((size_t)DEPTH * 3 * 6 * DM) * 4);
constexpr size_t OFF_x = END_mod;
constexpr size_t END_x = OFF_x + al256(((size_t)NROW * DM) * 4);
constexpr size_t OFF_gate_pre = END_x;
constexpr size_t END_gate_pre = OFF_gate_pre + al256(((size_t)NROW * 16) * 4);
constexpr size_t END_mergedf = END_gate_pre;
constexpr size_t OFF_dbuf = END_mergedf;
constexpr size_t END_dbuf = OFF_dbuf + al256(((size_t)NROW * DB) * 4);
constexpr size_t OFF_vn = END_dbuf;
constexpr size_t END_vn = OFF_vn + al256(((size_t)NROW * DB) * 4);
constexpr size_t OFF_Cloc = END_vn;
constexpr size_t END_Cloc = OFF_Cloc + al256(((size_t)2 * NH * NCHK * DH * DH) * 4);
constexpr size_t OFF_nloc = END_Cloc;
constexpr size_t END_nloc = OFF_nloc + al256(((size_t)2 * NH * NCHK * DH) * 4);
constexpr size_t OFF_bcum = END_nloc;
constexpr size_t END_bcum = OFF_bcum + al256((NAIVE_ONLY((size_t)2 * NH * NROW)) * 4);
constexpr size_t OFF_ival = END_bcum;
constexpr size_t END_ival = OFF_ival + al256((NAIVE_ONLY((size_t)2 * NH * NROW)) * 4);
constexpr size_t OFF_bL = END_ival;
constexpr size_t END_bL = OFF_bL + al256(((size_t)2 * NH * NCHK) * 4);
constexpr size_t OFF_Mloc = END_bL;
constexpr size_t END_Mloc = OFF_Mloc + al256(((size_t)2 * NH * NCHK) * 4);
constexpr size_t OFF_Mprev = END_Mloc;
constexpr size_t END_Mprev = OFF_Mprev + al256(((size_t)2 * NH * NCHK) * 4);
constexpr size_t OFF_MT = END_Mprev;
constexpr size_t END_MT = OFF_MT + al256((NAIVE_ONLY((size_t)2 * NH * NROW)) * 4);
constexpr size_t OFF_S = END_MT;
constexpr size_t END_S = OFF_S + al256((NAIVE_ONLY((size_t)2 * NH * NCHK * LCH * LCH)) * 4);
constexpr size_t OFF_hbuf = END_S;
constexpr size_t END_hbuf = OFF_hbuf + al256((NAIVE_ONLY((size_t)2 * NROW * DB)) * 4);
constexpr size_t OFF_Wt_in = END_hbuf;
constexpr size_t END_Wt_in = OFF_Wt_in + al256(((size_t)DEPTH * NIN_PAD * DM) * 2);
constexpr size_t OFF_Wt_br = END_Wt_in;
constexpr size_t END_Wt_br = OFF_Wt_br + al256(((size_t)DEPTH * 3 * DM * DB) * 2);
constexpr size_t OFF_Wt_out = END_Wt_br;
constexpr size_t END_Wt_out = OFF_Wt_out + al256(((size_t)DEPTH * DM * DM) * 2);
constexpr size_t OFF_Wt_ff1 = END_Wt_out;
constexpr size_t END_Wt_ff1 = OFF_Wt_ff1 + al256(((size_t)DEPTH * DFF * DM) * 2);
constexpr size_t OFF_Wt_ff2 = END_Wt_ff1;
constexpr size_t END_Wt_ff2 = OFF_Wt_ff2 + al256(((size_t)DEPTH * DM * DFF) * 2);
constexpr size_t OFF_u = END_Wt_ff2;
constexpr size_t END_u = OFF_u + al256(((size_t)NROW * DM) * 2);
constexpr size_t OFF_proj = END_u;
constexpr size_t END_proj = OFF_proj + al256(((size_t)NROW * PJ) * 2);
constexpr size_t OFF_ys = END_proj;
constexpr size_t END_ys = OFF_ys + al256(((size_t)NROW * 3 * DB) * 2);
constexpr size_t OFF_merged = END_ys;
constexpr size_t END_merged = OFF_merged + al256(((size_t)NROW * DM) * 2);
constexpr size_t END_hff = END_merged;
constexpr size_t OFF_CprevT = END_hff;
constexpr size_t END_CprevT = OFF_CprevT + al256(((size_t)2 * NH * NCHK * DH * DH) * 2);
constexpr size_t OFF_nprev = END_CprevT;
constexpr size_t END_nprev = OFF_nprev + al256(((size_t)2 * NH * NCHK * DH) * 4);
constexpr size_t OFF_dbf = END_nprev;
constexpr size_t END_dbf = OFF_dbf + al256(((size_t)NROW * DB) * 2);
constexpr size_t OFF_Wt_pool = END_dbf;
constexpr size_t END_Wt_pool = OFF_Wt_pool + al256(((size_t)DEPTH * NG * GRP * GRP) * 2);
constexpr size_t OFF_ssq = END_Wt_pool;
constexpr size_t END_ssq = OFF_ssq + al256(((size_t)2 * DEPTH * NROW * 4) * 4);
constexpr size_t OFF_gsc = END_ssq;
constexpr size_t END_gsc = OFF_gsc + al256(((size_t)3 * 2 * NH * NROW) * 4);
constexpr size_t OFF_VTg = END_gsc;
constexpr size_t END_VTg = OFF_VTg + al256(((size_t)NH * NCHK * DH * LCH) * 2);
constexpr size_t OFF_hbc = END_VTg;
constexpr size_t END_hbc = OFF_hbc + al256(((size_t)2 * R_CTX * DB) * 4);
constexpr size_t WS_TOTAL = END_hbc;
constexpr size_t OFF_mergedf = OFF_dbuf;
constexpr size_t OFF_hff = OFF_proj;
static_assert(END_vn - OFF_dbuf >= (size_t)NROW * DM * 4 && END_dbuf == OFF_vn, "mergedf alias");
static_assert((size_t)NROW * PJ >= (size_t)NROW * DFF, "hff alias");
#ifndef CPU_EMU
#define IN_TAB_OFF 64
#endif
struct P {
#ifdef CPU_EMU
    const float* inp[24];
    const float* in(int i) const { return inp[i]; }
#else
    __device__ __forceinline__ const float* in(int i) const { return (const float*)(*(const __attribute__((address_space(3))) unsigned long long*)(unsigned)(IN_TAB_OFF + 8 * i)); }
#endif
    __device__ __forceinline__ const float* x_prompt() const { return in(0); }
    __device__ __forceinline__ const float* x_sample() const { return in(1); }
    __device__ __forceinline__ const float* state_C() const { return in(2); }
    __device__ __forceinline__ const float* state_n() const { return in(3); }
    __device__ __forceinline__ const float* state_m() const { return in(4); }
    __device__ __forceinline__ const float* c() const { return in(5); }
    __device__ __forceinline__ const float* c_ctx() const { return in(6); }
    __device__ __forceinline__ const float* w_ada() const { return in(7); }
    __device__ __forceinline__ const float* b_ada() const { return in(8); }
    __device__ __forceinline__ const float* g_norm1() const { return in(9); }
    __device__ __forceinline__ const float* g_norm2() const { return in(10); }
    __device__ __forceinline__ const float* w_in() const { return in(11); }
    __device__ __forceinline__ const float* b_gates() const { return in(12); }
    __device__ __forceinline__ const float* w_pool() const { return in(13); }
    __device__ __forceinline__ const float* pool_scale() const { return in(14); }
    __device__ __forceinline__ const float* g_sgu() const { return in(15); }
    __device__ __forceinline__ const float* w_sgu() const { return in(16); }
    __device__ __forceinline__ const float* b_sgu() const { return in(17); }
    __device__ __forceinline__ const float* g_mlstm() const { return in(18); }
    __device__ __forceinline__ const float* w_branch() const { return in(19); }
    __device__ __forceinline__ const float* w_out() const { return in(20); }
    __device__ __forceinline__ const float* w_ff1() const { return in(21); }
    __device__ __forceinline__ const float* w_ff2() const { return in(22); }
    __device__ __forceinline__ const float* g_final() const { return in(23); }
    float* out; char* ws;
    __device__ __forceinline__ float* mod() const { return (float*)(ws + OFF_mod); }
    __device__ __forceinline__ float* x() const { return (float*)(ws + OFF_x); }
    __device__ __forceinline__ float* gate_pre() const { return (float*)(ws + OFF_gate_pre); }
    __device__ __forceinline__ float* mergedf() const { return (float*)(ws + OFF_mergedf); }
    __device__ __forceinline__ float* dbuf() const { return (float*)(ws + OFF_dbuf); }
    __device__ __forceinline__ float* vn() const { return (float*)(ws + OFF_vn); }
    __device__ __forceinline__ float* Cloc() const { return (float*)(ws + OFF_Cloc); }
    __device__ __forceinline__ float* nloc() const { return (float*)(ws + OFF_nloc); }
    __device__ __forceinline__ float* bcum() const { return (float*)(ws + OFF_bcum); }
    __device__ __forceinline__ float* ival() const { return (float*)(ws + OFF_ival); }
    __device__ __forceinline__ float* bL() const { return (float*)(ws + OFF_bL); }
    __device__ __forceinline__ float* Mloc() const { return (float*)(ws + OFF_Mloc); }
    __device__ __forceinline__ float* Mprev() const { return (float*)(ws + OFF_Mprev); }
    __device__ __forceinline__ float* MT() const { return (float*)(ws + OFF_MT); }
    __device__ __forceinline__ float* S() const { return (float*)(ws + OFF_S); }
    __device__ __forceinline__ float* hbuf() const { return (float*)(ws + OFF_hbuf); }
    __device__ __forceinline__ bf16_t* Wt_in() const { return (bf16_t*)(ws + OFF_Wt_in); }
    __device__ __forceinline__ bf16_t* Wt_br() const { return (bf16_t*)(ws + OFF_Wt_br); }
    __device__ __forceinline__ bf16_t* Wt_out() const { return (bf16_t*)(ws + OFF_Wt_out); }
    __device__ __forceinline__ bf16_t* Wt_ff1() const { return (bf16_t*)(ws + OFF_Wt_ff1); }
    __device__ __forceinline__ bf16_t* Wt_ff2() const { return (bf16_t*)(ws + OFF_Wt_ff2); }
    __device__ __forceinline__ bf16_t* u() const { return (bf16_t*)(ws + OFF_u); }
    __device__ __forceinline__ bf16_t* proj() const { return (bf16_t*)(ws + OFF_proj); }
    __device__ __forceinline__ bf16_t* ys() const { return (bf16_t*)(ws + OFF_ys); }
    __device__ __forceinline__ bf16_t* merged() const { return (bf16_t*)(ws + OFF_merged); }
    __device__ __forceinline__ bf16_t* hff() const { return (bf16_t*)(ws + OFF_hff); }
    __device__ __forceinline__ bf16_t* CprevT() const { return (bf16_t*)(ws + OFF_CprevT); }
    __device__ __forceinline__ float* nprev() const { return (float*)(ws + OFF_nprev); }
    __device__ __forceinline__ bf16_t* dbf() const { return (bf16_t*)(ws + OFF_dbf); }
    __device__ __forceinline__ bf16_t* Wt_pool() const { return (bf16_t*)(ws + OFF_Wt_pool); }
    __device__ __forceinline__ float* ssq() const { return (float*)(ws + OFF_ssq); }
    __device__ __forceinline__ float* gsc() const { return (float*)(ws + OFF_gsc); }
    __device__ __forceinline__ bf16_t* VTg() const { return (bf16_t*)(ws + OFF_VTg); }
    __device__ __forceinline__ float* hbc() const { return (float*)(ws + OFF_hbc); }
    __device__ __forceinline__ unsigned* cnt() const { return (unsigned*)(ws + OFF_CNT); }
};
#ifdef CPU_EMU
static inline unsigned f_as_u(float f) { unsigned u; memcpy(&u, &f, 4); return u; }
static inline float u_as_f(unsigned u) { float f; memcpy(&f, &u, 4); return f; }
#else
__device__ __forceinline__ unsigned f_as_u(float f) { return __float_as_uint(f); }
__device__ __forceinline__ float u_as_f(unsigned u) { return __uint_as_float(u); }
#endif
__device__ __forceinline__ bf16_t f2bf(float f) { unsigned u = f_as_u(f); u += 0x7FFFu + ((u >> 16) & 1u); return (bf16_t)(u >> 16); }
__device__ __forceinline__ float bf2f(bf16_t b) { return u_as_f(((unsigned)b) << 16); }
#define PRJ(row, col) bf2f(p.proj()[(size_t)(row) * PJ + (col)])

__device__ __forceinline__ float sigmoidf_(float x) { return 1.0f / (1.0f + expf(-x)); }
__device__ __forceinline__ float logsigmoidf_(float x) { return fminf(x, 0.0f) - log1pf(expf(-fabsf(x))); }
__device__ __forceinline__ int cond_of_row(int r) { return r < R_CTX ? 0 : 1 + (r - R_CTX) / T_LAT; }
__device__ __forceinline__ int seq_start(int s) { return s < NB_CTX ? s * T_CTX : R_CTX + (s - NB_CTX) * T_LAT; }
__device__ __forceinline__ int seq_len(int s) { return s < NB_CTX ? T_CTX : T_LAT; }

#define GTID ((size_t)blockIdx.x * blockDim.x + threadIdx.x)

__device__ __forceinline__ void b_mod(const P& p, size_t i) {

    int j = i % (6 * DM), ci = (i / (6 * DM)) % 3, l = i / (6 * DM * 3);
    const float* cond = ci == 0 ? p.c_ctx() : p.c() + (size_t)(ci - 1) * DM;
    const float* w = p.w_ada() + (size_t)l * DM * 6 * DM;
    float acc = 0.f;
    for (int k = 0; k < DM; ++k) { float cv = cond[k]; acc += cv * sigmoidf_(cv) * w[(size_t)k * 6 * DM + j]; }
    p.mod()[i] = acc + p.b_ada()[(size_t)l * 6 * DM + j];
}
__device__ __forceinline__ void b_copy_x(const P& p, size_t i) {

    p.x()[i] = i < (size_t)R_CTX * DM ? p.x_prompt()[i] : p.x_sample()[i - (size_t)R_CTX * DM];
}
__device__ __forceinline__ void b_norm(const P& p, size_t r, int l, int which) {

    const float* xr = p.x() + r * DM; float ss = 0.f;
    for (int k = 0; k < DM; ++k) ss += xr[k] * xr[k];
    float rs = 1.0f / sqrtf(ss / DM + EPSF);
    const float* g = (which ? p.g_norm2() : p.g_norm1()) + (size_t)l * DM;
    const float* md = p.mod() + ((size_t)l * 3 + cond_of_row((int)r)) * 6 * DM + (which ? 3 * DM : 0);
    for (int k = 0; k < DM; ++k) p.u()[r * DM + k] = f2bf(xr[k] * rs * g[k] * (1.0f + md[DM + k]) + md[k]);
}
__device__ __forceinline__ void b_conv(const P& p, size_t i) {
    const size_t n_in = (size_t)DEPTH * NIN_PAD * DM, n_br = (size_t)DEPTH * 3 * DM * DB, n_out = (size_t)DEPTH * DM * DM, n_f1 = (size_t)DEPTH * DFF * DM, n_f2 = (size_t)DEPTH * DM * DFF;
    if (i < n_in) { int k = i % DM; int n = (i / DM) % NIN_PAD; int l = i / ((size_t)DM * NIN_PAD);
        int col = n < 7 * DB ? n : (n < PJ ? n + 4 * NH : (n < PJ + 4 * NH ? C_G + (n - PJ) : -1));
        p.Wt_in()[i] = col >= 0 ? f2bf(p.w_in()[((size_t)l * DM + k) * D_IN + col]) : (bf16_t)0; return; }
    i -= n_in;
    if (i < n_br) { int k = i % DB; int n = (i / DB) % DM; int lr = i / ((size_t)DB * DM); p.Wt_br()[i] = f2bf(p.w_branch()[((size_t)lr * DB + k) * DM + n]); return; }
    i -= n_br;
    if (i < n_out) { int k = i % DM; int n = (i / DM) % DM; int l = i / ((size_t)DM * DM); p.Wt_out()[i] = f2bf(p.w_out()[((size_t)l * DM + k) * DM + n]); return; }
    i -= n_out;
    if (i < n_f1) { int k = i % DM; int n = (i / DM) % DFF; int l = i / ((size_t)DM * DFF); p.Wt_ff1()[i] = f2bf(p.w_ff1()[((size_t)l * DM + k) * DFF + n]); return; }
    i -= n_f1;
    if (i < n_f2) { int k = i % DFF; int n = (i / DFF) % DM; int l = i / ((size_t)DFF * DM); p.Wt_ff2()[i] = f2bf(p.w_ff2()[((size_t)l * DFF + k) * DM + n]); return; }
}
#define N_CONV ((size_t)DEPTH * ((size_t)NIN_PAD * DM + (size_t)3 * DM * DB + (size_t)DM * DM + (size_t)2 * DFF * DM))

__device__ __forceinline__ void epi_scalar(const P& p, int l, int mode, int z, int m, int n, float acc) {
    if (mode == 0) { if (n < PJ) p.proj()[(size_t)m * PJ + n] = f2bf(acc); else if (n < PJ + 4 * NH) p.gate_pre()[(size_t)m * 16 + (n - PJ)] = acc; }
    else if (mode == 1) { float g = sigmoidf_(PRJ(m, C_BR + z * DM + n)) * acc; float* t = p.mergedf() + (size_t)m * DM + n;
        if (z == 0) *t = g; else if (z == 1) *t += g; else p.merged()[(size_t)m * DM + n] = f2bf(*t + g); }
    else if (mode == 2) p.x()[(size_t)m * DM + n] += p.mod()[((size_t)l * 3 + cond_of_row(m)) * 6 * DM + 2 * DM + n] * acc;
    else if (mode == 3) { float r = fmaxf(acc, 0.f); p.hff()[(size_t)m * DFF + n] = f2bf(r * r); }
    else p.x()[(size_t)m * DM + n] += p.mod()[((size_t)l * 3 + cond_of_row(m)) * 6 * DM + 5 * DM + n] * acc;
}
struct GemmArgs { const bf16_t* A; const bf16_t* Bt; int lda, ldb, K, M, N, nZ; long zA, zB; };
__device__ __forceinline__ GemmArgs gemm_args(const P& p, int l, int mode) {
    GemmArgs g;
    if (mode == 0) g = GemmArgs{p.u(), p.Wt_in() + (size_t)l * NIN_PAD * DM, DM, DM, DM, NROW, NIN_PAD, 1, 0, 0};
    else if (mode == 1) g = GemmArgs{p.ys(), p.Wt_br() + (size_t)l * 3 * DM * DB, 3 * DB, DB, DB, NROW, DM, 3, DB, (long)DM * DB};
    else if (mode == 2) g = GemmArgs{p.merged(), p.Wt_out() + (size_t)l * DM * DM, DM, DM, DM, NROW, DM, 1, 0, 0};
    else if (mode == 3) g = GemmArgs{p.u(), p.Wt_ff1() + (size_t)l * DFF * DM, DM, DM, DM, NROW, DFF, 1, 0, 0};
    else g = GemmArgs{p.hff(), p.Wt_ff2() + (size_t)l * DM * DFF, DFF, DFF, DFF, NROW, DM, 1, 0, 0};
    return g;
}
#ifdef CPU_EMU
__device__ __forceinline__ void b_gemm(const P& p, size_t i, int l, int mode) {
    GemmArgs g = gemm_args(p, l, mode);
    int n = i % g.N; int m = i / g.N;
    for (int z = 0; z < g.nZ; ++z) { const bf16_t* a = g.A + z * g.zA + (size_t)m * g.lda; const bf16_t* b = g.Bt + z * g.zB + (size_t)n * g.ldb; float acc = 0.f;
        for (int k = 0; k < g.K; ++k) acc += bf2f(a[k]) * bf2f(b[k]);
        epi_scalar(p, l, mode, z, m, n, acc); }
}
#else
namespace pg8 {
#define PG8_LAS __attribute__((address_space(3)))
typedef short bf16x8 __attribute__((ext_vector_type(8)));
typedef float f32x4 __attribute__((ext_vector_type(4)));
typedef unsigned u32x4 __attribute__((ext_vector_type(4)));
typedef unsigned u32x2 __attribute__((ext_vector_type(2)));
constexpr int BM = 256, BK = 64, HALF = 128, HTB = HALF * BK * 2, STAGE_BYTES = 8 * HTB, NXCD = 8, WGM = 8;
__host__ __device__ __forceinline__ int lds_byte(int r, int c) { const int st = (r >> 4) * 2 + (c >> 5), rr = r & 15, cc = c & 31, ob = rr * 64 + cc * 2; return st * 1024 + (ob ^ (((ob >> 9) & 1) << 5)); }
__host__ __device__ __forceinline__ void stage_rc(int b, int& R, int& C) { const int st = b / 1024, sb = b % 1024, swz = sb ^ (((sb >> 9) & 1) << 5); R = (st >> 1) * 16 + swz / 64; C = (st & 1) * 32 + (swz % 64) / 2; }
__host__ __device__ __forceinline__ int perm32(int rho) { const int n = rho >> 4, i = rho & 15; return 8 * (i >> 2) + 4 * n + (i & 3); }
struct Unit { int pm, pn, z; };
struct Order {
    int nM, nN, nZ, nwg, G, c;
    __device__ void init(int M, int N, int nZ_, int G_, int c_) { nM = M / BM; nN = N / BM; nZ = nZ_; nwg = nM * nN; G = G_; c = c_; }
    __device__ bool next(int i, Unit& u) const {
        const int ti = i / nZ; u.z = i - ti * nZ;
        const long L = (long)ti * G + c; if (L >= nwg) return false;
        int wgid = (int)L; { const int q = nwg / NXCD, r = nwg % NXCD, xcd = wgid % NXCD, off = wgid / NXCD; wgid = (xcd < r ? xcd * (q + 1) : r * (q + 1) + (xcd - r) * q) + off; }
        const int nig = WGM * nN, gid = wgid / nig, fm = gid * WGM, gsz = (nM - fm) < WGM ? (nM - fm) : WGM;
        u.pm = fm + ((wgid % nig) % gsz); u.pn = (wgid % nig) / gsz; return true;
    }
};
__device__ __forceinline__ void st16_wt(void* base_uniform, unsigned byte_off, u32x4 v) {
    const __amdgpu_buffer_rsrc_t r = __builtin_amdgcn_make_buffer_rsrc(base_uniform, (short)0, 0x7fffffff, 0x00020000);
    __builtin_amdgcn_raw_buffer_store_b128(v, r, byte_off, 0, 16); }
typedef __bf16 bf16x2v __attribute__((ext_vector_type(2)));
__device__ __forceinline__ unsigned cvt_pk_bf16(float lo, float hi) { bf16x2v v; v.x = (__bf16)lo; v.y = (__bf16)hi; return __builtin_bit_cast(unsigned, v); }
__device__ __forceinline__ float bf_lo(unsigned w) { return __uint_as_float(w << 16); }
__device__ __forceinline__ float bf_hi(unsigned w) { return __uint_as_float(w & 0xffff0000u); }

template <int MODE> struct Epi {
    static constexpr bool PERM = (MODE == 0 || MODE == 1 || MODE == 3);
    P p; int l;
    __device__ __forceinline__ void operator()(const f32x4 (&acc)[2][2][4][2], const Unit& u, int wr, int wc, int fr, int fq) const {
        const int row0 = u.pm * BM + wr * 64 + fr;
        if constexpr (PERM) {
            const int col0 = u.pn * BM + wc * 32 + 8 * fq;
#pragma unroll
            for (int ai = 0; ai < 2; ++ai)
#pragma unroll
                for (int m = 0; m < 4; ++m) { const int row = row0 + ai * HALF + m * 16;
#pragma unroll
                    for (int bj = 0; bj < 2; ++bj) { const int col = col0 + bj * HALF; f32x4 v0 = acc[ai][bj][m][0], v1 = acc[ai][bj][m][1];
                        if constexpr (MODE == 0) {
                            if (col < PJ) { u32x4 w; w.x = cvt_pk_bf16(v0[0], v0[1]); w.y = cvt_pk_bf16(v0[2], v0[3]); w.z = cvt_pk_bf16(v1[0], v1[1]); w.w = cvt_pk_bf16(v1[2], v1[3]); st16_wt(p.proj(), (unsigned)(row * PJ + col) * 2u, w); }
                            else if (col < PJ + 16) { float* g = p.gate_pre() + (size_t)row * 16 + (col - PJ); *(f32x4*)g = v0; *(f32x4*)(g + 4) = v1; }
                        } else if constexpr (MODE == 1) {
                            const u32x4 gw = *(const u32x4*)(p.proj() + (size_t)row * PJ + C_BR + u.z * DM + col);
                            f32x4 g0, g1; g0[0] = bf_lo(gw.x); g0[1] = bf_hi(gw.x); g0[2] = bf_lo(gw.y); g0[3] = bf_hi(gw.y); g1[0] = bf_lo(gw.z); g1[1] = bf_hi(gw.z); g1[2] = bf_lo(gw.w); g1[3] = bf_hi(gw.w);
#pragma unroll
                            for (int j = 0; j < 4; ++j) { v0[j] *= __builtin_amdgcn_rcpf(1.0f + __expf(-g0[j])); v1[j] *= __builtin_amdgcn_rcpf(1.0f + __expf(-g1[j])); }
                            float* t = p.mergedf() + (size_t)row * DM + col;
                            if (u.z == 0) { *(f32x4*)t = v0; *(f32x4*)(t + 4) = v1; }
                            else if (u.z == 1) { *(f32x4*)t = *(f32x4*)t + v0; *(f32x4*)(t + 4) = *(f32x4*)(t + 4) + v1; }
                            else { v0 = v0 + *(f32x4*)t; v1 = v1 + *(f32x4*)(t + 4); u32x4 w; w.x = cvt_pk_bf16(v0[0], v0[1]); w.y = cvt_pk_bf16(v0[2], v0[3]); w.z = cvt_pk_bf16(v1[0], v1[1]); w.w = cvt_pk_bf16(v1[2], v1[3]); *(u32x4*)(p.merged() + (size_t)row * DM + col) = w; }
                        } else {
#pragma unroll
                            for (int j = 0; j < 4; ++j) { float a = fmaxf(v0[j], 0.f), b = fmaxf(v1[j], 0.f); v0[j] = a * a; v1[j] = b * b; }
                            u32x4 w; w.x = cvt_pk_bf16(v0[0], v0[1]); w.y = cvt_pk_bf16(v0[2], v0[3]); w.z = cvt_pk_bf16(v1[0], v1[1]); w.w = cvt_pk_bf16(v1[2], v1[3]); st16_wt(p.hff(), (unsigned)(row * DFF + col) * 2u, w);
                        } } }
        } else {
            const int col0 = u.pn * BM + wc * 32 + 4 * fq;
#pragma unroll
            for (int ai = 0; ai < 2; ++ai)
#pragma unroll
                for (int m = 0; m < 4; ++m) { const int row = row0 + ai * HALF + m * 16;
                    const float* gt = p.mod() + ((size_t)l * 3 + cond_of_row(row)) * 6 * DM + (MODE == 2 ? 2 : 5) * DM; float* xr = p.x() + (size_t)row * DM;
#pragma unroll
                    for (int bj = 0; bj < 2; ++bj)
#pragma unroll
                        for (int n = 0; n < 2; ++n) { const int col = col0 + bj * HALF + n * 16; *(f32x4*)(xr + col) = *(f32x4*)(xr + col) + *(const f32x4*)(gt + col) * acc[ai][bj][m][n]; } }
        }
    }
};

template <class EpiT, class OrderT, bool ALIGN_EPI, bool SP2, bool LAST_DRAIN>
__device__ __forceinline__ void gemm_phase(PG8_LAS unsigned char* lds, const GemmArgs g, const OrderT& S, const EpiT& E) {
    int tid = threadIdx.x; asm volatile("" : "+v"(tid));
    const int wid = __builtin_amdgcn_readfirstlane(tid >> 6), lane = tid & 63, wr = wid >> 2, wc = wid & 3, fr = lane & 15, fq = lane >> 4;
    const int nt = g.K / BK;
    unsigned voffA[2], voffB[2];
#pragma unroll
    for (int i = 0; i < 2; ++i) { int R, C; stage_rc(tid * 16 + i * 8192, R, C); const int Rb = EpiT::PERM ? ((R & ~31) + perm32(R & 31)) : R;
        voffA[i] = (unsigned)(R * g.lda + C) * 2u; voffB[i] = (unsigned)(Rb * g.ldb + C) * 2u; }
    const size_t kstep = (size_t)(BK * 2);
    const size_t hstepA = (size_t)HALF * g.lda * 2, hstepB = (size_t)HALF * g.ldb * 2;
    const unsigned ldsw = (unsigned)wid * 1024u;
    const int aoff = lds_byte(wr * 64 + fr, fq * 8), boff = lds_byte(wc * 32 + fr, fq * 8);
#define PG8_SA(b, h) (((b) * 2 + (h)) * HTB)
#define PG8_SB(b, h) ((4 + (b) * 2 + (h)) * HTB)
#define PG8_STAGE(bufoff, gbase, voff) do { _Pragma("unroll") for (int _i = 0; _i < 2; ++_i) \
        __builtin_amdgcn_global_load_lds((const unsigned*)((const char*)(gbase) + (voff)[_i]), (PG8_LAS unsigned*)(lds + (bufoff) + ldsw + _i * 8192), 16, 0, 0); } while (0)
#define PG8_LDA(dst, b, h) do { _Pragma("unroll") for (int m = 0; m < 4; ++m) _Pragma("unroll") for (int k = 0; k < 2; ++k) dst[m][k] = *(const PG8_LAS bf16x8*)(lds + PG8_SA(b, h) + aoff + m * 2048 + k * 1024); } while (0)
#define PG8_LDB(dst, b, h) do { _Pragma("unroll") for (int n = 0; n < 2; ++n) _Pragma("unroll") for (int k = 0; k < 2; ++k) dst[n][k] = *(const PG8_LAS bf16x8*)(lds + PG8_SB(b, h) + boff + n * 2048 + k * 1024); } while (0)
#define PG8_MMA(ai, bj, At, Bt) do { __builtin_amdgcn_s_setprio(1); _Pragma("unroll") for (int m = 0; m < 4; ++m) _Pragma("unroll") for (int n = 0; n < 2; ++n) _Pragma("unroll") for (int k = 0; k < 2; ++k) \
        acc[ai][bj][m][n] = __builtin_amdgcn_mfma_f32_16x16x32_bf16(Bt[n][k], At[m][k], acc[ai][bj][m][n], 0, 0, 0); __builtin_amdgcn_s_setprio(0); } while (0)
#define PG8_WAIT_V(n) asm volatile("s_waitcnt vmcnt(" #n ")" ::: "memory")
#define PG8_WAIT_L(n) asm volatile("s_waitcnt lgkmcnt(" #n ")" ::: "memory")
#define PG8_BAR __builtin_amdgcn_s_barrier()
#define PG8_SCHED __builtin_amdgcn_sched_barrier(0)
#define PG8_APTR(u) ((const char*)(g.A + (size_t)(u).z * g.zA + (size_t)(u).pm * BM * g.lda))
#define PG8_BPTR(u) ((const char*)(g.Bt + (size_t)(u).z * g.zB + (size_t)(u).pn * BM * g.ldb))
    Unit cur, nxt; int ui = 0;
    if (!S.next(0, cur)) return;
    f32x4 acc[2][2][4][2];
#pragma unroll
    for (int a = 0; a < 2; ++a)
#pragma unroll
        for (int b = 0; b < 2; ++b)
#pragma unroll
            for (int m = 0; m < 4; ++m)
#pragma unroll
                for (int n = 0; n < 2; ++n) acc[a][b][m][n] = (f32x4){0.f, 0.f, 0.f, 0.f};
    const char* cA = PG8_APTR(cur); const char* cB = PG8_BPTR(cur);
    if constexpr (SP2) {
        PG8_STAGE(PG8_SB(0, 0), cB, voffB); PG8_STAGE(PG8_SB(0, 1), cB + hstepB, voffB); PG8_STAGE(PG8_SA(0, 0), cA, voffA); PG8_STAGE(PG8_SA(0, 1), cA + hstepA, voffA);
        if (wr == 1) PG8_BAR;
        PG8_WAIT_V(2); PG8_BAR;
        PG8_STAGE(PG8_SB(1, 0), cB + kstep, voffB); PG8_STAGE(PG8_SA(1, 0), cA + kstep, voffA); PG8_STAGE(PG8_SB(1, 1), cB + hstepB + kstep, voffB);
        PG8_WAIT_V(6); PG8_BAR;
    } else {
        PG8_STAGE(PG8_SB(0, 0), cB, voffB); PG8_STAGE(PG8_SA(0, 0), cA, voffA); PG8_STAGE(PG8_SB(0, 1), cB + hstepB, voffB); PG8_STAGE(PG8_SA(0, 1), cA + hstepA, voffA);
        if (wr == 1) PG8_BAR;
        PG8_WAIT_V(4); PG8_BAR;
        PG8_STAGE(PG8_SB(1, 0), cB + kstep, voffB); PG8_STAGE(PG8_SA(1, 0), cA + kstep, voffA); PG8_STAGE(PG8_SB(1, 1), cB + hstepB + kstep, voffB);
        PG8_WAIT_V(6); PG8_BAR;
    }
    for (;;) {
        const bool has_next = S.next(ui + 1, nxt);
        const char* nA = has_next ? PG8_APTR(nxt) : cA; const char* nB = has_next ? PG8_BPTR(nxt) : cB;
        for (int t = 0; t < nt; t += 2) {
            bf16x8 At[4][2], B0[2][2], B1[2][2];
            const bool last = (t == nt - 2);
            const char* a1 = cA + (size_t)(t + 1) * kstep;
            const char* a2 = last ? nA : cA + (size_t)(t + 2) * kstep; const char* b2 = last ? nB : cB + (size_t)(t + 2) * kstep;
            const char* a3 = a2 + kstep; const char* b3 = b2 + kstep;
            if constexpr (SP2) {
            PG8_LDB(B0, 0, 0); PG8_LDB(B1, 0, 1); PG8_SCHED; PG8_LDA(At, 0, 0); PG8_STAGE(PG8_SA(1, 1), a1 + hstepA, voffA);
            PG8_WAIT_V(8); PG8_WAIT_L(0); PG8_BAR; PG8_MMA(0, 0, At, B0); PG8_MMA(0, 1, At, B1); PG8_BAR; PG8_SCHED;
            PG8_LDA(At, 0, 1); PG8_STAGE(PG8_SB(0, 0), b2, voffB); PG8_STAGE(PG8_SB(0, 1), b2 + hstepB, voffB); PG8_STAGE(PG8_SA(0, 0), a2, voffA);
            PG8_WAIT_V(8); PG8_WAIT_L(0); PG8_BAR; PG8_MMA(1, 0, At, B0); PG8_MMA(1, 1, At, B1); PG8_BAR; PG8_SCHED;
            PG8_LDB(B0, 1, 0); PG8_LDB(B1, 1, 1); PG8_SCHED; PG8_LDA(At, 1, 0); PG8_STAGE(PG8_SA(0, 1), a2 + hstepA, voffA);
            PG8_WAIT_V(8); PG8_WAIT_L(0); PG8_BAR; PG8_MMA(0, 0, At, B0); PG8_MMA(0, 1, At, B1); PG8_BAR; PG8_SCHED;
            PG8_LDA(At, 1, 1); PG8_STAGE(PG8_SB(1, 0), b3, voffB); PG8_STAGE(PG8_SB(1, 1), b3 + hstepB, voffB); PG8_STAGE(PG8_SA(1, 0), a3, voffA);
            PG8_WAIT_V(8); PG8_WAIT_L(0); PG8_BAR; PG8_MMA(1, 0, At, B0); PG8_MMA(1, 1, At, B1); PG8_BAR; PG8_SCHED;
            } else {
            PG8_LDB(B0, 0, 0); PG8_SCHED; PG8_LDA(At, 0, 0); PG8_STAGE(PG8_SA(1, 1), a1 + hstepA, voffA);
            PG8_WAIT_L(8); PG8_BAR; PG8_WAIT_L(0); PG8_MMA(0, 0, At, B0); PG8_BAR; PG8_SCHED;
            PG8_LDB(B1, 0, 1); PG8_STAGE(PG8_SB(0, 0), b2, voffB);
            PG8_BAR; PG8_WAIT_L(0); PG8_MMA(0, 1, At, B1); PG8_BAR;
            PG8_LDA(At, 0, 1); PG8_STAGE(PG8_SA(0, 0), a2, voffA);
            PG8_BAR; PG8_WAIT_L(0); PG8_MMA(1, 0, At, B0); PG8_BAR; PG8_SCHED;
            PG8_STAGE(PG8_SB(0, 1), b2 + hstepB, voffB);
            PG8_WAIT_V(6); PG8_BAR; PG8_MMA(1, 1, At, B1); PG8_BAR;
            PG8_LDB(B0, 1, 0); PG8_SCHED; PG8_LDA(At, 1, 0); PG8_STAGE(PG8_SA(0, 1), a2 + hstepA, voffA);
            PG8_WAIT_L(8); PG8_BAR; PG8_WAIT_L(0); PG8_MMA(0, 0, At, B0); PG8_BAR; PG8_SCHED;
            PG8_LDB(B1, 1, 1); PG8_STAGE(PG8_SB(1, 0), b3, voffB);
            PG8_BAR; PG8_WAIT_L(0); PG8_MMA(0, 1, At, B1); PG8_BAR;
            PG8_LDA(At, 1, 1); PG8_STAGE(PG8_SA(1, 0), a3, voffA);
            PG8_BAR; PG8_WAIT_L(0); PG8_MMA(1, 0, At, B0); PG8_BAR; PG8_SCHED;
            PG8_STAGE(PG8_SB(1, 1), b3 + hstepB, voffB);
            PG8_WAIT_V(6); PG8_BAR; PG8_MMA(1, 1, At, B1); PG8_BAR;
            }
        }
        if constexpr (ALIGN_EPI) { if (wr == 0) PG8_BAR; }
        if constexpr (LAST_DRAIN) { if (has_next) E(acc, cur, wr, wc, fr, fq, tid); } else E(acc, cur, wr, wc, fr, fq);
        if (!has_next) break;
#pragma unroll
        for (int a = 0; a < 2; ++a)
#pragma unroll
            for (int b = 0; b < 2; ++b)
#pragma unroll
                for (int m = 0; m < 4; ++m)
#pragma unroll
                    for (int n = 0; n < 2; ++n) acc[a][b][m][n] = (f32x4){0.f, 0.f, 0.f, 0.f};
        cur = nxt; cA = nA; cB = nB; ++ui;
        if constexpr (ALIGN_EPI) { if (wr == 1) PG8_BAR; }
    }
    PG8_WAIT_V(0);
    if constexpr (!ALIGN_EPI) { if (wr == 0) PG8_BAR; }
    PG8_BAR;
    if constexpr (LAST_DRAIN) E.fused(acc, cur, wr, wc, fr, fq, lds, tid);
#undef PG8_SA
#undef PG8_SB
#undef PG8_STAGE
#undef PG8_LDA
#undef PG8_LDB
#undef PG8_MMA
#undef PG8_WAIT_V
#undef PG8_WAIT_L
#undef PG8_BAR
#undef PG8_SCHED
#undef PG8_APTR
#undef PG8_BPTR
}
}
namespace pg8 {
constexpr int STG = 3 * HTB;
struct Order128 {
    int nM, nN, nZ, nwg, G, c;
    __device__ void init(int M, int N, int nZ_, int G_, int c_) { nM = M / HALF; nN = N / BM; nZ = nZ_; nwg = nM * nN; G = G_; c = c_; }
    __device__ bool next(int i, Unit& u) const {
        const int ti = i / nZ; u.z = i - ti * nZ;
        const long L = (long)ti * G + c; if (L >= nwg) return false;
        int wgid = (int)L; { const int q = nwg / NXCD, r = nwg % NXCD, xcd = wgid % NXCD, off = wgid / NXCD; wgid = (xcd < r ? xcd * (q + 1) : r * (q + 1) + (xcd - r) * q) + off; }
        const int nig = WGM * nN, gid = wgid / nig, fm = gid * WGM, gsz = (nM - fm) < WGM ? (nM - fm) : WGM;
        u.pm = fm + ((wgid % nig) % gsz); u.pn = (wgid % nig) / gsz; return true;
    }
};
template <int MODE> struct Epi128 {
    static constexpr bool PERM = (MODE == 1), AFTER_DRAIN = (MODE != 1);
    P p; int l; float gsc;
    mutable u32x2 rsum[2][4][2];
    __device__ __forceinline__ void operator()(f32x4 (&acc)[2][4][2], const Unit& u, int wr_, int wc_, int fr_, int fq_) const {
        if constexpr (MODE == 1) {
            int tid = threadIdx.x; asm volatile("" : "+v"(tid));
            const int wid = __builtin_amdgcn_readfirstlane(tid >> 6), lane = tid & 63, wr = wid >> 2, wc = wid & 3, fr = lane & 15, fq = lane >> 4;
            const int row0 = u.pm * HALF + wr * 64 + fr, col0 = u.pn * BM + wc * 32 + 8 * fq;
            { u32x4 gw[4][2];
#pragma unroll
              for (int m = 0; m < 4; ++m)
#pragma unroll
                  for (int bj = 0; bj < 2; ++bj) gw[m][bj] = *(const u32x4*)(p.proj() + (size_t)(row0 + m * 16) * PJ + C_BR + u.z * DM + col0 + bj * HALF);
#pragma unroll
              for (int m = 0; m < 4; ++m) {
#pragma unroll
                  for (int bj = 0; bj < 2; ++bj) { const u32x4 g = gw[m][bj]; const float g0[4] = {bf_lo(g.x), bf_hi(g.x), bf_lo(g.y), bf_hi(g.y)}, g1[4] = {bf_lo(g.z), bf_hi(g.z), bf_lo(g.w), bf_hi(g.w)};
#pragma unroll
                      for (int j = 0; j < 4; ++j) { acc[bj][m][0][j] *= __builtin_amdgcn_rcpf(1.0f + __expf(-g0[j])); acc[bj][m][1][j] *= __builtin_amdgcn_rcpf(1.0f + __expf(-g1[j])); } }
                  asm volatile("" : "+v"(acc[0][m][0]), "+v"(acc[0][m][1]), "+v"(acc[1][m][0]), "+v"(acc[1][m][1]) :: "memory"); } }
#pragma unroll
            for (int m = 0; m < 4; ++m)
#pragma unroll
                for (int bj = 0; bj < 2; ++bj)
#pragma unroll
                    for (int n = 0; n < 2; ++n) { f32x4 v = acc[bj][m][n];
                        if (u.z != 0) { const u32x2 s = rsum[bj][m][n]; v[0] += bf_lo(s.x); v[1] += bf_hi(s.x); v[2] += bf_lo(s.y); v[3] += bf_hi(s.y); }
                        u32x2 w; w.x = cvt_pk_bf16(v[0], v[1]); w.y = cvt_pk_bf16(v[2], v[3]); rsum[bj][m][n] = w; }
            if (u.z == 2) {
#pragma unroll
                for (int m = 0; m < 4; ++m)
#pragma unroll
                    for (int bj = 0; bj < 2; ++bj) { const size_t o = (size_t)(row0 + m * 16) * DM + col0 + bj * HALF; u32x4 w; w.x = rsum[bj][m][0].x; w.y = rsum[bj][m][0].y; w.z = rsum[bj][m][1].x; w.w = rsum[bj][m][1].y;
                        st16_wt(p.merged(), (unsigned)o * 2u, w); } }
        }
    }
    __device__ __forceinline__ void fused(f32x4 (&acc)[2][4][2], const Unit& u, int wr_, int wc_, int fr_, int fq_, PG8_LAS unsigned char* lds, int tid_) const {
        int tid = tid_; asm volatile("" : "+v"(tid));
        const int wid = __builtin_amdgcn_readfirstlane(tid >> 6), lane = tid & 63, wr = wid >> 2, wc = wid & 3, fr = lane & 15, fq = lane >> 4;
        const int row0 = u.pm * HALF + wr * 64 + fr, col0 = u.pn * BM + wc * 32 + 4 * fq, ci = cond_of_row(u.pm * HALF);
        const float* gt = p.mod() + ((size_t)l * 3 + ci) * 6 * DM + (MODE == 2 ? 2 : 5) * DM;
        f32x4 gv[2][2], xv[4][2][2];
#pragma unroll
        for (int bj = 0; bj < 2; ++bj)
#pragma unroll
            for (int n = 0; n < 2; ++n) gv[bj][n] = *(const f32x4*)(gt + col0 + bj * HALF + n * 16) * gsc;
#pragma unroll
        for (int m = 0; m < 4; ++m)
#pragma unroll
            for (int bj = 0; bj < 2; ++bj)
#pragma unroll
                for (int n = 0; n < 2; ++n) xv[m][bj][n] = *(const f32x4*)(p.x() + (size_t)(row0 + m * 16) * DM + col0 + bj * HALF + n * 16);
        PG8_LAS float* Pp = (PG8_LAS float*)lds;
        PG8_LAS float* Rr = Pp + 512;
#pragma unroll
        for (int m = 0; m < 4; ++m) { float s = 0.f;
#pragma unroll
            for (int bj = 0; bj < 2; ++bj)
#pragma unroll
                for (int n = 0; n < 2; ++n) { const f32x4 v = xv[m][bj][n] + gv[bj][n] * acc[bj][m][n]; xv[m][bj][n] = v; s += v[0] * v[0] + v[1] * v[1] + v[2] * v[2] + v[3] * v[3]; }
            s += __shfl_xor(s, 16, 64); s += __shfl_xor(s, 32, 64);
            if (fq == 0) Pp[(wr * 64 + m * 16 + fr) * 4 + wc] = s; }
        asm volatile("" ::: "memory");
        const int kind = MODE == 2 ? 0 : 1;
        float* slots = p.ssq() + ((size_t)(kind * DEPTH + l) * NROW + (size_t)u.pm * HALF) * 4;
        unsigned* cnt = p.cnt() + ((size_t)(kind * DEPTH + l) * (NROW / HALF) + u.pm) * 64;
        __syncthreads();
        if (tid < HALF) { const float t = (Pp[tid * 4] + Pp[tid * 4 + 1]) + (Pp[tid * 4 + 2] + Pp[tid * 4 + 3]); __hip_atomic_store(slots + tid * 4 + u.pn, t, __ATOMIC_RELAXED, __HIP_MEMORY_SCOPE_AGENT); }
        asm volatile("s_waitcnt vmcnt(0)" ::: "memory");
        __syncthreads();
        if (tid == 0) { __hip_atomic_fetch_add(cnt, 1u, __ATOMIC_RELAXED, __HIP_MEMORY_SCOPE_AGENT);
            unsigned sp = 0; while (__hip_atomic_load(cnt, __ATOMIC_RELAXED, __HIP_MEMORY_SCOPE_AGENT) < (unsigned)(DM / BM)) { __builtin_amdgcn_s_sleep(2); if (++sp > (1u << 22)) break; }
            }
        __syncthreads();
        if (tid < HALF) { float t = 0.f;
#pragma unroll
            for (int q = 0; q < DM / BM; ++q) t += __hip_atomic_load(slots + tid * 4 + q, __ATOMIC_RELAXED, __HIP_MEMORY_SCOPE_AGENT);
            Rr[tid] = 1.0f / sqrtf(t * (1.0f / DM) + EPSF); }
#pragma unroll
        for (int m = 0; m < 4; ++m)
#pragma unroll
            for (int bj = 0; bj < 2; ++bj)
#pragma unroll
                for (int n = 0; n < 2; ++n) *(f32x4*)(p.x() + (size_t)(row0 + m * 16) * DM + col0 + bj * HALF + n * 16) = xv[m][bj][n];
        __syncthreads();
        const bool fin = (MODE == 4 && l == DEPTH - 1);
        const int ln = MODE == 2 ? l : l + 1;
        const float* gn = fin ? p.g_final() : (MODE == 2 ? p.g_norm2() : p.g_norm1()) + (size_t)ln * DM;
        const float* md = p.mod() + ((size_t)(fin ? 0 : ln) * 3 + ci) * 6 * DM + (MODE == 2 ? 3 * DM : 0);
#pragma unroll
        for (int bj = 0; bj < 2; ++bj)
#pragma unroll
            for (int n = 0; n < 2; ++n) { const int col = col0 + bj * HALF + n * 16; f32x4 gg = *(const f32x4*)(gn + col), sh = {0.f, 0.f, 0.f, 0.f};
                if (!fin) { gg = gg * (*(const f32x4*)(md + DM + col) + 1.0f); sh = *(const f32x4*)(md + col); }
#pragma unroll
                for (int m = 0; m < 4; ++m) { const int r = wr * 64 + m * 16 + fr; const f32x4 o = xv[m][bj][n] * Rr[r] * gg + sh; const size_t off = (size_t)(u.pm * HALF + r) * DM + col;
                    if (fin) *(f32x4*)(p.out + off) = o;
                    else { u32x2 w; w.x = cvt_pk_bf16(o[0], o[1]); w.y = cvt_pk_bf16(o[2], o[3]); *(u32x2*)(p.u() + off) = w; } } }
    }
};
template <class EpiT>
__device__ __forceinline__ void gemm128_phase(PG8_LAS unsigned char* lds, const GemmArgs g, const Order128& S, const EpiT& E) {
    int tid = threadIdx.x; asm volatile("" : "+v"(tid));
    const int wid = __builtin_amdgcn_readfirstlane(tid >> 6), lane = tid & 63, wr = wid >> 2, wc = wid & 3, fr = lane & 15, fq = lane >> 4;
    const int nt = g.K / BK;
    unsigned voffA[2], voffB[2];
#pragma unroll
    for (int i = 0; i < 2; ++i) { int R, C; stage_rc(tid * 16 + i * 8192, R, C); const int Rb = EpiT::PERM ? ((R & ~31) + perm32(R & 31)) : R;
        voffA[i] = (unsigned)(R * g.lda + C) * 2u; voffB[i] = (unsigned)(Rb * g.ldb + C) * 2u; }
    const size_t kstep = (size_t)(BK * 2);
    const size_t hstepB = (size_t)HALF * g.ldb * 2;
    const unsigned ldsw = (unsigned)wid * 1024u;
    const int aoff = lds_byte(wr * 64 + fr, fq * 8), boff = lds_byte(wc * 32 + fr, fq * 8);
#define G1_STAGE(bufoff, gbase, voff) do { _Pragma("unroll") for (int _i = 0; _i < 2; ++_i) \
        __builtin_amdgcn_global_load_lds((const unsigned*)((const char*)(gbase) + (voff)[_i]), (PG8_LAS unsigned*)(lds + (bufoff) + ldsw + _i * 8192), 16, 0, 0); } while (0)
#define G1_STAGE3(so, pa, pb) do { G1_STAGE((so) + HTB, (pb), voffB); G1_STAGE((so) + 2 * HTB, (pb) + hstepB, voffB); G1_STAGE((so), (pa), voffA); } while (0)
#define G1_LDA(dst, so) do { _Pragma("unroll") for (int m = 0; m < 4; ++m) _Pragma("unroll") for (int k = 0; k < 2; ++k) dst[m][k] = *(const PG8_LAS bf16x8*)(lds + (so) + aoff + m * 2048 + k * 1024); } while (0)
#define G1_LDB(dst, so, h) do { _Pragma("unroll") for (int n = 0; n < 2; ++n) _Pragma("unroll") for (int k = 0; k < 2; ++k) dst[n][k] = *(const PG8_LAS bf16x8*)(lds + (so) + (1 + (h)) * HTB + boff + n * 2048 + k * 1024); } while (0)
#define G1_MMA(bj, At, Bt) do { _Pragma("unroll") for (int m = 0; m < 4; ++m) _Pragma("unroll") for (int n = 0; n < 2; ++n) _Pragma("unroll") for (int k = 0; k < 2; ++k) \
        acc[bj][m][n] = __builtin_amdgcn_mfma_f32_16x16x32_bf16(Bt[n][k], At[m][k], acc[bj][m][n], 0, 0, 0); } while (0)
#define G1_WAIT_V(n) asm volatile("s_waitcnt vmcnt(" #n ")" ::: "memory")
#define G1_WAIT_L(n) asm volatile("s_waitcnt lgkmcnt(" #n ")" ::: "memory")
#define G1_BAR __builtin_amdgcn_s_barrier()
#define G1_SCHED __builtin_amdgcn_sched_barrier(0)
#define G1_APTR(u) ((const char*)(g.A + (size_t)(u).z * g.zA + (size_t)(u).pm * HALF * g.lda))
#define G1_BPTR(u) ((const char*)(g.Bt + (size_t)(u).z * g.zB + (size_t)(u).pn * BM * g.ldb))
    Unit cur;
    if (!S.next(0, cur)) return;
    f32x4 acc[2][4][2];
#pragma unroll
    for (int b = 0; b < 2; ++b)
#pragma unroll
        for (int m = 0; m < 4; ++m)
#pragma unroll
            for (int n = 0; n < 2; ++n) acc[b][m][n] = (f32x4){0.f, 0.f, 0.f, 0.f};
    bf16x8 A0[4][2], P0[2][2], Q0[2][2], A1[4][2], P1[2][2], Q1[2][2];
    Unit iu = cur; int iui = 0, it = 0; const char* iA = G1_APTR(iu); const char* iB = G1_BPTR(iu); int iso = 0; bool ilive = true;
#define G1_ISSUE() do { G1_STAGE3(iso, iA + (size_t)it * kstep, iB + (size_t)it * kstep); iso = iso == 2 * STG ? 0 : iso + STG; \
        if (++it == nt) { it = 0; if (ilive) { Unit nx; if (S.next(iui + 1, nx)) { iu = nx; ++iui; iA = G1_APTR(iu); iB = G1_BPTR(iu); } else ilive = false; } } } while (0)
    G1_ISSUE(); G1_ISSUE(); G1_ISSUE();
    G1_WAIT_V(12); G1_BAR;
    G1_LDB(P0, 0, 0); G1_LDB(Q0, 0, 1); G1_LDA(A0, 0);
    G1_WAIT_L(0); G1_WAIT_V(6); G1_BAR;
    int so = STG;
    int ui = 0, t = 0;
    for (;;) {
        G1_ISSUE(); G1_LDB(P1, so, 0); G1_LDB(Q1, so, 1); G1_LDA(A1, so); so = so == 2 * STG ? 0 : so + STG;
        G1_SCHED; __builtin_amdgcn_s_setprio(1); G1_MMA(0, A0, P0); G1_MMA(1, A0, Q0); __builtin_amdgcn_s_setprio(0); G1_SCHED;
        G1_WAIT_L(0); G1_WAIT_V(6); G1_BAR;
        if (++t == nt) { t = 0; Unit nx; const bool hn = S.next(ui + 1, nx);
            if constexpr (!EpiT::AFTER_DRAIN) E(acc, cur, wr, wc, fr, fq);
            if (!hn) break;
#pragma unroll
            for (int b = 0; b < 2; ++b)
#pragma unroll
                for (int m = 0; m < 4; ++m)
#pragma unroll
                    for (int n = 0; n < 2; ++n) acc[b][m][n] = (f32x4){0.f, 0.f, 0.f, 0.f};
            cur = nx; ++ui; }
        G1_ISSUE(); G1_LDB(P0, so, 0); G1_LDB(Q0, so, 1); G1_LDA(A0, so); so = so == 2 * STG ? 0 : so + STG;
        G1_SCHED; __builtin_amdgcn_s_setprio(1); G1_MMA(0, A1, P1); G1_MMA(1, A1, Q1); __builtin_amdgcn_s_setprio(0); G1_SCHED;
        G1_WAIT_L(0); G1_WAIT_V(6); G1_BAR;
        if (++t == nt) { t = 0; Unit nx; const bool hn = S.next(ui + 1, nx);
            if constexpr (!EpiT::AFTER_DRAIN) E(acc, cur, wr, wc, fr, fq);
            if (!hn) break;
#pragma unroll
            for (int b = 0; b < 2; ++b)
#pragma unroll
                for (int m = 0; m < 4; ++m)
#pragma unroll
                    for (int n = 0; n < 2; ++n) acc[b][m][n] = (f32x4){0.f, 0.f, 0.f, 0.f};
            cur = nx; ++ui; }
    }
    G1_WAIT_V(0);
    G1_BAR;
    if constexpr (EpiT::AFTER_DRAIN) E.fused(acc, cur, wr, wc, fr, fq, lds, tid);
#undef G1_ISSUE
#undef G1_STAGE
#undef G1_STAGE3
#undef G1_LDA
#undef G1_LDB
#undef G1_MMA
#undef G1_WAIT_V
#undef G1_WAIT_L
#undef G1_BAR
#undef G1_SCHED
#undef G1_APTR
#undef G1_BPTR
}
template <class EpiT>
__device__ __forceinline__ void gemm128_phase_s(PG8_LAS unsigned char* lds, const GemmArgs g, const Order128& S, const EpiT& E) {
    int tid = threadIdx.x; asm volatile("" : "+v"(tid));
    const int wid = __builtin_amdgcn_readfirstlane(tid >> 6), lane = tid & 63, wr = wid >> 2, wc = wid & 3, fr = lane & 15, fq = lane >> 4;
    const int nt = g.K / BK;
    unsigned voffA[2], voffB[2];
#pragma unroll
    for (int i = 0; i < 2; ++i) { int R, C; stage_rc(tid * 16 + i * 8192, R, C); const int Rb = EpiT::PERM ? ((R & ~31) + perm32(R & 31)) : R;
        voffA[i] = (unsigned)(R * g.lda + C) * 2u; voffB[i] = (unsigned)(Rb * g.ldb + C) * 2u; }
    const size_t kstep = (size_t)(BK * 2);
    const size_t hstepB = (size_t)HALF * g.ldb * 2;
    const unsigned ldsw = (unsigned)wid * 1024u;
    const int aoff = lds_byte(wr * 64 + fr, fq * 8), boff = lds_byte(wc * 32 + fr, fq * 8);
#define G1_STAGE(bufoff, gbase, voff) do { _Pragma("unroll") for (int _i = 0; _i < 2; ++_i) \
        __builtin_amdgcn_global_load_lds((const unsigned*)((const char*)(gbase) + (voff)[_i]), (PG8_LAS unsigned*)(lds + (bufoff) + ldsw + _i * 8192), 16, 0, 0); } while (0)
#define G1_STAGE3(so, pa, pb) do { G1_STAGE((so) + HTB, (pb), voffB); G1_STAGE((so) + 2 * HTB, (pb) + hstepB, voffB); G1_STAGE((so), (pa), voffA); } while (0)
#define G1_LDA(dst, so) do { _Pragma("unroll") for (int m = 0; m < 4; ++m) _Pragma("unroll") for (int k = 0; k < 2; ++k) dst[m][k] = *(const PG8_LAS bf16x8*)(lds + (so) + aoff + m * 2048 + k * 1024); } while (0)
#define G1_LDB(dst, so, h) do { _Pragma("unroll") for (int n = 0; n < 2; ++n) _Pragma("unroll") for (int k = 0; k < 2; ++k) dst[n][k] = *(const PG8_LAS bf16x8*)(lds + (so) + (1 + (h)) * HTB + boff + n * 2048 + k * 1024); } while (0)
#define G1_MMA(bj, At, Bt) do { __builtin_amdgcn_s_setprio(1); _Pragma("unroll") for (int m = 0; m < 4; ++m) _Pragma("unroll") for (int n = 0; n < 2; ++n) _Pragma("unroll") for (int k = 0; k < 2; ++k) \
        acc[bj][m][n] = __builtin_amdgcn_mfma_f32_16x16x32_bf16(Bt[n][k], At[m][k], acc[bj][m][n], 0, 0, 0); __builtin_amdgcn_s_setprio(0); } while (0)
#define G1_WAIT_V(n) asm volatile("s_waitcnt vmcnt(" #n ")" ::: "memory")
#define G1_WAIT_L(n) asm volatile("s_waitcnt lgkmcnt(" #n ")" ::: "memory")
#define G1_BAR __builtin_amdgcn_s_barrier()
#define G1_SCHED __builtin_amdgcn_sched_barrier(0)
#define G1_APTR(u) ((const char*)(g.A + (size_t)(u).z * g.zA + (size_t)(u).pm * HALF * g.lda))
#define G1_BPTR(u) ((const char*)(g.Bt + (size_t)(u).z * g.zB + (size_t)(u).pn * BM * g.ldb))
    Unit cur, nxt; int ui = 0;
    if (!S.next(0, cur)) return;
    f32x4 acc[2][4][2];
#pragma unroll
    for (int b = 0; b < 2; ++b)
#pragma unroll
        for (int m = 0; m < 4; ++m)
#pragma unroll
            for (int n = 0; n < 2; ++n) acc[b][m][n] = (f32x4){0.f, 0.f, 0.f, 0.f};
    bf16x8 At[4][2], B0[2][2], B1[2][2];
    const char* cA = G1_APTR(cur); const char* cB = G1_BPTR(cur);
    G1_STAGE3(0, cA, cB); G1_STAGE3(STG, cA + kstep, cB + kstep);
    if (wr == 1) G1_BAR;
    G1_WAIT_V(6); G1_BAR; G1_BAR;
    int so = 0;
    for (;;) {
        const bool has_next = S.next(ui + 1, nxt);
        const char* nA = has_next ? G1_APTR(nxt) : cA; const char* nB = has_next ? G1_BPTR(nxt) : cB;
        for (int t = 0; t < nt; ++t) {
            const int t2 = t + 2; const bool over = t2 >= nt;
            const char* a2 = over ? nA + (size_t)(t2 - nt) * kstep : cA + (size_t)t2 * kstep; const char* b2 = over ? nB + (size_t)(t2 - nt) * kstep : cB + (size_t)t2 * kstep;
            const int sp = so == 0 ? 2 * STG : so - STG;
            G1_LDB(B0, so, 0); G1_LDB(B1, so, 1); G1_SCHED; G1_LDA(At, so); G1_STAGE3(sp, a2, b2);
            G1_WAIT_V(6); G1_WAIT_L(0); G1_BAR; G1_MMA(0, At, B0); G1_MMA(1, At, B1); G1_BAR; G1_SCHED;
            so = so == 2 * STG ? 0 : so + STG;
        }
        if constexpr (!EpiT::AFTER_DRAIN) E(acc, cur, wr, wc, fr, fq);
        if (!has_next) break;
#pragma unroll
        for (int b = 0; b < 2; ++b)
#pragma unroll
            for (int m = 0; m < 4; ++m)
#pragma unroll
                for (int n = 0; n < 2; ++n) acc[b][m][n] = (f32x4){0.f, 0.f, 0.f, 0.f};
        cur = nxt; cA = nA; cB = nB; ++ui;
    }
    G1_WAIT_V(0);
    if (wr == 0) G1_BAR;
    G1_BAR;
    if constexpr (EpiT::AFTER_DRAIN) E.fused(acc, cur, wr, wc, fr, fq, lds, tid);
#undef G1_STAGE
#undef G1_STAGE3
#undef G1_LDA
#undef G1_LDB
#undef G1_MMA
#undef G1_WAIT_V
#undef G1_WAIT_L
#undef G1_BAR
#undef G1_SCHED
#undef G1_APTR
#undef G1_BPTR
}
}
namespace pg8 {
constexpr int NT2 = (NROW / BM) * (DM / BM);
struct Order2K {
    int nZ, kh, slot; bool active;
    __device__ void init(int nZ_, int c) { nZ = nZ_; active = c < 2 * NT2; const int j = c & 7, i = c >> 3; kh = i & 1; slot = (i >> 1) * 8 + j; }
    __device__ bool next(int i, Unit& u) const {
        if (!active || i >= nZ) return false; u.z = i;
        constexpr int nN = DM / BM, nM = NROW / BM, nwg = nM * nN; int wgid = slot; { const int q = nwg / NXCD, r = nwg % NXCD, xcd = wgid % NXCD, off = wgid / NXCD; wgid = (xcd < r ? xcd * (q + 1) : r * (q + 1) + (xcd - r) * q) + off; }
        const int nig = WGM * nN, gid = wgid / nig, fm = gid * WGM, gsz = (nM - fm) < WGM ? (nM - fm) : WGM;
        u.pm = fm + ((wgid % nig) % gsz); u.pn = (wgid % nig) / gsz; return true;
    }
};
__device__ __forceinline__ void st_wt16(float* ptr, f32x4 v) { asm volatile("global_store_dwordx4 %0, %1, off sc1\n\ts_nop 1" :: "v"(ptr), "v"(v) : "memory"); }
__device__ __forceinline__ f32x4 ld_sc1_16(const float* ptr) { f32x4 v; asm volatile("global_load_dwordx4 %0, %1, off sc1" : "=v"(v) : "v"(ptr) : "memory"); return v; }
template <int MODE> struct EpiX {
    static constexpr bool PERM = (MODE == 1);
    P p; int l, kh, slot;
    __device__ __forceinline__ float* slab(int half) const { return p.Cloc() + ((size_t)slot * 2 + half) * (size_t)(BM * BM); }
    __device__ __forceinline__ unsigned* flag() const { return p.cnt() + 64 * (2 * DEPTH * (NROW / HALF)) + ((MODE == 1 ? 0 : (MODE == 2 ? 1 : 2)) * DEPTH + l) * NT2 + slot; }
    __device__ __forceinline__ void operator()(f32x4 (&acc)[2][2][4][2], const Unit& u, int wr_, int wc_, int fr_, int fq_, int tid_) const {
        if constexpr (MODE == 1) { int tid = tid_; asm volatile("" : "+v"(tid));
            const int wid = __builtin_amdgcn_readfirstlane(tid >> 6), lane = tid & 63, wr = wid >> 2, wc = wid & 3, fr = lane & 15, fq = lane >> 4;
            gate_mul(acc, u, wr, wc, fr, fq); float* s = slab(kh) + (size_t)tid * 4;
            if (u.z != 0) {
#pragma unroll
                for (int hh = 0; hh < 4; ++hh) { f32x4 t[8];
#pragma unroll
                    for (int i = 0; i < 8; ++i) t[i] = *(const f32x4*)(s + (size_t)(hh * 8 + i) * 2048);
#pragma unroll
                    for (int i = 0; i < 8; ++i) { const int q = hh * 8 + i; acc[q >> 4][(q >> 3) & 1][(q >> 1) & 3][q & 1] = acc[q >> 4][(q >> 3) & 1][(q >> 1) & 3][q & 1] + t[i]; }
#pragma unroll
                    for (int i = 0; i < 8; i += 2) { const int q = hh * 8 + i; asm volatile("" : "+v"(acc[q >> 4][(q >> 3) & 1][(q >> 1) & 3][0]), "+v"(acc[q >> 4][(q >> 3) & 1][(q >> 1) & 3][1]) :: "memory"); } } }
#pragma unroll
            for (int i = 0; i < 32; ++i) *(f32x4*)(s + (size_t)i * 2048) = acc[i >> 4][(i >> 3) & 1][(i >> 1) & 3][i & 1];
        }
    }
    __device__ __forceinline__ void gate_mul(f32x4 (&acc)[2][2][4][2], const Unit& u, int wr, int wc, int fr, int fq) const {
        const int row0 = u.pm * BM + wr * 64 + fr, col0 = u.pn * BM + wc * 32 + 8 * fq;
#pragma unroll
        for (int ai = 0; ai < 2; ++ai)
#pragma unroll
            for (int m = 0; m < 4; ++m) { u32x4 gw[2];
#pragma unroll
                for (int bj = 0; bj < 2; ++bj) gw[bj] = *(const u32x4*)(p.proj() + (size_t)(row0 + ai * HALF + m * 16) * PJ + C_BR + u.z * DM + col0 + bj * HALF);
#pragma unroll
                for (int bj = 0; bj < 2; ++bj) { const u32x4 g = gw[bj]; const float g0[4] = {bf_lo(g.x), bf_hi(g.x), bf_lo(g.y), bf_hi(g.y)}, g1[4] = {bf_lo(g.z), bf_hi(g.z), bf_lo(g.w), bf_hi(g.w)};
#pragma unroll
                    for (int j = 0; j < 4; ++j) { acc[ai][bj][m][0][j] *= __builtin_amdgcn_rcpf(1.0f + __expf(-g0[j])); acc[ai][bj][m][1][j] *= __builtin_amdgcn_rcpf(1.0f + __expf(-g1[j])); } }
                asm volatile("" : "+v"(acc[ai][0][m][0]), "+v"(acc[ai][0][m][1]), "+v"(acc[ai][1][m][0]), "+v"(acc[ai][1][m][1]) :: "memory"); }
    }
    __device__ __forceinline__ void fused(f32x4 (&acc)[2][2][4][2], const Unit& u, int wr_, int wc_, int fr_, int fq_, PG8_LAS unsigned char* lds, int tid_) const {
        int tid = tid_; asm volatile("" : "+v"(tid));
        const int wid = __builtin_amdgcn_readfirstlane(tid >> 6), lane = tid & 63, wr = wid >> 2, wc = wid & 3, fr = lane & 15, fq = lane >> 4;
        if constexpr (MODE == 1) { gate_mul(acc, u, wr, wc, fr, fq); const float* s = slab(kh) + (size_t)tid * 4;
#pragma unroll
            for (int hh = 0; hh < 4; ++hh) { f32x4 t[8];
#pragma unroll
                for (int i = 0; i < 8; ++i) t[i] = *(const f32x4*)(s + (size_t)(hh * 8 + i) * 2048);
#pragma unroll
                for (int i = 0; i < 8; ++i) { const int q = hh * 8 + i; acc[q >> 4][(q >> 3) & 1][(q >> 1) & 3][q & 1] = acc[q >> 4][(q >> 3) & 1][(q >> 1) & 3][q & 1] + t[i]; }
#pragma unroll
                for (int i = 0; i < 8; i += 2) { const int q = hh * 8 + i; asm volatile("" : "+v"(acc[q >> 4][(q >> 3) & 1][(q >> 1) & 3][0]), "+v"(acc[q >> 4][(q >> 3) & 1][(q >> 1) & 3][1]) :: "memory"); } } }
        if (kh == 1) {
            float* s = slab(1) + (size_t)tid * 4;
#pragma unroll
            for (int i = 0; i < 32; ++i) st_wt16(s + (size_t)i * 2048, acc[i >> 4][(i >> 3) & 1][(i >> 1) & 3][i & 1]);
            asm volatile("s_waitcnt vmcnt(0)" ::: "memory");
            __syncthreads();
            if (tid == 0) __hip_atomic_store(flag(), 1u, __ATOMIC_RELAXED, __HIP_MEMORY_SCOPE_AGENT);
            return;
        }
        if (tid == 0) { unsigned sp = 0; while (__hip_atomic_load(flag(), __ATOMIC_RELAXED, __HIP_MEMORY_SCOPE_AGENT) == 0u) { __builtin_amdgcn_s_sleep(2); if (++sp > (1u << 22)) break; }
            __builtin_amdgcn_fence(__ATOMIC_ACQUIRE, "agent"); asm volatile("s_waitcnt vmcnt(0)" ::: "memory"); }
        __syncthreads();
        { const float* s = slab(1) + (size_t)tid * 4;
#pragma unroll
          for (int h = 0; h < 4; ++h) { f32x4 t[8];
#pragma unroll
              for (int i = 0; i < 8; ++i) t[i] = *(const f32x4*)(s + (size_t)(h * 8 + i) * 2048);
#pragma unroll
              for (int i = 0; i < 8; ++i) { const int q = h * 8 + i; acc[q >> 4][(q >> 3) & 1][(q >> 1) & 3][q & 1] = acc[q >> 4][(q >> 3) & 1][(q >> 1) & 3][q & 1] + t[i]; }
#pragma unroll
              for (int i = 0; i < 8; i += 2) { const int q = h * 8 + i; asm volatile("" : "+v"(acc[q >> 4][(q >> 3) & 1][(q >> 1) & 3][0]), "+v"(acc[q >> 4][(q >> 3) & 1][(q >> 1) & 3][1]) :: "memory"); } } }
        const int row0 = u.pm * BM + wr * 64 + fr;
        if constexpr (MODE == 1) {
            const int col0 = u.pn * BM + wc * 32 + 8 * fq;
#pragma unroll
            for (int ai = 0; ai < 2; ++ai)
#pragma unroll
                for (int m = 0; m < 4; ++m)
#pragma unroll
                    for (int bj = 0; bj < 2; ++bj) { const f32x4 v0 = acc[ai][bj][m][0], v1 = acc[ai][bj][m][1]; u32x4 w; w.x = cvt_pk_bf16(v0[0], v0[1]); w.y = cvt_pk_bf16(v0[2], v0[3]); w.z = cvt_pk_bf16(v1[0], v1[1]); w.w = cvt_pk_bf16(v1[2], v1[3]);
                        *(u32x4*)(p.merged() + (size_t)(row0 + ai * HALF + m * 16) * DM + col0 + bj * HALF) = w; }
        } else {
            const int col0 = u.pn * BM + wc * 32 + 4 * fq, ci = cond_of_row(u.pm * BM);
            const float* gt = p.mod() + ((size_t)l * 3 + ci) * 6 * DM + (MODE == 2 ? 2 : 5) * DM;
            f32x4 gv[2][2];
#pragma unroll
            for (int bj = 0; bj < 2; ++bj)
#pragma unroll
                for (int n = 0; n < 2; ++n) gv[bj][n] = *(const f32x4*)(gt + col0 + bj * HALF + n * 16);
            PG8_LAS float* Pp = (PG8_LAS float*)lds;
            PG8_LAS float* Rr = Pp + 1024;
#pragma unroll
            for (int am = 0; am < 4; ++am) { const int ai = am >> 1; f32x4 xv[2][2][2];
#pragma unroll
                for (int mm = 0; mm < 2; ++mm)
#pragma unroll
                    for (int bj = 0; bj < 2; ++bj)
#pragma unroll
                        for (int n = 0; n < 2; ++n) xv[mm][bj][n] = *(const f32x4*)(p.x() + (size_t)(row0 + ai * HALF + ((am & 1) * 2 + mm) * 16) * DM + col0 + bj * HALF + n * 16);
#pragma unroll
                for (int mm = 0; mm < 2; ++mm) { const int m = (am & 1) * 2 + mm; float s = 0.f;
#pragma unroll
                    for (int bj = 0; bj < 2; ++bj)
#pragma unroll
                        for (int n = 0; n < 2; ++n) { const f32x4 v = xv[mm][bj][n] + gv[bj][n] * acc[ai][bj][m][n]; acc[ai][bj][m][n] = v; s += v[0] * v[0] + v[1] * v[1] + v[2] * v[2] + v[3] * v[3]; }
                    s += __shfl_xor(s, 16, 64); s += __shfl_xor(s, 32, 64);
                    if (fq == 0) Pp[(ai * HALF + wr * 64 + m * 16 + fr) * 4 + wc] = s;
                    asm volatile("" : "+v"(acc[ai][0][m][0]), "+v"(acc[ai][0][m][1]), "+v"(acc[ai][1][m][0]), "+v"(acc[ai][1][m][1]) :: "memory"); } }
            asm volatile("" ::: "memory");
            const int kind = MODE == 2 ? 0 : 1;
            float* slots = p.ssq() + ((size_t)(kind * DEPTH + l) * NROW + (size_t)u.pm * BM) * 4;
            unsigned* cnt = p.cnt() + ((size_t)(kind * DEPTH + l) * (NROW / HALF) + u.pm) * 64;
            __syncthreads();
            if (tid < BM) { const float t = (Pp[tid * 4] + Pp[tid * 4 + 1]) + (Pp[tid * 4 + 2] + Pp[tid * 4 + 3]); __hip_atomic_store(slots + tid * 4 + u.pn, t, __ATOMIC_RELAXED, __HIP_MEMORY_SCOPE_AGENT); }
#pragma unroll
            for (int ai = 0; ai < 2; ++ai)
#pragma unroll
                for (int m = 0; m < 4; ++m)
#pragma unroll
                    for (int bj = 0; bj < 2; ++bj)
#pragma unroll
                        for (int n = 0; n < 2; ++n) *(f32x4*)(p.x() + (size_t)(row0 + ai * HALF + m * 16) * DM + col0 + bj * HALF + n * 16) = acc[ai][bj][m][n];
            asm volatile("s_waitcnt vmcnt(0)" ::: "memory");
            __syncthreads();
            if (tid == 0) { __hip_atomic_fetch_add(cnt, 1u, __ATOMIC_RELAXED, __HIP_MEMORY_SCOPE_AGENT);
                unsigned sp = 0; while (__hip_atomic_load(cnt, __ATOMIC_RELAXED, __HIP_MEMORY_SCOPE_AGENT) < (unsigned)(DM / BM)) { __builtin_amdgcn_s_sleep(2); if (++sp > (1u << 22)) break; }
                __builtin_amdgcn_fence(__ATOMIC_ACQUIRE, "agent"); asm volatile("s_waitcnt vmcnt(0)" ::: "memory"); }
            __syncthreads();
            if (tid < BM) { float t = 0.f;
#pragma unroll
                for (int q = 0; q < DM / BM; ++q) t += __hip_atomic_load(slots + tid * 4 + q, __ATOMIC_RELAXED, __HIP_MEMORY_SCOPE_AGENT);
                Rr[tid] = 1.0f / sqrtf(t * (1.0f / DM) + EPSF); }
            __syncthreads();
            const bool fin = (MODE == 4 && l == DEPTH - 1);
            const int ln = MODE == 2 ? l : l + 1;
            const float* gn = fin ? p.g_final() : (MODE == 2 ? p.g_norm2() : p.g_norm1()) + (size_t)ln * DM;
            const float* md = p.mod() + ((size_t)(fin ? 0 : ln) * 3 + ci) * 6 * DM + (MODE == 2 ? 3 * DM : 0);
#pragma unroll
            for (int bj = 0; bj < 2; ++bj)
#pragma unroll
                for (int n = 0; n < 2; ++n) { const int col = col0 + bj * HALF + n * 16; f32x4 gg = *(const f32x4*)(gn + col), sh = {0.f, 0.f, 0.f, 0.f};
                    if (!fin) { gg = gg * (*(const f32x4*)(md + DM + col) + 1.0f); sh = *(const f32x4*)(md + col); }
#pragma unroll
                    for (int ai = 0; ai < 2; ++ai)
#pragma unroll
                        for (int m = 0; m < 4; ++m) { const int r = ai * HALF + wr * 64 + m * 16 + fr; const f32x4 o = acc[ai][bj][m][n] * Rr[r] * gg + sh; const size_t off = (size_t)(u.pm * BM + r) * DM + col;
                            if (fin) *(f32x4*)(p.out + off) = o;
                            else { u32x2 w; w.x = cvt_pk_bf16(o[0], o[1]); w.y = cvt_pk_bf16(o[2], o[3]); *(u32x2*)(p.u() + off) = w; } } }
        }
    }
};
}
#endif
__device__ __forceinline__ void b_pool_d(const P& p, size_t i) {

    int c = i % DB; int r = i / DB; int g = c / GRP; int win = 2 << g;
    float self = PRJ(r, C_XP + c); float pooled;
    if (r < R_CTX) {
        int b = r / T_CTX, t = r % T_CTX; int lo = t - win / 2; if (lo < 0) lo = 0; int hi = t + (win - win / 2); if (hi > T_CTX) hi = T_CTX;
        float s = 0.f; for (int tt = lo; tt < hi; ++tt) s += PRJ(b * T_CTX + tt, C_XP + c);
        pooled = s / (float)(hi - lo);
    } else {
        int rr = r - R_CTX; int b = rr / T_LAT, t = rr % T_LAT; int gy = t / GRID_W, gx = t % GRID_W; const int rows = T_LAT / GRID_W;
        int xlo = gx - win / 2; if (xlo < 0) xlo = 0; int xhi = gx + (win - win / 2); if (xhi > GRID_W) xhi = GRID_W;
        int ylo = gy - win / 2; if (ylo < 0) ylo = 0; int yhi = gy + (win - win / 2); if (yhi > rows) yhi = rows;
        float s = 0.f;
        for (int yy = ylo; yy < yhi; ++yy) { float sx = 0.f; for (int xx = xlo; xx < xhi; ++xx) sx += PRJ(R_CTX + b * T_LAT + yy * GRID_W + xx, C_XP + c); s += sx / (float)(xhi - xlo); }
        pooled = s / (float)(yhi - ylo);
    }
    p.dbuf()[i] = pooled - self;
}
__device__ __forceinline__ void b_pool_y(const P& p, size_t i, int l) {

    int c = i % DB; size_t r = i / DB; int g = c / GRP, dd = c % GRP;
    const float* d = p.dbuf() + r * DB + g * GRP; const float* w = p.w_pool() + ((size_t)l * NG + g) * GRP * GRP + dd; float acc = 0.f;
    for (int k = 0; k < GRP; ++k) acc += d[k] * w[(size_t)k * GRP];
    p.ys()[r * 3 * DB + c] = f2bf(acc * p.pool_scale()[(size_t)l * DB + c]);
}
__device__ __forceinline__ void b_sgu_vn(const P& p, size_t r, int l) {

    float ss = 0.f;
    for (int k = 0; k < DB; ++k) { float v = PRJ(r, C_SV + k); ss += v * v; }
    float rs = 1.0f / sqrtf(ss / DB + EPSF);
    for (int k = 0; k < DB; ++k) p.vn()[r * DB + k] = PRJ(r, C_SV + k) * rs * p.g_sgu()[(size_t)l * DB + k];
}
__device__ __forceinline__ void b_sgu_y(const P& p, size_t i, int l) {

    int c = i % DB; int r = i / DB; int g = c / GRP; int pp = r % SGU_CHUNK; int r0 = r - pp;
    const float* w = p.w_sgu() + (((size_t)l * NG + g) * SGU_CHUNK + pp) * SGU_CHUNK; float acc = 0.f;
    for (int q = 0; q < SGU_CHUNK; ++q) acc += w[q] * p.vn()[(size_t)(r0 + q) * DB + c];
    acc += p.b_sgu()[((size_t)l * NG + g) * SGU_CHUNK + pp];
    p.ys()[(size_t)r * 3 * DB + DB + c] = f2bf(PRJ(r, C_SU + c) * acc);
}
#define IDX_DHR(dir, h, row) (((size_t)(dir) * NH + (h)) * NROW + (row))
#define IDX_DHC(dir, h, gc) (((size_t)(dir) * NH + (h)) * NCHK + (gc))
__device__ __forceinline__ void b_ml_gates(const P& p, size_t i, int l) {

    int gc = i % NCHK, h = (i / NCHK) % NH, dir = i / (NCHK * NH); int c0 = gc * LCH;
    float b = 0.f;
    for (int tau = 0; tau < LCH; ++tau) {
        int row = dir == 0 ? c0 + tau : c0 + LCH - 1 - tau;
        const float* gp = p.gate_pre() + (size_t)row * 16; const float* bg = p.b_gates() + (size_t)l * 4 * NH;
        float iv = gp[dir * NH + h] + bg[dir * NH + h];
        float fv = gp[2 * NH + dir * NH + h] + bg[2 * NH + dir * NH + h];
        b += logsigmoidf_(fv);
        p.bcum()[IDX_DHR(dir, h, row)] = b; p.ival()[IDX_DHR(dir, h, row)] = iv;
    }
    float bL = b, mx = -INFINITY;
    for (int tau = 0; tau < LCH; ++tau) { int row = c0 + tau; float a = bL - p.bcum()[IDX_DHR(dir, h, row)] + p.ival()[IDX_DHR(dir, h, row)]; mx = fmaxf(mx, a); }
    p.bL()[IDX_DHC(dir, h, gc)] = bL; p.Mloc()[IDX_DHC(dir, h, gc)] = mx;
}
__device__ __forceinline__ void b_ml_cloc(const P& p, size_t i) {

    int e = i % DH, d = (i / DH) % DH; size_t j = i / (DH * DH); int gc = j % NCHK, h = (j / NCHK) % NH, dir = j / (NCHK * NH); int c0 = gc * LCH;
    float bL = p.bL()[IDX_DHC(dir, h, gc)], ml = p.Mloc()[IDX_DHC(dir, h, gc)]; const float ksc = 1.0f / sqrtf((float)DH);
    float acc = 0.f, accn = 0.f;
    for (int s = 0; s < LCH; ++s) { int row = c0 + s;
        float w = expf(bL - p.bcum()[IDX_DHR(dir, h, row)] + p.ival()[IDX_DHR(dir, h, row)] - ml);
        float kv = PRJ(row, C_K + h * DH + d) * ksc;
        acc += w * kv * PRJ(row, C_V + h * DH + e); accn += w * kv; }
    p.Cloc()[i] = acc; if (e == 0) p.nloc()[j * DH + d] = accn;
}
__device__ __forceinline__ void b_ml_scan(const P& p, size_t i, int l) {

    int e = i % DH, d = (i / DH) % DH; size_t j = i / (DH * DH); int s = j % NSEQ, h = (j / NSEQ) % NH, dir = j / (NSEQ * NH);
    int gc0 = seq_start(s) / LCH, nc = seq_len(s) / LCH;
    float C, n, m;
    if (s < NB_CTX) { C = 0.f; n = 0.f; m = 0.f; }
    else { int b = s - NB_CTX; size_t base = (((size_t)b * DEPTH + l) * 2 + dir) * NH + h; C = p.state_C()[(base * DH + d) * DH + e]; n = p.state_n()[base * DH + d]; m = p.state_m()[base]; }
    for (int jj = 0; jj < nc; ++jj) {
        int gc = gc0 + (dir == 0 ? jj : nc - 1 - jj); size_t ci = IDX_DHC(dir, h, gc);
        float bL = p.bL()[ci], ml = p.Mloc()[ci]; float mnew = fmaxf(bL + m, ml); float dec = expf(bL + m - mnew), sc = expf(ml - mnew);
        size_t ce = (ci * DH + d) * DH + e; float cl = p.Cloc()[ce]; p.Cloc()[ce] = C; C = dec * C + sc * cl;
        if (e == 0) { float nl = p.nloc()[ci * DH + d]; p.nloc()[ci * DH + d] = n; n = dec * n + sc * nl; }
        if (e == 0 && d == 0) p.Mprev()[ci] = m;
        m = mnew;
    }
    if (s < NB_CTX) {
        size_t base = (((size_t)s * DEPTH + l) * 2 + dir) * NH + h;
        float* oC = p.out + (size_t)NROW * DM; float* on = oC + (size_t)NB_CTX * DEPTH * 2 * NH * DH * DH; float* om = on + (size_t)NB_CTX * DEPTH * 2 * NH * DH;
        oC[(base * DH + d) * DH + e] = C; if (e == 0) on[base * DH + d] = n; if (e == 0 && d == 0) om[base] = m;
    }
}
__device__ __forceinline__ void b_ml_mt(const P& p, size_t i) {

    int row = i % NROW, h = (i / NROW) % NH, dir = i / ((size_t)NROW * NH); int gc = row / LCH, c0 = gc * LCH;
    int tau = dir == 0 ? row - c0 : c0 + LCH - 1 - row;
    float bt = p.bcum()[IDX_DHR(dir, h, row)]; float mt = bt + p.Mprev()[IDX_DHC(dir, h, gc)];
    for (int ts = 0; ts <= tau; ++ts) { int rs = dir == 0 ? c0 + ts : c0 + LCH - 1 - ts; mt = fmaxf(mt, bt - p.bcum()[IDX_DHR(dir, h, rs)] + p.ival()[IDX_DHR(dir, h, rs)]); }
    p.MT()[i] = mt;
}
__device__ __forceinline__ void b_ml_s(const P& p, size_t i) {

    int ts = i % LCH, tt = (i / LCH) % LCH; size_t j = i / (LCH * LCH); int gc = j % NCHK, h = (j / NCHK) % NH, dir = j / (NCHK * NH); int c0 = gc * LCH;
    float val = 0.f;
    if (ts <= tt) {
        int rt = dir == 0 ? c0 + tt : c0 + LCH - 1 - tt, rs = dir == 0 ? c0 + ts : c0 + LCH - 1 - ts;
        float acc = 0.f;
        for (int d = 0; d < DH; ++d) acc += PRJ(rt, C_Q + h * DH + d) * PRJ(rs, C_K + h * DH + d);
        acc *= 1.0f / sqrtf((float)DH);
        float dm = p.bcum()[IDX_DHR(dir, h, rt)] - p.bcum()[IDX_DHR(dir, h, rs)] + p.ival()[IDX_DHR(dir, h, rs)];
        val = acc * expf(dm - p.MT()[IDX_DHR(dir, h, rt)]);
    }
    p.S()[i] = val;
}
__device__ __forceinline__ void b_ml_h(const P& p, size_t i) {

    int c = i % DB; int row = (i / DB) % NROW; int dir = i / ((size_t)DB * NROW); int h = c / DH, e = c % DH; int gc = row / LCH, c0 = gc * LCH;
    int tau = dir == 0 ? row - c0 : c0 + LCH - 1 - row; size_t ci = IDX_DHC(dir, h, gc);
    const float* Srow = p.S() + (ci * LCH + tau) * LCH;
    float num = 0.f, den = 0.f;
    for (int ts = 0; ts <= tau; ++ts) { int rs = dir == 0 ? c0 + ts : c0 + LCH - 1 - ts; float sv = Srow[ts]; num += sv * PRJ(rs, C_V + h * DH + e); den += sv; }
    float mt = p.MT()[IDX_DHR(dir, h, row)]; float winter = expf(p.bcum()[IDX_DHR(dir, h, row)] + p.Mprev()[ci] - mt);
    float qc = 0.f, qn = 0.f;
    for (int d = 0; d < DH; ++d) { float qv = PRJ(row, C_Q + h * DH + d); qc += qv * p.Cloc()[(ci * DH + d) * DH + e]; qn += qv * p.nloc()[ci * DH + d]; }
    num += winter * qc; den += winter * qn;
    p.hbuf()[i] = num / fmaxf(fabsf(den), expf(-mt));
}
__device__ __forceinline__ void b_ml_fin(const P& p, size_t i, int l) {

    int h = i % NH; size_t row = i / NH;
    const float* h0 = p.hbuf() + row * DB + h * DH; const float* h1 = p.hbuf() + ((size_t)NROW + row) * DB + h * DH; float ss = 0.f;
    for (int e = 0; e < DH; ++e) { float v = h0[e] + h1[e]; ss += v * v; }
    float rs = 1.0f / sqrtf(ss / DH + EPSF);
    for (int e = 0; e < DH; ++e) { float v = (h0[e] + h1[e]) * rs * p.g_mlstm()[(size_t)l * DB + h * DH + e];
        p.ys()[row * 3 * DB + 2 * DB + h * DH + e] = f2bf(sigmoidf_(PRJ(row, C_O + h * DH + e)) * v); }
}
__device__ __forceinline__ void b_final(const P& p, size_t r) {

    const float* xr = p.x() + r * DM; float ss = 0.f;
    for (int k = 0; k < DM; ++k) ss += xr[k] * xr[k];
    float rs = 1.0f / sqrtf(ss / DM + EPSF);
    for (int k = 0; k < DM; ++k) p.out[r * DM + k] = xr[k] * rs * p.g_final()[k];
}


#ifndef CPU_EMU
#define XB_TMO      128
#define XB_XCNT(j)  (256  + 64 * (j))
#define XB_XSUB(j)  (1280 + 64 * (j))
#define XB_XGEN(j)  (2304 + 64 * (j))
#define XB_TOP      3328
#define XB_TOPGEN   3392
#define XCD_BAR_WORDS 3456
#define XB_SPIN_CAP (1u << 22)
#define LAS __attribute__((address_space(3)))
__device__ __forceinline__ unsigned xb_ld(unsigned* p)              { return __hip_atomic_load(p, __ATOMIC_RELAXED, __HIP_MEMORY_SCOPE_AGENT); }
__device__ __forceinline__ unsigned xb_add(unsigned* p, unsigned v) { return __hip_atomic_fetch_add(p, v, __ATOMIC_RELAXED, __HIP_MEMORY_SCOPE_AGENT); }
__device__ __forceinline__ unsigned xb_xcc_id() { return (unsigned)__builtin_amdgcn_s_getreg((3 << 11) | 20) & 0xFu; }
#define XB_SPIN(cond, bar) do { unsigned _sp = 0; while (cond) { __builtin_amdgcn_s_sleep(1); \
    if ((++_sp & 255u) == 0u) { if (xb_ld(&(bar)[XB_TMO])) break; if (_sp > XB_SPIN_CAP) { atomicAdd(&(bar)[XB_TMO], 1u); break; } } } } while (0)
struct XcdBarrier { unsigned* bar; unsigned x; volatile LAS unsigned* st; };
__device__ __forceinline__ XcdBarrier xcd_barrier_post(unsigned* bar, volatile LAS unsigned* st) {
    XcdBarrier b; b.bar = bar; b.x = xb_xcc_id(); b.st = st;
    if (threadIdx.x == 0) (void)xb_add(&bar[XB_XCNT(b.x)], 1u);
    return b;
}
__device__ __forceinline__ void xcd_barrier_complete(unsigned* bar, unsigned x, unsigned& nloc, unsigned& nx) {
    const unsigned G = gridDim.x * gridDim.y * gridDim.z;
    unsigned sum, cnt, mine, sp = 0u;
    for (;;) {
        sum = 0u; cnt = 0u; mine = 0u;
#pragma unroll
        for (unsigned j = 0; j < 16; ++j) { const unsigned c = xb_ld(&bar[XB_XCNT(j)]); sum += c; cnt += (c > 0u) ? 1u : 0u; mine = (j == x) ? c : mine; }
        if (sum == G) break;
        __builtin_amdgcn_s_sleep(1);
        if ((++sp & 255u) == 0u) { if (xb_ld(&bar[XB_TMO])) break; if (sp > XB_SPIN_CAP) { atomicAdd(&bar[XB_TMO], 1u); break; } }
    }
    nloc = mine > 0u ? mine : 1u; nx = cnt > 0u ? cnt : 1u;
}
__device__ __forceinline__ void xcd_barrier(const XcdBarrier& b) {
    asm volatile("s_waitcnt vmcnt(0)" ::: "memory");
    __syncthreads();
    if (threadIdx.x == 0) {
        unsigned* bar = b.bar; asm volatile("" : "+s"(bar));
        __builtin_amdgcn_s_waitcnt(0);
        unsigned nloc = b.st[0], nx = b.st[1];
        if (nloc == 0u) { xcd_barrier_complete(bar, b.x, nloc, nx); b.st[0] = nloc; b.st[1] = nx; }
        const unsigned old = xb_add(&bar[XB_XSUB(b.x)], 1u);
        const unsigned gen = old / nloc;
        if (old + 1u == (gen + 1u) * nloc) {
            __builtin_amdgcn_fence(__ATOMIC_RELEASE, "agent");
            asm volatile("s_waitcnt vmcnt(0)" ::: "memory");
            const unsigned og = xb_add(&bar[XB_TOP], 1u);
            const unsigned tg = og / nx;
            if (og + 1u == (tg + 1u) * nx) xb_add(&bar[XB_TOPGEN], 1u);
            else XB_SPIN(xb_ld(&bar[XB_TOPGEN]) == tg, bar);
            __builtin_amdgcn_fence(__ATOMIC_ACQUIRE, "agent");
            xb_add(&bar[XB_XGEN(b.x)], 1u);
            asm volatile("s_waitcnt vmcnt(0)" ::: "memory");
        } else {
            XB_SPIN(xb_ld(&bar[XB_XGEN(b.x)]) == gen, bar);
            __builtin_amdgcn_fence(__ATOMIC_ACQUIRE, "agent");
            asm volatile("s_waitcnt vmcnt(0)" ::: "memory");
        }
    }
    __syncthreads();
}

#endif

#ifndef CPU_EMU
#define NTHR 512
typedef short bf16x8 __attribute__((ext_vector_type(8)));
typedef float f32x4 __attribute__((ext_vector_type(4)));
typedef unsigned u32x4 __attribute__((ext_vector_type(4)));
typedef unsigned u32x2 __attribute__((ext_vector_type(2)));
#define MFMA16(a, b, c) __builtin_amdgcn_mfma_f32_16x16x32_bf16(a, b, c, 0, 0, 0)
typedef __bf16 bf16x2_t __attribute__((ext_vector_type(2)));
__device__ __forceinline__ unsigned pk_bf16(float lo, float hi) { bf16x2_t v; v.x = (__bf16)lo; v.y = (__bf16)hi; return __builtin_bit_cast(unsigned, v); }
__device__ __forceinline__ float bflo(unsigned w) { return __uint_as_float(w << 16); }
__device__ __forceinline__ float bfhi(unsigned w) { return __uint_as_float(w & 0xffff0000u); }
__device__ __forceinline__ float wscan_add(float v, int lane, int dir) {
#pragma unroll
    for (int off = 1; off < 64; off <<= 1) { const float o = dir == 0 ? __shfl_up(v, off, 64) : __shfl_down(v, off, 64); if (dir == 0 ? (lane >= off) : (lane + off < 64)) v += o; }
    return v; }
__device__ __forceinline__ float wscan_max(float v, int lane, int dir) {
#pragma unroll
    for (int off = 1; off < 64; off <<= 1) { const float o = dir == 0 ? __shfl_up(v, off, 64) : __shfl_down(v, off, 64); if (dir == 0 ? (lane >= off) : (lane + off < 64)) v = fmaxf(v, o); }
    return v; }
__device__ __forceinline__ float wred_max(float v) {
#pragma unroll
    for (int off = 32; off >= 1; off >>= 1) v = fmaxf(v, __shfl_xor(v, off, 64));
    return v; }
__device__ __forceinline__ void gate_lane(const P& p, int l, int h, int row, int dir, int lane, float& b, float& g) {
    const float* gp = p.gate_pre() + (size_t)row * 16; const float* bg = p.b_gates() + (size_t)l * 4 * NH;
    const float iv = gp[dir * NH + h] + bg[dir * NH + h];
    const float fv = gp[2 * NH + dir * NH + h] + bg[2 * NH + dir * NH + h];
    b = wscan_add(logsigmoidf_(fv), lane, dir); g = iv - b;
}
#define ML_LD 72
template <bool WITH_K> __device__ __forceinline__ void ml_stage_T(const P& p, int h, int c0, int wave, int lane, LAS bf16_t* VT, LAS bf16_t* KT, const LAS float* wl) {
#pragma unroll
    for (int i = 0; i < 2; ++i) { const int d0 = (wave * 2 + i) * 8;
        const u32x4 vv = *(const u32x4*)(p.proj() + (size_t)(c0 + lane) * PJ + C_V + h * DH + d0);
        const unsigned vw[4] = {vv.x, vv.y, vv.z, vv.w};
#pragma unroll
        for (int j = 0; j < 4; ++j) { VT[(d0 + 2 * j) * ML_LD + lane] = (bf16_t)(vw[j] & 0xffffu); VT[(d0 + 2 * j + 1) * ML_LD + lane] = (bf16_t)(vw[j] >> 16); }
        if constexpr (WITH_K) {
            const u32x4 kv = *(const u32x4*)(p.proj() + (size_t)(c0 + lane) * PJ + C_K + h * DH + d0);
            const unsigned kw[4] = {kv.x, kv.y, kv.z, kv.w}; const float w0 = wl[lane], w1 = wl[64 + lane];
#pragma unroll
            for (int j = 0; j < 4; ++j) { const float a = bflo(kw[j]), b = bfhi(kw[j]);
                KT[(d0 + 2 * j) * ML_LD + lane] = f2bf(a * w0); KT[(d0 + 2 * j + 1) * ML_LD + lane] = f2bf(b * w0);
                KT[(DH + d0 + 2 * j) * ML_LD + lane] = f2bf(a * w1); KT[(DH + d0 + 2 * j + 1) * ML_LD + lane] = f2bf(b * w1); }
        } }
}
__device__ __forceinline__ void unit_ml_cloc(const P& p, int l, int unit, LAS unsigned char* lds) {
    int tid = threadIdx.x; asm volatile("" : "+v"(tid));
    const int wave = __builtin_amdgcn_readfirstlane(tid >> 6), lane = tid & 63, fr = lane & 15, fq = lane >> 4;
    const int h = unit % NH, gc = unit / NH, c0 = gc * LCH;
    LAS float* wl = (LAS float*)lds;
    LAS bf16_t* VT = (LAS bf16_t*)(lds + 512);
    LAS bf16_t* KT = VT + DH * ML_LD;
    if (wave < 2) { const int dir = wave; float b, g; gate_lane(p, l, h, c0 + lane, dir, lane, b, g);
        const float total = __shfl(b, dir == 0 ? 63 : 0, 64), gmax = wred_max(g);
        wl[dir * 64 + lane] = expf(g - gmax) * 0.08838834764831845f;
        const float pm = wscan_max(g, lane, dir); float* gs = p.gsc() + IDX_DHR(dir, h, c0 + lane); gs[0] = b; gs[(size_t)2 * NH * NROW] = g; gs[(size_t)4 * NH * NROW] = pm;
        if (lane == 0) { p.bL()[IDX_DHC(dir, h, gc)] = total; p.Mloc()[IDX_DHC(dir, h, gc)] = total + gmax; } }
    __syncthreads();
    ml_stage_T<true>(p, h, c0, wave, lane, VT, KT, wl);
    __syncthreads();
    if (tid < 256) { const int dir = tid >> 7, d = tid & 127; float s = 0.f; const LAS bf16_t* r = KT + (dir * DH + d) * ML_LD;
#pragma unroll 8
        for (int j = 0; j < 64; ++j) s += bf2f(r[j]);
        p.nloc()[IDX_DHC(dir, h, gc) * DH + d] = s; }
    { const int e = tid >> 2, sg = (tid & 3) * 16; const LAS bf16_t* r = VT + e * ML_LD + sg; bf16_t* o = p.VTg() + ((size_t)(h * NCHK + gc) * DH + e) * LCH + sg;
      *(u32x4*)o = *(const LAS u32x4*)r; *(u32x4*)(o + 8) = *(const LAS u32x4*)(r + 8); }
#pragma unroll 1
    for (int dir = 0; dir < 2; ++dir) {
        f32x4 acc[8];
#pragma unroll
        for (int i = 0; i < 8; ++i) acc[i] = (f32x4){0.f, 0.f, 0.f, 0.f};
#pragma unroll
        for (int ks = 0; ks < 2; ++ks) { const bf16x8 a = *(const LAS bf16x8*)(VT + (16 * wave + fr) * ML_LD + 32 * ks + 8 * fq);
#pragma unroll
            for (int dt = 0; dt < 8; ++dt) { const bf16x8 b = *(const LAS bf16x8*)(KT + (dir * DH + 16 * dt + fr) * ML_LD + 32 * ks + 8 * fq); acc[dt] = MFMA16(b, a, acc[dt]); } }
        bf16_t* o = (bf16_t*)p.Cloc() + (IDX_DHC(dir, h, gc) * DH + 16 * wave + fr) * DH + 4 * fq;
#pragma unroll
        for (int dt = 0; dt < 8; ++dt) { u32x2 w; w.x = pk_bf16(acc[dt][0], acc[dt][1]); w.y = pk_bf16(acc[dt][2], acc[dt][3]); *(u32x2*)(o + 16 * dt) = w; }
    }
    __syncthreads();
}
struct ScanItem { int e, d, dir, h, sl; };
template <bool CTX> __device__ __forceinline__ ScanItem scan_decode(size_t i) { constexpr int NS = CTX ? NB_CTX : NB_LAT; ScanItem s; s.d = (int)(i % (DH / 4)) * 4; s.e = (int)((i / (DH / 4)) % DH); const size_t j = i / ((size_t)DH * DH / 4); s.sl = (int)(j % NS); s.h = (int)((j / NS) % NH); s.dir = (int)(j / (NS * NH)); return s; }
template <int NC, bool CTX> __device__ __forceinline__ void scan_load(const P& p, const ScanItem& it, u32x2 (&cl)[NC], float (&bLv)[NC], float (&mlv)[NC]) {
    const int gc0 = seq_start(CTX ? it.sl : NB_CTX + it.sl) / LCH;
#pragma unroll
    for (int jj = 0; jj < NC; ++jj) { const int gc = gc0 + (it.dir == 0 ? jj : NC - 1 - jj); const size_t ci = IDX_DHC(it.dir, it.h, gc);
        bLv[jj] = p.bL()[ci]; mlv[jj] = p.Mloc()[ci]; cl[jj] = *(const u32x2*)((const bf16_t*)p.Cloc() + (ci * DH + it.e) * DH + it.d); }
}
template <int NC, bool CTX> __device__ __forceinline__ void scan_run(const P& p, int l, const ScanItem& it, const u32x2 (&cl)[NC], const float (&bLv)[NC], const float (&mlv)[NC], f32x4& C, f32x4& n, float& m) {
    const int gc0 = seq_start(CTX ? it.sl : NB_CTX + it.sl) / LCH; const int e = it.e, d = it.d;
#pragma unroll
    for (int jj = 0; jj < NC; ++jj) {
        const int gc = gc0 + (it.dir == 0 ? jj : NC - 1 - jj); const size_t ci = IDX_DHC(it.dir, it.h, gc);
        const float mnew = fmaxf(bLv[jj] + m, mlv[jj]); const float dec = __expf(bLv[jj] + m - mnew), sc = __expf(mlv[jj] - mnew);
        u32x2 w; w.x = pk_bf16(C[0], C[1]); w.y = pk_bf16(C[2], C[3]); *(u32x2*)(p.CprevT() + (ci * DH + e) * DH + d) = w;
        C = dec * C + sc * (f32x4){bflo(cl[jj].x), bfhi(cl[jj].x), bflo(cl[jj].y), bfhi(cl[jj].y)};
        if (e == 0) { const f32x4 nl = *(const f32x4*)(p.nloc() + ci * DH + d); *(f32x4*)(p.nprev() + ci * DH + d) = n; n = dec * n + sc * nl; }
        if (e == 0 && d == 0) p.Mprev()[ci] = m;
        m = mnew;
    }
}
__device__ __forceinline__ void phase_scan(const P& p, int l, LAS unsigned char* lds) {
    int t_ = threadIdx.x; asm volatile("" : "+v"(t_));
    const size_t gtid = (size_t)blockIdx.x * NTHR + t_, nthr = (size_t)gridDim.x * NTHR;
    constexpr size_t NLAT = (size_t)2 * NH * NB_LAT * DH * (DH / 4); constexpr int NCL = T_LAT / LCH;
    for (size_t i = gtid; i < NLAT; i += nthr) { const ScanItem it = scan_decode<false>(i); u32x2 cl[NCL]; float bLv[NCL], mlv[NCL]; scan_load<NCL, false>(p, it, cl, bLv, mlv);
        const size_t base = (((size_t)it.sl * DEPTH + l) * 2 + it.dir) * NH + it.h; f32x4 C, n = {0.f, 0.f, 0.f, 0.f};
#pragma unroll
        for (int q = 0; q < 4; ++q) C[q] = p.state_C()[(base * DH + it.d + q) * DH + it.e];
        if (it.e == 0) n = *(const f32x4*)(p.state_n() + base * DH + it.d);
        float m = p.state_m()[base];
        asm volatile("" ::: "memory"); scan_run<NCL, false>(p, l, it, cl, bLv, mlv, C, n, m); }
}
__device__ __forceinline__ void unit_ml_out(const P& p, int l, int unit, LAS unsigned char* lds) {
    int tid = threadIdx.x; asm volatile("" : "+v"(tid));
    const int wave = __builtin_amdgcn_readfirstlane(tid >> 6), lane = tid & 63, fr = lane & 15, fq = lane >> 4;
    const int h = unit % NH, gc = unit / NH, c0 = gc * LCH;
    LAS float* ssq = (LAS float*)lds;
    LAS bf16_t* VT = (LAS bf16_t*)(lds + 1024);
    LAS bf16_t* SS = VT + DH * ML_LD;
    const bf16_t* Q = p.proj() + (size_t)c0 * PJ + C_Q + h * DH; const bf16_t* K = p.proj() + (size_t)c0 * PJ + C_K + h * DH;
    const int tt = wave & 3, wh = wave >> 2, t = 16 * tt + fr; const size_t row = (size_t)c0 + t;
    bf16x8 qf[4], kf[2][4], cf0[4][4], cf1[4][4];
#pragma unroll
    for (int ks = 0; ks < 4; ++ks) { qf[ks] = *(const bf16x8*)(Q + (size_t)t * PJ + 32 * ks + 8 * fq);
#pragma unroll
        for (int i = 0; i < 2; ++i) kf[i][ks] = *(const bf16x8*)(K + (size_t)(16 * (2 * wh + i) + fr) * PJ + 32 * ks + 8 * fq); }
    { const bf16_t* CT0 = p.CprevT() + IDX_DHC(0, h, gc) * DH * DH;
#pragma unroll
      for (int ks = 0; ks < 4; ++ks)
#pragma unroll
          for (int i = 0; i < 4; ++i) cf0[i][ks] = *(const bf16x8*)(CT0 + (size_t)(16 * (4 * wh + i) + fr) * DH + 32 * ks + 8 * fq); }
    { const int e = tid >> 2, sg = (tid & 3) * 16; const bf16_t* o = p.VTg() + ((size_t)(h * NCHK + gc) * DH + e) * LCH + sg; const u32x4 v0 = *(const u32x4*)o, v1 = *(const u32x4*)(o + 8);
      *(LAS u32x4*)(VT + e * ML_LD + sg) = v0; *(LAS u32x4*)(VT + e * ML_LD + sg + 8) = v1; }
    float rowterm[2], winter[2], emt[2], qn[2]; f32x4 colterm[2][2];
#pragma unroll
    for (int dir = 0; dir < 2; ++dir) { const float* gs = p.gsc() + IDX_DHR(dir, h, row); const float bt = gs[0], pmt = gs[(size_t)4 * NH * NROW]; const float mprev = p.Mprev()[IDX_DHC(dir, h, gc)];
        const float mt = bt + fmaxf(mprev, pmt); rowterm[dir] = bt - mt; winter[dir] = __expf(bt + mprev - mt); emt[dir] = __expf(-mt);
#pragma unroll
        for (int i = 0; i < 2; ++i) colterm[dir][i] = *(const f32x4*)(p.gsc() + (size_t)2 * NH * NROW + IDX_DHR(dir, h, c0 + 16 * (2 * wh + i) + 4 * fq));
        const float* np = p.nprev() + IDX_DHC(dir, h, gc) * DH + 8 * fq; float s = 0.f;
#pragma unroll
        for (int ks = 0; ks < 4; ++ks) { const f32x4 n0 = *(const f32x4*)(np + 32 * ks), n1 = *(const f32x4*)(np + 32 * ks + 4); const u32x4 qv = __builtin_bit_cast(u32x4, qf[ks]);
            s += bflo(qv.x) * n0[0] + bfhi(qv.x) * n0[1] + bflo(qv.y) * n0[2] + bfhi(qv.y) * n0[3] + bflo(qv.z) * n1[0] + bfhi(qv.z) * n1[1] + bflo(qv.w) * n1[2] + bfhi(qv.w) * n1[3]; }
        s += __shfl_xor(s, 16, 64); s += __shfl_xor(s, 32, 64); qn[dir] = s; asm volatile("" : "+v"(qn[dir]) :: "memory"); }
    {
        f32x4 sc[2] = {{0.f, 0.f, 0.f, 0.f}, {0.f, 0.f, 0.f, 0.f}};
#pragma unroll
        for (int ks = 0; ks < 4; ++ks)
#pragma unroll
            for (int i = 0; i < 2; ++i) sc[i] = MFMA16(kf[i][ks], qf[ks], sc[i]);
#pragma unroll
        for (int dir = 0; dir < 2; ++dir) {
#pragma unroll
            for (int i = 0; i < 2; ++i) { const int s0 = 16 * (2 * wh + i) + 4 * fq; float v[4];
#pragma unroll
                for (int j = 0; j < 4; ++j) { const int s = s0 + j; const bool ok = dir == 0 ? (s <= t) : (s >= t); v[j] = ok ? sc[i][j] * 0.08838834764831845f * __expf(rowterm[dir] + colterm[dir][i][j]) : 0.f; }
                u32x2 w; w.x = pk_bf16(v[0], v[1]); w.y = pk_bf16(v[2], v[3]); *(LAS u32x2*)(SS + (dir * 64 + t) * ML_LD + s0) = w; } }
    }
    asm volatile("" ::: "memory");
    { const bf16_t* CT1 = p.CprevT() + IDX_DHC(1, h, gc) * DH * DH;
#pragma unroll
      for (int ks = 0; ks < 4; ++ks)
#pragma unroll
          for (int i = 0; i < 4; ++i) cf1[i][ks] = *(const bf16x8*)(CT1 + (size_t)(16 * (4 * wh + i) + fr) * DH + 32 * ks + 8 * fq); }
    u32x2 ow[4];
#pragma unroll
    for (int i = 0; i < 4; ++i) ow[i] = *(const u32x2*)(p.proj() + row * PJ + C_O + h * DH + 16 * (4 * wh + i) + 4 * fq);
    __syncthreads();
    f32x4 hs[4];
#pragma unroll
    for (int i = 0; i < 4; ++i) hs[i] = (f32x4){0.f, 0.f, 0.f, 0.f};
#pragma unroll
    for (int dir = 0; dir < 2; ++dir) {
        f32x4 a1[4], a2[4];
#pragma unroll
        for (int i = 0; i < 4; ++i) { a1[i] = (f32x4){0.f, 0.f, 0.f, 0.f}; a2[i] = (f32x4){0.f, 0.f, 0.f, 0.f}; }
        const LAS bf16_t* Sd = SS + dir * 64 * ML_LD;
#pragma unroll
        for (int ks = 0; ks < 2; ++ks) { const bf16x8 sf = *(const LAS bf16x8*)(Sd + t * ML_LD + 32 * ks + 8 * fq);
#pragma unroll
            for (int i = 0; i < 4; ++i) { const bf16x8 vf = *(const LAS bf16x8*)(VT + (16 * (4 * wh + i) + fr) * ML_LD + 32 * ks + 8 * fq); a1[i] = MFMA16(vf, sf, a1[i]); } }
#pragma unroll
        for (int ks = 0; ks < 4; ++ks)
#pragma unroll
            for (int i = 0; i < 4; ++i) a2[i] = MFMA16(dir == 0 ? cf0[i][ks] : cf1[i][ks], qf[ks], a2[i]);
        float rs = 0.f;
        { const u32x4 s0 = *(const LAS u32x4*)(Sd + t * ML_LD + 16 * fq), s1 = *(const LAS u32x4*)(Sd + t * ML_LD + 16 * fq + 8);
            rs = bflo(s0.x) + bfhi(s0.x) + bflo(s0.y) + bfhi(s0.y) + bflo(s0.z) + bfhi(s0.z) + bflo(s0.w) + bfhi(s0.w) + bflo(s1.x) + bfhi(s1.x) + bflo(s1.y) + bfhi(s1.y) + bflo(s1.z) + bfhi(s1.z) + bflo(s1.w) + bfhi(s1.w); }
        rs += __shfl_xor(rs, 16, 64); rs += __shfl_xor(rs, 32, 64);
        const float wi = winter[dir]; const float den = rs + wi * qn[dir]; const float inv = 1.0f / fmaxf(fabsf(den), emt[dir]);
#pragma unroll
        for (int i = 0; i < 4; ++i) hs[i] = hs[i] + (a1[i] + wi * a2[i]) * inv;
    }
    f32x4 gm[4];
#pragma unroll
    for (int i = 0; i < 4; ++i) gm[i] = *(const f32x4*)(p.g_mlstm() + (size_t)l * DB + h * DH + 16 * (4 * wh + i) + 4 * fq);
    float q2 = 0.f;
#pragma unroll
    for (int i = 0; i < 4; ++i) q2 += hs[i][0] * hs[i][0] + hs[i][1] * hs[i][1] + hs[i][2] * hs[i][2] + hs[i][3] * hs[i][3];
    q2 += __shfl_xor(q2, 16, 64); q2 += __shfl_xor(q2, 32, 64);
    if (fq == 0) ssq[wh * 64 + t] = q2;
    __syncthreads();
    const float rstd = 1.0f / sqrtf((ssq[t] + ssq[64 + t]) * (1.0f / DH) + EPSF);
#pragma unroll
    for (int i = 0; i < 4; ++i) { const int e = 16 * (4 * wh + i) + 4 * fq;
        const float o0 = bflo(ow[i].x), o1 = bfhi(ow[i].x), o2 = bflo(ow[i].y), o3 = bfhi(ow[i].y);
        const float y0 = hs[i][0] * rstd * gm[i][0] * __builtin_amdgcn_rcpf(1.0f + __expf(-o0)), y1 = hs[i][1] * rstd * gm[i][1] * __builtin_amdgcn_rcpf(1.0f + __expf(-o1)), y2 = hs[i][2] * rstd * gm[i][2] * __builtin_amdgcn_rcpf(1.0f + __expf(-o2)), y3 = hs[i][3] * rstd * gm[i][3] * __builtin_amdgcn_rcpf(1.0f + __expf(-o3));
        u32x2 w; w.x = pk_bf16(y0, y1); w.y = pk_bf16(y2, y3); *(u32x2*)(p.ys() + row * 3 * DB + 2 * DB + h * DH + e) = w; }
    __syncthreads();
}
#endif
#ifndef CPU_EMU
#define SQ_LD 136
__device__ __forceinline__ void unit_ml_seq(const P& p, int l, int unit, LAS unsigned char* lds) {
    int tid = threadIdx.x; asm volatile("" : "+v"(tid));
    const int wave = __builtin_amdgcn_readfirstlane(tid >> 6), lane = tid & 63, fr = lane & 15, fq = lane >> 4;
    const int dir = unit & 1, h = (unit >> 1) & (NH - 1), b = unit / (2 * NH), r0 = b * T_CTX;
    constexpr int NCQ = T_CTX / LCH;
    LAS float* nst = (LAS float*)lds;
    LAS float* DEC = nst + 256;
    LAS float* GB = (LAS float*)(lds + 2048);
    LAS float* GG = GB + NCQ * 64;
    LAS float* GP = GG + NCQ * 64;
    LAS float* EM = GP + NCQ * 64;
    LAS float* WS = EM + NCQ * 64;
    LAS float* GT = WS + NCQ * 64; LAS float* GM = GT + NCQ;
    LAS bf16_t* VT = (LAS bf16_t*)(lds + 8192);
    LAS bf16_t* KT = VT + DH * ML_LD;
    LAS bf16_t* SS = KT + DH * ML_LD;
    LAS bf16_t* CTl = SS + 64 * ML_LD;
    const int tt = wave & 3, wh = wave >> 2, t = 16 * tt + fr;
    f32x4 cacc[8];
#pragma unroll
    for (int i = 0; i < 8; ++i) cacc[i] = (f32x4){0.f, 0.f, 0.f, 0.f};
    if (tid < DH) nst[tid] = 0.f;
    float* hb = p.hbc() + ((size_t)dir * R_CTX) * DB + h * DH;
    if (wave < NCQ) { const int jo = dir == 0 ? wave : NCQ - 1 - wave; float bb, g; gate_lane(p, l, h, r0 + jo * LCH + lane, dir, lane, bb, g);
        const float pm = wscan_max(g, lane, dir), total = __shfl(bb, dir == 0 ? 63 : 0, 64), gmax = wred_max(g);
        GB[wave * 64 + lane] = bb; GG[wave * 64 + lane] = g; GP[wave * 64 + lane] = pm; if (lane == 0) { GT[wave] = total; GM[wave] = gmax; } }
    bf16x8 qf[4], kf[2][4]; u32x4 kvr[2], vvr[2];
#define SQ_LOAD(jj_) do { const int jo_ = dir == 0 ? (jj_) : NCQ - 1 - (jj_), c0_ = r0 + jo_ * LCH; const bf16_t* Q_ = p.proj() + (size_t)c0_ * PJ + C_Q + h * DH; const bf16_t* K_ = p.proj() + (size_t)c0_ * PJ + C_K + h * DH; \
        _Pragma("unroll") for (int ks = 0; ks < 4; ++ks) { qf[ks] = *(const bf16x8*)(Q_ + (size_t)t * PJ + 32 * ks + 8 * fq); \
            _Pragma("unroll") for (int i = 0; i < 2; ++i) kf[i][ks] = *(const bf16x8*)(K_ + (size_t)(16 * (2 * wh + i) + fr) * PJ + 32 * ks + 8 * fq); } \
        _Pragma("unroll") for (int i = 0; i < 2; ++i) { const int d0 = (wave * 2 + i) * 8; kvr[i] = *(const u32x4*)(p.proj() + (size_t)(c0_ + lane) * PJ + C_K + h * DH + d0); vvr[i] = *(const u32x4*)(p.proj() + (size_t)(c0_ + lane) * PJ + C_V + h * DH + d0); } } while (0)
    SQ_LOAD(0);
    __syncthreads();
    if (wave == 0) { float mm = 0.f;
#pragma unroll
        for (int jj = 0; jj < NCQ; ++jj) { const float bb = GB[jj * 64 + lane], g = GG[jj * 64 + lane], pm = GP[jj * 64 + lane], total = GT[jj], gmax = GM[jj];
            const float mt = bb + fmaxf(mm, pm), mnew = total + fmaxf(mm, gmax);
            GB[jj * 64 + lane] = bb - mt; GP[jj * 64 + lane] = __expf(bb + mm - mt); EM[jj * 64 + lane] = __expf(-mt); WS[jj * 64 + lane] = __expf(total + g - mnew) * 0.08838834764831845f;
            if (lane == 0) DEC[jj] = __expf(total + mm - mnew);
            mm = mnew; }
        if (lane == 0) DEC[NCQ] = mm; }
    __syncthreads();
#pragma unroll 1
    for (int jj = 0; jj < NCQ; ++jj) {
        const int jo = dir == 0 ? jj : NCQ - 1 - jj, c0 = r0 + jo * LCH;
        { const float w0 = WS[jj * 64 + lane];
#pragma unroll
          for (int i = 0; i < 2; ++i) { const int d0 = (wave * 2 + i) * 8; const unsigned vw[4] = {vvr[i].x, vvr[i].y, vvr[i].z, vvr[i].w}, kw[4] = {kvr[i].x, kvr[i].y, kvr[i].z, kvr[i].w};
#pragma unroll
              for (int j = 0; j < 4; ++j) { VT[(d0 + 2 * j) * ML_LD + lane] = (bf16_t)(vw[j] & 0xffffu); VT[(d0 + 2 * j + 1) * ML_LD + lane] = (bf16_t)(vw[j] >> 16);
                  KT[(d0 + 2 * j) * ML_LD + lane] = f2bf(bflo(kw[j]) * w0); KT[(d0 + 2 * j + 1) * ML_LD + lane] = f2bf(bfhi(kw[j]) * w0); } } }
#pragma unroll
        for (int dt = 0; dt < 8; ++dt) { u32x2 w; w.x = pk_bf16(cacc[dt][0], cacc[dt][1]); w.y = pk_bf16(cacc[dt][2], cacc[dt][3]); *(LAS u32x2*)(CTl + (16 * wave + fr) * SQ_LD + 16 * dt + 4 * fq) = w; }
        {
            f32x4 sc[2] = {{0.f, 0.f, 0.f, 0.f}, {0.f, 0.f, 0.f, 0.f}};
#pragma unroll
            for (int ks = 0; ks < 4; ++ks)
#pragma unroll
                for (int i = 0; i < 2; ++i) sc[i] = MFMA16(kf[i][ks], qf[ks], sc[i]);
            const float rt = GB[jj * 64 + t];
#pragma unroll
            for (int i = 0; i < 2; ++i) { const int s0 = 16 * (2 * wh + i) + 4 * fq; float v[4];
#pragma unroll
                for (int j = 0; j < 4; ++j) { const int s = s0 + j; const bool ok = dir == 0 ? (s <= t) : (s >= t); v[j] = ok ? sc[i][j] * 0.08838834764831845f * __expf(rt + GG[jj * 64 + s]) : 0.f; }
                u32x2 w; w.x = pk_bf16(v[0], v[1]); w.y = pk_bf16(v[2], v[3]); *(LAS u32x2*)(SS + t * ML_LD + s0) = w; }
        }
        __syncthreads();
        {
            f32x4 a1[4], a2[4];
#pragma unroll
            for (int i = 0; i < 4; ++i) { a1[i] = (f32x4){0.f, 0.f, 0.f, 0.f}; a2[i] = (f32x4){0.f, 0.f, 0.f, 0.f}; }
#pragma unroll
            for (int ks = 0; ks < 2; ++ks) { const bf16x8 sf = *(const LAS bf16x8*)(SS + t * ML_LD + 32 * ks + 8 * fq);
#pragma unroll
                for (int i = 0; i < 4; ++i) { const bf16x8 vf = *(const LAS bf16x8*)(VT + (16 * (4 * wh + i) + fr) * ML_LD + 32 * ks + 8 * fq); a1[i] = MFMA16(vf, sf, a1[i]); } }
#pragma unroll
            for (int ks = 0; ks < 4; ++ks)
#pragma unroll
                for (int i = 0; i < 4; ++i) { const bf16x8 cf = *(const LAS bf16x8*)(CTl + (16 * (4 * wh + i) + fr) * SQ_LD + 32 * ks + 8 * fq); a2[i] = MFMA16(cf, qf[ks], a2[i]); }
            float qn = 0.f;
#pragma unroll
            for (int ks = 0; ks < 4; ++ks) { const LAS float* np = nst + (jj & 1) * DH + 32 * ks + 8 * fq; const f32x4 n0 = *(const LAS f32x4*)np, n1 = *(const LAS f32x4*)(np + 4); const u32x4 qv = __builtin_bit_cast(u32x4, qf[ks]);
                qn += bflo(qv.x) * n0[0] + bfhi(qv.x) * n0[1] + bflo(qv.y) * n0[2] + bfhi(qv.y) * n0[3] + bflo(qv.z) * n1[0] + bfhi(qv.z) * n1[1] + bflo(qv.w) * n1[2] + bfhi(qv.w) * n1[3]; }
            qn += __shfl_xor(qn, 16, 64); qn += __shfl_xor(qn, 32, 64);
            if (jj + 1 < NCQ) SQ_LOAD(jj + 1);
            float rs = 0.f;
            { const u32x4 s0 = *(const LAS u32x4*)(SS + t * ML_LD + 16 * fq), s1 = *(const LAS u32x4*)(SS + t * ML_LD + 16 * fq + 8);
                rs = bflo(s0.x) + bfhi(s0.x) + bflo(s0.y) + bfhi(s0.y) + bflo(s0.z) + bfhi(s0.z) + bflo(s0.w) + bfhi(s0.w) + bflo(s1.x) + bfhi(s1.x) + bflo(s1.y) + bfhi(s1.y) + bflo(s1.z) + bfhi(s1.z) + bflo(s1.w) + bfhi(s1.w); }
            rs += __shfl_xor(rs, 16, 64); rs += __shfl_xor(rs, 32, 64);
            const float wi = GP[jj * 64 + t]; const float den = rs + wi * qn; const float inv = 1.0f / fmaxf(fabsf(den), EM[jj * 64 + t]);
            float* ho = hb + (size_t)(c0 + t) * DB + 4 * fq;
#pragma unroll
            for (int i = 0; i < 4; ++i) *(f32x4*)(ho + 16 * (4 * wh + i)) = (a1[i] + wi * a2[i]) * inv;
        }
        const float decay = DEC[jj];
#pragma unroll
        for (int dt = 0; dt < 8; ++dt) cacc[dt] = cacc[dt] * decay;
#pragma unroll
        for (int ks = 0; ks < 2; ++ks) { const bf16x8 a = *(const LAS bf16x8*)(VT + (16 * wave + fr) * ML_LD + 32 * ks + 8 * fq);
#pragma unroll
            for (int dt = 0; dt < 8; ++dt) { const bf16x8 bb = *(const LAS bf16x8*)(KT + (16 * dt + fr) * ML_LD + 32 * ks + 8 * fq); cacc[dt] = MFMA16(bb, a, cacc[dt]); } }
        if (tid < DH) { float s = 0.f; const LAS bf16_t* r = KT + tid * ML_LD;
#pragma unroll
            for (int j4 = 0; j4 < 8; ++j4) { const u32x4 v = *(const LAS u32x4*)(r + 8 * j4); s += (bflo(v.x) + bfhi(v.x)) + (bflo(v.y) + bfhi(v.y)) + (bflo(v.z) + bfhi(v.z)) + (bflo(v.w) + bfhi(v.w)); }
            nst[((jj + 1) & 1) * DH + tid] = decay * nst[(jj & 1) * DH + tid] + s; }
        __syncthreads();
    }
#undef SQ_LOAD
    __syncthreads();
    { LAS float* T = (LAS float*)(lds + 8192);
#pragma unroll
      for (int dt = 0; dt < 8; ++dt)
#pragma unroll
          for (int j = 0; j < 4; ++j) T[(16 * wave + fr) * 129 + 16 * dt + 4 * fq + j] = cacc[dt][j];
      __syncthreads();
      const size_t base = (((size_t)b * DEPTH + l) * 2 + dir) * NH + h;
      float* oC = p.out + (size_t)NROW * DM; float* on = oC + (size_t)NB_CTX * DEPTH * 2 * NH * DH * DH; float* om = on + (size_t)NB_CTX * DEPTH * 2 * NH * DH;
      const int d = tid >> 2, es = (tid & 3) * 32;
#pragma unroll
      for (int k = 0; k < 8; ++k) { f32x4 v; v[0] = T[(es + 4 * k) * 129 + d]; v[1] = T[(es + 4 * k + 1) * 129 + d]; v[2] = T[(es + 4 * k + 2) * 129 + d]; v[3] = T[(es + 4 * k + 3) * 129 + d];
          *(f32x4*)(oC + (base * DH + d) * DH + es + 4 * k) = v; }
      if (tid < DH) on[base * DH + tid] = nst[(NCQ & 1) * DH + tid];
      if (tid == 0) om[base] = DEC[NCQ]; }
    __syncthreads();
}
__device__ __forceinline__ void phase_ctx_fin(const P& p, int l, int cu, int ncu) {
    int tid = threadIdx.x; asm volatile("" : "+v"(tid));
    const int wave = tid >> 6, lane = tid & 63, c = 8 * lane;
    const f32x4 g0 = *(const f32x4*)(p.g_mlstm() + (size_t)l * DB + c), g1 = *(const f32x4*)(p.g_mlstm() + (size_t)l * DB + c + 4);
    for (int r = (cu * 8 + wave) * 2; r < R_CTX; r += ncu * 16) {
        f32x4 v[2][2]; u32x4 ow[2];
#pragma unroll
        for (int k = 0; k < 2; ++k) { const float* h0 = p.hbc() + (size_t)(r + k) * DB + c; const float* h1 = h0 + (size_t)R_CTX * DB;
            v[k][0] = *(const f32x4*)h0 + *(const f32x4*)h1; v[k][1] = *(const f32x4*)(h0 + 4) + *(const f32x4*)(h1 + 4); ow[k] = *(const u32x4*)(p.proj() + (size_t)(r + k) * PJ + C_O + c); }
#pragma unroll
        for (int k = 0; k < 2; ++k) { float ss = 0.f;
#pragma unroll
            for (int j = 0; j < 4; ++j) ss += v[k][0][j] * v[k][0][j] + v[k][1][j] * v[k][1][j];
            ss += __shfl_xor(ss, 1, 64); ss += __shfl_xor(ss, 2, 64); ss += __shfl_xor(ss, 4, 64); ss += __shfl_xor(ss, 8, 64);
            const float rs = 1.0f / sqrtf(ss * (1.0f / DH) + EPSF); const u32x4 o = ow[k]; const float og[8] = {bflo(o.x), bfhi(o.x), bflo(o.y), bfhi(o.y), bflo(o.z), bfhi(o.z), bflo(o.w), bfhi(o.w)};
            float y[8];
#pragma unroll
            for (int j = 0; j < 4; ++j) { y[j] = v[k][0][j] * rs * g0[j] * __builtin_amdgcn_rcpf(1.0f + __expf(-og[j])); y[4 + j] = v[k][1][j] * rs * g1[j] * __builtin_amdgcn_rcpf(1.0f + __expf(-og[4 + j])); }
            u32x4 w; w.x = pk_bf16(y[0], y[1]); w.y = pk_bf16(y[2], y[3]); w.z = pk_bf16(y[4], y[5]); w.w = pk_bf16(y[6], y[7]);
            *(u32x4*)(p.ys() + (size_t)(r + k) * 3 * DB + 2 * DB + c) = w; }
    }
}
#define SG_LD 136
__device__ __forceinline__ void unit_sgu(const P& p, int l, int unit, LAS unsigned char* lds) {
    int tid = threadIdx.x; asm volatile("" : "+v"(tid));
    const int wave = __builtin_amdgcn_readfirstlane(tid >> 6), lane = tid & 63, fr = lane & 15, fq = lane >> 4;
    const int g = unit % NG, ch = unit / NG, r0 = ch * SGU_CHUNK;
    LAS float* rstd = (LAS float*)lds;
    LAS bf16_t* Aw = (LAS bf16_t*)(lds + 1024);
    LAS bf16_t* Bv = Aw + 128 * SG_LD;
    { const int row = tid >> 2, part = tid & 3; const bf16_t* sv = p.proj() + (size_t)(r0 + row) * PJ + C_SV + part * 128; float ss = 0.f;
#pragma unroll
        for (int c = 0; c < 16; ++c) { const u32x4 v = *(const u32x4*)(sv + 8 * c); const float a0 = bflo(v.x), a1 = bfhi(v.x), a2 = bflo(v.y), a3 = bfhi(v.y), a4 = bflo(v.z), a5 = bfhi(v.z), a6 = bflo(v.w), a7 = bfhi(v.w);
            ss += a0 * a0 + a1 * a1 + a2 * a2 + a3 * a3 + a4 * a4 + a5 * a5 + a6 * a6 + a7 * a7; }
        ss += __shfl_xor(ss, 1, 64); ss += __shfl_xor(ss, 2, 64);
        if (part == 0) rstd[row] = 1.0f / sqrtf(ss * (1.0f / DB) + EPSF); }
    { const float* W = p.w_sgu() + ((size_t)l * NG + g) * SGU_CHUNK * SGU_CHUNK;
#pragma unroll
        for (int it = 0; it < 8; ++it) { const int idx = (it * 512 + tid) * 4; const f32x4 w = *(const f32x4*)(W + idx); u32x2 o; o.x = pk_bf16(w[0], w[1]); o.y = pk_bf16(w[2], w[3]);
            *(LAS u32x2*)(Aw + (idx >> 7) * SG_LD + (idx & 127)) = o; } }
    u32x4 svv[2][2]; f32x4 gg0[2], gg1[2];
#pragma unroll
    for (int i = 0; i < 2; ++i) { const int cb = (wave * 2 + i) * 8; const float* gs = p.g_sgu() + (size_t)l * DB + g * GRP + cb; gg0[i] = *(const f32x4*)gs; gg1[i] = *(const f32x4*)(gs + 4);
#pragma unroll
        for (int half = 0; half < 2; ++half) svv[half][i] = *(const u32x4*)(p.proj() + (size_t)(r0 + 64 * half + lane) * PJ + C_SV + g * GRP + cb); }
    __syncthreads();
#pragma unroll
    for (int half = 0; half < 2; ++half) { const int q = 64 * half + lane; const float rs = rstd[q];
#pragma unroll
        for (int i = 0; i < 2; ++i) { const int cb = (wave * 2 + i) * 8;
            const u32x4 v = svv[half][i];
            const f32x4 g0 = gg0[i], g1 = gg1[i];
            Bv[(cb + 0) * SG_LD + q] = f2bf(bflo(v.x) * rs * g0[0]); Bv[(cb + 1) * SG_LD + q] = f2bf(bfhi(v.x) * rs * g0[1]);
            Bv[(cb + 2) * SG_LD + q] = f2bf(bflo(v.y) * rs * g0[2]); Bv[(cb + 3) * SG_LD + q] = f2bf(bfhi(v.y) * rs * g0[3]);
            Bv[(cb + 4) * SG_LD + q] = f2bf(bflo(v.z) * rs * g1[0]); Bv[(cb + 5) * SG_LD + q] = f2bf(bfhi(v.z) * rs * g1[1]);
            Bv[(cb + 6) * SG_LD + q] = f2bf(bflo(v.w) * rs * g1[2]); Bv[(cb + 7) * SG_LD + q] = f2bf(bfhi(v.w) * rs * g1[3]); } }
    const int pp = 16 * wave + fr; const size_t row = (size_t)r0 + pp; const float bias = p.b_sgu()[((size_t)l * NG + g) * SGU_CHUNK + pp];
    u32x2 suv[8];
#pragma unroll
    for (int ct = 0; ct < 8; ++ct) suv[ct] = *(const u32x2*)(p.proj() + row * PJ + C_SU + g * GRP + 16 * ct + 4 * fq);
    __syncthreads();
    f32x4 acc[8];
#pragma unroll
    for (int i = 0; i < 8; ++i) acc[i] = (f32x4){0.f, 0.f, 0.f, 0.f};
#pragma unroll
    for (int ks = 0; ks < 4; ++ks) { const bf16x8 a = *(const LAS bf16x8*)(Aw + (16 * wave + fr) * SG_LD + 32 * ks + 8 * fq);
#pragma unroll
        for (int ct = 0; ct < 8; ++ct) { const bf16x8 b = *(const LAS bf16x8*)(Bv + (16 * ct + fr) * SG_LD + 32 * ks + 8 * fq); acc[ct] = MFMA16(b, a, acc[ct]); } }
#pragma unroll
    for (int ct = 0; ct < 8; ++ct) { const int cc = g * GRP + 16 * ct + 4 * fq; const u32x2 su = suv[ct];
        u32x2 o; o.x = pk_bf16(bflo(su.x) * (acc[ct][0] + bias), bfhi(su.x) * (acc[ct][1] + bias)); o.y = pk_bf16(bflo(su.y) * (acc[ct][2] + bias), bfhi(su.y) * (acc[ct][3] + bias));
        *(u32x2*)(p.ys() + row * 3 * DB + DB + cc) = o; }
    __syncthreads();
}
#define N_POOL_ITEMS ((size_t)R_CTX * (DB / 2) + (size_t)NB_LAT * GRID_W * (DB / 2))
__device__ __forceinline__ void b_pool_d2(const P& p, size_t i) {
    const unsigned* pj = (const unsigned*)p.proj();
    if (i < (size_t)R_CTX * (DB / 2)) {
        const int c2 = i % (DB / 2); const int r = i / (DB / 2); const int g = (2 * c2) / GRP, win = 2 << g; const int b = r / T_CTX, t = r % T_CTX;
        int lo = t - win / 2; if (lo < 0) lo = 0; int hi = t + (win - win / 2); if (hi > T_CTX) hi = T_CTX;
        float s0 = 0.f, s1 = 0.f;
        for (int tt = lo; tt < hi; ++tt) { const unsigned w = pj[(size_t)(b * T_CTX + tt) * (PJ / 2) + c2]; s0 += bflo(w); s1 += bfhi(w); }
        const float inv = 1.0f / (float)(hi - lo); const unsigned w = pj[(size_t)r * (PJ / 2) + c2];
        ((unsigned*)p.dbf())[(size_t)r * (DB / 2) + c2] = pk_bf16(s0 * inv - bflo(w), s1 * inv - bfhi(w));
    } else {
        i -= (size_t)R_CTX * (DB / 2);
        const int c2 = i % (DB / 2); const int gx = (i / (DB / 2)) % GRID_W; const int b = i / ((size_t)(DB / 2) * GRID_W); const int g = (2 * c2) / GRP, win = 2 << g; constexpr int rows = T_LAT / GRID_W;
        int xlo = gx - win / 2; if (xlo < 0) xlo = 0; int xhi = gx + (win - win / 2); if (xhi > GRID_W) xhi = GRID_W; const float invx = 1.0f / (float)(xhi - xlo);
        float m0[rows], m1[rows];
#pragma unroll
        for (int y = 0; y < rows; ++y) { float s0 = 0.f, s1 = 0.f; const unsigned* rp = pj + (size_t)(R_CTX + b * T_LAT + y * GRID_W) * (PJ / 2) + c2;
            for (int xx = xlo; xx < xhi; ++xx) { const unsigned w = rp[(size_t)xx * (PJ / 2)]; s0 += bflo(w); s1 += bfhi(w); }
            m0[y] = s0 * invx; m1[y] = s1 * invx; }
#pragma unroll
        for (int y = 0; y < rows; ++y) { int ylo = y - win / 2; if (ylo < 0) ylo = 0; int yhi = y + (win - win / 2); if (yhi > rows) yhi = rows; float s0 = 0.f, s1 = 0.f;
#pragma unroll
            for (int yy = 0; yy < rows; ++yy) { const bool in = yy >= ylo && yy < yhi; s0 += in ? m0[yy] : 0.f; s1 += in ? m1[yy] : 0.f; }
            const float invy = 1.0f / (float)(yhi - ylo); const size_t r = (size_t)R_CTX + b * T_LAT + y * GRID_W + gx; const unsigned w = pj[r * (PJ / 2) + c2];
            ((unsigned*)p.dbf())[r * (DB / 2) + c2] = pk_bf16(s0 * invy - bflo(w), s1 * invy - bfhi(w)); }
    }
}
__device__ __forceinline__ void unit_pool(const P& p, int l, int unit) {
    int tid = threadIdx.x; asm volatile("" : "+v"(tid));
    const int wave = __builtin_amdgcn_readfirstlane(tid >> 6), lane = tid & 63, fr = lane & 15, fq = lane >> 4;
    const int g = unit % NG, r0 = (unit / NG) * 128 + 16 * wave;
    const bf16_t* A = p.dbf() + (size_t)(r0 + fr) * DB + g * GRP + 8 * fq; const bf16_t* B = p.Wt_pool() + ((size_t)l * NG + g) * GRP * GRP + (size_t)fr * GRP + 8 * fq;
    f32x4 acc[8];
#pragma unroll
    for (int i = 0; i < 8; ++i) acc[i] = (f32x4){0.f, 0.f, 0.f, 0.f};
#pragma unroll
    for (int ks = 0; ks < 4; ++ks) { const bf16x8 a = *(const bf16x8*)(A + 32 * ks);
#pragma unroll
        for (int dt = 0; dt < 8; ++dt) { const bf16x8 b = *(const bf16x8*)(B + (size_t)16 * dt * GRP + 32 * ks); acc[dt] = MFMA16(b, a, acc[dt]); } }
    const size_t row = (size_t)r0 + fr;
#pragma unroll
    for (int dt = 0; dt < 8; ++dt) { const int c = g * GRP + 16 * dt + 4 * fq; const f32x4 sc = *(const f32x4*)(p.pool_scale() + (size_t)l * DB + c);
        u32x2 o; o.x = pk_bf16(acc[dt][0] * sc[0], acc[dt][1] * sc[1]); o.y = pk_bf16(acc[dt][2] * sc[2], acc[dt][3] * sc[3]); *(u32x2*)(p.ys() + row * 3 * DB + c) = o; }
}
#define N_FOLD (DEPTH * NG * (DM / 32))
__device__ __forceinline__ void unit_fold(const P& p, int unit, LAS unsigned char* lds) {
    int tid = threadIdx.x; asm volatile("" : "+v"(tid));
    const int kt = unit % (DM / 32), g = (unit / (DM / 32)) % NG, l = unit / ((DM / 32) * NG), k0 = kt * 32;
    LAS float* Wp = (LAS float*)lds;
    LAS float* A = Wp + GRP * GRP;
    LAS float* T = A + 32 * GRP;
    const float* wp = p.w_pool() + ((size_t)l * NG + g) * GRP * GRP;
#pragma unroll
    for (int it = 0; it < 8; ++it) { const int idx = (it * 512 + tid) * 4; *(LAS f32x4*)(Wp + idx) = *(const f32x4*)(wp + idx); }
#pragma unroll
    for (int it = 0; it < 2; ++it) { const int idx = (it * 512 + tid) * 4; const int k = idx >> 7, c = idx & 127; *(LAS f32x4*)(A + idx) = *(const f32x4*)(p.w_in() + ((size_t)l * DM + k0 + k) * D_IN + g * GRP + c); }
    __syncthreads();
    { const int k = tid >> 4, ddb = (tid & 15) * 8; f32x4 a0 = {0.f, 0.f, 0.f, 0.f}, a1 = a0;
#pragma unroll 8
        for (int c = 0; c < GRP; ++c) { const float a = A[k * GRP + c]; a0 = a0 + a * *(const LAS f32x4*)(Wp + c * GRP + ddb); a1 = a1 + a * *(const LAS f32x4*)(Wp + c * GRP + ddb + 4); }
#pragma unroll
        for (int j = 0; j < 4; ++j) { T[(ddb + j) * 33 + k] = a0[j]; T[(ddb + 4 + j) * 33 + k] = a1[j]; } }
    __syncthreads();
    { const int dd = tid >> 2, ks = (tid & 3) * 8; const LAS float* t = T + dd * 33 + ks;
        u32x4 o; o.x = pk_bf16(t[0], t[1]); o.y = pk_bf16(t[2], t[3]); o.z = pk_bf16(t[4], t[5]); o.w = pk_bf16(t[6], t[7]);
        *(u32x4*)(p.Wt_in() + ((size_t)l * NIN_PAD + g * GRP + dd) * DM + k0 + ks) = o; }
    __syncthreads();
}
#define N_POOL_UNITS (NB_CTX * (T_CTX / 64) + NB_LAT * (DB / 16))
__device__ __forceinline__ void unit_pool2(const P& p, int l, int unit, LAS unsigned char* lds) {
    int tid = threadIdx.x; asm volatile("" : "+v"(tid));
    if (unit < NB_CTX * (T_CTX / 64)) {
        const int b = unit / (T_CTX / 64), t0 = (unit % (T_CTX / 64)) * 64; LAS bf16_t* Z = (LAS bf16_t*)lds;
#pragma unroll
        for (int it = 0; it < 10; ++it) { const int idx = it * 512 + tid; const int j = idx >> 6, c8 = idx & 63; const int t = t0 - 8 + j;
            if (t >= 0 && t < T_CTX) *(LAS u32x4*)(Z + j * DB + c8 * 8) = *(const u32x4*)(p.proj() + (size_t)(b * T_CTX + t) * PJ + c8 * 8); }
        __syncthreads();
#pragma unroll 2
        for (int it = 0; it < 8; ++it) { const int idx = it * 512 + tid; const int tl = idx >> 6, c8 = idx & 63; const int t = t0 + tl; const int win = 2 << (c8 >> 4);
            int lo = t - win / 2; if (lo < 0) lo = 0; int hi = t + (win - win / 2); if (hi > T_CTX) hi = T_CTX;
            float s[8] = {0.f, 0.f, 0.f, 0.f, 0.f, 0.f, 0.f, 0.f};
#pragma unroll
            for (int j = 0; j < 16; ++j) { const int tt = t - 8 + j; const bool ok = tt >= lo && tt < hi; const u32x4 v = *(const LAS u32x4*)(Z + (tl + j) * DB + c8 * 8);
                s[0] += ok ? bflo(v.x) : 0.f; s[1] += ok ? bfhi(v.x) : 0.f; s[2] += ok ? bflo(v.y) : 0.f; s[3] += ok ? bfhi(v.y) : 0.f; s[4] += ok ? bflo(v.z) : 0.f; s[5] += ok ? bfhi(v.z) : 0.f; s[6] += ok ? bflo(v.w) : 0.f; s[7] += ok ? bfhi(v.w) : 0.f; }
            const float inv = 1.0f / (float)(hi - lo); const u32x4 v = *(const LAS u32x4*)(Z + (tl + 8) * DB + c8 * 8);
            const float* sc = p.pool_scale() + (size_t)l * DB + c8 * 8; const f32x4 s0 = *(const f32x4*)sc, s1 = *(const f32x4*)(sc + 4);
            u32x4 o; o.x = pk_bf16((s[0] * inv - bflo(v.x)) * s0[0], (s[1] * inv - bfhi(v.x)) * s0[1]); o.y = pk_bf16((s[2] * inv - bflo(v.y)) * s0[2], (s[3] * inv - bfhi(v.y)) * s0[3]);
            o.z = pk_bf16((s[4] * inv - bflo(v.z)) * s1[0], (s[5] * inv - bfhi(v.z)) * s1[1]); o.w = pk_bf16((s[6] * inv - bflo(v.w)) * s1[2], (s[7] * inv - bfhi(v.w)) * s1[3]);
            pg8::st16_wt(p.ys(), (unsigned)((b * T_CTX + t) * 3 * DB + c8 * 8) * 2u, o); }
    } else {
        const int u2 = unit - NB_CTX * (T_CTX / 64); const int b = u2 / (DB / 16), cs = (u2 % (DB / 16)) * 16; const int win = 2 << (cs / GRP); constexpr int rows = T_LAT / GRID_W;
        LAS bf16_t* Z = (LAS bf16_t*)lds;
        LAS float* XM = (LAS float*)(lds + T_LAT * 32);
        const size_t rb = (size_t)R_CTX + (size_t)b * T_LAT;
#pragma unroll
        for (int it = 0; it < T_LAT * 2 / 512; ++it) { const int idx = it * 512 + tid; const int tok = idx >> 1, hf = idx & 1; *(LAS u32x4*)(Z + tok * 16 + hf * 8) = *(const u32x4*)(p.proj() + (rb + tok) * PJ + cs + hf * 8); }
        __syncthreads();
#pragma unroll 2
        for (int it = 0; it < T_LAT * 2 / 512; ++it) { const int idx = it * 512 + tid; const int tok = idx >> 1, hf = idx & 1; const int gy = tok / GRID_W, gx = tok % GRID_W;
            int xlo = gx - win / 2; if (xlo < 0) xlo = 0; int xhi = gx + (win - win / 2); if (xhi > GRID_W) xhi = GRID_W;
            float s[8] = {0.f, 0.f, 0.f, 0.f, 0.f, 0.f, 0.f, 0.f};
#pragma unroll
            for (int j = 0; j < 16; ++j) { const int xx = gx - 8 + j; const bool ok = xx >= xlo && xx < xhi; const int xc = xx < 0 ? 0 : (xx > GRID_W - 1 ? GRID_W - 1 : xx);
                const u32x4 v = *(const LAS u32x4*)(Z + (gy * GRID_W + xc) * 16 + hf * 8);
                s[0] += ok ? bflo(v.x) : 0.f; s[1] += ok ? bfhi(v.x) : 0.f; s[2] += ok ? bflo(v.y) : 0.f; s[3] += ok ? bfhi(v.y) : 0.f; s[4] += ok ? bflo(v.z) : 0.f; s[5] += ok ? bfhi(v.z) : 0.f; s[6] += ok ? bflo(v.w) : 0.f; s[7] += ok ? bfhi(v.w) : 0.f; }
            const float inv = 1.0f / (float)(xhi - xlo);
            *(LAS f32x4*)(XM + tok * 16 + hf * 8) = (f32x4){s[0] * inv, s[1] * inv, s[2] * inv, s[3] * inv}; *(LAS f32x4*)(XM + tok * 16 + hf * 8 + 4) = (f32x4){s[4] * inv, s[5] * inv, s[6] * inv, s[7] * inv}; }
        __syncthreads();
#pragma unroll 2
        for (int it = 0; it < T_LAT * 2 / 512; ++it) { const int idx = it * 512 + tid; const int tok = idx >> 1, hf = idx & 1; const int gy = tok / GRID_W, gx = tok % GRID_W;
            int ylo = gy - win / 2; if (ylo < 0) ylo = 0; int yhi = gy + (win - win / 2); if (yhi > rows) yhi = rows;
            f32x4 a0 = {0.f, 0.f, 0.f, 0.f}, a1 = a0;
#pragma unroll
            for (int j = 0; j < 16; ++j) { const int yy = gy - 8 + j; const bool ok = yy >= ylo && yy < yhi; const int yc = yy < 0 ? 0 : (yy > rows - 1 ? rows - 1 : yy);
                const f32x4 x0 = *(const LAS f32x4*)(XM + (yc * GRID_W + gx) * 16 + hf * 8), x1 = *(const LAS f32x4*)(XM + (yc * GRID_W + gx) * 16 + hf * 8 + 4);
                const float m = ok ? 1.0f : 0.0f; a0 = a0 + x0 * m; a1 = a1 + x1 * m; }
            const float inv = 1.0f / (float)(yhi - ylo); const u32x4 v = *(const LAS u32x4*)(Z + tok * 16 + hf * 8);
            const float* sc = p.pool_scale() + (size_t)l * DB + cs + hf * 8; const f32x4 s0 = *(const f32x4*)sc, s1 = *(const f32x4*)(sc + 4);
            u32x4 o; o.x = pk_bf16((a0[0] * inv - bflo(v.x)) * s0[0], (a0[1] * inv - bfhi(v.x)) * s0[1]); o.y = pk_bf16((a0[2] * inv - bflo(v.y)) * s0[2], (a0[3] * inv - bfhi(v.y)) * s0[3]);
            o.z = pk_bf16((a1[0] * inv - bflo(v.z)) * s1[0], (a1[1] * inv - bfhi(v.z)) * s1[1]); o.w = pk_bf16((a1[2] * inv - bflo(v.w)) * s1[2], (a1[3] * inv - bfhi(v.w)) * s1[3]);
            pg8::st16_wt(p.ys(), (unsigned)((rb + tok) * 3 * DB + cs + hf * 8) * 2u, o); }
    }
    __syncthreads();
}
__device__ __forceinline__ void phase_norm(const P& p, int l, int which) {
    int tid = threadIdx.x; asm volatile("" : "+v"(tid));
    const int wave = tid >> 6, lane = tid & 63; const int stride = gridDim.x * 8;
    for (int r0 = blockIdx.x * 8 + wave; r0 < NROW; r0 += 3 * stride) {
        f32x4 v[3][DM / 256];
#pragma unroll
        for (int q = 0; q < 3; ++q) { const int r = r0 + q * stride; if (r < NROW) { const float* xr = r < R_CTX ? p.x_prompt() + (size_t)r * DM : p.x_sample() + (size_t)(r - R_CTX) * DM;
#pragma unroll
            for (int i = 0; i < DM / 256; ++i) v[q][i] = *(const f32x4*)(xr + (i * 64 + lane) * 4); } }
#pragma unroll
        for (int q = 0; q < 3; ++q) { const int r = r0 + q * stride; if (r < NROW) { float ss = 0.f;
#pragma unroll
            for (int i = 0; i < DM / 256; ++i) { *(f32x4*)(p.x() + (size_t)r * DM + (i * 64 + lane) * 4) = v[q][i]; ss += v[q][i][0] * v[q][i][0] + v[q][i][1] * v[q][i][1] + v[q][i][2] * v[q][i][2] + v[q][i][3] * v[q][i][3]; }
#pragma unroll
            for (int off = 32; off >= 1; off >>= 1) ss += __shfl_xor(ss, off, 64);
            const float rs = 1.0f / sqrtf(ss * (1.0f / DM) + EPSF);
            const float* g = p.g_norm1() + (size_t)l * DM; const float* md = p.mod() + ((size_t)l * 3 + cond_of_row(r)) * 6 * DM;
#pragma unroll
            for (int i = 0; i < DM / 256; ++i) { const int k = (i * 64 + lane) * 4; const f32x4 o = v[q][i] * rs * *(const f32x4*)(g + k) * (*(const f32x4*)(md + DM + k) + 1.0f) + *(const f32x4*)(md + k);
                u32x2 w; w.x = pk_bf16(o[0], o[1]); w.y = pk_bf16(o[2], o[3]); *(u32x2*)(p.u() + (size_t)r * DM + k) = w; } } }
    }
}
#define N_MOD_BLK (DEPTH * (6 * DM / 128))
__device__ __forceinline__ void unit_mod(const P& p, int unit, LAS unsigned char* lds) {
    int tid = threadIdx.x; asm volatile("" : "+v"(tid));
    const int l = unit / (6 * DM / 128), j0 = (unit % (6 * DM / 128)) * 128; const int j4 = tid & 31, ks = tid >> 5, k0 = ks * (DM / 16);
    LAS float* R = (LAS float*)lds;
    const float* w = p.w_ada() + ((size_t)l * DM + k0) * 6 * DM + j0 + j4 * 4;
    f32x4 a0 = {0.f, 0.f, 0.f, 0.f}, a1 = a0, a2 = a0;
#pragma unroll 4
    for (int k = 0; k < DM / 16; ++k) { const f32x4 wv = *(const f32x4*)(w + (size_t)k * 6 * DM);
        const float c0 = p.c_ctx()[k0 + k], c1 = p.c()[k0 + k], c2 = p.c()[DM + k0 + k];
        a0 = a0 + wv * (c0 / (1.0f + expf(-c0))); a1 = a1 + wv * (c1 / (1.0f + expf(-c1))); a2 = a2 + wv * (c2 / (1.0f + expf(-c2))); }
    *(LAS f32x4*)(R + (ks * 3 + 0) * 128 + j4 * 4) = a0; *(LAS f32x4*)(R + (ks * 3 + 1) * 128 + j4 * 4) = a1; *(LAS f32x4*)(R + (ks * 3 + 2) * 128 + j4 * 4) = a2;
    __syncthreads();
    if (tid < 384) { const int ci = tid >> 7, j = tid & 127; float s = p.b_ada()[(size_t)l * 6 * DM + j0 + j];
#pragma unroll
        for (int q = 0; q < 16; ++q) s += R[(q * 3 + ci) * 128 + j];
        p.mod()[((size_t)l * 3 + ci) * 6 * DM + j0 + j] = s; }
    __syncthreads();
}
__device__ __forceinline__ void conv_tile(const float* __restrict__ W, int N, bf16_t* __restrict__ Wt, int K, int kt, int nt, int rowmap, LAS unsigned char* lds) {
    int tid = threadIdx.x; asm volatile("" : "+v"(tid));
    LAS float* T = (LAS float*)lds;
    const int k0 = kt * 64, n0 = nt * 256;
    { const int c4 = (tid & 63) * 4, kb = tid >> 6; f32x4 v[8];
#pragma unroll
        for (int i = 0; i < 8; ++i) { v[i] = (f32x4){0.f, 0.f, 0.f, 0.f}; if (n0 + c4 < N) v[i] = *(const f32x4*)(W + (size_t)(k0 + kb + 8 * i) * N + n0 + c4); }
#pragma unroll
        for (int i = 0; i < 8; ++i) *(LAS f32x4*)(T + (kb + 8 * i) * 260 + c4) = v[i]; }
    __syncthreads();
    { const int n = tid >> 1, ks = (tid & 1) * 32; const int col = n0 + n;
        if (col < N) { int row = col; if (rowmap) row = col < 7 * DB ? col : (col < 7 * DB + 4 * NH ? PJ + (col - 7 * DB) : col - 4 * NH);
            bf16_t* dst = Wt + (size_t)row * K + k0 + ks;
#pragma unroll
            for (int q = 0; q < 4; ++q) { const LAS float* t = T + (ks + q * 8) * 260 + n;
                u32x4 o; o.x = pk_bf16(t[0], t[260]); o.y = pk_bf16(t[2 * 260], t[3 * 260]); o.z = pk_bf16(t[4 * 260], t[5 * 260]); o.w = pk_bf16(t[6 * 260], t[7 * 260]);
                *(u32x4*)(dst + q * 8) = o; } } }
    __syncthreads();
}
#define CT_IN (16 * ((D_IN + 255) / 256))
#define CT_BR (3 * (DB / 64) * (DM / 256))
#define CT_OUT ((DM / 64) * (DM / 256))
#define CT_FF ((DM / 64) * (DFF / 256))
#define CT_LAYER (CT_IN + CT_BR + CT_OUT + 2 * CT_FF)
#define N_FOLD_L (NG * (DM / 32))
#define CONV_ITEMS (CT_LAYER + N_FOLD_L)
__device__ __forceinline__ void conv_layer(const P& p, int l, int i_lo, int i_hi, int cu, int ncu, LAS unsigned char* lds) {
    for (int t = i_lo + cu; t < i_hi; t += ncu) {
        int r = t;
        if (r >= CT_LAYER) { unit_fold(p, l * N_FOLD_L + (r - CT_LAYER), lds); continue; }
        if (r < CT_IN) { constexpr int nn = (D_IN + 255) / 256; if (r % nn >= DB / 256) conv_tile(p.w_in() + (size_t)l * DM * D_IN, D_IN, p.Wt_in() + (size_t)l * NIN_PAD * DM, DM, r / nn, r % nn, 1, lds); continue; } r -= CT_IN;
        if (r < CT_BR) { constexpr int per = (DB / 64) * (DM / 256); const int br = r / per, q = r % per; conv_tile(p.w_branch() + ((size_t)l * 3 + br) * DB * DM, DM, p.Wt_br() + ((size_t)l * 3 + br) * DM * DB, DB, q / (DM / 256), q % (DM / 256), 0, lds); continue; } r -= CT_BR;
        if (r < CT_OUT) { conv_tile(p.w_out() + (size_t)l * DM * DM, DM, p.Wt_out() + (size_t)l * DM * DM, DM, r / (DM / 256), r % (DM / 256), 0, lds); continue; } r -= CT_OUT;
        if (r < CT_FF) { conv_tile(p.w_ff1() + (size_t)l * DM * DFF, DFF, p.Wt_ff1() + (size_t)l * DFF * DM, DM, r / (DFF / 256), r % (DFF / 256), 0, lds); continue; } r -= CT_FF;
        conv_tile(p.w_ff2() + (size_t)l * DFF * DM, DM, p.Wt_ff2() + (size_t)l * DM * DFF, DFF, r / (DM / 256), r % (DM / 256), 0, lds);
    }
    if (i_lo == 0) { const size_t per = (size_t)(NIN_PAD - PJ - 4 * NH) * DM / 8;
      int tz = threadIdx.x; asm volatile("" : "+v"(tz));
      for (size_t i = (size_t)cu * NTHR + tz; i < per; i += (size_t)ncu * NTHR) *(u32x4*)(p.Wt_in() + ((size_t)l * NIN_PAD + PJ + 4 * NH) * DM + i * 8) = (u32x4){0u, 0u, 0u, 0u}; }
}
#endif
#ifndef CPU_EMU
#define STAGE_OFF 1024
#define LDS_BYTES (STAGE_OFF + 147456)
struct Args { const float* in[24]; P p; unsigned* bar; };
#define GS(n, call) do { int t_ = threadIdx.x; asm volatile("" : "+v"(t_)); const size_t nthr_ = (size_t)gridDim.x * NTHR; for (size_t i_ = (size_t)blockIdx.x * NTHR + t_; i_ < (size_t)(n); i_ += nthr_) { call; } } while (0)
#define BAR() xcd_barrier(bar)
template <int MODE> __device__ __forceinline__ void run_gemm128(const P& p, int l, LAS unsigned char* lds, float gsc = 1.0f, bool conv = true) {
    constexpr int NU = (NROW / 128) * (DM / 256);
    if ((int)blockIdx.x >= NU && l + 1 < DEPTH && conv) {
        constexpr int c0 = CONV_ITEMS * 25 / 100, c1 = CONV_ITEMS * 49 / 100;
        conv_layer(p, l + 1, MODE == 1 ? 0 : (MODE == 2 ? c0 : c1), MODE == 1 ? c0 : (MODE == 2 ? c1 : CONV_ITEMS), (int)blockIdx.x - NU, (int)gridDim.x - NU, lds + STAGE_OFF);
        return; }
    const GemmArgs g = gemm_args(p, l, MODE);
    pg8::Order128 S; S.init(g.M, g.N, g.nZ, (int)gridDim.x, (int)blockIdx.x);
    pg8::Epi128<MODE> E; E.p = p; E.l = l; E.gsc = gsc;
    if constexpr (MODE == 1) pg8::gemm128_phase_s<pg8::Epi128<MODE>>(lds + STAGE_OFF, g, S, E);
    else pg8::gemm128_phase<pg8::Epi128<MODE>>(lds + STAGE_OFF, g, S, E);
}
template <int MODE> __device__ __forceinline__ void run_gemm2k(const P& p, int l, LAS unsigned char* lds) {
    constexpr int NU = 2 * pg8::NT2;
    if ((int)blockIdx.x >= NU) {
        if (l + 1 < DEPTH) { constexpr int c0 = CONV_ITEMS * 25 / 100, c1 = CONV_ITEMS * 45 / 100;
            conv_layer(p, l + 1, MODE == 1 ? 0 : (MODE == 2 ? c0 : c1), MODE == 1 ? c0 : (MODE == 2 ? c1 : CONV_ITEMS), (int)blockIdx.x - NU, (int)gridDim.x - NU, lds + STAGE_OFF); }
        return; }
    GemmArgs g = gemm_args(p, l, MODE);
    pg8::Order2K S; S.init(g.nZ, (int)blockIdx.x);
    g.K /= 2; g.A += (size_t)S.kh * g.K; g.Bt += (size_t)S.kh * g.K;
    pg8::EpiX<MODE> E{p, l, S.kh, S.slot};
    pg8::gemm_phase<pg8::EpiX<MODE>, pg8::Order2K, true, true, true>(lds + STAGE_OFF, g, S, E);
}
template <int MODE> __device__ __forceinline__ void run_gemm(const P& p, int l, LAS unsigned char* lds) {
    const GemmArgs g = gemm_args(p, l, MODE);
    pg8::Order S; S.init(g.M, g.N, g.nZ, (int)gridDim.x, (int)blockIdx.x);
    pg8::Epi<MODE> E{p, l};
    pg8::gemm_phase<pg8::Epi<MODE>, pg8::Order, true, true, false>(lds + STAGE_OFF, g, S, E);
}
__global__ void __launch_bounds__(NTHR, 2) mega(Args a) {
    extern __shared__ __attribute__((aligned(16))) unsigned char lds_[];
    LAS unsigned char* lds = (LAS unsigned char*)lds_;
    volatile LAS unsigned* st = (volatile LAS unsigned*)lds;
    if (threadIdx.x < 4) st[threadIdx.x] = 0u;
    __syncthreads();
    if (threadIdx.x < 24) ((LAS unsigned long long*)(lds + IN_TAB_OFF))[threadIdx.x] = (unsigned long long)a.in[threadIdx.x];
    __syncthreads();
    XcdBarrier bar = xcd_barrier_post(a.bar, st);
    const P p = a.p;
    for (int u_ = blockIdx.x; u_ < N_MOD_BLK; u_ += gridDim.x) unit_mod(p, u_, lds + STAGE_OFF);
    conv_layer(p, 0, 0, CONV_ITEMS, (int)blockIdx.x, (int)gridDim.x, lds + STAGE_OFF); BAR();
#pragma unroll 1
    for (int l = 0; l < DEPTH; ++l) {
        if (l == 0) { phase_norm(p, 0, 3); BAR(); }
        run_gemm<0>(p, l, lds); BAR();
        { const int c = blockIdx.x, G = gridDim.x; constexpr int NSEQU = NB_CTX * NH * 2, LAT0 = (R_CTX / LCH) * NH, NLATU = (R_LAT / LCH) * NH;
          if (c < NSEQU) unit_ml_seq(p, l, c, lds + STAGE_OFF);
          else { int k = c - NSEQU;
              asm volatile("" : "+s"(k)); unit_ml_cloc(p, l, LAT0 + k, lds + STAGE_OFF);
              asm volatile("" : "+s"(k)); unit_pool2(p, l, k, lds + STAGE_OFF);
#pragma unroll 1
              for (int q = 0; q < 2; ++q) { asm volatile("" : "+s"(k)); if (q == 0 || k < 64) unit_sgu(p, l, q * 128 + k, lds + STAGE_OFF); } }
          BAR();
          phase_scan(p, l, lds + STAGE_OFF);
          BAR();
          if (c < NLATU) unit_ml_out(p, l, LAT0 + c, lds + STAGE_OFF); else phase_ctx_fin(p, l, c - NLATU, G - NLATU);
          BAR(); }
        run_gemm128<1>(p, l, lds); BAR();
        run_gemm128<2>(p, l, lds); BAR();
        run_gemm<3>(p, l, lds); BAR();
        run_gemm128<4>(p, l, lds); BAR();
    }
}
#endif

extern "C" void kernel_launch(void* const* d_in, const int* in_sizes, int n_in, void* d_out, int out_size, void* d_ws, size_t ws_size, hipStream_t stream) {
#ifndef CPU_EMU
    static int grid = 0;
    if (grid == 0) {
        int dev = 0, cus = 0, per_cu = 0;
        (void)hipGetDevice(&dev); (void)hipDeviceGetAttribute(&cus, hipDeviceAttributeMultiprocessorCount, dev);
        if (hipFuncSetAttribute((const void*)mega, hipFuncAttributeMaxDynamicSharedMemorySize, LDS_BYTES) != hipSuccess) { fprintf(stderr, "hipFuncSetAttribute failed\n"); grid = -1; return; }
        if (hipOccupancyMaxActiveBlocksPerMultiprocessor(&per_cu, (const void*)mega, NTHR, LDS_BYTES) != hipSuccess || per_cu < 1) { fprintf(stderr, "occupancy query failed (%d)\n", per_cu); grid = -1; return; }
        grid = cus * per_cu;
        if (grid != 256) { fprintf(stderr, "kernel_launch: this kernel's unit dealing is written for 256 workgroups (256 CUs x 1), got %d\n", grid); grid = -1; return; }
    }
    if (grid < 0) return;
    Args a{};
    P& p = a.p;
#else
    P p{};
#endif
#ifdef CPU_EMU
    for (int i = 0; i < 24; ++i) p.inp[i] = (const float*)d_in[i];
#else
    for (int i = 0; i < 24; ++i) a.in[i] = (const float*)d_in[i];
#endif
    p.out = (float*)d_out;
    p.ws = (char*)d_ws;
    if (ws_size < WS_TOTAL) { fprintf(stderr, "workspace too small: need %zu have %zu\n", (size_t)WS_TOTAL, ws_size); return; }
#ifndef CPU_EMU
    a.bar = (unsigned*)d_ws;
    (void)hipMemsetAsync(d_ws, 0, OFF_BAR_END, stream);
    void* args[] = {&a};
    hipError_t e = hipLaunchCooperativeKernel((const void*)mega, dim3(grid), dim3(NTHR), args, LDS_BYTES, stream);
    if (e != hipSuccess) fprintf(stderr, "cooperative launch failed: %s (grid %d)\n", hipGetErrorString(e), grid);
#else
    LAUNCH(k_body, (size_t)DEPTH * 3 * 6 * DM, b_mod(p, i_)); LAUNCH(k_body, (size_t)NROW * DM, b_copy_x(p, i_)); LAUNCH(k_body, N_CONV, b_conv(p, i_));
    for (int l = 0; l < DEPTH; ++l) {
        LAUNCH(k_body, NROW, b_norm(p, i_, l, 0));
        LAUNCH(k_body, (size_t)NROW * NIN_PAD, b_gemm(p, i_, l, 0));
        LAUNCH(k_body, (size_t)NROW * DB, b_pool_d(p, i_)); LAUNCH(k_body, NROW, b_sgu_vn(p, i_, l)); LAUNCH(k_body, (size_t)2 * NH * NCHK, b_ml_gates(p, i_, l));
        LAUNCH(k_body, (size_t)NROW * DB, b_pool_y(p, i_, l)); LAUNCH(k_body, (size_t)NROW * DB, b_sgu_y(p, i_, l)); LAUNCH(k_body, (size_t)2 * NH * NCHK * DH * DH, b_ml_cloc(p, i_));
        LAUNCH(k_body, (size_t)2 * NH * NSEQ * DH * DH, b_ml_scan(p, i_, l));
        LAUNCH(k_body, (size_t)2 * NH * NROW, b_ml_mt(p, i_));
        LAUNCH(k_body, (size_t)2 * NH * NCHK * LCH * LCH, b_ml_s(p, i_));
        LAUNCH(k_body, (size_t)2 * NROW * DB, b_ml_h(p, i_));
        LAUNCH(k_body, (size_t)NROW * NH, b_ml_fin(p, i_, l));
        LAUNCH(k_body, (size_t)NROW * DM, b_gemm(p, i_, l, 1));
        LAUNCH(k_body, (size_t)NROW * DM, b_gemm(p, i_, l, 2));
        LAUNCH(k_body, NROW, b_norm(p, i_, l, 1));
        LAUNCH(k_body, (size_t)NROW * DFF, b_gemm(p, i_, l, 3));
        LAUNCH(k_body, (size_t)NROW * DM, b_gemm(p, i_, l, 4));
    }
    LAUNCH(k_body, NROW, b_final(p, i_));
#endif
}
```

```cpp
#ifndef CPU_EMU
#include <hip/hip_runtime.h>
#include <cstdio>
#endif
#include <math.h>
#include <stddef.h>
#include <string.h>

#ifndef DM
#define DM 1024
#define NB_CTX 16
#define T_CTX 256
#define DEPTH 4
#define NB_LAT 2
#define T_LAT 1024
#define GRID_W 64
#define DB 512
#endif
#define NG 4
#define GRP (DB / NG)
#define SGU_CHUNK 128
#define NH 4
#define DH (DB / NH)
#define LCH 64
#define DFF (4 * DM)
#define D_IN (7 * DB + 4 * NH + 3 * DM)
#define R_CTX (NB_CTX * T_CTX)
#define R_LAT (NB_LAT * T_LAT)
#define NROW (R_CTX + R_LAT)
#define NCHK (NROW / LCH)
#define NSEQ (NB_CTX + NB_LAT)
#define EPSF 1e-6f
#define C_XP 0
#define C_SU (DB)
#define C_SV (2 * DB)
#define C_Q (3 * DB)
#define C_K (4 * DB)
#define C_V (5 * DB)
#define C_O (6 * DB)
#define C_G (7 * DB)
#define C_BR (7 * DB)
#define PJ (7 * DB + 3 * DM)
#define NIN_PAD (PJ + 256)
typedef unsigned short bf16_t;

#ifdef CPU_EMU
#define NAIVE_ONLY(n) (n)
#else
#define NAIVE_ONLY(n) ((size_t)64)
#endif
constexpr size_t al256(size_t b) { return (b + 255) / 256 * 256; }
constexpr size_t OFF_CNT = 16384;
constexpr size_t OFF_MIXF = OFF_CNT + (size_t)2 * DEPTH * (NROW / 128) * 256 + al256((size_t)3 * DEPTH * ((NROW / 256) * (DM / 256)) * 4);
constexpr size_t OFF_BAR_END = OFF_MIXF + (size_t)DEPTH * 144 * 64;
constexpr size_t OFF_mod = OFF_BAR_END;
constexpr size_t END_mod = OFF_mod + al256(((size_t)DEPTH * 3 * 6 * DM) * 4);
constexpr size_t OFF_x = END_mod;
constexpr size_t END_x = OFF_x + al256(((size_t)NROW * DM) * 4);
constexpr size_t OFF_gate_pre = END_x;
constexpr size_t END_gate_pre = OFF_gate_pre + al256(((size_t)NROW * 16) * 4);
constexpr size_t END_mergedf = END_gate_pre;
constexpr size_t OFF_dbuf = END_mergedf;
constexpr size_t END_dbuf = OFF_dbuf + al256(((size_t)NROW * DB) * 4);
constexpr size_t OFF_vn = END_dbuf;
constexpr size_t END_vn = OFF_vn + al256(((size_t)NROW * DB) * 4);
constexpr size_t OFF_Cloc = END_vn;
constexpr size_t END_Cloc = OFF_Cloc + al256(((size_t)2 * NH * NCHK * DH * DH) * 4);
constexpr size_t OFF_nloc = END_Cloc;
constexpr size_t END_nloc = OFF_nloc + al256(((size_t)2 * NH * NCHK * DH) * 4);
constexpr size_t OFF_bcum = END_nloc;
constexpr size_t END_bcum = OFF_bcum + al256((NAIVE_ONLY((size_t)2 * NH * NROW)) * 4);
constexpr size_t OFF_ival = END_bcum;
constexpr size_t END_ival = OFF_ival + al256((NAIVE_ONLY((size_t)2 * NH * NROW)) * 4);
constexpr size_t OFF_bL = END_ival;
constexpr size_t END_bL = OFF_bL + al256(((size_t)2 * NH * NCHK) * 4);
constexpr size_t OFF_Mloc = END_bL;
constexpr size_t END_Mloc = OFF_Mloc + al256(((size_t)2 * NH * NCHK) * 4);
constexpr size_t OFF_Mprev = END_Mloc;
constexpr size_t END_Mprev = OFF_Mprev + al256(((size_t)2 * NH * NCHK) * 4);
constexpr size_t OFF_MT = END_Mprev;
constexpr size_t END_MT = OFF_MT + al256((NAIVE_ONLY((size_t)2 * NH * NROW)) * 4);
constexpr size_t OFF_S = END_MT;
constexpr size_t END_S = OFF_S + al256((NAIVE_ONLY((size_t)2 * NH * NCHK * LCH * LCH)) * 4);
constexpr size_t OFF_hbuf = END_S;
constexpr size_t END_hbuf = OFF_hbuf + al256((NAIVE_ONLY((size_t)2 * NROW * DB)) * 4);
constexpr size_t OFF_Wt_in = END_hbuf;
constexpr size_t END_Wt_in = OFF_Wt_in + al256(((size_t)DEPTH * NIN_PAD * DM) * 2);
constexpr size_t OFF_Wt_br = END_Wt_in;
constexpr size_t END_Wt_br = OFF_Wt_br + al256(((size_t)DEPTH * 3 * DM * DB) * 2);
constexpr size_t OFF_Wt_out = END_Wt_br;
constexpr size_t END_Wt_out = OFF_Wt_out + al256(((size_t)DEPTH * DM * DM) * 2);
constexpr size_t OFF_Wt_ff1 = END_Wt_out;
constexpr size_t END_Wt_ff1 = OFF_Wt_ff1 + al256(((size_t)DEPTH * DFF * DM) * 2);
constexpr size_t OFF_Wt_ff2 = END_Wt_ff1;
constexpr size_t END_Wt_ff2 = OFF_Wt_ff2 + al256(((size_t)DEPTH * DM * DFF) * 2);
constexpr size_t OFF_u = END_Wt_ff2;
constexpr size_t END_u = OFF_u + al256(((size_t)NROW * DM) * 2);
constexpr size_t OFF_proj = END_u;
constexpr size_t END_proj = OFF_proj + al256(((size_t)NROW * PJ) * 2);
constexpr size_t OFF_ys = END_proj;
constexpr size_t END_ys = OFF_ys + al256(((size_t)NROW * 3 * DB) * 2);
constexpr size_t OFF_merged = END_ys;
constexpr size_t END_merged = OFF_merged + al256(((size_t)NROW * DM) * 2);
constexpr size_t END_hff = END_merged;
constexpr size_t OFF_CprevT = END_hff;
constexpr size_t END_CprevT = OFF_CprevT + al256(((size_t)2 * NH * NCHK * DH * DH) * 2);
constexpr size_t OFF_nprev = END_CprevT;
constexpr size_t END_nprev = OFF_nprev + al256(((size_t)2 * NH * NCHK * DH) * 4);
constexpr size_t OFF_dbf = END_nprev;
constexpr size_t END_dbf = OFF_dbf + al256(((size_t)NROW * DB) * 2);
constexpr size_t OFF_Wt_pool = END_dbf;
constexpr size_t END_Wt_pool = OFF_Wt_pool + al256(((size_t)DEPTH * NG * GRP * GRP) * 2);
constexpr size_t OFF_ssq = END_Wt_pool;
constexpr size_t END_ssq = OFF_ssq + al256(((size_t)2 * DEPTH * NROW * 4) * 4);
constexpr size_t OFF_gsc = END_ssq;
constexpr size_t END_gsc = OFF_gsc + al256(((size_t)3 * 2 * NH * NROW) * 4);
constexpr size_t OFF_VTg = END_gsc;
constexpr size_t END_VTg = OFF_VTg + al256(((size_t)NH * NCHK * DH * LCH) * 2);
constexpr size_t OFF_hbc = END_VTg;
constexpr size_t END_hbc = OFF_hbc + al256(((size_t)2 * R_CTX * DB) * 4);
constexpr size_t WS_TOTAL = END_hbc;
constexpr size_t OFF_mergedf = OFF_dbuf;
constexpr size_t OFF_hff = OFF_proj;
static_assert(END_vn - OFF_dbuf >= (size_t)NROW * DM * 4 && END_dbuf == OFF_vn, "mergedf alias");
static_assert((size_t)NROW * PJ >= (size_t)NROW * DFF, "hff alias");
#ifndef CPU_EMU
#define IN_TAB_OFF 64
#endif
struct P {
#ifdef CPU_EMU
    const float* inp[24];
    const float* in(int i) const { return inp[i]; }
#else
    __device__ __forceinline__ const float* in(int i) const { return (const float*)(*(const __attribute__((address_space(3))) unsigned long long*)(unsigned)(IN_TAB_OFF + 8 * i)); }
#endif
    __device__ __forceinline__ const float* x_prompt() const { return in(0); }
    __device__ __forceinline__ const float* x_sample() const { return in(1); }
    __device__ __forceinline__ const float* state_C() const { return in(2); }
    __device__ __forceinline__ const float* state_n() const { return in(3); }
    __device__ __forceinline__ const float* state_m() const { return in(4); }
    __device__ __forceinline__ const float* c() const { return in(5); }
    __device__ __forceinline__ const float* c_ctx() const { return in(6); }
    __device__ __forceinline__ const float* w_ada() const { return in(7); }
    __device__ __forceinline__ const float* b_ada() const { return in(8); }
    __device__ __forceinline__ const float* g_norm1() const { return in(9); }
    __device__ __forceinline__ const float* g_norm2() const { return in(10); }
    __device__ __forceinline__ const float* w_in() const { return in(11); }
    __device__ __forceinline__ const float* b_gates() const { return in(12); }
    __device__ __forceinline__ const float* w_pool() const { return in(13); }
    __device__ __forceinline__ const float* pool_scale() const { return in(14); }
    __device__ __forceinline__ const float* g_sgu() const { return in(15); }
    __device__ __forceinline__ const float* w_sgu() const { return in(16); }
    __device__ __forceinline__ const float* b_sgu() const { return in(17); }
    __device__ __forceinline__ const float* g_mlstm() const { return in(18); }
    __device__ __forceinline__ const float* w_branch() const { return in(19); }
    __device__ __forceinline__ const float* w_out() const { return in(20); }
    __device__ __forceinline__ const float* w_ff1() const { return in(21); }
    __device__ __forceinline__ const float* w_ff2() const { return in(22); }
    __device__ __forceinline__ const float* g_final() const { return in(23); }
    float* out; char* ws;
    __device__ __forceinline__ float* mod() const { return (float*)(ws + OFF_mod); }
    __device__ __forceinline__ float* x() const { return (float*)(ws + OFF_x); }
    __device__ __forceinline__ float* gate_pre() const { return (float*)(ws + OFF_gate_pre); }
    __device__ __forceinline__ float* mergedf() const { return (float*)(ws + OFF_mergedf); }
    __device__ __forceinline__ float* dbuf() const { return (float*)(ws + OFF_dbuf); }
    __device__ __forceinline__ float* vn() const { return (float*)(ws + OFF_vn); }
    __device__ __forceinline__ float* Cloc() const { return (float*)(ws + OFF_Cloc); }
    __device__ __forceinline__ float* nloc() const { return (float*)(ws + OFF_nloc); }
    __device__ __forceinline__ float* bcum() const { return (float*)(ws + OFF_bcum); }
    __device__ __forceinline__ float* ival() const { return (float*)(ws + OFF_ival); }
    __device__ __forceinline__ float* bL() const { return (float*)(ws + OFF_bL); }
    __device__ __forceinline__ float* Mloc() const { return (float*)(ws + OFF_Mloc); }
    __device__ __forceinline__ float* Mprev() const { return (float*)(ws + OFF_Mprev); }
    __device__ __forceinline__ float* MT() const { return (float*)(ws + OFF_MT); }
    __device__ __forceinline__ float* S() const { return (float*)(ws + OFF_S); }
    __device__ __forceinline__ float* hbuf() const { return (float*)(ws + OFF_hbuf); }
    __device__ __forceinline__ bf16_t* Wt_in() const { return (bf16_t*)(ws + OFF_Wt_in); }
    __device__ __forceinline__ bf16_t* Wt_br() const { return (bf16_t*)(ws + OFF_Wt_br); }
    __device__ __forceinline__ bf16_t* Wt_out() const { return (bf16_t*)(ws + OFF_Wt_out); }
    __device__ __forceinline__ bf16_t* Wt_ff1() const { return (bf16_t*)(ws + OFF_Wt_ff1); }
    __device__ __forceinline__ bf16_t* Wt_ff2() const { return (bf16_t*)(ws + OFF_Wt_ff2); }
    __device__ __forceinline__ bf16_t* u() const { return (bf16_t*)(ws + OFF_u); }
    __device__ __forceinline__ bf16_t* proj() const { return (bf16_t*)(ws + OFF_proj); }
    __device__ __forceinline__ bf16_t* ys() const { return (bf16_t*)(ws + OFF_ys); }
    __device__ __forceinline__ bf16_t* merged() const { return (bf16_t*)(ws + OFF_merged); }
    __device__ __forceinline__ bf16_t* hff() const { return (bf16_t*)(ws + OFF_hff); }
    __device__ __forceinline__ bf16_t* CprevT() const { return (bf16_t*)(ws + OFF_CprevT); }
    __device__ __forceinline__ float* nprev() const { return (float*)(ws + OFF_nprev); }
    __device__ __forceinline__ bf16_t* dbf() const { return (bf16_t*)(ws + OFF_dbf); }
    __device__ __forceinline__ bf16_t* Wt_pool() const { return (bf16_t*)(ws + OFF_Wt_pool); }
    __device__ __forceinline__ float* ssq() const { return (float*)(ws + OFF_ssq); }
    __device__ __forceinline__ float* gsc() const { return (float*)(ws + OFF_gsc); }
    __device__ __forceinline__ bf16_t* VTg() const { return (bf16_t*)(ws + OFF_VTg); }
    __device__ __forceinline__ float* hbc() const { return (float*)(ws + OFF_hbc); }
    __device__ __forceinline__ unsigned* cnt() const { return (unsigned*)(ws + OFF_CNT); }
    __device__ __forceinline__ unsigned* mixf() const { return (unsigned*)(ws + OFF_MIXF); }
    __device__ __forceinline__ bf16_t* C0T() const { return (bf16_t*)(ws + OFF_CprevT); }
};
#ifdef CPU_EMU
static inline unsigned f_as_u(float f) { unsigned u; memcpy(&u, &f, 4); return u; }
static inline float u_as_f(unsigned u) { float f; memcpy(&f, &u, 4); return f; }
#else
__device__ __forceinline__ unsigned f_as_u(float f) { return __float_as_uint(f); }
__device__ __forceinline__ float u_as_f(unsigned u) { return __uint_as_float(u); }
#endif
__device__ __forceinline__ bf16_t f2bf(float f) { unsigned u = f_as_u(f); u += 0x7FFFu + ((u >> 16) & 1u); return (bf16_t)(u >> 16); }
__device__ __forceinline__ float bf2f(bf16_t b) { return u_as_f(((unsigned)b) << 16); }
#define PRJ(row, col) bf2f(p.proj()[(size_t)(row) * PJ + (col)])

__device__ __forceinline__ float sigmoidf_(float x) { return 1.0f / (1.0f + expf(-x)); }
__device__ __forceinline__ float logsigmoidf_(float x) { return fminf(x, 0.0f) - log1pf(expf(-fabsf(x))); }
__device__ __forceinline__ int cond_of_row(int r) { return r < R_CTX ? 0 : 1 + (r - R_CTX) / T_LAT; }
__device__ __forceinline__ int seq_start(int s) { return s < NB_CTX ? s * T_CTX : R_CTX + (s - NB_CTX) * T_LAT; }
__device__ __forceinline__ int seq_len(int s) { return s < NB_CTX ? T_CTX : T_LAT; }

#define GTID ((size_t)blockIdx.x * blockDim.x + threadIdx.x)

__device__ __forceinline__ void b_mod(const P& p, size_t i) {

    int j = i % (6 * DM), ci = (i / (6 * DM)) % 3, l = i / (6 * DM * 3);
    const float* cond = ci == 0 ? p.c_ctx() : p.c() + (size_t)(ci - 1) * DM;
    const float* w = p.w_ada() + (size_t)l * DM * 6 * DM;
    float acc = 0.f;
    for (int k = 0; k < DM; ++k) { float cv = cond[k]; acc += cv * sigmoidf_(cv) * w[(size_t)k * 6 * DM + j]; }
    p.mod()[i] = acc + p.b_ada()[(size_t)l * 6 * DM + j];
}
__device__ __forceinline__ void b_copy_x(const P& p, size_t i) {

    p.x()[i] = i < (size_t)R_CTX * DM ? p.x_prompt()[i] : p.x_sample()[i - (size_t)R_CTX * DM];
}
__device__ __forceinline__ void b_norm(const P& p, size_t r, int l, int which) {

    const float* xr = p.x() + r * DM; float ss = 0.f;
    for (int k = 0; k < DM; ++k) ss += xr[k] * xr[k];
    float rs = 1.0f / sqrtf(ss / DM + EPSF);
    const float* g = (which ? p.g_norm2() : p.g_norm1()) + (size_t)l * DM;
    const float* md = p.mod() + ((size_t)l * 3 + cond_of_row((int)r)) * 6 * DM + (which ? 3 * DM : 0);
    for (int k = 0; k < DM; ++k) p.u()[r * DM + k] = f2bf(xr[k] * rs * g[k] * (1.0f + md[DM + k]) + md[k]);
}
__device__ __forceinline__ void b_conv(const P& p, size_t i) {
    const size_t n_in = (size_t)DEPTH * NIN_PAD * DM, n_br = (size_t)DEPTH * 3 * DM * DB, n_out = (size_t)DEPTH * DM * DM, n_f1 = (size_t)DEPTH * DFF * DM, n_f2 = (size_t)DEPTH * DM * DFF;
    if (i < n_in) { int k = i % DM; int n = (i / DM) % NIN_PAD; int l = i / ((size_t)DM * NIN_PAD);
        int col = n < 7 * DB ? n : (n < PJ ? n + 4 * NH : (n < PJ + 4 * NH ? C_G + (n - PJ) : -1));
        p.Wt_in()[i] = col >= 0 ? f2bf(p.w_in()[((size_t)l * DM + k) * D_IN + col]) : (bf16_t)0; return; }
    i -= n_in;
    if (i < n_br) { int k = i % DB; int n = (i / DB) % DM; int lr = i / ((size_t)DB * DM); p.Wt_br()[i] = f2bf(p.w_branch()[((size_t)lr * DB + k) * DM + n]); return; }
    i -= n_br;
    if (i < n_out) { int k = i % DM; int n = (i / DM) % DM; int l = i / ((size_t)DM * DM); p.Wt_out()[i] = f2bf(p.w_out()[((size_t)l * DM + k) * DM + n]); return; }
    i -= n_out;
    if (i < n_f1) { int k = i % DM; int n = (i / DM) % DFF; int l = i / ((size_t)DM * DFF); p.Wt_ff1()[i] = f2bf(p.w_ff1()[((size_t)l * DM + k) * DFF + n]); return; }
    i -= n_f1;
    if (i < n_f2) { int k = i % DFF; int n = (i / DFF) % DM; int l = i / ((size_t)DFF * DM); p.Wt_ff2()[i] = f2bf(p.w_ff2()[((size_t)l * DFF + k) * DM + n]); return; }
}
#define N_CONV ((size_t)DEPTH * ((size_t)NIN_PAD * DM + (size_t)3 * DM * DB + (size_t)DM * DM + (size_t)2 * DFF * DM))

__device__ __forceinline__ void epi_scalar(const P& p, int l, int mode, int z, int m, int n, float acc) {
    if (mode == 0) { if (n < PJ) p.proj()[(size_t)m * PJ + n] = f2bf(acc); else if (n < PJ + 4 * NH) p.gate_pre()[(size_t)m * 16 + (n - PJ)] = acc; }
    else if (mode == 1) { float g = sigmoidf_(PRJ(m, C_BR + z * DM + n)) * acc; float* t = p.mergedf() + (size_t)m * DM + n;
        if (z == 0) *t = g; else if (z == 1) *t += g; else p.merged()[(size_t)m * DM + n] = f2bf(*t + g); }
    else if (mode == 2) p.x()[(size_t)m * DM + n] += p.mod()[((size_t)l * 3 + cond_of_row(m)) * 6 * DM + 2 * DM + n] * acc;
    else if (mode == 3) { float r = fmaxf(acc, 0.f); p.hff()[(size_t)m * DFF + n] = f2bf(r * r); }
    else p.x()[(size_t)m * DM + n] += p.mod()[((size_t)l * 3 + cond_of_row(m)) * 6 * DM + 5 * DM + n] * acc;
}
struct GemmArgs { const bf16_t* A; const bf16_t* Bt; int lda, ldb, K, M, N, nZ; long zA, zB; };
__device__ __forceinline__ GemmArgs gemm_args(const P& p, int l, int mode) {
    GemmArgs g;
    if (mode == 0) g = GemmArgs{p.u(), p.Wt_in() + (size_t)l * NIN_PAD * DM, DM, DM, DM, NROW, NIN_PAD, 1, 0, 0};
    else if (mode == 1) g = GemmArgs{p.ys(), p.Wt_br() + (size_t)l * 3 * DM * DB, 3 * DB, DB, DB, NROW, DM, 3, DB, (long)DM * DB};
    else if (mode == 2) g = GemmArgs{p.merged(), p.Wt_out() + (size_t)l * DM * DM, DM, DM, DM, NROW, DM, 1, 0, 0};
    else if (mode == 3) g = GemmArgs{p.u(), p.Wt_ff1() + (size_t)l * DFF * DM, DM, DM, DM, NROW, DFF, 1, 0, 0};
    else g = GemmArgs{p.hff(), p.Wt_ff2() + (size_t)l * DM * DFF, DFF, DFF, DFF, NROW, DM, 1, 0, 0};
    return g;
}
#ifdef CPU_EMU
__device__ __forceinline__ void b_gemm(const P& p, size_t i, int l, int mode) {
    GemmArgs g = gemm_args(p, l, mode);
    int n = i % g.N; int m = i / g.N;
    for (int z = 0; z < g.nZ; ++z) { const bf16_t* a = g.A + z * g.zA + (size_t)m * g.lda; const bf16_t* b = g.Bt + z * g.zB + (size_t)n * g.ldb; float acc = 0.f;
        for (int k = 0; k < g.K; ++k) acc += bf2f(a[k]) * bf2f(b[k]);
        epi_scalar(p, l, mode, z, m, n, acc); }
}
#else
namespace pg8 {
#define PG8_LAS __attribute__((address_space(3)))
typedef short bf16x8 __attribute__((ext_vector_type(8)));
typedef float f32x4 __attribute__((ext_vector_type(4)));
typedef unsigned u32x4 __attribute__((ext_vector_type(4)));
typedef unsigned u32x2 __attribute__((ext_vector_type(2)));
constexpr int BM = 256, BK = 64, HALF = 128, HTB = HALF * BK * 2, STAGE_BYTES = 8 * HTB, NXCD = 8, WGM = 8;
__host__ __device__ __forceinline__ int lds_byte(int r, int c) { const int st = (r >> 4) * 2 + (c >> 5), rr = r & 15, cc = c & 31, ob = rr * 64 + cc * 2; return st * 1024 + (ob ^ (((ob >> 9) & 1) << 5)); }
__host__ __device__ __forceinline__ void stage_rc(int b, int& R, int& C) { const int st = b / 1024, sb = b % 1024, swz = sb ^ (((sb >> 9) & 1) << 5); R = (st >> 1) * 16 + swz / 64; C = (st & 1) * 32 + (swz % 64) / 2; }
__host__ __device__ __forceinline__ int perm32(int rho) { const int n = rho >> 4, i = rho & 15; return 8 * (i >> 2) + 4 * n + (i & 3); }
struct Unit { int pm, pn, z; };
struct Order {
    int nM, nN, nZ, nwg, G, c;
    __device__ void init(int M, int N, int nZ_, int G_, int c_) { nM = M / BM; nN = N / BM; nZ = nZ_; nwg = nM * nN; G = G_; c = c_; }
    __device__ bool next(int i, Unit& u) const {
        const int ti = i / nZ; u.z = i - ti * nZ;
        const long L = (long)ti * G + c; if (L >= nwg) return false;
        int wgid = (int)L; { const int q = nwg / NXCD, r = nwg % NXCD, xcd = wgid % NXCD, off = wgid / NXCD; wgid = (xcd < r ? xcd * (q + 1) : r * (q + 1) + (xcd - r) * q) + off; }
        const int nig = WGM * nN, gid = wgid / nig, fm = gid * WGM, gsz = (nM - fm) < WGM ? (nM - fm) : WGM;
        u.pm = fm + ((wgid % nig) % gsz); u.pn = (wgid % nig) / gsz; return true;
    }
};
__device__ __forceinline__ void st16_wt(void* base_uniform, unsigned byte_off, u32x4 v) {
    const __amdgpu_buffer_rsrc_t r = __builtin_amdgcn_make_buffer_rsrc(base_uniform, (short)0, 0x7fffffff, 0x00020000);
    __builtin_amdgcn_raw_buffer_store_b128(v, r, byte_off, 0, 16); }
typedef __bf16 bf16x2v __attribute__((ext_vector_type(2)));
__device__ __forceinline__ unsigned cvt_pk_bf16(float lo, float hi) { bf16x2v v; v.x = (__bf16)lo; v.y = (__bf16)hi; return __builtin_bit_cast(unsigned, v); }
__device__ __forceinline__ float bf_lo(unsigned w) { return __uint_as_float(w << 16); }
__device__ __forceinline__ float bf_hi(unsigned w) { return __uint_as_float(w & 0xffff0000u); }

template <int MODE> struct Epi {
    static constexpr bool PERM = (MODE == 0 || MODE == 1 || MODE == 3);
    P p; int l;
    __device__ __forceinline__ void operator()(const f32x4 (&acc)[2][2][4][2], const Unit& u, int wr, int wc, int fr, int fq) const {
        const int row0 = u.pm * BM + wr * 64 + fr;
        if constexpr (PERM) {
            const int col0 = u.pn * BM + wc * 32 + 8 * fq;
#pragma unroll
            for (int ai = 0; ai < 2; ++ai)
#pragma unroll
                for (int m = 0; m < 4; ++m) { const int row = row0 + ai * HALF + m * 16;
#pragma unroll
                    for (int bj = 0; bj < 2; ++bj) { const int col = col0 + bj * HALF; f32x4 v0 = acc[ai][bj][m][0], v1 = acc[ai][bj][m][1];
                        if constexpr (MODE == 0) {
                            if (col < PJ) { u32x4 w; w.x = cvt_pk_bf16(v0[0], v0[1]); w.y = cvt_pk_bf16(v0[2], v0[3]); w.z = cvt_pk_bf16(v1[0], v1[1]); w.w = cvt_pk_bf16(v1[2], v1[3]); st16_wt(p.proj(), (unsigned)(row * PJ + col) * 2u, w); }
                            else if (col < PJ + 16) { float* g = p.gate_pre() + (size_t)row * 16 + (col - PJ); *(f32x4*)g = v0; *(f32x4*)(g + 4) = v1; }
                        } else if constexpr (MODE == 1) {
                            const u32x4 gw = *(const u32x4*)(p.proj() + (size_t)row * PJ + C_BR + u.z * DM + col);
                            f32x4 g0, g1; g0[0] = bf_lo(gw.x); g0[1] = bf_hi(gw.x); g0[2] = bf_lo(gw.y); g0[3] = bf_hi(gw.y); g1[0] = bf_lo(gw.z); g1[1] = bf_hi(gw.z); g1[2] = bf_lo(gw.w); g1[3] = bf_hi(gw.w);
#pragma unroll
                            for (int j = 0; j < 4; ++j) { v0[j] *= __builtin_amdgcn_rcpf(1.0f + __expf(-g0[j])); v1[j] *= __builtin_amdgcn_rcpf(1.0f + __expf(-g1[j])); }
                            float* t = p.mergedf() + (size_t)row * DM + col;
                            if (u.z == 0) { *(f32x4*)t = v0; *(f32x4*)(t + 4) = v1; }
                            else if (u.z == 1) { *(f32x4*)t = *(f32x4*)t + v0; *(f32x4*)(t + 4) = *(f32x4*)(t + 4) + v1; }
                            else { v0 = v0 + *(f32x4*)t; v1 = v1 + *(f32x4*)(t + 4); u32x4 w; w.x = cvt_pk_bf16(v0[0], v0[1]); w.y = cvt_pk_bf16(v0[2], v0[3]); w.z = cvt_pk_bf16(v1[0], v1[1]); w.w = cvt_pk_bf16(v1[2], v1[3]); *(u32x4*)(p.merged() + (size_t)row * DM + col) = w; }
                        } else {
#pragma unroll
                            for (int j = 0; j < 4; ++j) { float a = fmaxf(v0[j], 0.f), b = fmaxf(v1[j], 0.f); v0[j] = a * a; v1[j] = b * b; }
                            u32x4 w; w.x = cvt_pk_bf16(v0[0], v0[1]); w.y = cvt_pk_bf16(v0[2], v0[3]); w.z = cvt_pk_bf16(v1[0], v1[1]); w.w = cvt_pk_bf16(v1[2], v1[3]); st16_wt(p.hff(), (unsigned)(row * DFF + col) * 2u, w);
                        } } }
        } else {
            const int col0 = u.pn * BM + wc * 32 + 4 * fq;
#pragma unroll
            for (int ai = 0; ai < 2; ++ai)
#pragma unroll
                for (int m = 0; m < 4; ++m) { const int row = row0 + ai * HALF + m * 16;
                    const float* gt = p.mod() + ((size_t)l * 3 + cond_of_row(row)) * 6 * DM + (MODE == 2 ? 2 : 5) * DM; float* xr = p.x() + (size_t)row * DM;
#pragma unroll
                    for (int bj = 0; bj < 2; ++bj)
#pragma unroll
                        for (int n = 0; n < 2; ++n) { const int col = col0 + bj * HALF + n * 16; *(f32x4*)(xr + col) = *(f32x4*)(xr + col) + *(const f32x4*)(gt + col) * acc[ai][bj][m][n]; } }
        }
    }
};

template <class EpiT, class OrderT, bool ALIGN_EPI, bool SP2, bool LAST_DRAIN>
__device__ __forceinline__ void gemm_phase(PG8_LAS unsigned char* lds, const GemmArgs g, const OrderT& S, const EpiT& E) {
    int tid = threadIdx.x; asm volatile("" : "+v"(tid));
    const int wid = __builtin_amdgcn_readfirstlane(tid >> 6), lane = tid & 63, wr = wid >> 2, wc = wid & 3, fr = lane & 15, fq = lane >> 4;
    const int nt = g.K / BK;
    unsigned voffA[2], voffB[2];
#pragma unroll
    for (int i = 0; i < 2; ++i) { int R, C; stage_rc(tid * 16 + i * 8192, R, C); const int Rb = EpiT::PERM ? ((R & ~31) + perm32(R & 31)) : R;
        voffA[i] = (unsigned)(R * g.lda + C) * 2u; voffB[i] = (unsigned)(Rb * g.ldb + C) * 2u; }
    const size_t kstep = (size_t)(BK * 2);
    const size_t hstepA = (size_t)HALF * g.lda * 2, hstepB = (size_t)HALF * g.ldb * 2;
    const unsigned ldsw = (unsigned)wid * 1024u;
    const int aoff = lds_byte(wr * 64 + fr, fq * 8), boff = lds_byte(wc * 32 + fr, fq * 8);
#define PG8_SA(b, h) (((b) * 2 + (h)) * HTB)
#define PG8_SB(b, h) ((4 + (b) * 2 + (h)) * HTB)
#define PG8_STAGE(bufoff, gbase, voff) do { _Pragma("unroll") for (int _i = 0; _i < 2; ++_i) \
        __builtin_amdgcn_global_load_lds((const unsigned*)((const char*)(gbase) + (voff)[_i]), (PG8_LAS unsigned*)(lds + (bufoff) + ldsw + _i * 8192), 16, 0, 0); } while (0)
#define PG8_LDA(dst, b, h) do { _Pragma("unroll") for (int m = 0; m < 4; ++m) _Pragma("unroll") for (int k = 0; k < 2; ++k) dst[m][k] = *(const PG8_LAS bf16x8*)(lds + PG8_SA(b, h) + aoff + m * 2048 + k * 1024); } while (0)
#define PG8_LDB(dst, b, h) do { _Pragma("unroll") for (int n = 0; n < 2; ++n) _Pragma("unroll") for (int k = 0; k < 2; ++k) dst[n][k] = *(const PG8_LAS bf16x8*)(lds + PG8_SB(b, h) + boff + n * 2048 + k * 1024); } while (0)
#define PG8_MMA(ai, bj, At, Bt) do { __builtin_amdgcn_s_setprio(1); _Pragma("unroll") for (int m = 0; m < 4; ++m) _Pragma("unroll") for (int n = 0; n < 2; ++n) _Pragma("unroll") for (int k = 0; k < 2; ++k) \
        acc[ai][bj][m][n] = __builtin_amdgcn_mfma_f32_16x16x32_bf16(Bt[n][k], At[m][k], acc[ai][bj][m][n], 0, 0, 0); __builtin_amdgcn_s_setprio(0); } while (0)
#define PG8_WAIT_V(n) asm volatile("s_waitcnt vmcnt(" #n ")" ::: "memory")
#define PG8_WAIT_L(n) asm volatile("s_waitcnt lgkmcnt(" #n ")" ::: "memory")
#define PG8_BAR __builtin_amdgcn_s_barrier()
#define PG8_SCHED __builtin_amdgcn_sched_barrier(0)
#define PG8_APTR(u) ((const char*)(g.A + (size_t)(u).z * g.zA + (size_t)(u).pm * BM * g.lda))
#define PG8_BPTR(u) ((const char*)(g.Bt + (size_t)(u).z * g.zB + (size_t)(u).pn * BM * g.ldb))
    Unit cur, nxt; int ui = 0;
    if (!S.next(0, cur)) return;
    f32x4 acc[2][2][4][2];
#pragma unroll
    for (int a = 0; a < 2; ++a)
#pragma unroll
        for (int b = 0; b < 2; ++b)
#pragma unroll
            for (int m = 0; m < 4; ++m)
#pragma unroll
                for (int n = 0; n < 2; ++n) acc[a][b][m][n] = (f32x4){0.f, 0.f, 0.f, 0.f};
    const char* cA = PG8_APTR(cur); const char* cB = PG8_BPTR(cur);
    if constexpr (SP2) {
        PG8_STAGE(PG8_SB(0, 0), cB, voffB); PG8_STAGE(PG8_SB(0, 1), cB + hstepB, voffB); PG8_STAGE(PG8_SA(0, 0), cA, voffA); PG8_STAGE(PG8_SA(0, 1), cA + hstepA, voffA);
        if (wr == 1) PG8_BAR;
        PG8_WAIT_V(2); PG8_BAR;
        PG8_STAGE(PG8_SB(1, 0), cB + kstep, voffB); PG8_STAGE(PG8_SA(1, 0), cA + kstep, voffA); PG8_STAGE(PG8_SB(1, 1), cB + hstepB + kstep, voffB);
        PG8_WAIT_V(6); PG8_BAR;
    } else {
        PG8_STAGE(PG8_SB(0, 0), cB, voffB); PG8_STAGE(PG8_SA(0, 0), cA, voffA); PG8_STAGE(PG8_SB(0, 1), cB + hstepB, voffB); PG8_STAGE(PG8_SA(0, 1), cA + hstepA, voffA);
        if (wr == 1) PG8_BAR;
        PG8_WAIT_V(4); PG8_BAR;
        PG8_STAGE(PG8_SB(1, 0), cB + kstep, voffB); PG8_STAGE(PG8_SA(1, 0), cA + kstep, voffA); PG8_STAGE(PG8_SB(1, 1), cB + hstepB + kstep, voffB);
        PG8_WAIT_V(6); PG8_BAR;
    }
    for (;;) {
        const bool has_next = S.next(ui + 1, nxt);
        const char* nA = has_next ? PG8_APTR(nxt) : cA; const char* nB = has_next ? PG8_BPTR(nxt) : cB;
        for (int t = 0; t < nt; t += 2) {
            bf16x8 At[4][2], B0[2][2], B1[2][2];
            const bool last = (t == nt - 2);
            const char* a1 = cA + (size_t)(t + 1) * kstep;
            const char* a2 = last ? nA : cA + (size_t)(t + 2) * kstep; const char* b2 = last ? nB : cB + (size_t)(t + 2) * kstep;
            const char* a3 = a2 + kstep; const char* b3 = b2 + kstep;
            if constexpr (SP2) {
            PG8_LDB(B0, 0, 0); PG8_LDB(B1, 0, 1); PG8_SCHED; PG8_LDA(At, 0, 0); PG8_STAGE(PG8_SA(1, 1), a1 + hstepA, voffA);
            PG8_WAIT_V(8); PG8_WAIT_L(0); PG8_BAR; PG8_MMA(0, 0, At, B0); PG8_MMA(0, 1, At, B1); PG8_BAR; PG8_SCHED;
            PG8_LDA(At, 0, 1); PG8_STAGE(PG8_SB(0, 0), b2, voffB); PG8_STAGE(PG8_SB(0, 1), b2 + hstepB, voffB); PG8_STAGE(PG8_SA(0, 0), a2, voffA);
            PG8_WAIT_V(8); PG8_WAIT_L(0); PG8_BAR; PG8_MMA(1, 0, At, B0); PG8_MMA(1, 1, At, B1); PG8_BAR; PG8_SCHED;
            PG8_LDB(B0, 1, 0); PG8_LDB(B1, 1, 1); PG8_SCHED; PG8_LDA(At, 1, 0); PG8_STAGE(PG8_SA(0, 1), a2 + hstepA, voffA);
            PG8_WAIT_V(8); PG8_WAIT_L(0); PG8_BAR; PG8_MMA(0, 0, At, B0); PG8_MMA(0, 1, At, B1); PG8_BAR; PG8_SCHED;
            PG8_LDA(At, 1, 1); PG8_STAGE(PG8_SB(1, 0), b3, voffB); PG8_STAGE(PG8_SB(1, 1), b3 + hstepB, voffB); PG8_STAGE(PG8_SA(1, 0), a3, voffA);
            PG8_WAIT_V(8); PG8_WAIT_L(0); PG8_BAR; PG8_MMA(1, 0, At, B0); PG8_MMA(1, 1, At, B1); PG8_BAR; PG8_SCHED;
            } else {
            PG8_LDB(B0, 0, 0); PG8_SCHED; PG8_LDA(At, 0, 0); PG8_STAGE(PG8_SA(1, 1), a1 + hstepA, voffA);
            PG8_WAIT_L(8); PG8_BAR; PG8_WAIT_L(0); PG8_MMA(0, 0, At, B0); PG8_BAR; PG8_SCHED;
            PG8_LDB(B1, 0, 1); PG8_STAGE(PG8_SB(0, 0), b2, voffB);
            PG8_BAR; PG8_WAIT_L(0); PG8_MMA(0, 1, At, B1); PG8_BAR;
            PG8_LDA(At, 0, 1); PG8_STAGE(PG8_SA(0, 0), a2, voffA);
            PG8_BAR; PG8_WAIT_L(0); PG8_MMA(1, 0, At, B0); PG8_BAR; PG8_SCHED;
            PG8_STAGE(PG8_SB(0, 1), b2 + hstepB, voffB);
            PG8_WAIT_V(6); PG8_BAR; PG8_MMA(1, 1, At, B1); PG8_BAR;
            PG8_LDB(B0, 1, 0); PG8_SCHED; PG8_LDA(At, 1, 0); PG8_STAGE(PG8_SA(0, 1), a2 + hstepA, voffA);
            PG8_WAIT_L(8); PG8_BAR; PG8_WAIT_L(0); PG8_MMA(0, 0, At, B0); PG8_BAR; PG8_SCHED;
            PG8_LDB(B1, 1, 1); PG8_STAGE(PG8_SB(1, 0), b3, voffB);
            PG8_BAR; PG8_WAIT_L(0); PG8_MMA(0, 1, At, B1); PG8_BAR;
            PG8_LDA(At, 1, 1); PG8_STAGE(PG8_SA(1, 0), a3, voffA);
            PG8_BAR; PG8_WAIT_L(0); PG8_MMA(1, 0, At, B0); PG8_BAR; PG8_SCHED;
            PG8_STAGE(PG8_SB(1, 1), b3 + hstepB, voffB);
            PG8_WAIT_V(6); PG8_BAR; PG8_MMA(1, 1, At, B1); PG8_BAR;
            }
        }
        if constexpr (ALIGN_EPI) { if (wr == 0) PG8_BAR; }
        if constexpr (LAST_DRAIN) { if (has_next) E(acc, cur, wr, wc, fr, fq, tid); } else E(acc, cur, wr, wc, fr, fq);
        if (!has_next) break;
#pragma unroll
        for (int a = 0; a < 2; ++a)
#pragma unroll
            for (int b = 0; b < 2; ++b)
#pragma unroll
                for (int m = 0; m < 4; ++m)
#pragma unroll
                    for (int n = 0; n < 2; ++n) acc[a][b][m][n] = (f32x4){0.f, 0.f, 0.f, 0.f};
        cur = nxt; cA = nA; cB = nB; ++ui;
        if constexpr (ALIGN_EPI) { if (wr == 1) PG8_BAR; }
    }
    PG8_WAIT_V(0);
    if constexpr (!ALIGN_EPI) { if (wr == 0) PG8_BAR; }
    PG8_BAR;
    if constexpr (LAST_DRAIN) E.fused(acc, cur, wr, wc, fr, fq, lds, tid);
#undef PG8_SA
#undef PG8_SB
#undef PG8_STAGE
#undef PG8_LDA
#undef PG8_LDB
#undef PG8_MMA
#undef PG8_WAIT_V
#undef PG8_WAIT_L
#undef PG8_BAR
#undef PG8_SCHED
#undef PG8_APTR
#undef PG8_BPTR
}
}
namespace pg8 {
constexpr int STG = 3 * HTB;
struct Order128 {
    int nM, nN, nZ, nwg, G, c;
    __device__ void init(int M, int N, int nZ_, int G_, int c_) { nM = M / HALF; nN = N / BM; nZ = nZ_; nwg = nM * nN; G = G_; c = c_; }
    __device__ bool next(int i, Unit& u) const {
        const int ti = i / nZ; u.z = i - ti * nZ;
        const long L = (long)ti * G + c; if (L >= nwg) return false;
        int wgid = (int)L; { const int q = nwg / NXCD, r = nwg % NXCD, xcd = wgid % NXCD, off = wgid / NXCD; wgid = (xcd < r ? xcd * (q + 1) : r * (q + 1) + (xcd - r) * q) + off; }
        const int nig = WGM * nN, gid = wgid / nig, fm = gid * WGM, gsz = (nM - fm) < WGM ? (nM - fm) : WGM;
        u.pm = fm + ((wgid % nig) % gsz); u.pn = (wgid % nig) / gsz; return true;
    }
};
template <int MODE> struct Epi128 {
    static constexpr bool PERM = (MODE == 1), AFTER_DRAIN = (MODE != 1);
    P p; int l; float gsc;
    mutable u32x2 rsum[2][4][2];
    __device__ __forceinline__ void operator()(f32x4 (&acc)[2][4][2], const Unit& u, int wr_, int wc_, int fr_, int fq_) const {
        if constexpr (MODE == 1) {
            int tid = threadIdx.x; asm volatile("" : "+v"(tid));
            const int wid = __builtin_amdgcn_readfirstlane(tid >> 6), lane = tid & 63, wr = wid >> 2, wc = wid & 3, fr = lane & 15, fq = lane >> 4;
            const int row0 = u.pm * HALF + wr * 64 + fr, col0 = u.pn * BM + wc * 32 + 8 * fq;
            { u32x4 gw[4][2];
#pragma unroll
              for (int m = 0; m < 4; ++m)
#pragma unroll
                  for (int bj = 0; bj < 2; ++bj) gw[m][bj] = *(const u32x4*)(p.proj() + (size_t)(row0 + m * 16) * PJ + C_BR + u.z * DM + col0 + bj * HALF);
#pragma unroll
              for (int m = 0; m < 4; ++m) {
#pragma unroll
                  for (int bj = 0; bj < 2; ++bj) { const u32x4 g = gw[m][bj]; const float g0[4] = {bf_lo(g.x), bf_hi(g.x), bf_lo(g.y), bf_hi(g.y)}, g1[4] = {bf_lo(g.z), bf_hi(g.z), bf_lo(g.w), bf_hi(g.w)};
#pragma unroll
                      for (int j = 0; j < 4; ++j) { acc[bj][m][0][j] *= __builtin_amdgcn_rcpf(1.0f + __expf(-g0[j])); acc[bj][m][1][j] *= __builtin_amdgcn_rcpf(1.0f + __expf(-g1[j])); } }
                  asm volatile("" : "+v"(acc[0][m][0]), "+v"(acc[0][m][1]), "+v"(acc[1][m][0]), "+v"(acc[1][m][1]) :: "memory"); } }
#pragma unroll
            for (int m = 0; m < 4; ++m)
#pragma unroll
                for (int bj = 0; bj < 2; ++bj)
#pragma unroll
                    for (int n = 0; n < 2; ++n) { f32x4 v = acc[bj][m][n];
                        if (u.z != 0) { const u32x2 s = rsum[bj][m][n]; v[0] += bf_lo(s.x); v[1] += bf_hi(s.x); v[2] += bf_lo(s.y); v[3] += bf_hi(s.y); }
                        u32x2 w; w.x = cvt_pk_bf16(v[0], v[1]); w.y = cvt_pk_bf16(v[2], v[3]); rsum[bj][m][n] = w; }
            if (u.z == 2) {
#pragma unroll
                for (int m = 0; m < 4; ++m)
#pragma unroll
                    for (int bj = 0; bj < 2; ++bj) { const size_t o = (size_t)(row0 + m * 16) * DM + col0 + bj * HALF; u32x4 w; w.x = rsum[bj][m][0].x; w.y = rsum[bj][m][0].y; w.z = rsum[bj][m][1].x; w.w = rsum[bj][m][1].y;
                        st16_wt(p.merged(), (unsigned)o * 2u, w); } }
        }
    }
    __device__ __forceinline__ void fused(f32x4 (&acc)[2][4][2], const Unit& u, int wr_, int wc_, int fr_, int fq_, PG8_LAS unsigned char* lds, int tid_) const {
        int tid = tid_; asm volatile("" : "+v"(tid));
        const int wid = __builtin_amdgcn_readfirstlane(tid >> 6), lane = tid & 63, wr = wid >> 2, wc = wid & 3, fr = lane & 15, fq = lane >> 4;
        const int row0 = u.pm * HALF + wr * 64 + fr, col0 = u.pn * BM + wc * 32 + 4 * fq, ci = cond_of_row(u.pm * HALF);
        const float* gt = p.mod() + ((size_t)l * 3 + ci) * 6 * DM + (MODE == 2 ? 2 : 5) * DM;
        f32x4 gv[2][2], xv[4][2][2];
#pragma unroll
        for (int bj = 0; bj < 2; ++bj)
#pragma unroll
            for (int n = 0; n < 2; ++n) gv[bj][n] = *(const f32x4*)(gt + col0 + bj * HALF + n * 16) * gsc;
#pragma unroll
        for (int m = 0; m < 4; ++m)
#pragma unroll
            for (int bj = 0; bj < 2; ++bj)
#pragma unroll
                for (int n = 0; n < 2; ++n) xv[m][bj][n] = *(const f32x4*)(p.x() + (size_t)(row0 + m * 16) * DM + col0 + bj * HALF + n * 16);
        PG8_LAS float* Pp = (PG8_LAS float*)lds;
        PG8_LAS float* Rr = Pp + 512;
#pragma unroll
        for (int m = 0; m < 4; ++m) { float s = 0.f;
#pragma unroll
            for (int bj = 0; bj < 2; ++bj)
#pragma unroll
                for (int n = 0; n < 2; ++n) { const f32x4 v = xv[m][bj][n] + gv[bj][n] * acc[bj][m][n]; xv[m][bj][n] = v; s += v[0] * v[0] + v[1] * v[1] + v[2] * v[2] + v[3] * v[3]; }
            s += __shfl_xor(s, 16, 64); s += __shfl_xor(s, 32, 64);
            if (fq == 0) Pp[(wr * 64 + m * 16 + fr) * 4 + wc] = s; }
        asm volatile("" ::: "memory");
        const int kind = MODE == 2 ? 0 : 1;
        float* slots = p.ssq() + ((size_t)(kind * DEPTH + l) * NROW + (size_t)u.pm * HALF) * 4;
        unsigned* cnt = p.cnt() + ((size_t)(kind * DEPTH + l) * (NROW / HALF) + u.pm) * 64;
        __syncthreads();
        if (tid < HALF) { const float t = (Pp[tid * 4] + Pp[tid * 4 + 1]) + (Pp[tid * 4 + 2] + Pp[tid * 4 + 3]); __hip_atomic_store(slots + tid * 4 + u.pn, t, __ATOMIC_RELAXED, __HIP_MEMORY_SCOPE_AGENT); }
        asm volatile("s_waitcnt vmcnt(0)" ::: "memory");
        __syncthreads();
        if (tid == 0) { __hip_atomic_fetch_add(cnt, 1u, __ATOMIC_RELAXED, __HIP_MEMORY_SCOPE_AGENT);
            unsigned sp = 0; while (__hip_atomic_load(cnt, __ATOMIC_RELAXED, __HIP_MEMORY_SCOPE_AGENT) < (unsigned)(DM / BM)) { __builtin_amdgcn_s_sleep(2); if (++sp > (1u << 22)) break; }
            }
        __syncthreads();
        if (tid < HALF) { float t = 0.f;
#pragma unroll
            for (int q = 0; q < DM / BM; ++q) t += __hip_atomic_load(slots + tid * 4 + q, __ATOMIC_RELAXED, __HIP_MEMORY_SCOPE_AGENT);
            Rr[tid] = 1.0f / sqrtf(t * (1.0f / DM) + EPSF); }
#pragma unroll
        for (int m = 0; m < 4; ++m)
#pragma unroll
            for (int bj = 0; bj < 2; ++bj)
#pragma unroll
                for (int n = 0; n < 2; ++n) *(f32x4*)(p.x() + (size_t)(row0 + m * 16) * DM + col0 + bj * HALF + n * 16) = xv[m][bj][n];
        __syncthreads();
        const bool fin = (MODE == 4 && l == DEPTH - 1);
        const int ln = MODE == 2 ? l : l + 1;
        const float* gn = fin ? p.g_final() : (MODE == 2 ? p.g_norm2() : p.g_norm1()) + (size_t)ln * DM;
        const float* md = p.mod() + ((size_t)(fin ? 0 : ln) * 3 + ci) * 6 * DM + (MODE == 2 ? 3 * DM : 0);
#pragma unroll
        for (int bj = 0; bj < 2; ++bj)
#pragma unroll
            for (int n = 0; n < 2; ++n) { const int col = col0 + bj * HALF + n * 16; f32x4 gg = *(const f32x4*)(gn + col), sh = {0.f, 0.f, 0.f, 0.f};
                if (!fin) { gg = gg * (*(const f32x4*)(md + DM + col) + 1.0f); sh = *(const f32x4*)(md + col); }
#pragma unroll
                for (int m = 0; m < 4; ++m) { const int r = wr * 64 + m * 16 + fr; const f32x4 o = xv[m][bj][n] * Rr[r] * gg + sh; const size_t off = (size_t)(u.pm * HALF + r) * DM + col;
                    if (fin) *(f32x4*)(p.out + off) = o;
                    else { u32x2 w; w.x = cvt_pk_bf16(o[0], o[1]); w.y = cvt_pk_bf16(o[2], o[3]); *(u32x2*)(p.u() + off) = w; } } }
    }
};
template <class EpiT>
__device__ __forceinline__ void gemm128_phase(PG8_LAS unsigned char* lds, const GemmArgs g, const Order128& S, const EpiT& E) {
    int tid = threadIdx.x; asm volatile("" : "+v"(tid));
    const int wid = __builtin_amdgcn_readfirstlane(tid >> 6), lane = tid & 63, wr = wid >> 2, wc = wid & 3, fr = lane & 15, fq = lane >> 4;
    const int nt = g.K / BK;
    unsigned voffA[2], voffB[2];
#pragma unroll
    for (int i = 0; i < 2; ++i) { int R, C; stage_rc(tid * 16 + i * 8192, R, C); const int Rb = EpiT::PERM ? ((R & ~31) + perm32(R & 31)) : R;
        voffA[i] = (unsigned)(R * g.lda + C) * 2u; voffB[i] = (unsigned)(Rb * g.ldb + C) * 2u; }
    const size_t kstep = (size_t)(BK * 2);
    const size_t hstepB = (size_t)HALF * g.ldb * 2;
    const unsigned ldsw = (unsigned)wid * 1024u;
    const int aoff = lds_byte(wr * 64 + fr, fq * 8), boff = lds_byte(wc * 32 + fr, fq * 8);
#define G1_STAGE(bufoff, gbase, voff) do { _Pragma("unroll") for (int _i = 0; _i < 2; ++_i) \
        __builtin_amdgcn_global_load_lds((const unsigned*)((const char*)(gbase) + (voff)[_i]), (PG8_LAS unsigned*)(lds + (bufoff) + ldsw + _i * 8192), 16, 0, 0); } while (0)
#define G1_STAGE3(so, pa, pb) do { G1_STAGE((so) + HTB, (pb), voffB); G1_STAGE((so) + 2 * HTB, (pb) + hstepB, voffB); G1_STAGE((so), (pa), voffA); } while (0)
#define G1_LDA(dst, so) do { _Pragma("unroll") for (int m = 0; m < 4; ++m) _Pragma("unroll") for (int k = 0; k < 2; ++k) dst[m][k] = *(const PG8_LAS bf16x8*)(lds + (so) + aoff + m * 2048 + k * 1024); } while (0)
#define G1_LDB(dst, so, h) do { _Pragma("unroll") for (int n = 0; n < 2; ++n) _Pragma("unroll") for (int k = 0; k < 2; ++k) dst[n][k] = *(const PG8_LAS bf16x8*)(lds + (so) + (1 + (h)) * HTB + boff + n * 2048 + k * 1024); } while (0)
#define G1_MMA(bj, At, Bt) do { _Pragma("unroll") for (int m = 0; m < 4; ++m) _Pragma("unroll") for (int n = 0; n < 2; ++n) _Pragma("unroll") for (int k = 0; k < 2; ++k) \
        acc[bj][m][n] = __builtin_amdgcn_mfma_f32_16x16x32_bf16(Bt[n][k], At[m][k], acc[bj][m][n], 0, 0, 0); } while (0)
#define G1_WAIT_V(n) asm volatile("s_waitcnt vmcnt(" #n ")" ::: "memory")
#define G1_WAIT_L(n) asm volatile("s_waitcnt lgkmcnt(" #n ")" ::: "memory")
#define G1_BAR __builtin_amdgcn_s_barrier()
#define G1_SCHED __builtin_amdgcn_sched_barrier(0)
#define G1_APTR(u) ((const char*)(g.A + (size_t)(u).z * g.zA + (size_t)(u).pm * HALF * g.lda))
#define G1_BPTR(u) ((const char*)(g.Bt + (size_t)(u).z * g.zB + (size_t)(u).pn * BM * g.ldb))
    Unit cur;
    if (!S.next(0, cur)) return;
    f32x4 acc[2][4][2];
#pragma unroll
    for (int b = 0; b < 2; ++b)
#pragma unroll
        for (int m = 0; m < 4; ++m)
#pragma unroll
            for (int n = 0; n < 2; ++n) acc[b][m][n] = (f32x4){0.f, 0.f, 0.f, 0.f};
    bf16x8 A0[4][2], P0[2][2], Q0[2][2], A1[4][2], P1[2][2], Q1[2][2];
    Unit iu = cur; int iui = 0, it = 0; const char* iA = G1_APTR(iu); const char* iB = G1_BPTR(iu); int iso = 0; bool ilive = true;
#define G1_ISSUE() do { G1_STAGE3(iso, iA + (size_t)it * kstep, iB + (size_t)it * kstep); iso = iso == 2 * STG ? 0 : iso + STG; \
        if (++it == nt) { it = 0; if (ilive) { Unit nx; if (S.next(iui + 1, nx)) { iu = nx; ++iui; iA = G1_APTR(iu); iB = G1_BPTR(iu); } else ilive = false; } } } while (0)
    G1_ISSUE(); G1_ISSUE(); G1_ISSUE();
    G1_WAIT_V(12); G1_BAR;
    G1_LDB(P0, 0, 0); G1_LDB(Q0, 0, 1); G1_LDA(A0, 0);
    G1_WAIT_L(0); G1_WAIT_V(6); G1_BAR;
    int so = STG;
    int ui = 0, t = 0;
    for (;;) {
        G1_ISSUE(); G1_LDB(P1, so, 0); G1_LDB(Q1, so, 1); G1_LDA(A1, so); so = so == 2 * STG ? 0 : so + STG;
        G1_SCHED; __builtin_amdgcn_s_setprio(1); G1_MMA(0, A0, P0); G1_MMA(1, A0, Q0); __builtin_amdgcn_s_setprio(0); G1_SCHED;
        G1_WAIT_L(0); G1_WAIT_V(6); G1_BAR;
        if (++t == nt) { t = 0; Unit nx; const bool hn = S.next(ui + 1, nx);
            if constexpr (!EpiT::AFTER_DRAIN) E(acc, cur, wr, wc, fr, fq);
            if (!hn) break;
#pragma unroll
            for (int b = 0; b < 2; ++b)
#pragma unroll
                for (int m = 0; m < 4; ++m)
#pragma unroll
                    for (int n = 0; n < 2; ++n) acc[b][m][n] = (f32x4){0.f, 0.f, 0.f, 0.f};
            cur = nx; ++ui; }
        G1_ISSUE(); G1_LDB(P0, so, 0); G1_LDB(Q0, so, 1); G1_LDA(A0, so); so = so == 2 * STG ? 0 : so + STG;
        G1_SCHED; __builtin_amdgcn_s_setprio(1); G1_MMA(0, A1, P1); G1_MMA(1, A1, Q1); __builtin_amdgcn_s_setprio(0); G1_SCHED;
        G1_WAIT_L(0); G1_WAIT_V(6); G1_BAR;
        if (++t == nt) { t = 0; Unit nx; const bool hn = S.next(ui + 1, nx);
            if constexpr (!EpiT::AFTER_DRAIN) E(acc, cur, wr, wc, fr, fq);
            if (!hn) break;
#pragma unroll
            for (int b = 0; b < 2; ++b)
#pragma unroll
                for (int m = 0; m < 4; ++m)
#pragma unroll
                    for (int n = 0; n < 2; ++n) acc[b][m][n] = (f32x4){0.f, 0.f, 0.f, 0.f};
            cur = nx; ++ui; }
    }
    G1_WAIT_V(0);
    G1_BAR;
    if constexpr (EpiT::AFTER_DRAIN) E.fused(acc, cur, wr, wc, fr, fq, lds, tid);
#undef G1_ISSUE
#undef G1_STAGE
#undef G1_STAGE3
#undef G1_LDA
#undef G1_LDB
#undef G1_MMA
#undef G1_WAIT_V
#undef G1_WAIT_L
#undef G1_BAR
#undef G1_SCHED
#undef G1_APTR
#undef G1_BPTR
}
template <class EpiT>
__device__ __forceinline__ void gemm128_phase_s(PG8_LAS unsigned char* lds, const GemmArgs g, const Order128& S, const EpiT& E) {
    int tid = threadIdx.x; asm volatile("" : "+v"(tid));
    const int wid = __builtin_amdgcn_readfirstlane(tid >> 6), lane = tid & 63, wr = wid >> 2, wc = wid & 3, fr = lane & 15, fq = lane >> 4;
    const int nt = g.K / BK;
    unsigned voffA[2], voffB[2];
#pragma unroll
    for (int i = 0; i < 2; ++i) { int R, C; stage_rc(tid * 16 + i * 8192, R, C); const int Rb = EpiT::PERM ? ((R & ~31) + perm32(R & 31)) : R;
        voffA[i] = (unsigned)(R * g.lda + C) * 2u; voffB[i] = (unsigned)(Rb * g.ldb + C) * 2u; }
    const size_t kstep = (size_t)(BK * 2);
    const size_t hstepB = (size_t)HALF * g.ldb * 2;
    const unsigned ldsw = (unsigned)wid * 1024u;
    const int aoff = lds_byte(wr * 64 + fr, fq * 8), boff = lds_byte(wc * 32 + fr, fq * 8);
#define G1_STAGE(bufoff, gbase, voff) do { _Pragma("unroll") for (int _i = 0; _i < 2; ++_i) \
        __builtin_amdgcn_global_load_lds((const unsigned*)((const char*)(gbase) + (voff)[_i]), (PG8_LAS unsigned*)(lds + (bufoff) + ldsw + _i * 8192), 16, 0, 0); } while (0)
#define G1_STAGE3(so, pa, pb) do { G1_STAGE((so) + HTB, (pb), voffB); G1_STAGE((so) + 2 * HTB, (pb) + hstepB, voffB); G1_STAGE((so), (pa), voffA); } while (0)
#define G1_LDA(dst, so) do { _Pragma("unroll") for (int m = 0; m < 4; ++m) _Pragma("unroll") for (int k = 0; k < 2; ++k) dst[m][k] = *(const PG8_LAS bf16x8*)(lds + (so) + aoff + m * 2048 + k * 1024); } while (0)
#define G1_LDB(dst, so, h) do { _Pragma("unroll") for (int n = 0; n < 2; ++n) _Pragma("unroll") for (int k = 0; k < 2; ++k) dst[n][k] = *(const PG8_LAS bf16x8*)(lds + (so) + (1 + (h)) * HTB + boff + n * 2048 + k * 1024); } while (0)
#define G1_MMA(bj, At, Bt) do { __builtin_amdgcn_s_setprio(1); _Pragma("unroll") for (int m = 0; m < 4; ++m) _Pragma("unroll") for (int n = 0; n < 2; ++n) _Pragma("unroll") for (int k = 0; k < 2; ++k) \
        acc[bj][m][n] = __builtin_amdgcn_mfma_f32_16x16x32_bf16(Bt[n][k], At[m][k], acc[bj][m][n], 0, 0, 0); __builtin_amdgcn_s_setprio(0); } while (0)
#define G1_WAIT_V(n) asm volatile("s_waitcnt vmcnt(" #n ")" ::: "memory")
#define G1_WAIT_L(n) asm volatile("s_waitcnt lgkmcnt(" #n ")" ::: "memory")
#define G1_BAR __builtin_amdgcn_s_barrier()
#define G1_SCHED __builtin_amdgcn_sched_barrier(0)
#define G1_APTR(u) ((const char*)(g.A + (size_t)(u).z * g.zA + (size_t)(u).pm * HALF * g.lda))
#define G1_BPTR(u) ((const char*)(g.Bt + (size_t)(u).z * g.zB + (size_t)(u).pn * BM * g.ldb))
    Unit cur, nxt; int ui = 0;
    if (!S.next(0, cur)) return;
    f32x4 acc[2][4][2];
#pragma unroll
    for (int b = 0; b < 2; ++b)
#pragma unroll
        for (int m = 0; m < 4; ++m)
#pragma unroll
            for (int n = 0; n < 2; ++n) acc[b][m][n] = (f32x4){0.f, 0.f, 0.f, 0.f};
    bf16x8 At[4][2], B0[2][2], B1[2][2];
    const char* cA = G1_APTR(cur); const char* cB = G1_BPTR(cur);
    G1_STAGE3(0, cA, cB); G1_STAGE3(STG, cA + kstep, cB + kstep);
    if (wr == 1) G1_BAR;
    G1_WAIT_V(6); G1_BAR; G1_BAR;
    int so = 0;
    for (;;) {
        const bool has_next = S.next(ui + 1, nxt);
        const char* nA = has_next ? G1_APTR(nxt) : cA; const char* nB = has_next ? G1_BPTR(nxt) : cB;
        for (int t = 0; t < nt; ++t) {
            const int t2 = t + 2; const bool over = t2 >= nt;
            const char* a2 = over ? nA + (size_t)(t2 - nt) * kstep : cA + (size_t)t2 * kstep; const char* b2 = over ? nB + (size_t)(t2 - nt) * kstep : cB + (size_t)t2 * kstep;
            const int sp = so == 0 ? 2 * STG : so - STG;
            G1_LDB(B0, so, 0); G1_LDB(B1, so, 1); G1_SCHED; G1_LDA(At, so); G1_STAGE3(sp, a2, b2);
            G1_WAIT_V(6); G1_WAIT_L(0); G1_BAR; G1_MMA(0, At, B0); G1_MMA(1, At, B1); G1_BAR; G1_SCHED;
            so = so == 2 * STG ? 0 : so + STG;
        }
        if constexpr (!EpiT::AFTER_DRAIN) E(acc, cur, wr, wc, fr, fq);
        if (!has_next) break;
#pragma unroll
        for (int b = 0; b < 2; ++b)
#pragma unroll
            for (int m = 0; m < 4; ++m)
#pragma unroll
                for (int n = 0; n < 2; ++n) acc[b][m][n] = (f32x4){0.f, 0.f, 0.f, 0.f};
        cur = nxt; cA = nA; cB = nB; ++ui;
    }
    G1_WAIT_V(0);
    if (wr == 0) G1_BAR;
    G1_BAR;
    if constexpr (EpiT::AFTER_DRAIN) E.fused(acc, cur, wr, wc, fr, fq, lds, tid);
#undef G1_STAGE
#undef G1_STAGE3
#undef G1_LDA
#undef G1_LDB
#undef G1_MMA
#undef G1_WAIT_V
#undef G1_WAIT_L
#undef G1_BAR
#undef G1_SCHED
#undef G1_APTR
#undef G1_BPTR
}
}
namespace pg8 {
constexpr int NT2 = (NROW / BM) * (DM / BM);
struct Order2K {
    int nZ, kh, slot; bool active;
    __device__ void init(int nZ_, int c) { nZ = nZ_; active = c < 2 * NT2; const int j = c & 7, i = c >> 3; kh = i & 1; slot = (i >> 1) * 8 + j; }
    __device__ bool next(int i, Unit& u) const {
        if (!active || i >= nZ) return false; u.z = i;
        constexpr int nN = DM / BM, nM = NROW / BM, nwg = nM * nN; int wgid = slot; { const int q = nwg / NXCD, r = nwg % NXCD, xcd = wgid % NXCD, off = wgid / NXCD; wgid = (xcd < r ? xcd * (q + 1) : r * (q + 1) + (xcd - r) * q) + off; }
        const int nig = WGM * nN, gid = wgid / nig, fm = gid * WGM, gsz = (nM - fm) < WGM ? (nM - fm) : WGM;
        u.pm = fm + ((wgid % nig) % gsz); u.pn = (wgid % nig) / gsz; return true;
    }
};
__device__ __forceinline__ void st_wt16(float* ptr, f32x4 v) { asm volatile("global_store_dwordx4 %0, %1, off sc1\n\ts_nop 1" :: "v"(ptr), "v"(v) : "memory"); }
__device__ __forceinline__ f32x4 ld_sc1_16(const float* ptr) { f32x4 v; asm volatile("global_load_dwordx4 %0, %1, off sc1" : "=v"(v) : "v"(ptr) : "memory"); return v; }
template <int MODE> struct EpiX {
    static constexpr bool PERM = (MODE == 1);
    P p; int l, kh, slot;
    __device__ __forceinline__ float* slab(int half) const { return p.Cloc() + ((size_t)slot * 2 + half) * (size_t)(BM * BM); }
    __device__ __forceinline__ unsigned* flag() const { return p.cnt() + 64 * (2 * DEPTH * (NROW / HALF)) + ((MODE == 1 ? 0 : (MODE == 2 ? 1 : 2)) * DEPTH + l) * NT2 + slot; }
    __device__ __forceinline__ void operator()(f32x4 (&acc)[2][2][4][2], const Unit& u, int wr_, int wc_, int fr_, int fq_, int tid_) const {
        if constexpr (MODE == 1) { int tid = tid_; asm volatile("" : "+v"(tid));
            const int wid = __builtin_amdgcn_readfirstlane(tid >> 6), lane = tid & 63, wr = wid >> 2, wc = wid & 3, fr = lane & 15, fq = lane >> 4;
            gate_mul(acc, u, wr, wc, fr, fq); float* s = slab(kh) + (size_t)tid * 4;
            if (u.z != 0) {
#pragma unroll
                for (int hh = 0; hh < 4; ++hh) { f32x4 t[8];
#pragma unroll
                    for (int i = 0; i < 8; ++i) t[i] = *(const f32x4*)(s + (size_t)(hh * 8 + i) * 2048);
#pragma unroll
                    for (int i = 0; i < 8; ++i) { const int q = hh * 8 + i; acc[q >> 4][(q >> 3) & 1][(q >> 1) & 3][q & 1] = acc[q >> 4][(q >> 3) & 1][(q >> 1) & 3][q & 1] + t[i]; }
#pragma unroll
                    for (int i = 0; i < 8; i += 2) { const int q = hh * 8 + i; asm volatile("" : "+v"(acc[q >> 4][(q >> 3) & 1][(q >> 1) & 3][0]), "+v"(acc[q >> 4][(q >> 3) & 1][(q >> 1) & 3][1]) :: "memory"); } } }
#pragma unroll
            for (int i = 0; i < 32; ++i) *(f32x4*)(s + (size_t)i * 2048) = acc[i >> 4][(i >> 3) & 1][(i >> 1) & 3][i & 1];
        }
    }
    __device__ __forceinline__ void gate_mul(f32x4 (&acc)[2][2][4][2], const Unit& u, int wr, int wc, int fr, int fq) const {
        const int row0 = u.pm * BM + wr * 64 + fr, col0 = u.pn * BM + wc * 32 + 8 * fq;
#pragma unroll
        for (int ai = 0; ai < 2; ++ai)
#pragma unroll
            for (int m = 0; m < 4; ++m) { u32x4 gw[2];
#pragma unroll
                for (int bj = 0; bj < 2; ++bj) gw[bj] = *(const u32x4*)(p.proj() + (size_t)(row0 + ai * HALF + m * 16) * PJ + C_BR + u.z * DM + col0 + bj * HALF);
#pragma unroll
                for (int bj = 0; bj < 2; ++bj) { const u32x4 g = gw[bj]; const float g0[4] = {bf_lo(g.x), bf_hi(g.x), bf_lo(g.y), bf_hi(g.y)}, g1[4] = {bf_lo(g.z), bf_hi(g.z), bf_lo(g.w), bf_hi(g.w)};
#pragma unroll
                    for (int j = 0; j < 4; ++j) { acc[ai][bj][m][0][j] *= __builtin_amdgcn_rcpf(1.0f + __expf(-g0[j])); acc[ai][bj][m][1][j] *= __builtin_amdgcn_rcpf(1.0f + __expf(-g1[j])); } }
                asm volatile("" : "+v"(acc[ai][0][m][0]), "+v"(acc[ai][0][m][1]), "+v"(acc[ai][1][m][0]), "+v"(acc[ai][1][m][1]) :: "memory"); }
    }
    __device__ __forceinline__ void fused(f32x4 (&acc)[2][2][4][2], const Unit& u, int wr_, int wc_, int fr_, int fq_, PG8_LAS unsigned char* lds, int tid_) const {
        int tid = tid_; asm volatile("" : "+v"(tid));
        const int wid = __builtin_amdgcn_readfirstlane(tid >> 6), lane = tid & 63, wr = wid >> 2, wc = wid & 3, fr = lane & 15, fq = lane >> 4;
        if constexpr (MODE == 1) { gate_mul(acc, u, wr, wc, fr, fq); const float* s = slab(kh) + (size_t)tid * 4;
#pragma unroll
            for (int hh = 0; hh < 4; ++hh) { f32x4 t[8];
#pragma unroll
                for (int i = 0; i < 8; ++i) t[i] = *(const f32x4*)(s + (size_t)(hh * 8 + i) * 2048);
#pragma unroll
                for (int i = 0; i < 8; ++i) { const int q = hh * 8 + i; acc[q >> 4][(q >> 3) & 1][(q >> 1) & 3][q & 1] = acc[q >> 4][(q >> 3) & 1][(q >> 1) & 3][q & 1] + t[i]; }
#pragma unroll
                for (int i = 0; i < 8; i += 2) { const int q = hh * 8 + i; asm volatile("" : "+v"(acc[q >> 4][(q >> 3) & 1][(q >> 1) & 3][0]), "+v"(acc[q >> 4][(q >> 3) & 1][(q >> 1) & 3][1]) :: "memory"); } } }
        if (kh == 1) {
            float* s = slab(1) + (size_t)tid * 4;
#pragma unroll
            for (int i = 0; i < 32; ++i) st_wt16(s + (size_t)i * 2048, acc[i >> 4][(i >> 3) & 1][(i >> 1) & 3][i & 1]);
            asm volatile("s_waitcnt vmcnt(0)" ::: "memory");
            __syncthreads();
            if (tid == 0) __hip_atomic_store(flag(), 1u, __ATOMIC_RELAXED, __HIP_MEMORY_SCOPE_AGENT);
            return;
        }
        if (tid == 0) { unsigned sp = 0; while (__hip_atomic_load(flag(), __ATOMIC_RELAXED, __HIP_MEMORY_SCOPE_AGENT) == 0u) { __builtin_amdgcn_s_sleep(2); if (++sp > (1u << 22)) break; }
            __builtin_amdgcn_fence(__ATOMIC_ACQUIRE, "agent"); asm volatile("s_waitcnt vmcnt(0)" ::: "memory"); }
        __syncthreads();
        { const float* s = slab(1) + (size_t)tid * 4;
#pragma unroll
          for (int h = 0; h < 4; ++h) { f32x4 t[8];
#pragma unroll
              for (int i = 0; i < 8; ++i) t[i] = *(const f32x4*)(s + (size_t)(h * 8 + i) * 2048);
#pragma unroll
              for (int i = 0; i < 8; ++i) { const int q = h * 8 + i; acc[q >> 4][(q >> 3) & 1][(q >> 1) & 3][q & 1] = acc[q >> 4][(q >> 3) & 1][(q >> 1) & 3][q & 1] + t[i]; }
#pragma unroll
              for (int i = 0; i < 8; i += 2) { const int q = h * 8 + i; asm volatile("" : "+v"(acc[q >> 4][(q >> 3) & 1][(q >> 1) & 3][0]), "+v"(acc[q >> 4][(q >> 3) & 1][(q >> 1) & 3][1]) :: "memory"); } } }
        const int row0 = u.pm * BM + wr * 64 + fr;
        if constexpr (MODE == 1) {
            const int col0 = u.pn * BM + wc * 32 + 8 * fq;
#pragma unroll
            for (int ai = 0; ai < 2; ++ai)
#pragma unroll
                for (int m = 0; m < 4; ++m)
#pragma unroll
                    for (int bj = 0; bj < 2; ++bj) { const f32x4 v0 = acc[ai][bj][m][0], v1 = acc[ai][bj][m][1]; u32x4 w; w.x = cvt_pk_bf16(v0[0], v0[1]); w.y = cvt_pk_bf16(v0[2], v0[3]); w.z = cvt_pk_bf16(v1[0], v1[1]); w.w = cvt_pk_bf16(v1[2], v1[3]);
                        *(u32x4*)(p.merged() + (size_t)(row0 + ai * HALF + m * 16) * DM + col0 + bj * HALF) = w; }
        } else {
            const int col0 = u.pn * BM + wc * 32 + 4 * fq, ci = cond_of_row(u.pm * BM);
            const float* gt = p.mod() + ((size_t)l * 3 + ci) * 6 * DM + (MODE == 2 ? 2 : 5) * DM;
            f32x4 gv[2][2];
#pragma unroll
            for (int bj = 0; bj < 2; ++bj)
#pragma unroll
                for (int n = 0; n < 2; ++n) gv[bj][n] = *(const f32x4*)(gt + col0 + bj * HALF + n * 16);
            PG8_LAS float* Pp = (PG8_LAS float*)lds;
            PG8_LAS float* Rr = Pp + 1024;
#pragma unroll
            for (int am = 0; am < 4; ++am) { const int ai = am >> 1; f32x4 xv[2][2][2];
#pragma unroll
                for (int mm = 0; mm < 2; ++mm)
#pragma unroll
                    for (int bj = 0; bj < 2; ++bj)
#pragma unroll
                        for (int n = 0; n < 2; ++n) xv[mm][bj][n] = *(const f32x4*)(p.x() + (size_t)(row0 + ai * HALF + ((am & 1) * 2 + mm) * 16) * DM + col0 + bj * HALF + n * 16);
#pragma unroll
                for (int mm = 0; mm < 2; ++mm) { const int m = (am & 1) * 2 + mm; float s = 0.f;
#pragma unroll
                    for (int bj = 0; bj < 2; ++bj)
#pragma unroll
                        for (int n = 0; n < 2; ++n) { const f32x4 v = xv[mm][bj][n] + gv[bj][n] * acc[ai][bj][m][n]; acc[ai][bj][m][n] = v; s += v[0] * v[0] + v[1] * v[1] + v[2] * v[2] + v[3] * v[3]; }
                    s += __shfl_xor(s, 16, 64); s += __shfl_xor(s, 32, 64);
                    if (fq == 0) Pp[(ai * HALF + wr * 64 + m * 16 + fr) * 4 + wc] = s;
                    asm volatile("" : "+v"(acc[ai][0][m][0]), "+v"(acc[ai][0][m][1]), "+v"(acc[ai][1][m][0]), "+v"(acc[ai][1][m][1]) :: "memory"); } }
            asm volatile("" ::: "memory");
            const int kind = MODE == 2 ? 0 : 1;
            float* slots = p.ssq() + ((size_t)(kind * DEPTH + l) * NROW + (size_t)u.pm * BM) * 4;
            unsigned* cnt = p.cnt() + ((size_t)(kind * DEPTH + l) * (NROW / HALF) + u.pm) * 64;
            __syncthreads();
            if (tid < BM) { const float t = (Pp[tid * 4] + Pp[tid * 4 + 1]) + (Pp[tid * 4 + 2] + Pp[tid * 4 + 3]); __hip_atomic_store(slots + tid * 4 + u.pn, t, __ATOMIC_RELAXED, __HIP_MEMORY_SCOPE_AGENT); }
#pragma unroll
            for (int ai = 0; ai < 2; ++ai)
#pragma unroll
                for (int m = 0; m < 4; ++m)
#pragma unroll
                    for (int bj = 0; bj < 2; ++bj)
#pragma unroll
                        for (int n = 0; n < 2; ++n) *(f32x4*)(p.x() + (size_t)(row0 + ai * HALF + m * 16) * DM + col0 + bj * HALF + n * 16) = acc[ai][bj][m][n];
            asm volatile("s_waitcnt vmcnt(0)" ::: "memory");
            __syncthreads();
            if (tid == 0) { __hip_atomic_fetch_add(cnt, 1u, __ATOMIC_RELAXED, __HIP_MEMORY_SCOPE_AGENT);
                unsigned sp = 0; while (__hip_atomic_load(cnt, __ATOMIC_RELAXED, __HIP_MEMORY_SCOPE_AGENT) < (unsigned)(DM / BM)) { __builtin_amdgcn_s_sleep(2); if (++sp > (1u << 22)) break; }
                __builtin_amdgcn_fence(__ATOMIC_ACQUIRE, "agent"); asm volatile("s_waitcnt vmcnt(0)" ::: "memory"); }
            __syncthreads();
            if (tid < BM) { float t = 0.f;
#pragma unroll
                for (int q = 0; q < DM / BM; ++q) t += __hip_atomic_load(slots + tid * 4 + q, __ATOMIC_RELAXED, __HIP_MEMORY_SCOPE_AGENT);
                Rr[tid] = 1.0f / sqrtf(t * (1.0f / DM) + EPSF); }
            __syncthreads();
            const bool fin = (MODE == 4 && l == DEPTH - 1);
            const int ln = MODE == 2 ? l : l + 1;
            const float* gn = fin ? p.g_final() : (MODE == 2 ? p.g_norm2() : p.g_norm1()) + (size_t)ln * DM;
            const float* md = p.mod() + ((size_t)(fin ? 0 : ln) * 3 + ci) * 6 * DM + (MODE == 2 ? 3 * DM : 0);
#pragma unroll
            for (int bj = 0; bj < 2; ++bj)
#pragma unroll
                for (int n = 0; n < 2; ++n) { const int col = col0 + bj * HALF + n * 16; f32x4 gg = *(const f32x4*)(gn + col), sh = {0.f, 0.f, 0.f, 0.f};
                    if (!fin) { gg = gg * (*(const f32x4*)(md + DM + col) + 1.0f); sh = *(const f32x4*)(md + col); }
#pragma unroll
                    for (int ai = 0; ai < 2; ++ai)
#pragma unroll
                        for (int m = 0; m < 4; ++m) { const int r = ai * HALF + wr * 64 + m * 16 + fr; const f32x4 o = acc[ai][bj][m][n] * Rr[r] * gg + sh; const size_t off = (size_t)(u.pm * BM + r) * DM + col;
                            if (fin) *(f32x4*)(p.out + off) = o;
                            else { u32x2 w; w.x = cvt_pk_bf16(o[0], o[1]); w.y = cvt_pk_bf16(o[2], o[3]); *(u32x2*)(p.u() + off) = w; } } }
        }
    }
};
}
#endif
__device__ __forceinline__ void b_pool_d(const P& p, size_t i) {

    int c = i % DB; int r = i / DB; int g = c / GRP; int win = 2 << g;
    float self = PRJ(r, C_XP + c); float pooled;
    if (r < R_CTX) {
        int b = r / T_CTX, t = r % T_CTX; int lo = t - win / 2; if (lo < 0) lo = 0; int hi = t + (win - win / 2); if (hi > T_CTX) hi = T_CTX;
        float s = 0.f; for (int tt = lo; tt < hi; ++tt) s += PRJ(b * T_CTX + tt, C_XP + c);
        pooled = s / (float)(hi - lo);
    } else {
        int rr = r - R_CTX; int b = rr / T_LAT, t = rr % T_LAT; int gy = t / GRID_W, gx = t % GRID_W; const int rows = T_LAT / GRID_W;
        int xlo = gx - win / 2; if (xlo < 0) xlo = 0; int xhi = gx + (win - win / 2); if (xhi > GRID_W) xhi = GRID_W;
        int ylo = gy - win / 2; if (ylo < 0) ylo = 0; int yhi = gy + (win - win / 2); if (yhi > rows) yhi = rows;
        float s = 0.f;
        for (int yy = ylo; yy < yhi; ++yy) { float sx = 0.f; for (int xx = xlo; xx < xhi; ++xx) sx += PRJ(R_CTX + b * T_LAT + yy * GRID_W + xx, C_XP + c); s += sx / (float)(xhi - xlo); }
        pooled = s / (float)(yhi - ylo);
    }
    p.dbuf()[i] = pooled - self;
}
__device__ __forceinline__ void b_pool_y(const P& p, size_t i, int l) {

    int c = i % DB; size_t r = i / DB; int g = c / GRP, dd = c % GRP;
    const float* d = p.dbuf() + r * DB + g * GRP; const float* w = p.w_pool() + ((size_t)l * NG + g) * GRP * GRP + dd; float acc = 0.f;
    for (int k = 0; k < GRP; ++k) acc += d[k] * w[(size_t)k * GRP];
    p.ys()[r * 3 * DB + c] = f2bf(acc * p.pool_scale()[(size_t)l * DB + c]);
}
__device__ __forceinline__ void b_sgu_vn(const P& p, size_t r, int l) {

    float ss = 0.f;
    for (int k = 0; k < DB; ++k) { float v = PRJ(r, C_SV + k); ss += v * v; }
    float rs = 1.0f / sqrtf(ss / DB + EPSF);
    for (int k = 0; k < DB; ++k) p.vn()[r * DB + k] = PRJ(r, C_SV + k) * rs * p.g_sgu()[(size_t)l * DB + k];
}
__device__ __forceinline__ void b_sgu_y(const P& p, size_t i, int l) {

    int c = i % DB; int r = i / DB; int g = c / GRP; int pp = r % SGU_CHUNK; int r0 = r - pp;
    const float* w = p.w_sgu() + (((size_t)l * NG + g) * SGU_CHUNK + pp) * SGU_CHUNK; float acc = 0.f;
    for (int q = 0; q < SGU_CHUNK; ++q) acc += w[q] * p.vn()[(size_t)(r0 + q) * DB + c];
    acc += p.b_sgu()[((size_t)l * NG + g) * SGU_CHUNK + pp];
    p.ys()[(size_t)r * 3 * DB + DB + c] = f2bf(PRJ(r, C_SU + c) * acc);
}
#define IDX_DHR(dir, h, row) (((size_t)(dir) * NH + (h)) * NROW + (row))
#define IDX_DHC(dir, h, gc) (((size_t)(dir) * NH + (h)) * NCHK + (gc))
__device__ __forceinline__ void b_ml_gates(const P& p, size_t i, int l) {

    int gc = i % NCHK, h = (i / NCHK) % NH, dir = i / (NCHK * NH); int c0 = gc * LCH;
    float b = 0.f;
    for (int tau = 0; tau < LCH; ++tau) {
        int row = dir == 0 ? c0 + tau : c0 + LCH - 1 - tau;
        const float* gp = p.gate_pre() + (size_t)row * 16; const float* bg = p.b_gates() + (size_t)l * 4 * NH;
        float iv = gp[dir * NH + h] + bg[dir * NH + h];
        float fv = gp[2 * NH + dir * NH + h] + bg[2 * NH + dir * NH + h];
        b += logsigmoidf_(fv);
        p.bcum()[IDX_DHR(dir, h, row)] = b; p.ival()[IDX_DHR(dir, h, row)] = iv;
    }
    float bL = b, mx = -INFINITY;
    for (int tau = 0; tau < LCH; ++tau) { int row = c0 + tau; float a = bL - p.bcum()[IDX_DHR(dir, h, row)] + p.ival()[IDX_DHR(dir, h, row)]; mx = fmaxf(mx, a); }
    p.bL()[IDX_DHC(dir, h, gc)] = bL; p.Mloc()[IDX_DHC(dir, h, gc)] = mx;
}
__device__ __forceinline__ void b_ml_cloc(const P& p, size_t i) {

    int e = i % DH, d = (i / DH) % DH; size_t j = i / (DH * DH); int gc = j % NCHK, h = (j / NCHK) % NH, dir = j / (NCHK * NH); int c0 = gc * LCH;
    float bL = p.bL()[IDX_DHC(dir, h, gc)], ml = p.Mloc()[IDX_DHC(dir, h, gc)]; const float ksc = 1.0f / sqrtf((float)DH);
    float acc = 0.f, accn = 0.f;
    for (int s = 0; s < LCH; ++s) { int row = c0 + s;
        float w = expf(bL - p.bcum()[IDX_DHR(dir, h, row)] + p.ival()[IDX_DHR(dir, h, row)] - ml);
        float kv = PRJ(row, C_K + h * DH + d) * ksc;
        acc += w * kv * PRJ(row, C_V + h * DH + e); accn += w * kv; }
    p.Cloc()[i] = acc; if (e == 0) p.nloc()[j * DH + d] = accn;
}
__device__ __forceinline__ void b_ml_scan(const P& p, size_t i, int l) {

    int e = i % DH, d = (i / DH) % DH; size_t j = i / (DH * DH); int s = j % NSEQ, h = (j / NSEQ) % NH, dir = j / (NSEQ * NH);
    int gc0 = seq_start(s) / LCH, nc = seq_len(s) / LCH;
    float C, n, m;
    if (s < NB_CTX) { C = 0.f; n = 0.f; m = 0.f; }
    else { int b = s - NB_CTX; size_t base = (((size_t)b * DEPTH + l) * 2 + dir) * NH + h; C = p.state_C()[(base * DH + d) * DH + e]; n = p.state_n()[base * DH + d]; m = p.state_m()[base]; }
    for (int jj = 0; jj < nc; ++jj) {
        int gc = gc0 + (dir == 0 ? jj : nc - 1 - jj); size_t ci = IDX_DHC(dir, h, gc);
        float bL = p.bL()[ci], ml = p.Mloc()[ci]; float mnew = fmaxf(bL + m, ml); float dec = expf(bL + m - mnew), sc = expf(ml - mnew);
        size_t ce = (ci * DH + d) * DH + e; float cl = p.Cloc()[ce]; p.Cloc()[ce] = C; C = dec * C + sc * cl;
        if (e == 0) { float nl = p.nloc()[ci * DH + d]; p.nloc()[ci * DH + d] = n; n = dec * n + sc * nl; }
        if (e == 0 && d == 0) p.Mprev()[ci] = m;
        m = mnew;
    }
    if (s < NB_CTX) {
        size_t base = (((size_t)s * DEPTH + l) * 2 + dir) * NH + h;
        float* oC = p.out + (size_t)NROW * DM; float* on = oC + (size_t)NB_CTX * DEPTH * 2 * NH * DH * DH; float* om = on + (size_t)NB_CTX * DEPTH * 2 * NH * DH;
        oC[(base * DH + d) * DH + e] = C; if (e == 0) on[base * DH + d] = n; if (e == 0 && d == 0) om[base] = m;
    }
}
__device__ __forceinline__ void b_ml_mt(const P& p, size_t i) {

    int row = i % NROW, h = (i / NROW) % NH, dir = i / ((size_t)NROW * NH); int gc = row / LCH, c0 = gc * LCH;
    int tau = dir == 0 ? row - c0 : c0 + LCH - 1 - row;
    float bt = p.bcum()[IDX_DHR(dir, h, row)]; float mt = bt + p.Mprev()[IDX_DHC(dir, h, gc)];
    for (int ts = 0; ts <= tau; ++ts) { int rs = dir == 0 ? c0 + ts : c0 + LCH - 1 - ts; mt = fmaxf(mt, bt - p.bcum()[IDX_DHR(dir, h, rs)] + p.ival()[IDX_DHR(dir, h, rs)]); }
    p.MT()[i] = mt;
}
__device__ __forceinline__ void b_ml_s(const P& p, size_t i) {

    int ts = i % LCH, tt = (i / LCH) % LCH; size_t j = i / (LCH * LCH); int gc = j % NCHK, h = (j / NCHK) % NH, dir = j / (NCHK * NH); int c0 = gc * LCH;
    float val = 0.f;
    if (ts <= tt) {
        int rt = dir == 0 ? c0 + tt : c0 + LCH - 1 - tt, rs = dir == 0 ? c0 + ts : c0 + LCH - 1 - ts;
        float acc = 0.f;
        for (int d = 0; d < DH; ++d) acc += PRJ(rt, C_Q + h * DH + d) * PRJ(rs, C_K + h * DH + d);
        acc *= 1.0f / sqrtf((float)DH);
        float dm = p.bcum()[IDX_DHR(dir, h, rt)] - p.bcum()[IDX_DHR(dir, h, rs)] + p.ival()[IDX_DHR(dir, h, rs)];
        val = acc * expf(dm - p.MT()[IDX_DHR(dir, h, rt)]);
    }
    p.S()[i] = val;
}
__device__ __forceinline__ void b_ml_h(const P& p, size_t i) {

    int c = i % DB; int row = (i / DB) % NROW; int dir = i / ((size_t)DB * NROW); int h = c / DH, e = c % DH; int gc = row / LCH, c0 = gc * LCH;
    int tau = dir == 0 ? row - c0 : c0 + LCH - 1 - row; size_t ci = IDX_DHC(dir, h, gc);
    const float* Srow = p.S() + (ci * LCH + tau) * LCH;
    float num = 0.f, den = 0.f;
    for (int ts = 0; ts <= tau; ++ts) { int rs = dir == 0 ? c0 + ts : c0 + LCH - 1 - ts; float sv = Srow[ts]; num += sv * PRJ(rs, C_V + h * DH + e); den += sv; }
    float mt = p.MT()[IDX_DHR(dir, h, row)]; float winter = expf(p.bcum()[IDX_DHR(dir, h, row)] + p.Mprev()[ci] - mt);
    float qc = 0.f, qn = 0.f;
    for (int d = 0; d < DH; ++d) { float qv = PRJ(row, C_Q + h * DH + d); qc += qv * p.Cloc()[(ci * DH + d) * DH + e]; qn += qv * p.nloc()[ci * DH + d]; }
    num += winter * qc; den += winter * qn;
    p.hbuf()[i] = num / fmaxf(fabsf(den), expf(-mt));
}
__device__ __forceinline__ void b_ml_fin(const P& p, size_t i, int l) {

    int h = i % NH; size_t row = i / NH;
    const float* h0 = p.hbuf() + row * DB + h * DH; const float* h1 = p.hbuf() + ((size_t)NROW + row) * DB + h * DH; float ss = 0.f;
    for (int e = 0; e < DH; ++e) { float v = h0[e] + h1[e]; ss += v * v; }
    float rs = 1.0f / sqrtf(ss / DH + EPSF);
    for (int e = 0; e < DH; ++e) { float v = (h0[e] + h1[e]) * rs * p.g_mlstm()[(size_t)l * DB + h * DH + e];
        p.ys()[row * 3 * DB + 2 * DB + h * DH + e] = f2bf(sigmoidf_(PRJ(row, C_O + h * DH + e)) * v); }
}
__device__ __forceinline__ void b_final(const P& p, size_t r) {

    const float* xr = p.x() + r * DM; float ss = 0.f;
    for (int k = 0; k < DM; ++k) ss += xr[k] * xr[k];
    float rs = 1.0f / sqrtf(ss / DM + EPSF);
    for (int k = 0; k < DM; ++k) p.out[r * DM + k] = xr[k] * rs * p.g_final()[k];
}


#ifndef CPU_EMU
#define XB_TMO      128
#define XB_XCNT(j)  (256  + 64 * (j))
#define XB_XSUB(j)  (1280 + 64 * (j))
#define XB_XGEN(j)  (2304 + 64 * (j))
#define XB_TOP      3328
#define XB_TOPGEN   3392
#define XCD_BAR_WORDS 3456
#define XB_SPIN_CAP (1u << 22)
#define LAS __attribute__((address_space(3)))
__device__ __forceinline__ unsigned xb_ld(unsigned* p)              { return __hip_atomic_load(p, __ATOMIC_RELAXED, __HIP_MEMORY_SCOPE_AGENT); }
__device__ __forceinline__ unsigned xb_add(unsigned* p, unsigned v) { return __hip_atomic_fetch_add(p, v, __ATOMIC_RELAXED, __HIP_MEMORY_SCOPE_AGENT); }
__device__ __forceinline__ unsigned xb_xcc_id() { return (unsigned)__builtin_amdgcn_s_getreg((3 << 11) | 20) & 0xFu; }
#define XB_SPIN(cond, bar) do { unsigned _sp = 0; while (cond) { __builtin_amdgcn_s_sleep(1); \
    if ((++_sp & 255u) == 0u) { if (xb_ld(&(bar)[XB_TMO])) break; if (_sp > XB_SPIN_CAP) { atomicAdd(&(bar)[XB_TMO], 1u); break; } } } } while (0)
struct XcdBarrier { unsigned* bar; unsigned x; volatile LAS unsigned* st; };
__device__ __forceinline__ XcdBarrier xcd_barrier_post(unsigned* bar, volatile LAS unsigned* st) {
    XcdBarrier b; b.bar = bar; b.x = xb_xcc_id(); b.st = st;
    if (threadIdx.x == 0) (void)xb_add(&bar[XB_XCNT(b.x)], 1u);
    return b;
}
__device__ __forceinline__ void xcd_barrier_complete(unsigned* bar, unsigned x, unsigned& nloc, unsigned& nx) {
    const unsigned G = gridDim.x * gridDim.y * gridDim.z;
    unsigned sum, cnt, mine, sp = 0u;
    for (;;) {
        sum = 0u; cnt = 0u; mine = 0u;
#pragma unroll
        for (unsigned j = 0; j < 16; ++j) { const unsigned c = xb_ld(&bar[XB_XCNT(j)]); sum += c; cnt += (c > 0u) ? 1u : 0u; mine = (j == x) ? c : mine; }
        if (sum == G) break;
        __builtin_amdgcn_s_sleep(1);
        if ((++sp & 255u) == 0u) { if (xb_ld(&bar[XB_TMO])) break; if (sp > XB_SPIN_CAP) { atomicAdd(&bar[XB_TMO], 1u); break; } }
    }
    nloc = mine > 0u ? mine : 1u; nx = cnt > 0u ? cnt : 1u;
}
__device__ __forceinline__ void xcd_barrier(const XcdBarrier& b) {
    asm volatile("s_waitcnt vmcnt(0)" ::: "memory");
    __syncthreads();
    if (threadIdx.x == 0) {
        unsigned* bar = b.bar; asm volatile("" : "+s"(bar));
        __builtin_amdgcn_s_waitcnt(0);
        unsigned nloc = b.st[0], nx = b.st[1];
        if (nloc == 0u) { xcd_barrier_complete(bar, b.x, nloc, nx); b.st[0] = nloc; b.st[1] = nx; }
        const unsigned old = xb_add(&bar[XB_XSUB(b.x)], 1u);
        const unsigned gen = old / nloc;
        if (old + 1u == (gen + 1u) * nloc) {
            __builtin_amdgcn_fence(__ATOMIC_RELEASE, "agent");
            asm volatile("s_waitcnt vmcnt(0)" ::: "memory");
            const unsigned og = xb_add(&bar[XB_TOP], 1u);
            const unsigned tg = og / nx;
            if (og + 1u == (tg + 1u) * nx) xb_add(&bar[XB_TOPGEN], 1u);
            else XB_SPIN(xb_ld(&bar[XB_TOPGEN]) == tg, bar);
            __builtin_amdgcn_fence(__ATOMIC_ACQUIRE, "agent");
            xb_add(&bar[XB_XGEN(b.x)], 1u);
            asm volatile("s_waitcnt vmcnt(0)" ::: "memory");
        } else {
            XB_SPIN(xb_ld(&bar[XB_XGEN(b.x)]) == gen, bar);
            __builtin_amdgcn_fence(__ATOMIC_ACQUIRE, "agent");
            asm volatile("s_waitcnt vmcnt(0)" ::: "memory");
        }
    }
    __syncthreads();
}

#endif

#ifndef CPU_EMU
#define NTHR 512
typedef short bf16x8 __attribute__((ext_vector_type(8)));
typedef float f32x4 __attribute__((ext_vector_type(4)));
typedef unsigned u32x4 __attribute__((ext_vector_type(4)));
typedef unsigned u32x2 __attribute__((ext_vector_type(2)));
#define MFMA16(a, b, c) __builtin_amdgcn_mfma_f32_16x16x32_bf16(a, b, c, 0, 0, 0)
typedef __bf16 bf16x2_t __attribute__((ext_vector_type(2)));
__device__ __forceinline__ unsigned pk_bf16(float lo, float hi) { bf16x2_t v; v.x = (__bf16)lo; v.y = (__bf16)hi; return __builtin_bit_cast(unsigned, v); }
__device__ __forceinline__ float bflo(unsigned w) { return __uint_as_float(w << 16); }
__device__ __forceinline__ float bfhi(unsigned w) { return __uint_as_float(w & 0xffff0000u); }
__device__ __forceinline__ float wscan_add(float v, int lane, int dir) {
#pragma unroll
    for (int off = 1; off < 64; off <<= 1) { const float o = dir == 0 ? __shfl_up(v, off, 64) : __shfl_down(v, off, 64); if (dir == 0 ? (lane >= off) : (lane + off < 64)) v += o; }
    return v; }
__device__ __forceinline__ float wscan_max(float v, int lane, int dir) {
#pragma unroll
    for (int off = 1; off < 64; off <<= 1) { const float o = dir == 0 ? __shfl_up(v, off, 64) : __shfl_down(v, off, 64); if (dir == 0 ? (lane >= off) : (lane + off < 64)) v = fmaxf(v, o); }
    return v; }
__device__ __forceinline__ float wred_max(float v) {
#pragma unroll
    for (int off = 32; off >= 1; off >>= 1) v = fmaxf(v, __shfl_xor(v, off, 64));
    return v; }
__device__ __forceinline__ void gate_lane(const P& p, int l, int h, int row, int dir, int lane, float& b, float& g) {
    const float* gp = p.gate_pre() + (size_t)row * 16; const float* bg = p.b_gates() + (size_t)l * 4 * NH;
    const float iv = gp[dir * NH + h] + bg[dir * NH + h];
    const float fv = gp[2 * NH + dir * NH + h] + bg[2 * NH + dir * NH + h];
    b = wscan_add(logsigmoidf_(fv), lane, dir); g = iv - b;
}
#define ML_LD 72
template <bool WITH_K> __device__ __forceinline__ void ml_stage_T(const P& p, int h, int c0, int wave, int lane, LAS bf16_t* VT, LAS bf16_t* KT, const LAS float* wl) {
#pragma unroll
    for (int i = 0; i < 2; ++i) { const int d0 = (wave * 2 + i) * 8;
        const u32x4 vv = *(const u32x4*)(p.proj() + (size_t)(c0 + lane) * PJ + C_V + h * DH + d0);
        const unsigned vw[4] = {vv.x, vv.y, vv.z, vv.w};
#pragma unroll
        for (int j = 0; j < 4; ++j) { VT[(d0 + 2 * j) * ML_LD + lane] = (bf16_t)(vw[j] & 0xffffu); VT[(d0 + 2 * j + 1) * ML_LD + lane] = (bf16_t)(vw[j] >> 16); }
        if constexpr (WITH_K) {
            const u32x4 kv = *(const u32x4*)(p.proj() + (size_t)(c0 + lane) * PJ + C_K + h * DH + d0);
            const unsigned kw[4] = {kv.x, kv.y, kv.z, kv.w}; const float w0 = wl[lane], w1 = wl[64 + lane];
#pragma unroll
            for (int j = 0; j < 4; ++j) { const float a = bflo(kw[j]), b = bfhi(kw[j]);
                KT[(d0 + 2 * j) * ML_LD + lane] = f2bf(a * w0); KT[(d0 + 2 * j + 1) * ML_LD + lane] = f2bf(b * w0);
                KT[(DH + d0 + 2 * j) * ML_LD + lane] = f2bf(a * w1); KT[(DH + d0 + 2 * j + 1) * ML_LD + lane] = f2bf(b * w1); }
        } }
}
__device__ __forceinline__ void unit_ml_cloc(const P& p, int l, int unit, LAS unsigned char* lds, unsigned* cntw) {
    int tid = threadIdx.x; asm volatile("" : "+v"(tid));
    const int wave = __builtin_amdgcn_readfirstlane(tid >> 6), lane = tid & 63, fr = lane & 15, fq = lane >> 4;
    const int h = unit % NH, gc = unit / NH, c0 = gc * LCH;
    LAS float* wl = (LAS float*)lds;
    LAS bf16_t* VT = (LAS bf16_t*)(lds + 512);
    LAS bf16_t* KT = VT + DH * ML_LD;
    if (wave < 2) { const int dir = wave; float b, g; gate_lane(p, l, h, c0 + lane, dir, lane, b, g);
        const float total = __shfl(b, dir == 0 ? 63 : 0, 64), gmax = wred_max(g);
        wl[dir * 64 + lane] = expf(g - gmax) * 0.08838834764831845f;
        const float pm = wscan_max(g, lane, dir); float* gs = p.gsc() + IDX_DHR(dir, h, c0 + lane); gs[0] = b; gs[(size_t)2 * NH * NROW] = g; gs[(size_t)4 * NH * NROW] = pm;
        if (lane == 0) { __hip_atomic_store(p.bL() + IDX_DHC(dir, h, gc), total, __ATOMIC_RELAXED, __HIP_MEMORY_SCOPE_AGENT); __hip_atomic_store(p.Mloc() + IDX_DHC(dir, h, gc), total + gmax, __ATOMIC_RELAXED, __HIP_MEMORY_SCOPE_AGENT); } }
    __syncthreads();
    ml_stage_T<true>(p, h, c0, wave, lane, VT, KT, wl);
    __syncthreads();
    if (tid < 256) { const int dir = tid >> 7, d = tid & 127; float s = 0.f; const LAS bf16_t* r = KT + (dir * DH + d) * ML_LD;
#pragma unroll 8
        for (int j = 0; j < 64; ++j) s += bf2f(r[j]);
        __hip_atomic_store(p.nloc() + IDX_DHC(dir, h, gc) * DH + d, s, __ATOMIC_RELAXED, __HIP_MEMORY_SCOPE_AGENT); }
    { const int e = tid >> 2, sg = (tid & 3) * 16; const LAS bf16_t* r = VT + e * ML_LD + sg; bf16_t* o = p.VTg() + ((size_t)(h * NCHK + gc) * DH + e) * LCH + sg;
      *(u32x4*)o = *(const LAS u32x4*)r; *(u32x4*)(o + 8) = *(const LAS u32x4*)(r + 8); }
#pragma unroll 1
    for (int dir = 0; dir < 2; ++dir) {
        f32x4 acc[8];
#pragma unroll
        for (int i = 0; i < 8; ++i) acc[i] = (f32x4){0.f, 0.f, 0.f, 0.f};
#pragma unroll
        for (int ks = 0; ks < 2; ++ks) { const bf16x8 a = *(const LAS bf16x8*)(VT + (16 * wave + fr) * ML_LD + 32 * ks + 8 * fq);
#pragma unroll
            for (int dt = 0; dt < 8; ++dt) { const bf16x8 b = *(const LAS bf16x8*)(KT + (dir * DH + 16 * dt + fr) * ML_LD + 32 * ks + 8 * fq); acc[dt] = MFMA16(b, a, acc[dt]); } }
        bf16_t* o = (bf16_t*)p.Cloc() + (IDX_DHC(dir, h, gc) * DH + 16 * wave + fr) * DH + 4 * fq;
#pragma unroll
        for (int dt = 0; dt < 8; ++dt) { const unsigned long long w = (unsigned long long)pk_bf16(acc[dt][0], acc[dt][1]) | ((unsigned long long)pk_bf16(acc[dt][2], acc[dt][3]) << 32);
            __hip_atomic_store((unsigned long long*)(o + 16 * dt), w, __ATOMIC_RELAXED, __HIP_MEMORY_SCOPE_AGENT); }
    }
    asm volatile("s_waitcnt vmcnt(0)" ::: "memory");
    __syncthreads();
    if (tid == 0) __hip_atomic_fetch_add(cntw, 1u, __ATOMIC_RELAXED, __HIP_MEMORY_SCOPE_AGENT);
}
struct ScanItem { int e, d, dir, h, sl; };
template <bool CTX> __device__ __forceinline__ ScanItem scan_decode(size_t i) { constexpr int NS = CTX ? NB_CTX : NB_LAT; ScanItem s; s.d = (int)(i % (DH / 4)) * 4; s.e = (int)((i / (DH / 4)) % DH); const size_t j = i / ((size_t)DH * DH / 4); s.sl = (int)(j % NS); s.h = (int)((j / NS) % NH); s.dir = (int)(j / (NS * NH)); return s; }
template <int NC, bool CTX> __device__ __forceinline__ void scan_load(const P& p, const ScanItem& it, u32x2 (&cl)[NC], float (&bLv)[NC], float (&mlv)[NC]) {
    const int gc0 = seq_start(CTX ? it.sl : NB_CTX + it.sl) / LCH;
#pragma unroll
    for (int jj = 0; jj < NC; ++jj) { const int gc = gc0 + (it.dir == 0 ? jj : NC - 1 - jj); const size_t ci = IDX_DHC(it.dir, it.h, gc);
        bLv[jj] = p.bL()[ci]; mlv[jj] = p.Mloc()[ci]; cl[jj] = *(const u32x2*)((const bf16_t*)p.Cloc() + (ci * DH + it.e) * DH + it.d); }
}
template <int NC, bool CTX> __device__ __forceinline__ void scan_run(const P& p, int l, const ScanItem& it, const u32x2 (&cl)[NC], const float (&bLv)[NC], const float (&mlv)[NC], f32x4& C, f32x4& n, float& m) {
    const int gc0 = seq_start(CTX ? it.sl : NB_CTX + it.sl) / LCH; const int e = it.e, d = it.d;
#pragma unroll
    for (int jj = 0; jj < NC; ++jj) {
        const int gc = gc0 + (it.dir == 0 ? jj : NC - 1 - jj); const size_t ci = IDX_DHC(it.dir, it.h, gc);
        const float mnew = fmaxf(bLv[jj] + m, mlv[jj]); const float dec = __expf(bLv[jj] + m - mnew), sc = __expf(mlv[jj] - mnew);
        u32x2 w; w.x = pk_bf16(C[0], C[1]); w.y = pk_bf16(C[2], C[3]); *(u32x2*)(p.CprevT() + (ci * DH + e) * DH + d) = w;
        C = dec * C + sc * (f32x4){bflo(cl[jj].x), bfhi(cl[jj].x), bflo(cl[jj].y), bfhi(cl[jj].y)};
        if (e == 0) { const f32x4 nl = *(const f32x4*)(p.nloc() + ci * DH + d); *(f32x4*)(p.nprev() + ci * DH + d) = n; n = dec * n + sc * nl; }
        if (e == 0 && d == 0) p.Mprev()[ci] = m;
        m = mnew;
    }
}
__device__ __forceinline__ void phase_scan(const P& p, int l, LAS unsigned char* lds) {
    int t_ = threadIdx.x; asm volatile("" : "+v"(t_));
    const size_t gtid = (size_t)blockIdx.x * NTHR + t_, nthr = (size_t)gridDim.x * NTHR;
    constexpr size_t NLAT = (size_t)2 * NH * NB_LAT * DH * (DH / 4); constexpr int NCL = T_LAT / LCH;
    for (size_t i = gtid; i < NLAT; i += nthr) { const ScanItem it = scan_decode<false>(i); u32x2 cl[NCL]; float bLv[NCL], mlv[NCL]; scan_load<NCL, false>(p, it, cl, bLv, mlv);
        const size_t base = (((size_t)it.sl * DEPTH + l) * 2 + it.dir) * NH + it.h; f32x4 C, n = {0.f, 0.f, 0.f, 0.f};
#pragma unroll
        for (int q = 0; q < 4; ++q) C[q] = p.state_C()[(base * DH + it.d + q) * DH + it.e];
        if (it.e == 0) n = *(const f32x4*)(p.state_n() + base * DH + it.d);
        float m = p.state_m()[base];
        asm volatile("" ::: "memory"); scan_run<NCL, false>(p, l, it, cl, bLv, mlv, C, n, m); }
}
__device__ __forceinline__ void unit_ml_out(const P& p, int l, int unit, LAS unsigned char* lds) {
    int tid = threadIdx.x; asm volatile("" : "+v"(tid));
    const int wave = __builtin_amdgcn_readfirstlane(tid >> 6), lane = tid & 63, fr = lane & 15, fq = lane >> 4;
    const int h = unit % NH, gc = unit / NH, c0 = gc * LCH;
    LAS float* ssq = (LAS float*)lds;
    LAS bf16_t* VT = (LAS bf16_t*)(lds + 1024);
    LAS bf16_t* SS = VT + DH * ML_LD;
    const bf16_t* Q = p.proj() + (size_t)c0 * PJ + C_Q + h * DH; const bf16_t* K = p.proj() + (size_t)c0 * PJ + C_K + h * DH;
    const int tt = wave & 3, wh = wave >> 2, t = 16 * tt + fr; const size_t row = (size_t)c0 + t;
    bf16x8 qf[4], kf[2][4], cf0[4][4], cf1[4][4];
#pragma unroll
    for (int ks = 0; ks < 4; ++ks) { qf[ks] = *(const bf16x8*)(Q + (size_t)t * PJ + 32 * ks + 8 * fq);
#pragma unroll
        for (int i = 0; i < 2; ++i) kf[i][ks] = *(const bf16x8*)(K + (size_t)(16 * (2 * wh + i) + fr) * PJ + 32 * ks + 8 * fq); }
    { const bf16_t* CT0 = p.CprevT() + IDX_DHC(0, h, gc) * DH * DH;
#pragma unroll
      for (int ks = 0; ks < 4; ++ks)
#pragma unroll
          for (int i = 0; i < 4; ++i) cf0[i][ks] = *(const bf16x8*)(CT0 + (size_t)(16 * (4 * wh + i) + fr) * DH + 32 * ks + 8 * fq); }
    { const int e = tid >> 2, sg = (tid & 3) * 16; const bf16_t* o = p.VTg() + ((size_t)(h * NCHK + gc) * DH + e) * LCH + sg; const u32x4 v0 = *(const u32x4*)o, v1 = *(const u32x4*)(o + 8);
      *(LAS u32x4*)(VT + e * ML_LD + sg) = v0; *(LAS u32x4*)(VT + e * ML_LD + sg + 8) = v1; }
    float rowterm[2], winter[2], emt[2], qn[2]; f32x4 colterm[2][2];
#pragma unroll
    for (int dir = 0; dir < 2; ++dir) { const float* gs = p.gsc() + IDX_DHR(dir, h, row); const float bt = gs[0], pmt = gs[(size_t)4 * NH * NROW]; const float mprev = p.Mprev()[IDX_DHC(dir, h, gc)];
        const float mt = bt + fmaxf(mprev, pmt); rowterm[dir] = bt - mt; winter[dir] = __expf(bt + mprev - mt); emt[dir] = __expf(-mt);
#pragma unroll
        for (int i = 0; i < 2; ++i) colterm[dir][i] = *(const f32x4*)(p.gsc() + (size_t)2 * NH * NROW + IDX_DHR(dir, h, c0 + 16 * (2 * wh + i) + 4 * fq));
        const float* np = p.nprev() + IDX_DHC(dir, h, gc) * DH + 8 * fq; float s = 0.f;
#pragma unroll
        for (int ks = 0; ks < 4; ++ks) { const f32x4 n0 = *(const f32x4*)(np + 32 * ks), n1 = *(const f32x4*)(np + 32 * ks + 4); const u32x4 qv = __builtin_bit_cast(u32x4, qf[ks]);
            s += bflo(qv.x) * n0[0] + bfhi(qv.x) * n0[1] + bflo(qv.y) * n0[2] + bfhi(qv.y) * n0[3] + bflo(qv.z) * n1[0] + bfhi(qv.z) * n1[1] + bflo(qv.w) * n1[2] + bfhi(qv.w) * n1[3]; }
        s += __shfl_xor(s, 16, 64); s += __shfl_xor(s, 32, 64); qn[dir] = s; asm volatile("" : "+v"(qn[dir]) :: "memory"); }
    {
        f32x4 sc[2] = {{0.f, 0.f, 0.f, 0.f}, {0.f, 0.f, 0.f, 0.f}};
#pragma unroll
        for (int ks = 0; ks < 4; ++ks)
#pragma unroll
            for (int i = 0; i < 2; ++i) sc[i] = MFMA16(kf[i][ks], qf[ks], sc[i]);
#pragma unroll
        for (int dir = 0; dir < 2; ++dir) {
#pragma unroll
            for (int i = 0; i < 2; ++i) { const int s0 = 16 * (2 * wh + i) + 4 * fq; float v[4];
#pragma unroll
                for (int j = 0; j < 4; ++j) { const int s = s0 + j; const bool ok = dir == 0 ? (s <= t) : (s >= t); v[j] = ok ? sc[i][j] * 0.08838834764831845f * __expf(rowterm[dir] + colterm[dir][i][j]) : 0.f; }
                u32x2 w; w.x = pk_bf16(v[0], v[1]); w.y = pk_bf16(v[2], v[3]); *(LAS u32x2*)(SS + (dir * 64 + t) * ML_LD + s0) = w; } }
    }
    asm volatile("" ::: "memory");
    { const bf16_t* CT1 = p.CprevT() + IDX_DHC(1, h, gc) * DH * DH;
#pragma unroll
      for (int ks = 0; ks < 4; ++ks)
#pragma unroll
          for (int i = 0; i < 4; ++i) cf1[i][ks] = *(const bf16x8*)(CT1 + (size_t)(16 * (4 * wh + i) + fr) * DH + 32 * ks + 8 * fq); }
    u32x2 ow[4];
#pragma unroll
    for (int i = 0; i < 4; ++i) ow[i] = *(const u32x2*)(p.proj() + row * PJ + C_O + h * DH + 16 * (4 * wh + i) + 4 * fq);
    __syncthreads();
    f32x4 hs[4];
#pragma unroll
    for (int i = 0; i < 4; ++i) hs[i] = (f32x4){0.f, 0.f, 0.f, 0.f};
#pragma unroll
    for (int dir = 0; dir < 2; ++dir) {
        f32x4 a1[4], a2[4];
#pragma unroll
        for (int i = 0; i < 4; ++i) { a1[i] = (f32x4){0.f, 0.f, 0.f, 0.f}; a2[i] = (f32x4){0.f, 0.f, 0.f, 0.f}; }
        const LAS bf16_t* Sd = SS + dir * 64 * ML_LD;
#pragma unroll
        for (int ks = 0; ks < 2; ++ks) { const bf16x8 sf = *(const LAS bf16x8*)(Sd + t * ML_LD + 32 * ks + 8 * fq);
#pragma unroll
            for (int i = 0; i < 4; ++i) { const bf16x8 vf = *(const LAS bf16x8*)(VT + (16 * (4 * wh + i) + fr) * ML_LD + 32 * ks + 8 * fq); a1[i] = MFMA16(vf, sf, a1[i]); } }
#pragma unroll
        for (int ks = 0; ks < 4; ++ks)
#pragma unroll
            for (int i = 0; i < 4; ++i) a2[i] = MFMA16(dir == 0 ? cf0[i][ks] : cf1[i][ks], qf[ks], a2[i]);
        float rs = 0.f;
        { const u32x4 s0 = *(const LAS u32x4*)(Sd + t * ML_LD + 16 * fq), s1 = *(const LAS u32x4*)(Sd + t * ML_LD + 16 * fq + 8);
            rs = bflo(s0.x) + bfhi(s0.x) + bflo(s0.y) + bfhi(s0.y) + bflo(s0.z) + bfhi(s0.z) + bflo(s0.w) + bfhi(s0.w) + bflo(s1.x) + bfhi(s1.x) + bflo(s1.y) + bfhi(s1.y) + bflo(s1.z) + bfhi(s1.z) + bflo(s1.w) + bfhi(s1.w); }
        rs += __shfl_xor(rs, 16, 64); rs += __shfl_xor(rs, 32, 64);
        const float wi = winter[dir]; const float den = rs + wi * qn[dir]; const float inv = 1.0f / fmaxf(fabsf(den), emt[dir]);
#pragma unroll
        for (int i = 0; i < 4; ++i) hs[i] = hs[i] + (a1[i] + wi * a2[i]) * inv;
    }
    f32x4 gm[4];
#pragma unroll
    for (int i = 0; i < 4; ++i) gm[i] = *(const f32x4*)(p.g_mlstm() + (size_t)l * DB + h * DH + 16 * (4 * wh + i) + 4 * fq);
    float q2 = 0.f;
#pragma unroll
    for (int i = 0; i < 4; ++i) q2 += hs[i][0] * hs[i][0] + hs[i][1] * hs[i][1] + hs[i][2] * hs[i][2] + hs[i][3] * hs[i][3];
    q2 += __shfl_xor(q2, 16, 64); q2 += __shfl_xor(q2, 32, 64);
    if (fq == 0) ssq[wh * 64 + t] = q2;
    __syncthreads();
    const float rstd = 1.0f / sqrtf((ssq[t] + ssq[64 + t]) * (1.0f / DH) + EPSF);
#pragma unroll
    for (int i = 0; i < 4; ++i) { const int e = 16 * (4 * wh + i) + 4 * fq;
        const float o0 = bflo(ow[i].x), o1 = bfhi(ow[i].x), o2 = bflo(ow[i].y), o3 = bfhi(ow[i].y);
        const float y0 = hs[i][0] * rstd * gm[i][0] * __builtin_amdgcn_rcpf(1.0f + __expf(-o0)), y1 = hs[i][1] * rstd * gm[i][1] * __builtin_amdgcn_rcpf(1.0f + __expf(-o1)), y2 = hs[i][2] * rstd * gm[i][2] * __builtin_amdgcn_rcpf(1.0f + __expf(-o2)), y3 = hs[i][3] * rstd * gm[i][3] * __builtin_amdgcn_rcpf(1.0f + __expf(-o3));
        u32x2 w; w.x = pk_bf16(y0, y1); w.y = pk_bf16(y2, y3); *(u32x2*)(p.ys() + row * 3 * DB + 2 * DB + h * DH + e) = w; }
    __syncthreads();
}
#define CT_LD 136
typedef float f32x2 __attribute__((ext_vector_type(2)));
__device__ __forceinline__ void unit_ml_out2(const P& p, int l, int sl, int h, int jc, LAS unsigned char* lds, unsigned* cntw) {
    int tid = threadIdx.x; asm volatile("" : "+v"(tid));
    const int wave = __builtin_amdgcn_readfirstlane(tid >> 6), lane = tid & 63, fr = lane & 15, fq = lane >> 4;
    const int gc0 = (R_CTX + sl * T_LAT) / LCH, gc = gc0 + jc, c0 = gc * LCH;
    LAS float* ssq = (LAS float*)lds;
    LAS float* cf = (LAS float*)(lds + 512);
    LAS float* npv = (LAS float*)(lds + 1024);
    LAS bf16_t* VT = (LAS bf16_t*)(lds + 2048);
    LAS bf16_t* SS = VT + DH * ML_LD;
    LAS bf16_t* CT = SS + 2 * 64 * ML_LD;
    if (tid == 0) { unsigned sp = 0; while (__hip_atomic_load(cntw, __ATOMIC_RELAXED, __HIP_MEMORY_SCOPE_AGENT) < 16u) { __builtin_amdgcn_s_sleep(2); if (++sp > (1u << 22)) break; }
        __builtin_amdgcn_fence(__ATOMIC_ACQUIRE, "agent"); asm volatile("s_waitcnt vmcnt(0)" ::: "memory"); }
    __syncthreads();
    const size_t sbase = (((size_t)sl * DEPTH + l) * 2) * NH + h;
    if (wave < 2) { const int dir = wave, o = lane & 15; const size_t ci = IDX_DHC(dir, h, gc0 + o);
        const float bl = p.bL()[ci], ml = p.Mloc()[ci], m0 = p.state_m()[sbase + dir * NH];
        const bool act = dir == 0 ? (o < jc) : (o > jc);
        float sb = 0.f, tot = 0.f;
#pragma unroll
        for (int i = 0; i < 16; ++i) { const float bi = __shfl(bl, i, 64); const bool ai = dir == 0 ? (i < jc) : (i > jc); const bool later = dir == 0 ? (i > o) : (i < o);
            tot += ai ? bi : 0.f; sb += (ai && later) ? bi : 0.f; }
        const float a = act ? ml + sb : -3.0e38f, a0 = m0 + tot;
        const float mp = fmaxf(wred_max(a), a0);
        if (lane < 16) cf[dir * 32 + o] = act ? __expf(a - mp) : 0.f;
        if (lane == 0) { cf[dir * 32 + 16] = __expf(a0 - mp); cf[dir * 32 + 17] = mp; } }
    __syncthreads();
    if (tid < 256) { const int dir = tid >> 7, d = tid & 127; float s = cf[dir * 32 + 16] * p.state_n()[(sbase + dir * NH) * DH + d];
#pragma unroll
        for (int o = 0; o < 16; ++o) s += cf[dir * 32 + o] * p.nloc()[IDX_DHC(dir, h, gc0 + o) * DH + d];
        npv[tid] = s; }
    {
        f32x2 a0[4][4], a1[4][4];
#pragma unroll
        for (int q = 0; q < 4; ++q)
#pragma unroll
            for (int w = 0; w < 4; ++w) { a0[q][w] = (f32x2){0.f, 0.f}; a1[q][w] = (f32x2){0.f, 0.f}; }
        const int e_ = tid >> 4, d8 = (tid & 15) * 8;
        const bf16_t* CL = (const bf16_t*)p.Cloc() + (size_t)e_ * DH + d8;
#define OUT2_FMA(acc, wgt, vv) do { const unsigned w_[4] = {(vv).x, (vv).y, (vv).z, (vv).w}; _Pragma("unroll") for (int w = 0; w < 4; ++w) acc[w] = acc[w] + (f32x2){bflo(w_[w]), bfhi(w_[w])} * (wgt); } while (0)
#pragma unroll 1
        for (int ob = 0; ob < 16; ob += 4) {
            u32x4 v[4][4];
#pragma unroll
            for (int oo = 0; oo < 4; ++oo) { const int o = ob + oo; const bf16_t* src = CL + IDX_DHC(o > jc ? 1 : 0, h, gc0 + o) * DH * DH;
#pragma unroll
                for (int q = 0; q < 4; ++q) v[oo][q] = *(const u32x4*)(src + (size_t)q * 32 * DH); }
#pragma unroll
            for (int oo = 0; oo < 4; ++oo) { const int o = ob + oo;
                if (o < jc) { const float wg = cf[o];
#pragma unroll
                    for (int q = 0; q < 4; ++q) OUT2_FMA(a0[q], wg, v[oo][q]); }
                else { const float wg = cf[32 + o];
#pragma unroll
                    for (int q = 0; q < 4; ++q) OUT2_FMA(a1[q], wg, v[oo][q]); } }
        }
        { const bf16_t* s0 = p.C0T() + (sbase * DH + e_) * DH + d8; const bf16_t* s1 = s0 + (size_t)NH * DH * DH; u32x4 v0[4], v1[4];
#pragma unroll
          for (int q = 0; q < 4; ++q) { v0[q] = *(const u32x4*)(s0 + (size_t)q * 32 * DH); v1[q] = *(const u32x4*)(s1 + (size_t)q * 32 * DH); }
          const float w0 = cf[16], w1 = cf[48];
#pragma unroll
          for (int q = 0; q < 4; ++q) { OUT2_FMA(a0[q], w0, v0[q]); OUT2_FMA(a1[q], w1, v1[q]); } }
#undef OUT2_FMA
#pragma unroll
        for (int q = 0; q < 4; ++q) { u32x4 w0, w1;
            w0.x = pk_bf16(a0[q][0].x, a0[q][0].y); w0.y = pk_bf16(a0[q][1].x, a0[q][1].y); w0.z = pk_bf16(a0[q][2].x, a0[q][2].y); w0.w = pk_bf16(a0[q][3].x, a0[q][3].y);
            w1.x = pk_bf16(a1[q][0].x, a1[q][0].y); w1.y = pk_bf16(a1[q][1].x, a1[q][1].y); w1.z = pk_bf16(a1[q][2].x, a1[q][2].y); w1.w = pk_bf16(a1[q][3].x, a1[q][3].y);
            *(LAS u32x4*)(CT + (e_ + 32 * q) * CT_LD + d8) = w0; *(LAS u32x4*)(CT + (DH + e_ + 32 * q) * CT_LD + d8) = w1; }
    }
    __syncthreads();
    const bf16_t* Q = p.proj() + (size_t)c0 * PJ + C_Q + h * DH; const bf16_t* K = p.proj() + (size_t)c0 * PJ + C_K + h * DH;
    const int tt = wave & 3, wh = wave >> 2, t = 16 * tt + fr; const size_t row = (size_t)c0 + t;
    bf16x8 qf[4], kf[2][4];
#pragma unroll
    for (int ks = 0; ks < 4; ++ks) { qf[ks] = *(const bf16x8*)(Q + (size_t)t * PJ + 32 * ks + 8 * fq);
#pragma unroll
        for (int i = 0; i < 2; ++i) kf[i][ks] = *(const bf16x8*)(K + (size_t)(16 * (2 * wh + i) + fr) * PJ + 32 * ks + 8 * fq); }
    { const int e = tid >> 2, sg = (tid & 3) * 16; const bf16_t* o = p.VTg() + ((size_t)(h * NCHK + gc) * DH + e) * LCH + sg; const u32x4 v0 = *(const u32x4*)o, v1 = *(const u32x4*)(o + 8);
      *(LAS u32x4*)(VT + e * ML_LD + sg) = v0; *(LAS u32x4*)(VT + e * ML_LD + sg + 8) = v1; }
    float rowterm[2], winter[2], emt[2], qn[2]; f32x4 colterm[2][2];
#pragma unroll
    for (int dir = 0; dir < 2; ++dir) { const float* gs = p.gsc() + IDX_DHR(dir, h, row); const float bt = gs[0], pmt = gs[(size_t)4 * NH * NROW]; const float mprev = cf[dir * 32 + 17];
        const float mt = bt + fmaxf(mprev, pmt); rowterm[dir] = bt - mt; winter[dir] = __expf(bt + mprev - mt); emt[dir] = __expf(-mt);
#pragma unroll
        for (int i = 0; i < 2; ++i) colterm[dir][i] = *(const f32x4*)(p.gsc() + (size_t)2 * NH * NROW + IDX_DHR(dir, h, c0 + 16 * (2 * wh + i) + 4 * fq));
        const LAS float* np = npv + dir * DH + 8 * fq; float s = 0.f;
#pragma unroll
        for (int ks = 0; ks < 4; ++ks) { const f32x4 n0 = *(const LAS f32x4*)(np + 32 * ks), n1 = *(const LAS f32x4*)(np + 32 * ks + 4); const u32x4 qv = __builtin_bit_cast(u32x4, qf[ks]);
            s += bflo(qv.x) * n0[0] + bfhi(qv.x) * n0[1] + bflo(qv.y) * n0[2] + bfhi(qv.y) * n0[3] + bflo(qv.z) * n1[0] + bfhi(qv.z) * n1[1] + bflo(qv.w) * n1[2] + bfhi(qv.w) * n1[3]; }
        s += __shfl_xor(s, 16, 64); s += __shfl_xor(s, 32, 64); qn[dir] = s; }
    {
        f32x4 sc[2] = {{0.f, 0.f, 0.f, 0.f}, {0.f, 0.f, 0.f, 0.f}};
#pragma unroll
        for (int ks = 0; ks < 4; ++ks)
#pragma unroll
            for (int i = 0; i < 2; ++i) sc[i] = MFMA16(kf[i][ks], qf[ks], sc[i]);
#pragma unroll
        for (int dir = 0; dir < 2; ++dir) {
#pragma unroll
            for (int i = 0; i < 2; ++i) { const int s0 = 16 * (2 * wh + i) + 4 * fq; float v[4];
#pragma unroll
                for (int j = 0; j < 4; ++j) { const int s = s0 + j; const bool ok = dir == 0 ? (s <= t) : (s >= t); v[j] = ok ? sc[i][j] * 0.08838834764831845f * __expf(rowterm[dir] + colterm[dir][i][j]) : 0.f; }
                u32x2 w; w.x = pk_bf16(v[0], v[1]); w.y = pk_bf16(v[2], v[3]); *(LAS u32x2*)(SS + (dir * 64 + t) * ML_LD + s0) = w; } }
    }
    u32x2 ow[4];
#pragma unroll
    for (int i = 0; i < 4; ++i) ow[i] = *(const u32x2*)(p.proj() + row * PJ + C_O + h * DH + 16 * (4 * wh + i) + 4 * fq);
    __syncthreads();
    f32x4 hs[4];
#pragma unroll
    for (int i = 0; i < 4; ++i) hs[i] = (f32x4){0.f, 0.f, 0.f, 0.f};
#pragma unroll
    for (int dir = 0; dir < 2; ++dir) {
        f32x4 a1[4], a2[4];
#pragma unroll
        for (int i = 0; i < 4; ++i) { a1[i] = (f32x4){0.f, 0.f, 0.f, 0.f}; a2[i] = (f32x4){0.f, 0.f, 0.f, 0.f}; }
        const LAS bf16_t* Sd = SS + dir * 64 * ML_LD;
#pragma unroll
        for (int ks = 0; ks < 2; ++ks) { const bf16x8 sf = *(const LAS bf16x8*)(Sd + t * ML_LD + 32 * ks + 8 * fq);
#pragma unroll
            for (int i = 0; i < 4; ++i) { const bf16x8 vf = *(const LAS bf16x8*)(VT + (16 * (4 * wh + i) + fr) * ML_LD + 32 * ks + 8 * fq); a1[i] = MFMA16(vf, sf, a1[i]); } }
#pragma unroll
        for (int ks = 0; ks < 4; ++ks)
#pragma unroll
            for (int i = 0; i < 4; ++i) { const bf16x8 cfr = *(const LAS bf16x8*)(CT + (dir * DH + 16 * (4 * wh + i) + fr) * CT_LD + 32 * ks + 8 * fq); a2[i] = MFMA16(cfr, qf[ks], a2[i]); }
        float rs = 0.f;
        { const u32x4 s0 = *(const LAS u32x4*)(Sd + t * ML_LD + 16 * fq), s1 = *(const LAS u32x4*)(Sd + t * ML_LD + 16 * fq + 8);
            rs = bflo(s0.x) + bfhi(s0.x) + bflo(s0.y) + bfhi(s0.y) + bflo(s0.z) + bfhi(s0.z) + bflo(s0.w) + bfhi(s0.w) + bflo(s1.x) + bfhi(s1.x) + bflo(s1.y) + bfhi(s1.y) + bflo(s1.z) + bfhi(s1.z) + bflo(s1.w) + bfhi(s1.w); }
        rs += __shfl_xor(rs, 16, 64); rs += __shfl_xor(rs, 32, 64);
        const float wi = winter[dir]; const float den = rs + wi * qn[dir]; const float inv = 1.0f / fmaxf(fabsf(den), emt[dir]);
#pragma unroll
        for (int i = 0; i < 4; ++i) hs[i] = hs[i] + (a1[i] + wi * a2[i]) * inv;
    }
    f32x4 gm[4];
#pragma unroll
    for (int i = 0; i < 4; ++i) gm[i] = *(const f32x4*)(p.g_mlstm() + (size_t)l * DB + h * DH + 16 * (4 * wh + i) + 4 * fq);
    float q2 = 0.f;
#pragma unroll
    for (int i = 0; i < 4; ++i) q2 += hs[i][0] * hs[i][0] + hs[i][1] * hs[i][1] + hs[i][2] * hs[i][2] + hs[i][3] * hs[i][3];
    q2 += __shfl_xor(q2, 16, 64); q2 += __shfl_xor(q2, 32, 64);
    if (fq == 0) ssq[wh * 64 + t] = q2;
    __syncthreads();
    const float rstd = 1.0f / sqrtf((ssq[t] + ssq[64 + t]) * (1.0f / DH) + EPSF);
#pragma unroll
    for (int i = 0; i < 4; ++i) { const int e = 16 * (4 * wh + i) + 4 * fq;
        const float o0 = bflo(ow[i].x), o1 = bfhi(ow[i].x), o2 = bflo(ow[i].y), o3 = bfhi(ow[i].y);
        const float y0 = hs[i][0] * rstd * gm[i][0] * __builtin_amdgcn_rcpf(1.0f + __expf(-o0)), y1 = hs[i][1] * rstd * gm[i][1] * __builtin_amdgcn_rcpf(1.0f + __expf(-o1)), y2 = hs[i][2] * rstd * gm[i][2] * __builtin_amdgcn_rcpf(1.0f + __expf(-o2)), y3 = hs[i][3] * rstd * gm[i][3] * __builtin_amdgcn_rcpf(1.0f + __expf(-o3));
        u32x2 w; w.x = pk_bf16(y0, y1); w.y = pk_bf16(y2, y3); *(u32x2*)(p.ys() + row * 3 * DB + 2 * DB + h * DH + e) = w; }
    __syncthreads();
}
#endif
#ifndef CPU_EMU
#define SQ_LD 136
__device__ __forceinline__ void unit_ml_seq(const P& p, int l, int unit, LAS unsigned char* lds, unsigned* flags) {
    int tid = threadIdx.x; asm volatile("" : "+v"(tid));
    const int wave = __builtin_amdgcn_readfirstlane(tid >> 6), lane = tid & 63, fr = lane & 15, fq = lane >> 4;
    const int dir = unit & 1, h = (unit >> 1) & (NH - 1), b = unit / (2 * NH), r0 = b * T_CTX;
    constexpr int NCQ = T_CTX / LCH;
    LAS float* nst = (LAS float*)lds;
    LAS float* DEC = nst + 256;
    LAS float* GB = (LAS float*)(lds + 2048);
    LAS float* GG = GB + NCQ * 64;
    LAS float* GP = GG + NCQ * 64;
    LAS float* EM = GP + NCQ * 64;
    LAS float* WS = EM + NCQ * 64;
    LAS float* GT = WS + NCQ * 64; LAS float* GM = GT + NCQ;
    LAS bf16_t* VT = (LAS bf16_t*)(lds + 8192);
    LAS bf16_t* KT = VT + DH * ML_LD;
    LAS bf16_t* SS = KT + DH * ML_LD;
    LAS bf16_t* CTl = SS + 64 * ML_LD;
    const int tt = wave & 3, wh = wave >> 2, t = 16 * tt + fr;
    f32x4 cacc[8];
#pragma unroll
    for (int i = 0; i < 8; ++i) cacc[i] = (f32x4){0.f, 0.f, 0.f, 0.f};
    if (tid < DH) nst[tid] = 0.f;
    float* hb = p.hbc() + ((size_t)dir * R_CTX) * DB + h * DH;
    if (wave < NCQ) { const int jo = dir == 0 ? wave : NCQ - 1 - wave; float bb, g; gate_lane(p, l, h, r0 + jo * LCH + lane, dir, lane, bb, g);
        const float pm = wscan_max(g, lane, dir), total = __shfl(bb, dir == 0 ? 63 : 0, 64), gmax = wred_max(g);
        GB[wave * 64 + lane] = bb; GG[wave * 64 + lane] = g; GP[wave * 64 + lane] = pm; if (lane == 0) { GT[wave] = total; GM[wave] = gmax; } }
    bf16x8 qf[4], kf[2][4]; u32x4 kvr[2], vvr[2];
#define SQ_LOAD(jj_) do { const int jo_ = dir == 0 ? (jj_) : NCQ - 1 - (jj_), c0_ = r0 + jo_ * LCH; const bf16_t* Q_ = p.proj() + (size_t)c0_ * PJ + C_Q + h * DH; const bf16_t* K_ = p.proj() + (size_t)c0_ * PJ + C_K + h * DH; \
        _Pragma("unroll") for (int ks = 0; ks < 4; ++ks) { qf[ks] = *(const bf16x8*)(Q_ + (size_t)t * PJ + 32 * ks + 8 * fq); \
            _Pragma("unroll") for (int i = 0; i < 2; ++i) kf[i][ks] = *(const bf16x8*)(K_ + (size_t)(16 * (2 * wh + i) + fr) * PJ + 32 * ks + 8 * fq); } \
        _Pragma("unroll") for (int i = 0; i < 2; ++i) { const int d0 = (wave * 2 + i) * 8; kvr[i] = *(const u32x4*)(p.proj() + (size_t)(c0_ + lane) * PJ + C_K + h * DH + d0); vvr[i] = *(const u32x4*)(p.proj() + (size_t)(c0_ + lane) * PJ + C_V + h * DH + d0); } } while (0)
    SQ_LOAD(0);
    __syncthreads();
    if (wave == 0) { float mm = 0.f;
#pragma unroll
        for (int jj = 0; jj < NCQ; ++jj) { const float bb = GB[jj * 64 + lane], g = GG[jj * 64 + lane], pm = GP[jj * 64 + lane], total = GT[jj], gmax = GM[jj];
            const float mt = bb + fmaxf(mm, pm), mnew = total + fmaxf(mm, gmax);
            GB[jj * 64 + lane] = bb - mt; GP[jj * 64 + lane] = __expf(bb + mm - mt); EM[jj * 64 + lane] = __expf(-mt); WS[jj * 64 + lane] = __expf(total + g - mnew) * 0.08838834764831845f;
            if (lane == 0) DEC[jj] = __expf(total + mm - mnew);
            mm = mnew; }
        if (lane == 0) DEC[NCQ] = mm; }
    __syncthreads();
#pragma unroll 1
    for (int jj = 0; jj < NCQ; ++jj) {
        const int jo = dir == 0 ? jj : NCQ - 1 - jj, c0 = r0 + jo * LCH;
        { const float w0 = WS[jj * 64 + lane];
#pragma unroll
          for (int i = 0; i < 2; ++i) { const int d0 = (wave * 2 + i) * 8; const unsigned vw[4] = {vvr[i].x, vvr[i].y, vvr[i].z, vvr[i].w}, kw[4] = {kvr[i].x, kvr[i].y, kvr[i].z, kvr[i].w};
#pragma unroll
              for (int j = 0; j < 4; ++j) { VT[(d0 + 2 * j) * ML_LD + lane] = (bf16_t)(vw[j] & 0xffffu); VT[(d0 + 2 * j + 1) * ML_LD + lane] = (bf16_t)(vw[j] >> 16);
                  KT[(d0 + 2 * j) * ML_LD + lane] = f2bf(bflo(kw[j]) * w0); KT[(d0 + 2 * j + 1) * ML_LD + lane] = f2bf(bfhi(kw[j]) * w0); } } }
#pragma unroll
        for (int dt = 0; dt < 8; ++dt) { u32x2 w; w.x = pk_bf16(cacc[dt][0], cacc[dt][1]); w.y = pk_bf16(cacc[dt][2], cacc[dt][3]); *(LAS u32x2*)(CTl + (16 * wave + fr) * SQ_LD + 16 * dt + 4 * fq) = w; }
        {
            f32x4 sc[2] = {{0.f, 0.f, 0.f, 0.f}, {0.f, 0.f, 0.f, 0.f}};
#pragma unroll
            for (int ks = 0; ks < 4; ++ks)
#pragma unroll
                for (int i = 0; i < 2; ++i) sc[i] = MFMA16(kf[i][ks], qf[ks], sc[i]);
            const float rt = GB[jj * 64 + t];
#pragma unroll
            for (int i = 0; i < 2; ++i) { const int s0 = 16 * (2 * wh + i) + 4 * fq; float v[4];
#pragma unroll
                for (int j = 0; j < 4; ++j) { const int s = s0 + j; const bool ok = dir == 0 ? (s <= t) : (s >= t); v[j] = ok ? sc[i][j] * 0.08838834764831845f * __expf(rt + GG[jj * 64 + s]) : 0.f; }
                u32x2 w; w.x = pk_bf16(v[0], v[1]); w.y = pk_bf16(v[2], v[3]); *(LAS u32x2*)(SS + t * ML_LD + s0) = w; }
        }
        __syncthreads();
        {
            f32x4 a1[4], a2[4];
#pragma unroll
            for (int i = 0; i < 4; ++i) { a1[i] = (f32x4){0.f, 0.f, 0.f, 0.f}; a2[i] = (f32x4){0.f, 0.f, 0.f, 0.f}; }
#pragma unroll
            for (int ks = 0; ks < 2; ++ks) { const bf16x8 sf = *(const LAS bf16x8*)(SS + t * ML_LD + 32 * ks + 8 * fq);
#pragma unroll
                for (int i = 0; i < 4; ++i) { const bf16x8 vf = *(const LAS bf16x8*)(VT + (16 * (4 * wh + i) + fr) * ML_LD + 32 * ks + 8 * fq); a1[i] = MFMA16(vf, sf, a1[i]); } }
#pragma unroll
            for (int ks = 0; ks < 4; ++ks)
#pragma unroll
                for (int i = 0; i < 4; ++i) { const bf16x8 cf = *(const LAS bf16x8*)(CTl + (16 * (4 * wh + i) + fr) * SQ_LD + 32 * ks + 8 * fq); a2[i] = MFMA16(cf, qf[ks], a2[i]); }
            float qn = 0.f;
#pragma unroll
            for (int ks = 0; ks < 4; ++ks) { const LAS float* np = nst + (jj & 1) * DH + 32 * ks + 8 * fq; const f32x4 n0 = *(const LAS f32x4*)np, n1 = *(const LAS f32x4*)(np + 4); const u32x4 qv = __builtin_bit_cast(u32x4, qf[ks]);
                qn += bflo(qv.x) * n0[0] + bfhi(qv.x) * n0[1] + bflo(qv.y) * n0[2] + bfhi(qv.y) * n0[3] + bflo(qv.z) * n1[0] + bfhi(qv.z) * n1[1] + bflo(qv.w) * n1[2] + bfhi(qv.w) * n1[3]; }
            qn += __shfl_xor(qn, 16, 64); qn += __shfl_xor(qn, 32, 64);
            if (jj + 1 < NCQ) SQ_LOAD(jj + 1);
            float rs = 0.f;
            { const u32x4 s0 = *(const LAS u32x4*)(SS + t * ML_LD + 16 * fq), s1 = *(const LAS u32x4*)(SS + t * ML_LD + 16 * fq + 8);
                rs = bflo(s0.x) + bfhi(s0.x) + bflo(s0.y) + bfhi(s0.y) + bflo(s0.z) + bfhi(s0.z) + bflo(s0.w) + bfhi(s0.w) + bflo(s1.x) + bfhi(s1.x) + bflo(s1.y) + bfhi(s1.y) + bflo(s1.z) + bfhi(s1.z) + bflo(s1.w) + bfhi(s1.w); }
            rs += __shfl_xor(rs, 16, 64); rs += __shfl_xor(rs, 32, 64);
            const float wi = GP[jj * 64 + t]; const float den = rs + wi * qn; const float inv = 1.0f / fmaxf(fabsf(den), EM[jj * 64 + t]);
            const unsigned ho = (unsigned)(((c0 + t) * DB + 4 * fq) * 4);
#pragma unroll
            for (int i = 0; i < 4; ++i) { const f32x4 hv = (a1[i] + wi * a2[i]) * inv; pg8::st16_wt(hb, ho + 64u * (4 * wh + i), __builtin_bit_cast(u32x4, hv)); }
        }
        const float decay = DEC[jj];
#pragma unroll
        for (int dt = 0; dt < 8; ++dt) cacc[dt] = cacc[dt] * decay;
#pragma unroll
        for (int ks = 0; ks < 2; ++ks) { const bf16x8 a = *(const LAS bf16x8*)(VT + (16 * wave + fr) * ML_LD + 32 * ks + 8 * fq);
#pragma unroll
            for (int dt = 0; dt < 8; ++dt) { const bf16x8 bb = *(const LAS bf16x8*)(KT + (16 * dt + fr) * ML_LD + 32 * ks + 8 * fq); cacc[dt] = MFMA16(bb, a, cacc[dt]); } }
        if (tid < DH) { float s = 0.f; const LAS bf16_t* r = KT + tid * ML_LD;
#pragma unroll
            for (int j4 = 0; j4 < 8; ++j4) { const u32x4 v = *(const LAS u32x4*)(r + 8 * j4); s += (bflo(v.x) + bfhi(v.x)) + (bflo(v.y) + bfhi(v.y)) + (bflo(v.z) + bfhi(v.z)) + (bflo(v.w) + bfhi(v.w)); }
            nst[((jj + 1) & 1) * DH + tid] = decay * nst[(jj & 1) * DH + tid] + s; }
        __syncthreads();
    }
#undef SQ_LOAD
    asm volatile("s_waitcnt vmcnt(0)" ::: "memory");
    __syncthreads();
    if (tid == 0) __hip_atomic_store(flags + (size_t)unit * 16, 1u, __ATOMIC_RELAXED, __HIP_MEMORY_SCOPE_AGENT);
    { LAS float* T = (LAS float*)(lds + 8192);
#pragma unroll
      for (int dt = 0; dt < 8; ++dt)
#pragma unroll
          for (int j = 0; j < 4; ++j) T[(16 * wave + fr) * 129 + 16 * dt + 4 * fq + j] = cacc[dt][j];
      __syncthreads();
      const size_t base = (((size_t)b * DEPTH + l) * 2 + dir) * NH + h;
      float* oC = p.out + (size_t)NROW * DM; float* on = oC + (size_t)NB_CTX * DEPTH * 2 * NH * DH * DH; float* om = on + (size_t)NB_CTX * DEPTH * 2 * NH * DH;
      const int d = tid >> 2, es = (tid & 3) * 32;
#pragma unroll
      for (int k = 0; k < 8; ++k) { f32x4 v; v[0] = T[(es + 4 * k) * 129 + d]; v[1] = T[(es + 4 * k + 1) * 129 + d]; v[2] = T[(es + 4 * k + 2) * 129 + d]; v[3] = T[(es + 4 * k + 3) * 129 + d];
          *(f32x4*)(oC + (base * DH + d) * DH + es + 4 * k) = v; }
      if (tid < DH) on[base * DH + tid] = nst[(NCQ & 1) * DH + tid];
      if (tid == 0) om[base] = DEC[NCQ]; }
    if (tid == 0) { unsigned sp = 0; while (__hip_atomic_load(flags + (size_t)(unit ^ 1) * 16, __ATOMIC_RELAXED, __HIP_MEMORY_SCOPE_AGENT) == 0u) { __builtin_amdgcn_s_sleep(2); if (++sp > (1u << 22)) break; }
        __builtin_amdgcn_fence(__ATOMIC_ACQUIRE, "agent"); asm volatile("s_waitcnt vmcnt(0)" ::: "memory"); }
    __syncthreads();
    { const int c8 = h * DH + 8 * (lane & 15), rr = lane >> 4;
      const f32x4 g0 = *(const f32x4*)(p.g_mlstm() + (size_t)l * DB + c8), g1 = *(const f32x4*)(p.g_mlstm() + (size_t)l * DB + c8 + 4);
#pragma unroll 1
      for (int it = 0; it < 4; it += 2) {
          f32x4 v[2][2]; u32x4 ow[2];
#pragma unroll
          for (int k = 0; k < 2; ++k) { const size_t r = (size_t)r0 + dir * 128 + (it + k) * 32 + wave * 4 + rr; const float* h0 = p.hbc() + r * DB + c8; const float* h1 = h0 + (size_t)R_CTX * DB;
              v[k][0] = *(const f32x4*)h0 + *(const f32x4*)h1; v[k][1] = *(const f32x4*)(h0 + 4) + *(const f32x4*)(h1 + 4); ow[k] = *(const u32x4*)(p.proj() + r * PJ + C_O + c8); }
#pragma unroll
          for (int k = 0; k < 2; ++k) { const size_t r = (size_t)r0 + dir * 128 + (it + k) * 32 + wave * 4 + rr; float ss = 0.f;
#pragma unroll
              for (int j = 0; j < 4; ++j) ss += v[k][0][j] * v[k][0][j] + v[k][1][j] * v[k][1][j];
              ss += __shfl_xor(ss, 1, 64); ss += __shfl_xor(ss, 2, 64); ss += __shfl_xor(ss, 4, 64); ss += __shfl_xor(ss, 8, 64);
              const float rs = 1.0f / sqrtf(ss * (1.0f / DH) + EPSF); const u32x4 o = ow[k]; const float og[8] = {bflo(o.x), bfhi(o.x), bflo(o.y), bfhi(o.y), bflo(o.z), bfhi(o.z), bflo(o.w), bfhi(o.w)};
              float y[8];
#pragma unroll
              for (int j = 0; j < 4; ++j) { y[j] = v[k][0][j] * rs * g0[j] * __builtin_amdgcn_rcpf(1.0f + __expf(-og[j])); y[4 + j] = v[k][1][j] * rs * g1[j] * __builtin_amdgcn_rcpf(1.0f + __expf(-og[4 + j])); }
              u32x4 w; w.x = pk_bf16(y[0], y[1]); w.y = pk_bf16(y[2], y[3]); w.z = pk_bf16(y[4], y[5]); w.w = pk_bf16(y[6], y[7]);
              *(u32x4*)(p.ys() + r * 3 * DB + 2 * DB + c8) = w; } } }
    __syncthreads();
}
__device__ __forceinline__ void phase_ctx_fin(const P& p, int l, int cu, int ncu) {
    int tid = threadIdx.x; asm volatile("" : "+v"(tid));
    const int wave = tid >> 6, lane = tid & 63, c = 8 * lane;
    const f32x4 g0 = *(const f32x4*)(p.g_mlstm() + (size_t)l * DB + c), g1 = *(const f32x4*)(p.g_mlstm() + (size_t)l * DB + c + 4);
    for (int r = (cu * 8 + wave) * 2; r < R_CTX; r += ncu * 16) {
        f32x4 v[2][2]; u32x4 ow[2];
#pragma unroll
        for (int k = 0; k < 2; ++k) { const float* h0 = p.hbc() + (size_t)(r + k) * DB + c; const float* h1 = h0 + (size_t)R_CTX * DB;
            v[k][0] = *(const f32x4*)h0 + *(const f32x4*)h1; v[k][1] = *(const f32x4*)(h0 + 4) + *(const f32x4*)(h1 + 4); ow[k] = *(const u32x4*)(p.proj() + (size_t)(r + k) * PJ + C_O + c); }
#pragma unroll
        for (int k = 0; k < 2; ++k) { float ss = 0.f;
#pragma unroll
            for (int j = 0; j < 4; ++j) ss += v[k][0][j] * v[k][0][j] + v[k][1][j] * v[k][1][j];
            ss += __shfl_xor(ss, 1, 64); ss += __shfl_xor(ss, 2, 64); ss += __shfl_xor(ss, 4, 64); ss += __shfl_xor(ss, 8, 64);
            const float rs = 1.0f / sqrtf(ss * (1.0f / DH) + EPSF); const u32x4 o = ow[k]; const float og[8] = {bflo(o.x), bfhi(o.x), bflo(o.y), bfhi(o.y), bflo(o.z), bfhi(o.z), bflo(o.w), bfhi(o.w)};
            float y[8];
#pragma unroll
            for (int j = 0; j < 4; ++j) { y[j] = v[k][0][j] * rs * g0[j] * __builtin_amdgcn_rcpf(1.0f + __expf(-og[j])); y[4 + j] = v[k][1][j] * rs * g1[j] * __builtin_amdgcn_rcpf(1.0f + __expf(-og[4 + j])); }
            u32x4 w; w.x = pk_bf16(y[0], y[1]); w.y = pk_bf16(y[2], y[3]); w.z = pk_bf16(y[4], y[5]); w.w = pk_bf16(y[6], y[7]);
            *(u32x4*)(p.ys() + (size_t)(r + k) * 3 * DB + 2 * DB + c) = w; }
    }
}
#define SG_LD 136
__device__ __forceinline__ void unit_sgu(const P& p, int l, int unit, LAS unsigned char* lds) {
    int tid = threadIdx.x; asm volatile("" : "+v"(tid));
    const int wave = __builtin_amdgcn_readfirstlane(tid >> 6), lane = tid & 63, fr = lane & 15, fq = lane >> 4;
    const int g = unit % NG, ch = unit / NG, r0 = ch * SGU_CHUNK;
    LAS float* rstd = (LAS float*)lds;
    LAS bf16_t* Aw = (LAS bf16_t*)(lds + 1024);
    LAS bf16_t* Bv = Aw + 128 * SG_LD;
    { const int row = tid >> 2, part = tid & 3; const bf16_t* sv = p.proj() + (size_t)(r0 + row) * PJ + C_SV + part * 128; float ss = 0.f;
#pragma unroll
        for (int c = 0; c < 16; ++c) { const u32x4 v = *(const u32x4*)(sv + 8 * c); const float a0 = bflo(v.x), a1 = bfhi(v.x), a2 = bflo(v.y), a3 = bfhi(v.y), a4 = bflo(v.z), a5 = bfhi(v.z), a6 = bflo(v.w), a7 = bfhi(v.w);
            ss += a0 * a0 + a1 * a1 + a2 * a2 + a3 * a3 + a4 * a4 + a5 * a5 + a6 * a6 + a7 * a7; }
        ss += __shfl_xor(ss, 1, 64); ss += __shfl_xor(ss, 2, 64);
        if (part == 0) rstd[row] = 1.0f / sqrtf(ss * (1.0f / DB) + EPSF); }
    { const float* W = p.w_sgu() + ((size_t)l * NG + g) * SGU_CHUNK * SGU_CHUNK;
#pragma unroll
        for (int it = 0; it < 8; ++it) { const int idx = (it * 512 + tid) * 4; const f32x4 w = *(const f32x4*)(W + idx); u32x2 o; o.x = pk_bf16(w[0], w[1]); o.y = pk_bf16(w[2], w[3]);
            *(LAS u32x2*)(Aw + (idx >> 7) * SG_LD + (idx & 127)) = o; } }
    u32x4 svv[2][2]; f32x4 gg0[2], gg1[2];
#pragma unroll
    for (int i = 0; i < 2; ++i) { const int cb = (wave * 2 + i) * 8; const float* gs = p.g_sgu() + (size_t)l * DB + g * GRP + cb; gg0[i] = *(const f32x4*)gs; gg1[i] = *(const f32x4*)(gs + 4);
#pragma unroll
        for (int half = 0; half < 2; ++half) svv[half][i] = *(const u32x4*)(p.proj() + (size_t)(r0 + 64 * half + lane) * PJ + C_SV + g * GRP + cb); }
    __syncthreads();
#pragma unroll
    for (int half = 0; half < 2; ++half) { const int q = 64 * half + lane; const float rs = rstd[q];
#pragma unroll
        for (int i = 0; i < 2; ++i) { const int cb = (wave * 2 + i) * 8;
            const u32x4 v = svv[half][i];
            const f32x4 g0 = gg0[i], g1 = gg1[i];
            Bv[(cb + 0) * SG_LD + q] = f2bf(bflo(v.x) * rs * g0[0]); Bv[(cb + 1) * SG_LD + q] = f2bf(bfhi(v.x) * rs * g0[1]);
            Bv[(cb + 2) * SG_LD + q] = f2bf(bflo(v.y) * rs * g0[2]); Bv[(cb + 3) * SG_LD + q] = f2bf(bfhi(v.y) * rs * g0[3]);
            Bv[(cb + 4) * SG_LD + q] = f2bf(bflo(v.z) * rs * g1[0]); Bv[(cb + 5) * SG_LD + q] = f2bf(bfhi(v.z) * rs * g1[1]);
            Bv[(cb + 6) * SG_LD + q] = f2bf(bflo(v.w) * rs * g1[2]); Bv[(cb + 7) * SG_LD + q] = f2bf(bfhi(v.w) * rs * g1[3]); } }
    const int pp = 16 * wave + fr; const size_t row = (size_t)r0 + pp; const float bias = p.b_sgu()[((size_t)l * NG + g) * SGU_CHUNK + pp];
    u32x2 suv[8];
#pragma unroll
    for (int ct = 0; ct < 8; ++ct) suv[ct] = *(const u32x2*)(p.proj() + row * PJ + C_SU + g * GRP + 16 * ct + 4 * fq);
    __syncthreads();
    f32x4 acc[8];
#pragma unroll
    for (int i = 0; i < 8; ++i) acc[i] = (f32x4){0.f, 0.f, 0.f, 0.f};
#pragma unroll
    for (int ks = 0; ks < 4; ++ks) { const bf16x8 a = *(const LAS bf16x8*)(Aw + (16 * wave + fr) * SG_LD + 32 * ks + 8 * fq);
#pragma unroll
        for (int ct = 0; ct < 8; ++ct) { const bf16x8 b = *(const LAS bf16x8*)(Bv + (16 * ct + fr) * SG_LD + 32 * ks + 8 * fq); acc[ct] = MFMA16(b, a, acc[ct]); } }
#pragma unroll
    for (int ct = 0; ct < 8; ++ct) { const int cc = g * GRP + 16 * ct + 4 * fq; const u32x2 su = suv[ct];
        u32x2 o; o.x = pk_bf16(bflo(su.x) * (acc[ct][0] + bias), bfhi(su.x) * (acc[ct][1] + bias)); o.y = pk_bf16(bflo(su.y) * (acc[ct][2] + bias), bfhi(su.y) * (acc[ct][3] + bias));
        *(u32x2*)(p.ys() + row * 3 * DB + DB + cc) = o; }
    __syncthreads();
}
#define N_POOL_ITEMS ((size_t)R_CTX * (DB / 2) + (size_t)NB_LAT * GRID_W * (DB / 2))
__device__ __forceinline__ void b_pool_d2(const P& p, size_t i) {
    const unsigned* pj = (const unsigned*)p.proj();
    if (i < (size_t)R_CTX * (DB / 2)) {
        const int c2 = i % (DB / 2); const int r = i / (DB / 2); const int g = (2 * c2) / GRP, win = 2 << g; const int b = r / T_CTX, t = r % T_CTX;
        int lo = t - win / 2; if (lo < 0) lo = 0; int hi = t + (win - win / 2); if (hi > T_CTX) hi = T_CTX;
        float s0 = 0.f, s1 = 0.f;
        for (int tt = lo; tt < hi; ++tt) { const unsigned w = pj[(size_t)(b * T_CTX + tt) * (PJ / 2) + c2]; s0 += bflo(w); s1 += bfhi(w); }
        const float inv = 1.0f / (float)(hi - lo); const unsigned w = pj[(size_t)r * (PJ / 2) + c2];
        ((unsigned*)p.dbf())[(size_t)r * (DB / 2) + c2] = pk_bf16(s0 * inv - bflo(w), s1 * inv - bfhi(w));
    } else {
        i -= (size_t)R_CTX * (DB / 2);
        const int c2 = i % (DB / 2); const int gx = (i / (DB / 2)) % GRID_W; const int b = i / ((size_t)(DB / 2) * GRID_W); const int g = (2 * c2) / GRP, win = 2 << g; constexpr int rows = T_LAT / GRID_W;
        int xlo = gx - win / 2; if (xlo < 0) xlo = 0; int xhi = gx + (win - win / 2); if (xhi > GRID_W) xhi = GRID_W; const float invx = 1.0f / (float)(xhi - xlo);
        float m0[rows], m1[rows];
#pragma unroll
        for (int y = 0; y < rows; ++y) { float s0 = 0.f, s1 = 0.f; const unsigned* rp = pj + (size_t)(R_CTX + b * T_LAT + y * GRID_W) * (PJ / 2) + c2;
            for (int xx = xlo; xx < xhi; ++xx) { const unsigned w = rp[(size_t)xx * (PJ / 2)]; s0 += bflo(w); s1 += bfhi(w); }
            m0[y] = s0 * invx; m1[y] = s1 * invx; }
#pragma unroll
        for (int y = 0; y < rows; ++y) { int ylo = y - win / 2; if (ylo < 0) ylo = 0; int yhi = y + (win - win / 2); if (yhi > rows) yhi = rows; float s0 = 0.f, s1 = 0.f;
#pragma unroll
            for (int yy = 0; yy < rows; ++yy) { const bool in = yy >= ylo && yy < yhi; s0 += in ? m0[yy] : 0.f; s1 += in ? m1[yy] : 0.f; }
            const float invy = 1.0f / (float)(yhi - ylo); const size_t r = (size_t)R_CTX + b * T_LAT + y * GRID_W + gx; const unsigned w = pj[r * (PJ / 2) + c2];
            ((unsigned*)p.dbf())[r * (DB / 2) + c2] = pk_bf16(s0 * invy - bflo(w), s1 * invy - bfhi(w)); }
    }
}
__device__ __forceinline__ void unit_pool(const P& p, int l, int unit) {
    int tid = threadIdx.x; asm volatile("" : "+v"(tid));
    const int wave = __builtin_amdgcn_readfirstlane(tid >> 6), lane = tid & 63, fr = lane & 15, fq = lane >> 4;
    const int g = unit % NG, r0 = (unit / NG) * 128 + 16 * wave;
    const bf16_t* A = p.dbf() + (size_t)(r0 + fr) * DB + g * GRP + 8 * fq; const bf16_t* B = p.Wt_pool() + ((size_t)l * NG + g) * GRP * GRP + (size_t)fr * GRP + 8 * fq;
    f32x4 acc[8];
#pragma unroll
    for (int i = 0; i < 8; ++i) acc[i] = (f32x4){0.f, 0.f, 0.f, 0.f};
#pragma unroll
    for (int ks = 0; ks < 4; ++ks) { const bf16x8 a = *(const bf16x8*)(A + 32 * ks);
#pragma unroll
        for (int dt = 0; dt < 8; ++dt) { const bf16x8 b = *(const bf16x8*)(B + (size_t)16 * dt * GRP + 32 * ks); acc[dt] = MFMA16(b, a, acc[dt]); } }
    const size_t row = (size_t)r0 + fr;
#pragma unroll
    for (int dt = 0; dt < 8; ++dt) { const int c = g * GRP + 16 * dt + 4 * fq; const f32x4 sc = *(const f32x4*)(p.pool_scale() + (size_t)l * DB + c);
        u32x2 o; o.x = pk_bf16(acc[dt][0] * sc[0], acc[dt][1] * sc[1]); o.y = pk_bf16(acc[dt][2] * sc[2], acc[dt][3] * sc[3]); *(u32x2*)(p.ys() + row * 3 * DB + c) = o; }
}
#define N_FOLD (DEPTH * NG * (DM / 32))
__device__ __forceinline__ void unit_fold(const P& p, int unit, LAS unsigned char* lds) {
    int tid = threadIdx.x; asm volatile("" : "+v"(tid));
    const int kt = unit % (DM / 32), g = (unit / (DM / 32)) % NG, l = unit / ((DM / 32) * NG), k0 = kt * 32;
    LAS float* Wp = (LAS float*)lds;
    LAS float* A = Wp + GRP * GRP;
    LAS float* T = A + 32 * GRP;
    const float* wp = p.w_pool() + ((size_t)l * NG + g) * GRP * GRP;
#pragma unroll
    for (int it = 0; it < 8; ++it) { const int idx = (it * 512 + tid) * 4; *(LAS f32x4*)(Wp + idx) = *(const f32x4*)(wp + idx); }
#pragma unroll
    for (int it = 0; it < 2; ++it) { const int idx = (it * 512 + tid) * 4; const int k = idx >> 7, c = idx & 127; *(LAS f32x4*)(A + idx) = *(const f32x4*)(p.w_in() + ((size_t)l * DM + k0 + k) * D_IN + g * GRP + c); }
    __syncthreads();
    { const int k = tid >> 4, ddb = (tid & 15) * 8; f32x4 a0 = {0.f, 0.f, 0.f, 0.f}, a1 = a0;
#pragma unroll 8
        for (int c = 0; c < GRP; ++c) { const float a = A[k * GRP + c]; a0 = a0 + a * *(const LAS f32x4*)(Wp + c * GRP + ddb); a1 = a1 + a * *(const LAS f32x4*)(Wp + c * GRP + ddb + 4); }
#pragma unroll
        for (int j = 0; j < 4; ++j) { T[(ddb + j) * 33 + k] = a0[j]; T[(ddb + 4 + j) * 33 + k] = a1[j]; } }
    __syncthreads();
    { const int dd = tid >> 2, ks = (tid & 3) * 8; const LAS float* t = T + dd * 33 + ks;
        u32x4 o; o.x = pk_bf16(t[0], t[1]); o.y = pk_bf16(t[2], t[3]); o.z = pk_bf16(t[4], t[5]); o.w = pk_bf16(t[6], t[7]);
        *(u32x4*)(p.Wt_in() + ((size_t)l * NIN_PAD + g * GRP + dd) * DM + k0 + ks) = o; }
    __syncthreads();
}
#define N_POOL_UNITS (NB_CTX * (T_CTX / 64) + NB_LAT * (DB / 16))
__device__ __forceinline__ void unit_pool2(const P& p, int l, int unit, LAS unsigned char* lds) {
    int tid = threadIdx.x; asm volatile("" : "+v"(tid));
    if (unit < NB_CTX * (T_CTX / 64)) {
        const int b = unit / (T_CTX / 64), t0 = (unit % (T_CTX / 64)) * 64; LAS bf16_t* Z = (LAS bf16_t*)lds;
#pragma unroll
        for (int it = 0; it < 10; ++it) { const int idx = it * 512 + tid; const int j = idx >> 6, c8 = idx & 63; const int t = t0 - 8 + j;
            if (t >= 0 && t < T_CTX) *(LAS u32x4*)(Z + j * DB + c8 * 8) = *(const u32x4*)(p.proj() + (size_t)(b * T_CTX + t) * PJ + c8 * 8); }
        __syncthreads();
#pragma unroll 2
        for (int it = 0; it < 8; ++it) { const int idx = it * 512 + tid; const int tl = idx >> 6, c8 = idx & 63; const int t = t0 + tl; const int win = 2 << (c8 >> 4);
            int lo = t - win / 2; if (lo < 0) lo = 0; int hi = t + (win - win / 2); if (hi > T_CTX) hi = T_CTX;
            float s[8] = {0.f, 0.f, 0.f, 0.f, 0.f, 0.f, 0.f, 0.f};
#pragma unroll
            for (int j = 0; j < 16; ++j) { const int tt = t - 8 + j; const bool ok = tt >= lo && tt < hi; const u32x4 v = *(const LAS u32x4*)(Z + (tl + j) * DB + c8 * 8);
                s[0] += ok ? bflo(v.x) : 0.f; s[1] += ok ? bfhi(v.x) : 0.f; s[2] += ok ? bflo(v.y) : 0.f; s[3] += ok ? bfhi(v.y) : 0.f; s[4] += ok ? bflo(v.z) : 0.f; s[5] += ok ? bfhi(v.z) : 0.f; s[6] += ok ? bflo(v.w) : 0.f; s[7] += ok ? bfhi(v.w) : 0.f; }
            const float inv = 1.0f / (float)(hi - lo); const u32x4 v = *(const LAS u32x4*)(Z + (tl + 8) * DB + c8 * 8);
            const float* sc = p.pool_scale() + (size_t)l * DB + c8 * 8; const f32x4 s0 = *(const f32x4*)sc, s1 = *(const f32x4*)(sc + 4);
            u32x4 o; o.x = pk_bf16((s[0] * inv - bflo(v.x)) * s0[0], (s[1] * inv - bfhi(v.x)) * s0[1]); o.y = pk_bf16((s[2] * inv - bflo(v.y)) * s0[2], (s[3] * inv - bfhi(v.y)) * s0[3]);
            o.z = pk_bf16((s[4] * inv - bflo(v.z)) * s1[0], (s[5] * inv - bfhi(v.z)) * s1[1]); o.w = pk_bf16((s[6] * inv - bflo(v.w)) * s1[2], (s[7] * inv - bfhi(v.w)) * s1[3]);
            pg8::st16_wt(p.ys(), (unsigned)((b * T_CTX + t) * 3 * DB + c8 * 8) * 2u, o); }
    } else {
        const int u2 = unit - NB_CTX * (T_CTX / 64); const int b = u2 / (DB / 16), cs = (u2 % (DB / 16)) * 16; const int win = 2 << (cs / GRP); constexpr int rows = T_LAT / GRID_W;
        LAS bf16_t* Z = (LAS bf16_t*)lds;
        LAS float* XM = (LAS float*)(lds + T_LAT * 32);
        const size_t rb = (size_t)R_CTX + (size_t)b * T_LAT;
#pragma unroll
        for (int it = 0; it < T_LAT * 2 / 512; ++it) { const int idx = it * 512 + tid; const int tok = idx >> 1, hf = idx & 1; *(LAS u32x4*)(Z + tok * 16 + hf * 8) = *(const u32x4*)(p.proj() + (rb + tok) * PJ + cs + hf * 8); }
        __syncthreads();
#pragma unroll 2
        for (int it = 0; it < T_LAT * 2 / 512; ++it) { const int idx = it * 512 + tid; const int tok = idx >> 1, hf = idx & 1; const int gy = tok / GRID_W, gx = tok % GRID_W;
            int xlo = gx - win / 2; if (xlo < 0) xlo = 0; int xhi = gx + (win - win / 2); if (xhi > GRID_W) xhi = GRID_W;
            float s[8] = {0.f, 0.f, 0.f, 0.f, 0.f, 0.f, 0.f, 0.f};
#pragma unroll
            for (int j = 0; j < 16; ++j) { const int xx = gx - 8 + j; const bool ok = xx >= xlo && xx < xhi; const int xc = xx < 0 ? 0 : (xx > GRID_W - 1 ? GRID_W - 1 : xx);
                const u32x4 v = *(const LAS u32x4*)(Z + (gy * GRID_W + xc) * 16 + hf * 8);
                s[0] += ok ? bflo(v.x) : 0.f; s[1] += ok ? bfhi(v.x) : 0.f; s[2] += ok ? bflo(v.y) : 0.f; s[3] += ok ? bfhi(v.y) : 0.f; s[4] += ok ? bflo(v.z) : 0.f; s[5] += ok ? bfhi(v.z) : 0.f; s[6] += ok ? bflo(v.w) : 0.f; s[7] += ok ? bfhi(v.w) : 0.f; }
            const float inv = 1.0f / (float)(xhi - xlo);
            *(LAS f32x4*)(XM + tok * 16 + hf * 8) = (f32x4){s[0] * inv, s[1] * inv, s[2] * inv, s[3] * inv}; *(LAS f32x4*)(XM + tok * 16 + hf * 8 + 4) = (f32x4){s[4] * inv, s[5] * inv, s[6] * inv, s[7] * inv}; }
        __syncthreads();
#pragma unroll 2
        for (int it = 0; it < T_LAT * 2 / 512; ++it) { const int idx = it * 512 + tid; const int tok = idx >> 1, hf = idx & 1; const int gy = tok / GRID_W, gx = tok % GRID_W;
            int ylo = gy - win / 2; if (ylo < 0) ylo = 0; int yhi = gy + (win - win / 2); if (yhi > rows) yhi = rows;
            f32x4 a0 = {0.f, 0.f, 0.f, 0.f}, a1 = a0;
#pragma unroll
            for (int j = 0; j < 16; ++j) { const int yy = gy - 8 + j; const bool ok = yy >= ylo && yy < yhi; const int yc = yy < 0 ? 0 : (yy > rows - 1 ? rows - 1 : yy);
                const f32x4 x0 = *(const LAS f32x4*)(XM + (yc * GRID_W + gx) * 16 + hf * 8), x1 = *(const LAS f32x4*)(XM + (yc * GRID_W + gx) * 16 + hf * 8 + 4);
                const float m = ok ? 1.0f : 0.0f; a0 = a0 + x0 * m; a1 = a1 + x1 * m; }
            const float inv = 1.0f / (float)(yhi - ylo); const u32x4 v = *(const LAS u32x4*)(Z + tok * 16 + hf * 8);
            const float* sc = p.pool_scale() + (size_t)l * DB + cs + hf * 8; const f32x4 s0 = *(const f32x4*)sc, s1 = *(const f32x4*)(sc + 4);
            u32x4 o; o.x = pk_bf16((a0[0] * inv - bflo(v.x)) * s0[0], (a0[1] * inv - bfhi(v.x)) * s0[1]); o.y = pk_bf16((a0[2] * inv - bflo(v.y)) * s0[2], (a0[3] * inv - bfhi(v.y)) * s0[3]);
            o.z = pk_bf16((a1[0] * inv - bflo(v.z)) * s1[0], (a1[1] * inv - bfhi(v.z)) * s1[1]); o.w = pk_bf16((a1[2] * inv - bflo(v.w)) * s1[2], (a1[3] * inv - bfhi(v.w)) * s1[3]);
            pg8::st16_wt(p.ys(), (unsigned)((rb + tok) * 3 * DB + cs + hf * 8) * 2u, o); }
    }
    __syncthreads();
}
__device__ __forceinline__ void phase_norm(const P& p, int l, int which) {
    int tid = threadIdx.x; asm volatile("" : "+v"(tid));
    const int wave = tid >> 6, lane = tid & 63; const int stride = gridDim.x * 8;
    for (int r0 = blockIdx.x * 8 + wave; r0 < NROW; r0 += 3 * stride) {
        f32x4 v[3][DM / 256];
#pragma unroll
        for (int q = 0; q < 3; ++q) { const int r = r0 + q * stride; if (r < NROW) { const float* xr = r < R_CTX ? p.x_prompt() + (size_t)r * DM : p.x_sample() + (size_t)(r - R_CTX) * DM;
#pragma unroll
            for (int i = 0; i < DM / 256; ++i) v[q][i] = *(const f32x4*)(xr + (i * 64 + lane) * 4); } }
#pragma unroll
        for (int q = 0; q < 3; ++q) { const int r = r0 + q * stride; if (r < NROW) { float ss = 0.f;
#pragma unroll
            for (int i = 0; i < DM / 256; ++i) { *(f32x4*)(p.x() + (size_t)r * DM + (i * 64 + lane) * 4) = v[q][i]; ss += v[q][i][0] * v[q][i][0] + v[q][i][1] * v[q][i][1] + v[q][i][2] * v[q][i][2] + v[q][i][3] * v[q][i][3]; }
#pragma unroll
            for (int off = 32; off >= 1; off >>= 1) ss += __shfl_xor(ss, off, 64);
            const float rs = 1.0f / sqrtf(ss * (1.0f / DM) + EPSF);
            const float* g = p.g_norm1() + (size_t)l * DM; const float* md = p.mod() + ((size_t)l * 3 + cond_of_row(r)) * 6 * DM;
#pragma unroll
            for (int i = 0; i < DM / 256; ++i) { const int k = (i * 64 + lane) * 4; const f32x4 o = v[q][i] * rs * *(const f32x4*)(g + k) * (*(const f32x4*)(md + DM + k) + 1.0f) + *(const f32x4*)(md + k);
                u32x2 w; w.x = pk_bf16(o[0], o[1]); w.y = pk_bf16(o[2], o[3]); *(u32x2*)(p.u() + (size_t)r * DM + k) = w; } } }
    }
}
#define N_MOD_BLK (DEPTH * (6 * DM / 128))
__device__ __forceinline__ void phase_c0t(const P& p) {
    int t_ = threadIdx.x; asm volatile("" : "+v"(t_));
    constexpr size_t NI = (size_t)NB_LAT * DEPTH * 2 * NH * (DH / 8) * DH;
    for (size_t i = (size_t)blockIdx.x * NTHR + t_; i < NI; i += (size_t)gridDim.x * NTHR) { const int e = (int)(i & (DH - 1)), d8 = (int)((i / DH) % (DH / 8)) * 8; const size_t mat = i / ((size_t)DH * DH / 8);
        const float* s = p.state_C() + (mat * DH + d8) * DH + e; float v[8];
#pragma unroll
        for (int j = 0; j < 8; ++j) v[j] = s[(size_t)j * DH];
        u32x4 w; w.x = pk_bf16(v[0], v[1]); w.y = pk_bf16(v[2], v[3]); w.z = pk_bf16(v[4], v[5]); w.w = pk_bf16(v[6], v[7]);
        *(u32x4*)(p.C0T() + (mat * DH + e) * DH + d8) = w; }
}
__device__ __forceinline__ void unit_mod(const P& p, int unit, LAS unsigned char* lds) {
    int tid = threadIdx.x; asm volatile("" : "+v"(tid));
    const int l = unit / (6 * DM / 128), j0 = (unit % (6 * DM / 128)) * 128; const int j4 = tid & 31, ks = tid >> 5, k0 = ks * (DM / 16);
    LAS float* R = (LAS float*)lds;
    const float* w = p.w_ada() + ((size_t)l * DM + k0) * 6 * DM + j0 + j4 * 4;
    f32x4 a0 = {0.f, 0.f, 0.f, 0.f}, a1 = a0, a2 = a0;
#pragma unroll 4
    for (int k = 0; k < DM / 16; ++k) { const f32x4 wv = *(const f32x4*)(w + (size_t)k * 6 * DM);
        const float c0 = p.c_ctx()[k0 + k], c1 = p.c()[k0 + k], c2 = p.c()[DM + k0 + k];
        a0 = a0 + wv * (c0 / (1.0f + expf(-c0))); a1 = a1 + wv * (c1 / (1.0f + expf(-c1))); a2 = a2 + wv * (c2 / (1.0f + expf(-c2))); }
    *(LAS f32x4*)(R + (ks * 3 + 0) * 128 + j4 * 4) = a0; *(LAS f32x4*)(R + (ks * 3 + 1) * 128 + j4 * 4) = a1; *(LAS f32x4*)(R + (ks * 3 + 2) * 128 + j4 * 4) = a2;
    __syncthreads();
    if (tid < 384) { const int ci = tid >> 7, j = tid & 127; float s = p.b_ada()[(size_t)l * 6 * DM + j0 + j];
#pragma unroll
        for (int q = 0; q < 16; ++q) s += R[(q * 3 + ci) * 128 + j];
        p.mod()[((size_t)l * 3 + ci) * 6 * DM + j0 + j] = s; }
    __syncthreads();
}
__device__ __forceinline__ void conv_tile(const float* __restrict__ W, int N, bf16_t* __restrict__ Wt, int K, int kt, int nt, int rowmap, LAS unsigned char* lds) {
    int tid = threadIdx.x; asm volatile("" : "+v"(tid));
    LAS float* T = (LAS float*)lds;
    const int k0 = kt * 64, n0 = nt * 256;
    { const int c4 = (tid & 63) * 4, kb = tid >> 6; f32x4 v[8];
#pragma unroll
        for (int i = 0; i < 8; ++i) { v[i] = (f32x4){0.f, 0.f, 0.f, 0.f}; if (n0 + c4 < N) v[i] = *(const f32x4*)(W + (size_t)(k0 + kb + 8 * i) * N + n0 + c4); }
#pragma unroll
        for (int i = 0; i < 8; ++i) *(LAS f32x4*)(T + (kb + 8 * i) * 260 + c4) = v[i]; }
    __syncthreads();
    { const int n = tid >> 1, ks = (tid & 1) * 32; const int col = n0 + n;
        if (col < N) { int row = col; if (rowmap) row = col < 7 * DB ? col : (col < 7 * DB + 4 * NH ? PJ + (col - 7 * DB) : col - 4 * NH);
            bf16_t* dst = Wt + (size_t)row * K + k0 + ks;
#pragma unroll
            for (int q = 0; q < 4; ++q) { const LAS float* t = T + (ks + q * 8) * 260 + n;
                u32x4 o; o.x = pk_bf16(t[0], t[260]); o.y = pk_bf16(t[2 * 260], t[3 * 260]); o.z = pk_bf16(t[4 * 260], t[5 * 260]); o.w = pk_bf16(t[6 * 260], t[7 * 260]);
                *(u32x4*)(dst + q * 8) = o; } } }
    __syncthreads();
}
#define CT_IN (16 * ((D_IN + 255) / 256))
#define CT_BR (3 * (DB / 64) * (DM / 256))
#define CT_OUT ((DM / 64) * (DM / 256))
#define CT_FF ((DM / 64) * (DFF / 256))
#define CT_LAYER (CT_IN + CT_BR + CT_OUT + 2 * CT_FF)
#define N_FOLD_L (NG * (DM / 32))
#define CONV_ITEMS (CT_LAYER + N_FOLD_L)
__device__ __forceinline__ void conv_layer(const P& p, int l, int i_lo, int i_hi, int cu, int ncu, LAS unsigned char* lds) {
    for (int t = i_lo + cu; t < i_hi; t += ncu) {
        int r = t;
        if (r >= CT_LAYER) { unit_fold(p, l * N_FOLD_L + (r - CT_LAYER), lds); continue; }
        if (r < CT_IN) { constexpr int nn = (D_IN + 255) / 256; if (r % nn >= DB / 256) conv_tile(p.w_in() + (size_t)l * DM * D_IN, D_IN, p.Wt_in() + (size_t)l * NIN_PAD * DM, DM, r / nn, r % nn, 1, lds); continue; } r -= CT_IN;
        if (r < CT_BR) { constexpr int per = (DB / 64) * (DM / 256); const int br = r / per, q = r % per; conv_tile(p.w_branch() + ((size_t)l * 3 + br) * DB * DM, DM, p.Wt_br() + ((size_t)l * 3 + br) * DM * DB, DB, q / (DM / 256), q % (DM / 256), 0, lds); continue; } r -= CT_BR;
        if (r < CT_OUT) { conv_tile(p.w_out() + (size_t)l * DM * DM, DM, p.Wt_out() + (size_t)l * DM * DM, DM, r / (DM / 256), r % (DM / 256), 0, lds); continue; } r -= CT_OUT;
        if (r < CT_FF) { conv_tile(p.w_ff1() + (size_t)l * DM * DFF, DFF, p.Wt_ff1() + (size_t)l * DFF * DM, DM, r / (DFF / 256), r % (DFF / 256), 0, lds); continue; } r -= CT_FF;
        conv_tile(p.w_ff2() + (size_t)l * DFF * DM, DM, p.Wt_ff2() + (size_t)l * DM * DFF, DFF, r / (DM / 256), r % (DM / 256), 0, lds);
    }
    if (i_lo == 0) { const size_t per = (size_t)(NIN_PAD - PJ - 4 * NH) * DM / 8;
      int tz = threadIdx.x; asm volatile("" : "+v"(tz));
      for (size_t i = (size_t)cu * NTHR + tz; i < per; i += (size_t)ncu * NTHR) *(u32x4*)(p.Wt_in() + ((size_t)l * NIN_PAD + PJ + 4 * NH) * DM + i * 8) = (u32x4){0u, 0u, 0u, 0u}; }
}
#endif
#ifndef CPU_EMU
#define STAGE_OFF 1024
#define LDS_BYTES (STAGE_OFF + 147456)
struct Args { const float* in[24]; P p; unsigned* bar; };
#define GS(n, call) do { int t_ = threadIdx.x; asm volatile("" : "+v"(t_)); const size_t nthr_ = (size_t)gridDim.x * NTHR; for (size_t i_ = (size_t)blockIdx.x * NTHR + t_; i_ < (size_t)(n); i_ += nthr_) { call; } } while (0)
#define BAR() xcd_barrier(bar)
template <int MODE> __device__ __forceinline__ void run_gemm128(const P& p, int l, LAS unsigned char* lds, float gsc = 1.0f, bool conv = true) {
    constexpr int NU = (NROW / 128) * (DM / 256);
    if ((int)blockIdx.x >= NU && l + 1 < DEPTH && conv) {
        constexpr int c0 = CONV_ITEMS * 25 / 100, c1 = CONV_ITEMS * 49 / 100;
        conv_layer(p, l + 1, MODE == 1 ? 0 : (MODE == 2 ? c0 : c1), MODE == 1 ? c0 : (MODE == 2 ? c1 : CONV_ITEMS), (int)blockIdx.x - NU, (int)gridDim.x - NU, lds + STAGE_OFF);
        return; }
    const GemmArgs g = gemm_args(p, l, MODE);
    pg8::Order128 S; S.init(g.M, g.N, g.nZ, (int)gridDim.x, (int)blockIdx.x);
    pg8::Epi128<MODE> E; E.p = p; E.l = l; E.gsc = gsc;
    if constexpr (MODE == 1) pg8::gemm128_phase_s<pg8::Epi128<MODE>>(lds + STAGE_OFF, g, S, E);
    else pg8::gemm128_phase<pg8::Epi128<MODE>>(lds + STAGE_OFF, g, S, E);
}
template <int MODE> __device__ __forceinline__ void run_gemm2k(const P& p, int l, LAS unsigned char* lds) {
    constexpr int NU = 2 * pg8::NT2;
    if ((int)blockIdx.x >= NU) {
        if (l + 1 < DEPTH) { constexpr int c0 = CONV_ITEMS * 25 / 100, c1 = CONV_ITEMS * 45 / 100;
            conv_layer(p, l + 1, MODE == 1 ? 0 : (MODE == 2 ? c0 : c1), MODE == 1 ? c0 : (MODE == 2 ? c1 : CONV_ITEMS), (int)blockIdx.x - NU, (int)gridDim.x - NU, lds + STAGE_OFF); }
        return; }
    GemmArgs g = gemm_args(p, l, MODE);
    pg8::Order2K S; S.init(g.nZ, (int)blockIdx.x);
    g.K /= 2; g.A += (size_t)S.kh * g.K; g.Bt += (size_t)S.kh * g.K;
    pg8::EpiX<MODE> E{p, l, S.kh, S.slot};
    pg8::gemm_phase<pg8::EpiX<MODE>, pg8::Order2K, true, true, true>(lds + STAGE_OFF, g, S, E);
}
template <int MODE> __device__ __forceinline__ void run_gemm(const P& p, int l, LAS unsigned char* lds) {
    const GemmArgs g = gemm_args(p, l, MODE);
    pg8::Order S; S.init(g.M, g.N, g.nZ, (int)gridDim.x, (int)blockIdx.x);
    pg8::Epi<MODE> E{p, l};
    pg8::gemm_phase<pg8::Epi<MODE>, pg8::Order, true, true, false>(lds + STAGE_OFF, g, S, E);
}
__global__ void __launch_bounds__(NTHR, 2) mega(Args a) {
    extern __shared__ __attribute__((aligned(16))) unsigned char lds_[];
    LAS unsigned char* lds = (LAS unsigned char*)lds_;
    volatile LAS unsigned* st = (volatile LAS unsigned*)lds;
    if (threadIdx.x < 4) st[threadIdx.x] = 0u;
    __syncthreads();
    if (threadIdx.x < 24) ((LAS unsigned long long*)(lds + IN_TAB_OFF))[threadIdx.x] = (unsigned long long)a.in[threadIdx.x];
    __syncthreads();
    XcdBarrier bar = xcd_barrier_post(a.bar, st);
    const P p = a.p;
    for (int u_ = blockIdx.x; u_ < N_MOD_BLK; u_ += gridDim.x) unit_mod(p, u_, lds + STAGE_OFF);
    phase_c0t(p);
    conv_layer(p, 0, 0, CONV_ITEMS, (int)blockIdx.x, (int)gridDim.x, lds + STAGE_OFF); BAR();
#pragma unroll 1
    for (int l = 0; l < DEPTH; ++l) {
        if (l == 0) { phase_norm(p, 0, 3); BAR(); }
        run_gemm<0>(p, l, lds); BAR();
        { const int c = blockIdx.x; constexpr int NSEQU = NB_CTX * NH * 2;
          unsigned* mf = p.mixf() + (size_t)l * 144 * 16;
          if (c < NSEQU) unit_ml_seq(p, l, c, lds + STAGE_OFF, mf);
          else { int k = c - NSEQU;
              asm volatile("" : "+s"(k)); { const int g = k & 7, jc = k >> 3; unit_ml_cloc(p, l, ((R_CTX + (g >> 2) * T_LAT) / LCH + jc) * NH + (g & 3), lds + STAGE_OFF, mf + (size_t)(NSEQU + g) * 16); }
              asm volatile("" : "+s"(k)); unit_pool2(p, l, k, lds + STAGE_OFF);
#pragma unroll 1
              for (int q = 0; q < 2; ++q) { asm volatile("" : "+s"(k)); if (q == 0 || k < 64) unit_sgu(p, l, q * 128 + k, lds + STAGE_OFF); }
              asm volatile("" : "+s"(k)); { const int g = k & 7, jc = k >> 3; unit_ml_out2(p, l, g >> 2, g & 3, jc, lds + STAGE_OFF, mf + (size_t)(NSEQU + g) * 16); } }
          BAR(); }
        run_gemm128<1>(p, l, lds); BAR();
        run_gemm128<2>(p, l, lds); BAR();
        run_gemm<3>(p, l, lds); BAR();
        run_gemm128<4>(p, l, lds); BAR();
    }
}
#endif

extern "C" void kernel_launch(void* const* d_in, const int* in_sizes, int n_in, void* d_out, int out_size, void* d_ws, size_t ws_size, hipStream_t stream) {
#ifndef CPU_EMU
    static int grid = 0;
    if (grid == 0) {
        int dev = 0, cus = 0, per_cu = 0;
        (void)hipGetDevice(&dev); (void)hipDeviceGetAttribute(&cus, hipDeviceAttributeMultiprocessorCount, dev);
        if (hipFuncSetAttribute((const void*)mega, hipFuncAttributeMaxDynamicSharedMemorySize, LDS_BYTES) != hipSuccess) { fprintf(stderr, "hipFuncSetAttribute failed\n"); grid = -1; return; }
        if (hipOccupancyMaxActiveBlocksPerMultiprocessor(&per_cu, (const void*)mega, NTHR, LDS_BYTES) != hipSuccess || per_cu < 1) { fprintf(stderr, "occupancy query failed (%d)\n", per_cu); grid = -1; return; }
        grid = cus * per_cu;
        if (grid != 256) { fprintf(stderr, "kernel_launch: this kernel's unit dealing is written for 256 workgroups (256 CUs x 1), got %d\n", grid); grid = -1; return; }
    }
    if (grid < 0) return;
    Args a{};
    P& p = a.p;
#else
    P p{};
#endif
#ifdef CPU_EMU
    for (int i = 0; i < 24; ++i) p.inp[i] = (const float*)d_in[i];
#else
    for (int i = 0; i < 24; ++i) a.in[i] = (const float*)d_in[i];
#endif
    p.out = (float*)d_out;
    p.ws = (char*)d_ws;
    if (ws_size < WS_TOTAL) { fprintf(stderr, "workspace too small: need %zu have %zu\n", (size_t)WS_TOTAL, ws_size); return; }
#ifndef CPU_EMU
    a.bar = (unsigned*)d_ws;
    (void)hipMemsetAsync(d_ws, 0, OFF_BAR_END, stream);
    void* args[] = {&a};
    hipError_t e = hipLaunchCooperativeKernel((const void*)mega, dim3(grid), dim3(NTHR), args, LDS_BYTES, stream);
    if (e != hipSuccess) fprintf(stderr, "cooperative launch failed: %s (grid %d)\n", hipGetErrorString(e), grid);
#else
    LAUNCH(k_body, (size_t)DEPTH * 3 * 6 * DM, b_mod(p, i_)); LAUNCH(k_body, (size_t)NROW * DM, b_copy_x(p, i_)); LAUNCH(k_body, N_CONV, b_conv(p, i_));
    for (int l = 0; l < DEPTH; ++l) {
        LAUNCH(k_body, NROW, b_norm(p, i_, l, 0));
        LAUNCH(k_body, (size_t)NROW * NIN_PAD, b_gemm(p, i_, l, 0));
        LAUNCH(k_body, (size_t)NROW * DB, b_pool_d(p, i_)); LAUNCH(k_body, NROW, b_sgu_vn(p, i_, l)); LAUNCH(k_body, (size_t)2 * NH * NCHK, b_ml_gates(p, i_, l));
        LAUNCH(k_body, (size_t)NROW * DB, b_pool_y(p, i_, l)); LAUNCH(k_body, (size_t)NROW * DB, b_sgu_y(p, i_, l)); LAUNCH(k_body, (size_t)2 * NH * NCHK * DH * DH, b_ml_cloc(p, i_));
        LAUNCH(k_body, (size_t)2 * NH * NSEQ * DH * DH, b_ml_scan(p, i_, l));
        LAUNCH(k_body, (size_t)2 * NH * NROW, b_ml_mt(p, i_));
        LAUNCH(k_body, (size_t)2 * NH * NCHK * LCH * LCH, b_ml_s(p, i_));
        LAUNCH(k_body, (size_t)2 * NROW * DB, b_ml_h(p, i_));
        LAUNCH(k_body, (size_t)NROW * NH, b_ml_fin(p, i_, l));
        LAUNCH(k_body, (size_t)NROW * DM, b_gemm(p, i_, l, 1));
        LAUNCH(k_body, (size_t)NROW * DM, b_gemm(p, i_, l, 2));
        LAUNCH(k_body, NROW, b_norm(p, i_, l, 1));
        LAUNCH(k_body, (size_t)NROW * DFF, b_gemm(p, i_, l, 3));
        LAUNCH(k_body, (size_t)NROW * DM, b_gemm(p, i_, l, 4));
    }
    LAUNCH(k_body, NROW, b_final(p, i_));
#endif
}
```
